# Optimizing an MI355X kernel written in HIP

```python
import jax, jax.numpy as jnp
from jax import lax
import numpy as np

D_MODEL = 2048
BATCH = 8
SEQ = 4096
DEPTH = 4

GRID_W = 64
CTX_LEN = 256
N_MIXERS = 3
N_LAYERS_A = (DEPTH + 2) // 3
N_LAYERS_B = (DEPTH + 1) // 3
N_LAYERS_C = DEPTH // 3
N_MOD = 6
DEEPNORM_ALPHA = (2 * DEPTH) ** 0.25
DEEPNORM_BETA = (8 * DEPTH) ** -0.25
LN_EPS = 1e-6
A_HEADS = 4
A_DV = D_MODEL // A_HEADS
A_DK = A_DV // 2
A_CHUNK = 128
GATE_CAP = 15.0
A_IN = 2 * A_HEADS * A_DK + A_HEADS * A_DV + D_MODEL + 4 * A_HEADS
B_CHUNK = 128
B_INNER = 2 * D_MODEL
B_GROUPS = 8
C_HEADS = 16
C_KV_HEADS = 4
C_HEAD_DIM = D_MODEL // C_HEADS
C_QBLOCK = 128
ROPE_THETA = 10000.0
P_HEADS = 8
P_NKEYS = 128
P_EXPERTS = P_NKEYS * P_NKEYS
P_TOPK = 16
P_DQ = 256
P_BLOCK = 128

kernel_name = 'hybrid_mlstm_gmlp_gqa_peer_dit'


def layer_norm(x, g, b):
    xf = x.astype(jnp.float32)
    mu = jnp.mean(xf, -1, keepdims=True)
    var = jnp.mean(jnp.square(xf - mu), -1, keepdims=True)
    return ((xf - mu) * lax.rsqrt(var + LN_EPS) * g.astype(jnp.float32) + b.astype(jnp.float32)).astype(x.dtype)


def rms_norm(x, g):
    xf = x.astype(jnp.float32)
    return (xf * lax.rsqrt(jnp.mean(jnp.square(xf), -1, keepdims=True) + LN_EPS) * g.astype(jnp.float32)).astype(x.dtype)


def modulate(x, shift, scale):
    return x * (1 + scale) + shift


def _mlstm_project(h, w_in, b_gate):
    bsz, n, _ = h.shape
    z = h @ w_in
    qk = A_HEADS * A_DK
    vd = A_HEADS * A_DV
    q, k, v, o, g = jnp.split(z, [qk, 2 * qk, 2 * qk + vd, 2 * qk + vd + D_MODEL], axis=-1)
    def heads(t, d):
        return t.reshape(bsz, n, A_HEADS, d).transpose(0, 2, 1, 3).astype(jnp.float32)
    q = heads(q, A_DK)
    k = heads(k, A_DK) * (A_DK ** -0.5)
    v = heads(v, A_DV)
    g = g.astype(jnp.float32) + b_gate.astype(jnp.float32)
    g = GATE_CAP * jnp.tanh(g / GATE_CAP)
    g = g.reshape(bsz, n, 4, A_HEADS).transpose(2, 0, 3, 1)
    fwd = (g[0], jax.nn.log_sigmoid(g[1]))
    bwd = (g[2], jax.nn.log_sigmoid(g[3]))
    return q, k, v, o, fwd, bwd


def mlstm_scan(q, k, v, li, lf, state):
    bsz, nh, n, _ = q.shape
    nc = n // A_CHUNK
    def chunks(t):
        return jnp.moveaxis(t.reshape(bsz, nh, nc, A_CHUNK, *t.shape[3:]), 2, 0)
    mask = jnp.tril(jnp.ones((A_CHUNK, A_CHUNK), dtype=bool))
    def body(carry, inp):
        cmat, nvec, m = carry
        qc, kc, vc, lic, lfc = inp
        b = jnp.cumsum(lfc, axis=-1)
        g = b[..., -1]
        dmat = jnp.where(mask, b[..., :, None] - b[..., None, :] + lic[..., None, :], -jnp.inf)
        inter = b + m[..., None]
        mt = jnp.maximum(inter, jnp.max(dmat, -1))
        w_intra = jnp.exp(dmat - mt[..., None])
        w_inter = jnp.exp(inter - mt)
        s = jnp.einsum('bhtd,bhsd->bhts', qc, kc) * w_intra
        num = w_inter[..., None] * jnp.einsum('bhvd,bhtd->bhtv', cmat, qc) + jnp.einsum('bhts,bhsv->bhtv', s, vc)
        den = w_inter * jnp.einsum('bhd,bhtd->bht', nvec, qc) + jnp.sum(s, -1)
        h = num / jnp.maximum(jnp.abs(den), jnp.exp(-mt))[..., None]
        wk = g[..., None] - b + lic
        m_new = jnp.maximum(g + m, jnp.max(wk, -1))
        decay = jnp.exp(g + m - m_new)
        ws = jnp.exp(wk - m_new[..., None])
        cmat = decay[..., None, None] * cmat + jnp.einsum('bhsv,bhsd->bhvd', vc * ws[..., None], kc)
        nvec = decay[..., None] * nvec + jnp.einsum('bhs,bhsd->bhd', ws, kc)
        return (cmat, nvec, m_new), h
    state, hs = lax.scan(body, state, (chunks(q), chunks(k), chunks(v), chunks(li), chunks(lf)))
    hs = jnp.moveaxis(hs, 0, 2).reshape(bsz, nh, n, -1)
    return hs, state


def _mlstm_out(hsum, o, norm_g, w_out, dtype):
    bsz, nh, n, dv = hsum.shape
    hh = jnp.transpose(hsum, (0, 2, 1, 3))
    hh = hh * lax.rsqrt(jnp.mean(jnp.square(hh), -1, keepdims=True) + LN_EPS)
    hh = hh.reshape(bsz, n, nh * dv) * norm_g.astype(jnp.float32) * jax.nn.sigmoid(o.astype(jnp.float32))
    return hh.astype(dtype) @ w_out


def mlstm_mixer(h_lat, h_ctx, w_in, b_gate, norm_g, w_out, need_ctx):
    ql, kl, vl, ol, gfl, gbl = _mlstm_project(h_lat, w_in, b_gate)
    qc, kc, vc, oc, gfc, gbc = _mlstm_project(h_ctx, w_in, b_gate)
    bsz = h_lat.shape[0]
    zero = (jnp.zeros((bsz, A_HEADS, A_DV, A_DK), jnp.float32),
            jnp.zeros((bsz, A_HEADS, A_DK), jnp.float32),
            jnp.zeros((bsz, A_HEADS), jnp.float32))
    def flip(t):
        return jnp.flip(t, axis=2)
    hcf, st_f = mlstm_scan(qc, kc, vc, gfc[0], gfc[1], zero)
    hcb, st_b = mlstm_scan(flip(qc), flip(kc), flip(vc), flip(gbc[0]), flip(gbc[1]), zero)
    hlf, _ = mlstm_scan(ql, kl, vl, gfl[0], gfl[1], st_f)
    hlb, _ = mlstm_scan(flip(ql), flip(kl), flip(vl), flip(gbl[0]), flip(gbl[1]), st_b)
    y_lat = _mlstm_out(hlf + flip(hlb), ol, norm_g, w_out, h_lat.dtype)
    y_ctx = _mlstm_out(hcf + flip(hcb), oc, norm_g, w_out, h_ctx.dtype) if need_ctx else None
    return y_lat, y_ctx


def chunk_mlp_mixer(h_lat, h_ctx, w_in, b_in, ln_g_v, ln_b_v, w_s, b_s, w_out, need_ctx):
    def apply(h):
        bsz, n, _ = h.shape
        z = jax.nn.gelu(h @ w_in + b_in)
        u, v = z[..., :B_INNER], z[..., B_INNER:]
        v = layer_norm(v, ln_g_v, ln_b_v).reshape(bsz, n // B_CHUNK, B_CHUNK, B_GROUPS, B_INNER // B_GROUPS)
        sv = jnp.einsum('gts,bcsgd->bctgd', w_s, v) + b_s.T[:, :, None]
        return (u * sv.reshape(bsz, n, B_INNER)) @ w_out
    return apply(h_lat), (apply(h_ctx) if need_ctx else None)


def rope_1d(x, pos):
    half = x.shape[-1] // 2
    freqs = ROPE_THETA ** (-jnp.arange(half, dtype=jnp.float32) / half)
    ang = pos.astype(jnp.float32)[:, None] * freqs
    cos = jnp.cos(ang)[:, None, :]
    sin = jnp.sin(ang)[:, None, :]
    x1, x2 = x[..., :half], x[..., half:]
    return jnp.concatenate([x1 * cos - x2 * sin, x1 * sin + x2 * cos], -1)


def axial_rope(x, rows, cols):
    xf = x.astype(jnp.float32)
    half = x.shape[-1] // 2
    return jnp.concatenate([rope_1d(xf[..., :half], rows), rope_1d(xf[..., half:], cols)], -1).astype(x.dtype)


def gqa_mixer(h_lat, h_ctx, w_qkv, q_g, k_g, w_out, rows, cols, need_ctx):
    n_grp = C_HEADS // C_KV_HEADS
    scale = C_HEAD_DIM ** -0.5
    def project(h):
        bsz, n, _ = h.shape
        q, k, v = jnp.split(h @ w_qkv, [C_HEADS * C_HEAD_DIM, (C_HEADS + C_KV_HEADS) * C_HEAD_DIM], axis=-1)
        q = rms_norm(q.reshape(bsz, n, C_HEADS, C_HEAD_DIM), q_g)
        k = rms_norm(k.reshape(bsz, n, C_KV_HEADS, C_HEAD_DIM), k_g)
        return q, k, v.reshape(bsz, n, C_KV_HEADS, C_HEAD_DIM)
    def attend(q, k, v):
        s = jnp.einsum('bkgqd,bskd->bkgqs', q, k).astype(jnp.float32) * scale
        p = jax.nn.softmax(s, axis=-1).astype(v.dtype)
        return jnp.einsum('bkgqs,bskd->bqkgd', p, v)
    ql, kl, vl = project(h_lat)
    qc, kc, vc = project(h_ctx)
    ql = axial_rope(ql, rows, cols)
    kl = axial_rope(kl, rows, cols)
    k_all = jnp.concatenate([kl, kc], axis=1)
    v_all = jnp.concatenate([vl, vc], axis=1)
    bsz, n = h_lat.shape[:2]
    qb = ql.reshape(bsz, n // C_QBLOCK, C_QBLOCK, C_KV_HEADS, n_grp, C_HEAD_DIM).transpose(1, 0, 3, 4, 2, 5)
    ob = lax.map(lambda qblk: attend(qblk, k_all, v_all), qb)
    y_lat = ob.transpose(1, 0, 2, 3, 4, 5).reshape(bsz, n, D_MODEL) @ w_out
    y_ctx = None
    if need_ctx:
        n_c = h_ctx.shape[1]
        qcr = qc.reshape(bsz, n_c, C_KV_HEADS, n_grp, C_HEAD_DIM).transpose(0, 2, 3, 1, 4)
        y_ctx = attend(qcr, kc, vc).reshape(bsz, n_c, D_MODEL) @ w_out
    return y_lat, y_ctx


def peer_ffn(h, w_q, k1, k2, w_u, w_v):
    shp = h.shape
    tok = h.reshape(-1, P_BLOCK, shp[-1])
    half = P_DQ // 2
    def block(hb):
        q = (hb @ w_q).reshape(P_BLOCK, P_HEADS, P_DQ)
        s1 = jnp.einsum('thd,kd->thk', q[..., :half], k1).astype(jnp.float32)
        s2 = jnp.einsum('thd,kd->thk', q[..., half:], k2).astype(jnp.float32)
        v1, i1 = lax.top_k(s1, P_TOPK)
        v2, i2 = lax.top_k(s2, P_TOPK)
        cand = (v1[..., :, None] + v2[..., None, :]).reshape(P_BLOCK, P_HEADS, P_TOPK * P_TOPK)
        sc, ci = lax.top_k(cand, P_TOPK)
        e = jnp.take_along_axis(i1, ci // P_TOPK, -1) * P_NKEYS + jnp.take_along_axis(i2, ci % P_TOPK, -1)
        gate = jax.nn.softmax(sc, axis=-1)
        u = jnp.take(w_u, e, axis=0)
        a = jnp.einsum('td,thkd->thk', hb, u)
        hid = (jax.nn.gelu(a.astype(jnp.float32)) * gate).astype(hb.dtype)
        vv = jnp.take(w_v, e, axis=0)
        return jnp.einsum('thk,thkd->td', hid, vv)
    return lax.map(block, tok).reshape(shp)


def setup_inputs(seed: int = 0) -> dict:
    key = jax.random.key(seed)
    ks = iter(jax.random.split(key, 40))
    def nrm(shape, scale):
        return jax.random.normal(next(ks), shape, jnp.float32) * scale
    D = D_MODEL
    f_bias = jnp.linspace(3.0, 6.0, A_HEADS, dtype=jnp.float32)
    zeros_h = jnp.zeros((A_HEADS,), jnp.float32)
    gate_base = jnp.stack([zeros_h, f_bias, zeros_h, f_bias])
    return {
        'x': nrm((BATCH, SEQ, D), 1.0),
        'c': nrm((BATCH, D), 1.0),
        'ctx': nrm((BATCH, CTX_LEN, D), 1.0),
        'c_ctx': nrm((D,), 1.0),
        'w_mod': nrm((DEPTH, D, N_MOD * D), 0.5 * D ** -0.5),
        'b_mod': nrm((DEPTH, N_MOD * D), 0.02),
        'ln_g': 1.0 + nrm((DEPTH, 2, D), 0.02),
        'ln_b': nrm((DEPTH, 2, D), 0.02),
        'a_w_in': nrm((N_LAYERS_A, D, A_IN), D ** -0.5),
        'a_b_gate': (gate_base[None] + nrm((N_LAYERS_A, 4, A_HEADS), 0.1)).reshape(N_LAYERS_A, 4 * A_HEADS),
        'a_norm_g': 1.0 + nrm((N_LAYERS_A, A_HEADS * A_DV), 0.02),
        'a_w_out': nrm((N_LAYERS_A, A_HEADS * A_DV, D), (A_HEADS * A_DV) ** -0.5 * DEEPNORM_BETA),
        'b_w_in': nrm((N_LAYERS_B, D, 2 * B_INNER), D ** -0.5),
        'b_b_in': nrm((N_LAYERS_B, 2 * B_INNER), 0.02),
        'b_ln_g': 1.0 + nrm((N_LAYERS_B, B_INNER), 0.02),
        'b_ln_b': nrm((N_LAYERS_B, B_INNER), 0.02),
        'b_w_s': nrm((N_LAYERS_B, B_GROUPS, B_CHUNK, B_CHUNK), B_CHUNK ** -0.5),
        'b_b_s': 1.0 + nrm((N_LAYERS_B, B_GROUPS, B_CHUNK), 0.02),
        'b_w_out': nrm((N_LAYERS_B, B_INNER, D), B_INNER ** -0.5 * DEEPNORM_BETA),
        'c_w_qkv': nrm((N_LAYERS_C, D, (C_HEADS + 2 * C_KV_HEADS) * C_HEAD_DIM), D ** -0.5),
        'c_q_g': 1.0 + nrm((N_LAYERS_C, C_HEAD_DIM), 0.02),
        'c_k_g': 1.0 + nrm((N_LAYERS_C, C_HEAD_DIM), 0.02),
        'c_w_out': nrm((N_LAYERS_C, C_HEADS * C_HEAD_DIM, D), (C_HEADS * C_HEAD_DIM) ** -0.5 * DEEPNORM_BETA),
        'p_w_q': nrm((DEPTH, D, P_HEADS * P_DQ), D ** -0.5),
        'p_k1': nrm((DEPTH, P_NKEYS, P_DQ // 2), (P_DQ // 2) ** -0.5),
        'p_k2': nrm((DEPTH, P_NKEYS, P_DQ // 2), (P_DQ // 2) ** -0.5),
        'p_u': nrm((DEPTH, P_EXPERTS, D), D ** -0.5),
        'p_v': nrm((DEPTH, P_EXPERTS, D), DEEPNORM_BETA),
    }


def reference(x, c, ctx, c_ctx, w_mod, b_mod, ln_g, ln_b, a_w_in, a_b_gate, a_norm_g, a_w_out,
              b_w_in, b_b_in, b_ln_g, b_ln_b, b_w_s, b_b_s, b_w_out, c_w_qkv, c_q_g, c_k_g, c_w_out,
              p_w_q, p_k1, p_k2, p_u, p_v):
    bsz, n, _ = x.shape
    grid_rows = n // GRID_W
    rows = jnp.repeat(jnp.arange(grid_rows, dtype=jnp.int32), GRID_W)
    cols = jnp.tile(jnp.arange(GRID_W, dtype=jnp.int32), grid_rows)
    cond_lat = jax.nn.silu(c)
    cond_ctx = jax.nn.silu(c_ctx)
    x_lat, x_ctx = x, ctx
    for i in range(DEPTH):
        need_ctx = i < DEPTH - 1
        mixer, j = i % N_MIXERS, i // N_MIXERS
        mod_l = (cond_lat @ w_mod[i] + b_mod[i]).reshape(bsz, N_MOD, 1, D_MODEL)
        mod_c = (cond_ctx @ w_mod[i] + b_mod[i]).reshape(N_MOD, D_MODEL)
        h_l = modulate(x_lat, mod_l[:, 0], mod_l[:, 1])
        h_c = modulate(x_ctx, mod_c[0], mod_c[1])
        if mixer == 0:
            y_l, y_c = mlstm_mixer(h_l, h_c, a_w_in[j], a_b_gate[j], a_norm_g[j], a_w_out[j], need_ctx)
        elif mixer == 1:
            y_l, y_c = chunk_mlp_mixer(h_l, h_c, b_w_in[j], b_b_in[j], b_ln_g[j], b_ln_b[j], b_w_s[j], b_b_s[j],
                                       b_w_out[j], need_ctx)
        else:
            y_l, y_c = gqa_mixer(h_l, h_c, c_w_qkv[j], c_q_g[j], c_k_g[j], c_w_out[j], rows, cols, need_ctx)
        x_lat = layer_norm(DEEPNORM_ALPHA * x_lat + mod_l[:, 2] * y_l, ln_g[i, 0], ln_b[i, 0])
        if need_ctx:
            x_ctx = layer_norm(DEEPNORM_ALPHA * x_ctx + mod_c[2] * y_c, ln_g[i, 0], ln_b[i, 0])
        h_l = modulate(x_lat, mod_l[:, 3], mod_l[:, 4])
        f_l = peer_ffn(h_l, p_w_q[i], p_k1[i], p_k2[i], p_u[i], p_v[i])
        x_lat = layer_norm(DEEPNORM_ALPHA * x_lat + mod_l[:, 5] * f_l, ln_g[i, 1], ln_b[i, 1])
        if need_ctx:
            h_c = modulate(x_ctx, mod_c[3], mod_c[4])
            f_c = peer_ffn(h_c, p_w_q[i], p_k1[i], p_k2[i], p_u[i], p_v[i])
            x_ctx = layer_norm(DEEPNORM_ALPHA * x_ctx + mod_c[5] * f_c, ln_g[i, 1], ln_b[i, 1])
    return x_lat
```

```cpp
#include <hip/hip_runtime.h>
#include <cstdio>
#include <cstdint>

#define GAS __attribute__((address_space(1)))
#define LAS __attribute__((address_space(3)))
typedef unsigned short bf16;
typedef unsigned v4u __attribute__((ext_vector_type(4)));
typedef unsigned v2u __attribute__((ext_vector_type(2)));
typedef float f32x4 __attribute__((ext_vector_type(4)));
typedef float f32x2 __attribute__((ext_vector_type(2)));
typedef short bf16x8 __attribute__((ext_vector_type(8)));
typedef short s16x4 __attribute__((ext_vector_type(4)));
typedef int v8i_t __attribute__((ext_vector_type(8)));
typedef int v4i_t __attribute__((ext_vector_type(4)));
#define LDS_WAIT() asm volatile("s_waitcnt lgkmcnt(0)" ::: "memory")
#define VM_WAIT() asm volatile("s_waitcnt vmcnt(0)" ::: "memory")

constexpr int D = 2048, NB = 8, SEQ = 4096, CL = 256, DEPTH = 4;
constexpr int TL = NB * SEQ, TC = NB * CL, T = TL + TC;
constexpr int NMOD = 6 * D;
constexpr float ALPHA = 1.681792830507429f;
constexpr float LN_EPS = 1e-6f;
constexpr int A_HEADS = 4, A_DV = 512, A_DK = 256, A_CHUNK = 128, A_IN = 6160, A_INP = 6400;
constexpr int B_INNER = 4096, B_GROUPS = 8;
constexpr int C_HEADS = 16, C_KV = 4, C_HD = 128, C_QKV = 3072, SKV = SEQ + CL;
constexpr int P_HEADS = 8, P_NK = 128, P_TOPK = 16, P_E = 16384;
constexpr int NWAVES = 8, NTHR = 512;

constexpr size_t MiB = 1u << 20;
constexpr size_t WS_CTL = 0, CTL_ZERO_BYTES = 1 * MiB;
constexpr size_t WS_MOD = 1 * MiB;
constexpr size_t WS_STAT = 3 * MiB;
constexpr size_t WS_GATE = 4 * MiB;
constexpr size_t WS_K12 = 7 * MiB;
constexpr size_t WS_WS = 8 * MiB;
constexpr size_t WS_WT = 9 * MiB;
constexpr size_t WT_AIN = 0, WT_AOUT = WT_AIN + (size_t)2 * A_INP * D, WT_BIN = WT_AOUT + (size_t)2 * D * D, WT_BOUT = WT_BIN + (size_t)8192 * D,
                 WT_CQKV = WT_BOUT + (size_t)D * 4096, WT_COUT = WT_CQKV + (size_t)C_QKV * D, WT_PQ = WT_COUT + (size_t)D * D, WT_END = WT_PQ + (size_t)4 * D * D * 2;
constexpr int PQ_FP8_MASK = 0x0;
constexpr float WSCALE = 64.0f;
constexpr size_t WS_PU8 = 192 * MiB;
constexpr size_t WS_PV8 = WS_PU8 + (size_t)4 * P_E * D;
constexpr size_t WS_SC = WS_PV8 + (size_t)4 * P_E * D;
constexpr size_t WS_X = WS_SC + 1 * MiB;
constexpr size_t WS_GP = WS_X + (size_t)T * D * 2;
constexpr size_t WS_H = WS_X + (size_t)T * D * 4;
constexpr size_t WS_Y = WS_H + (size_t)T * D * 2;
constexpr size_t WS_Z = WS_Y + (size_t)T * D * 2;
constexpr size_t WS_IDX = WS_Z + (size_t)T * 8192 * 2;
constexpr size_t WS_PG = WS_IDX + (size_t)T * 128 * 4;
constexpr size_t WS_END = WS_PG + (size_t)T * 128 * 4;
static_assert(WS_WT + WT_END <= WS_PU8, "weights fit");
constexpr size_t ZQ = 0, ZK = (size_t)T * 1024 * 2, ZV = ZK + (size_t)T * 1024 * 2, ZO = ZV + (size_t)T * 2048 * 2, ZG = 0;
constexpr size_t ZU = 0, ZVV = (size_t)T * 4096 * 2;
constexpr size_t ZAQ = 0, ZAK = (size_t)T * 2048 * 2, ZAV = ZAK + (size_t)T * 512 * 2, ZKC = ZAV + (size_t)T * 512 * 2, ZVC = ZKC + (size_t)NB * SKV * 512 * 2;
constexpr int CW_BAR = 4096;

constexpr int LDS_BYTES = 155648;
constexpr int MISC_OFF = 151552;

typedef __bf16 bf16x2_t __attribute__((ext_vector_type(2)));
__device__ __forceinline__ unsigned cvt_pk_bf16(float lo, float hi) { const f32x2 v = {lo, hi}; return __builtin_bit_cast(unsigned, __builtin_convertvector(v, bf16x2_t)); }
__device__ __forceinline__ unsigned pk4_fp8(float a, float b, float c, float d) { int w = __builtin_amdgcn_cvt_pk_fp8_f32(a, b, 0, false); return (unsigned)__builtin_amdgcn_cvt_pk_fp8_f32(c, d, w, true); }
typedef float f32x16_t __attribute__((ext_vector_type(16)));
__device__ __forceinline__ f32x4 zero4() { f32x4 z = {0.f, 0.f, 0.f, 0.f}; asm volatile("" : "+v"(z)); return z; }
__device__ __forceinline__ f32x16_t zero16() { f32x16_t z = {}; asm volatile("" : "+v"(z)); return z; }
__device__ __forceinline__ float bf_lo(unsigned u) { return __uint_as_float(u << 16); }
__device__ __forceinline__ float bf_hi(unsigned u) { return __uint_as_float(u & 0xffff0000u); }
__device__ __forceinline__ float bf2f(bf16 b) { return __uint_as_float(((unsigned)b) << 16); }
__device__ __forceinline__ float wave_sum(float v) {
#pragma unroll
    for (int o = 1; o < 64; o <<= 1) v += __shfl_xor(v, o);
    return v;
}
__device__ __forceinline__ float wave_max(float v) {
#pragma unroll
    for (int o = 1; o < 64; o <<= 1) v = fmaxf(v, __shfl_xor(v, o));
    return v;
}
__device__ __forceinline__ float fast_exp(float x) { return __builtin_amdgcn_exp2f(x * 1.4426950408889634f); }
__device__ __forceinline__ float gelu_tanh(float x) {
    const float u = 0.7978845608028654f * (x + 0.044715f * x * x * x);
    const float e = __builtin_amdgcn_exp2f(-2.0f * 1.4426950408889634f * u);
    return x * __builtin_amdgcn_rcpf(1.0f + e);
}
__device__ __forceinline__ float silu(float x) { return x / (1.0f + __expf(-x)); }

#define XB_TMO      128
#define XB_XCNT(j)  (256  + 64 * (j))
#define XB_XSUB(j)  (1280 + 64 * (j))
#define XB_XGEN(j)  (2304 + 64 * (j))
#define XB_TOP      3328
#define XB_TOPGEN   3392
#define XCD_BAR_WORDS 3456
#define XB_SPIN_CAP (1u << 22)

__device__ __forceinline__ unsigned xb_ld(unsigned* p)              { return __hip_atomic_load(p, __ATOMIC_RELAXED, __HIP_MEMORY_SCOPE_AGENT); }
__device__ __forceinline__ unsigned xb_add(unsigned* p, unsigned v) { return __hip_atomic_fetch_add(p, v, __ATOMIC_RELAXED, __HIP_MEMORY_SCOPE_AGENT); }
__device__ __forceinline__ unsigned xb_xcc_id() { return (unsigned)__builtin_amdgcn_s_getreg((3 << 11) | 20) & 0xFu; }
#define XB_SPIN(cond, bar) do { unsigned _sp = 0; while (cond) { __builtin_amdgcn_s_sleep(1); \
    if ((++_sp & 255u) == 0u) { if (xb_ld(&(bar)[XB_TMO])) break; if (_sp > XB_SPIN_CAP) { atomicAdd(&(bar)[XB_TMO], 1u); break; } } } } while (0)

struct XcdBarrier { unsigned* bar; unsigned x; volatile LAS unsigned* st; };
__device__ __forceinline__ XcdBarrier xcd_barrier_post(unsigned* bar, volatile LAS unsigned* st) {
    XcdBarrier b; b.bar = bar; b.x = xb_xcc_id(); b.st = st;
    if (threadIdx.x == 0) (void)xb_add(&bar[XB_XCNT(b.x)], 1u);
    return b;
}
__device__ __forceinline__ void xcd_barrier_complete(unsigned* bar, unsigned x, unsigned& nloc, unsigned& nx) {
    const unsigned G = gridDim.x * gridDim.y * gridDim.z;
    unsigned sum, cnt, mine, sp = 0u;
    for (;;) {
        sum = 0u; cnt = 0u; mine = 0u;
#pragma unroll
        for (unsigned j = 0; j < 16; ++j) { const unsigned c = xb_ld(&bar[XB_XCNT(j)]); sum += c; cnt += (c > 0u) ? 1u : 0u; mine = (j == x) ? c : mine; }
        if (sum == G) break;
        __builtin_amdgcn_s_sleep(1);
        if ((++sp & 255u) == 0u) { if (xb_ld(&bar[XB_TMO])) break; if (sp > XB_SPIN_CAP) { atomicAdd(&bar[XB_TMO], 1u); break; } }
    }
    nloc = mine > 0u ? mine : 1u; nx = cnt > 0u ? cnt : 1u;
}
__device__ __forceinline__ void xcd_barrier(const XcdBarrier& b) {
    asm volatile("s_waitcnt vmcnt(0)" ::: "memory");
    __syncthreads();
    if (threadIdx.x == 0) {
        unsigned* bar = b.bar;
        __builtin_amdgcn_s_waitcnt(0);
        unsigned nloc = b.st[0], nx = b.st[1];
        if (nloc == 0u) { xcd_barrier_complete(bar, b.x, nloc, nx); b.st[0] = nloc; b.st[1] = nx; }
        const unsigned old = xb_add(&bar[XB_XSUB(b.x)], 1u);
        const unsigned gen = old / nloc;
        if (old + 1u == (gen + 1u) * nloc) {
            __builtin_amdgcn_fence(__ATOMIC_RELEASE, "agent");
            asm volatile("s_waitcnt vmcnt(0)" ::: "memory");
            const unsigned og = xb_add(&bar[XB_TOP], 1u);
            const unsigned tg = og / nx;
            if (og + 1u == (tg + 1u) * nx) xb_add(&bar[XB_TOPGEN], 1u);
            else XB_SPIN(xb_ld(&bar[XB_TOPGEN]) == tg, bar);
            __builtin_amdgcn_fence(__ATOMIC_ACQUIRE, "agent");
            xb_add(&bar[XB_XGEN(b.x)], 1u);
            asm volatile("s_waitcnt vmcnt(0)" ::: "memory");
        } else {
            XB_SPIN(xb_ld(&bar[XB_XGEN(b.x)]) == gen, bar);
            __builtin_amdgcn_fence(__ATOMIC_ACQUIRE, "agent");
            asm volatile("s_waitcnt vmcnt(0)" ::: "memory");
        }
    }
    __syncthreads();
}

namespace pg8 {
#define PG8_LAS __attribute__((address_space(3)))
typedef unsigned short bf16_t;
typedef unsigned u32x4 __attribute__((ext_vector_type(4)));
using ::v4i_t; using ::v8i_t;
constexpr int BM = 256, BK = 64, HALF = 128, HTB = HALF * BK * 2, STAGE_BYTES = 8 * HTB, NXCD = 8, WGM = 8;
__host__ __device__ __forceinline__ int lds_byte(int r, int c) { const int st = (r >> 4) * 2 + (c >> 5), rr = r & 15, cc = c & 31, ob = rr * 64 + cc * 2; return st * 1024 + (ob ^ (((ob >> 9) & 1) << 5)); }
__host__ __device__ __forceinline__ void stage_rc(int b, int& R, int& C) { const int st = b / 1024, sb = b % 1024, swz = sb ^ (((sb >> 9) & 1) << 5); R = (st >> 1) * 16 + swz / 64; C = (st & 1) * 32 + (swz % 64) / 2; }
__host__ __device__ __forceinline__ int perm32(int rho) { const int n = rho >> 4, i = rho & 15; return 8 * (i >> 2) + 4 * n + (i & 3); }
struct Unit { int pm, pn; };
struct Gemm { const bf16_t* A; const bf16_t* Bt; int M, N, K; };
struct StaticOrder {
    int nM, nN, nwg, G, c;
    __host__ __device__ void init(int M, int N, int G_, int c_) { nM = M / BM; nN = N / BM; nwg = nM * nN; G = G_; c = c_; }
    __host__ __device__ bool next(int i, Unit& u) const {
        const long L = (long)i * G + c; if (L >= nwg) return false;
        int wgid = (int)L; { const int q = nwg / NXCD, r = nwg % NXCD, xcd = wgid % NXCD, off = wgid / NXCD; wgid = (xcd < r ? xcd * (q + 1) : r * (q + 1) + (xcd - r) * q) + off; }
        const int nig = WGM * nN, gid = wgid / nig, fm = gid * WGM, gsz = (nM - fm) < WGM ? (nM - fm) : WGM;
        u.pm = fm + ((wgid % nig) % gsz); u.pn = (wgid % nig) / gsz; return true;
    }
    __device__ __forceinline__ void a_ready(const Unit&) const {}
    __device__ __forceinline__ void done(const Unit&) const {}
};
template <int MODE> struct EpiSeg {
    static constexpr bool PERM = true, AFTER_DRAIN = false;
    unsigned char* base; int ld; const float* bias; float* gates; float oscale;
    __device__ __forceinline__ void operator()(const f32x4 (&acc)[2][2][4][2], const Unit& u, int wr, int wc, int fr, int fq) const {
        const int row0 = u.pm * BM + wr * 64 + fr;
        if (MODE == 1 && u.pn >= 24) {
            if (wc == 0 && fq < 2) {
#pragma unroll
                for (int ai = 0; ai < 2; ++ai)
#pragma unroll
                    for (int m = 0; m < 4; ++m) { float* rp = gates + (size_t)(row0 + ai * HALF + m * 16) * 16 + 8 * fq;
                        *(f32x4*)(rp) = acc[ai][0][m][0] * oscale; *(f32x4*)(rp + 4) = acc[ai][0][m][1] * oscale; }
            }
        } else {
        size_t off = 0; int ldc = ld, tb = 0;
        if (MODE == 1) { ldc = u.pn < 8 ? 1024 : 2048; tb = u.pn < 4 ? 0 : u.pn < 8 ? 4 : u.pn < 16 ? 8 : 16; off = u.pn < 4 ? ZQ : u.pn < 8 ? ZK : u.pn < 16 ? ZV : ZO; }
        if (MODE == 2) { ldc = 4096; tb = u.pn < 16 ? 0 : 16; off = u.pn < 16 ? ZU : ZVV; }
        if (MODE == 3) { ldc = u.pn < 8 ? 2048 : 512; tb = u.pn < 8 ? 0 : u.pn < 10 ? 8 : 10; off = u.pn < 8 ? ZAQ : u.pn < 10 ? ZAK : ZAV; }
        bf16_t* ob = (bf16_t*)(base + off);
        const int col0 = (u.pn - tb) * BM + wc * 32 + 8 * fq, bcol0 = u.pn * BM + wc * 32 + 8 * fq;
        f32x4 bv[2][2];
#pragma unroll
        for (int bj = 0; bj < 2; ++bj)
#pragma unroll
            for (int n = 0; n < 2; ++n) bv[bj][n] = (MODE == 2) ? *(const f32x4*)(bias + bcol0 + bj * HALF + 4 * n) : (f32x4){0.f, 0.f, 0.f, 0.f};
#pragma unroll
        for (int ai = 0; ai < 2; ++ai)
#pragma unroll
            for (int m = 0; m < 4; ++m) { bf16_t* rowp = ob + (size_t)(row0 + ai * HALF + m * 16) * ldc + col0;
#pragma unroll
                for (int bj = 0; bj < 2; ++bj) { f32x4 v0 = acc[ai][bj][m][0] * oscale + bv[bj][0], v1 = acc[ai][bj][m][1] * oscale + bv[bj][1];
                    if (MODE == 2) {
#pragma unroll
                        for (int j = 0; j < 4; ++j) { v0[j] = gelu_tanh(v0[j]); v1[j] = gelu_tanh(v1[j]); } }
                    u32x4 w; w.x = cvt_pk_bf16(v0[0], v0[1]); w.y = cvt_pk_bf16(v0[2], v0[3]); w.z = cvt_pk_bf16(v1[0], v1[1]); w.w = cvt_pk_bf16(v1[2], v1[3]);
                    *(u32x4*)(rowp + bj * HALF) = w; } }
        }
    }
};
template <bool FP8, class Epi, class Sched>
__device__ __forceinline__ void gemm_phase(PG8_LAS unsigned char* lds, const Gemm g, const Sched& S, const Epi& E) {
    const int tid = threadIdx.x, wid = __builtin_amdgcn_readfirstlane(tid >> 6), lane = tid & 63, wr = wid >> 2, wc = wid & 3, fr = lane & 15, fq = lane >> 4;
    const int K = g.K, nt = K / BK;
    unsigned voffA[2], voffB[2];
#pragma unroll
    for (int i = 0; i < 2; ++i) { int R, C; stage_rc(tid * 16 + i * 8192, R, C); const int Rb = Epi::PERM ? ((R & ~31) + perm32(R & 31)) : R;
        voffA[i] = (unsigned)(R * K + C) * 2u; voffB[i] = (unsigned)(Rb * K + C) * 2u; }
    const size_t kstep = (size_t)(BK * 2);
    const size_t hstep = (size_t)HALF * K * 2;
    const size_t tstep = 2 * hstep;
    const unsigned ldsw = (unsigned)wid * 1024u;
    const int aoff = lds_byte(wr * 64 + fr, fq * 8), boff = lds_byte(wc * 32 + fr, fq * 8);
#define PG8_SA(b, h) (((b) * 2 + (h)) * HTB)
#define PG8_SB(b, h) ((4 + (b) * 2 + (h)) * HTB)
#define PG8_STAGE(bufoff, gbase, voff) do { _Pragma("unroll") for (int _i = 0; _i < 2; ++_i) \
        __builtin_amdgcn_global_load_lds((const unsigned*)((const char*)(gbase) + (voff)[_i]), (PG8_LAS unsigned*)(lds + (bufoff) + ldsw + _i * 8192), 16, 0, 0); } while (0)
#define PG8_LDH(dst8, addr) do { const v4i_t lo_ = *(const PG8_LAS v4i_t*)(addr), hi_ = *(const PG8_LAS v4i_t*)((addr) + 1024); dst8 = __builtin_shufflevector(lo_, hi_, 0, 1, 2, 3, 4, 5, 6, 7); } while (0)
#define PG8_LDA(dst, b, h) do { _Pragma("unroll") for (int m = 0; m < 4; ++m) PG8_LDH(dst[m], lds + PG8_SA(b, h) + aoff + m * 2048); } while (0)
#define PG8_LDB(dst, b, h) do { _Pragma("unroll") for (int n = 0; n < 2; ++n) PG8_LDH(dst[n], lds + PG8_SB(b, h) + boff + n * 2048); } while (0)
#define PG8_HALF(v8, k) __builtin_bit_cast(bf16x8, __builtin_shufflevector(v8, v8, 4 * (k), 4 * (k) + 1, 4 * (k) + 2, 4 * (k) + 3))
#define PG8_MMA(ai, bj, At, Bt) do { __builtin_amdgcn_s_setprio(1); _Pragma("unroll") for (int m = 0; m < 4; ++m) _Pragma("unroll") for (int n = 0; n < 2; ++n) { \
        acc[ai][bj][m][n] = __builtin_amdgcn_mfma_f32_16x16x32_bf16(PG8_HALF(Bt[n], 0), PG8_HALF(At[m], 0), acc[ai][bj][m][n], 0, 0, 0); \
        acc[ai][bj][m][n] = __builtin_amdgcn_mfma_f32_16x16x32_bf16(PG8_HALF(Bt[n], 1), PG8_HALF(At[m], 1), acc[ai][bj][m][n], 0, 0, 0); } __builtin_amdgcn_s_setprio(0); } while (0)
#define PG8_MMA8(ai, bj, At, Bt) do { __builtin_amdgcn_s_setprio(1); _Pragma("unroll") for (int m = 0; m < 4; ++m) _Pragma("unroll") for (int n = 0; n < 2; ++n) \
        asm volatile("v_mfma_scale_f32_16x16x128_f8f6f4 %0, %1, %2, %0, %3, %3 op_sel_hi:[0,0,0]" : "+v"(acc[ai][bj][m][n]) : "v"(Bt[n]), "v"(At[m]), "v"(mxs)); __builtin_amdgcn_s_setprio(0); } while (0)
#define PG8_MMA8_DRAIN() asm volatile("s_nop 15\n\ts_nop 15" ::: "memory")
#define PG8_WAIT_V(n) asm volatile("s_waitcnt vmcnt(" #n ")" ::: "memory")
#define PG8_WAIT_L(n) asm volatile("s_waitcnt lgkmcnt(" #n ")" ::: "memory")
#define PG8_BAR __builtin_amdgcn_s_barrier()
#define PG8_SCHED __builtin_amdgcn_sched_barrier(0)
    Unit cur, nxt; int ui = 0;
    if (!S.next(0, cur)) return;
    f32x4 acc[2][2][4][2];
#pragma unroll
    for (int a = 0; a < 2; ++a)
#pragma unroll
        for (int b = 0; b < 2; ++b)
#pragma unroll
            for (int m = 0; m < 4; ++m)
#pragma unroll
                for (int n = 0; n < 2; ++n) acc[a][b][m][n] = (f32x4){0.f, 0.f, 0.f, 0.f};
    v8i_t At[4], B0[2], B1[2]; int mxs = 0x7f7f7f7f; asm volatile("" : "+v"(mxs));
    const char* cA = (const char*)g.A + (size_t)cur.pm * tstep; const char* cB = (const char*)g.Bt + (size_t)cur.pn * tstep;
    S.a_ready(cur);
    PG8_STAGE(PG8_SB(0, 0), cB, voffB); PG8_STAGE(PG8_SA(0, 0), cA, voffA); PG8_STAGE(PG8_SB(0, 1), cB + hstep, voffB); PG8_STAGE(PG8_SA(0, 1), cA + hstep, voffA);
    if (wr == 1) PG8_BAR;
    PG8_WAIT_V(4); PG8_BAR;
    PG8_STAGE(PG8_SB(1, 0), cB + kstep, voffB); PG8_STAGE(PG8_SA(1, 0), cA + kstep, voffA); PG8_STAGE(PG8_SB(1, 1), cB + hstep + kstep, voffB);
    PG8_WAIT_V(6); PG8_BAR;
    for (;;) {
        const bool has_next = S.next(ui + 1, nxt);
        const char* nA = has_next ? (const char*)g.A + (size_t)nxt.pm * tstep : cA; const char* nB = has_next ? (const char*)g.Bt + (size_t)nxt.pn * tstep : cB;
        for (int t = 0; t < nt; t += 2) {
            const bool last = (t == nt - 2);
            const char* a1 = cA + (size_t)(t + 1) * kstep;
            const char* a2 = last ? nA : cA + (size_t)(t + 2) * kstep; const char* b2 = last ? nB : cB + (size_t)(t + 2) * kstep;
            const char* a3 = a2 + kstep; const char* b3 = b2 + kstep;
            if (last && has_next) S.a_ready(nxt);
            PG8_LDB(B0, 0, 0); PG8_SCHED; PG8_LDA(At, 0, 0); PG8_STAGE(PG8_SA(1, 1), a1 + hstep, voffA);
            PG8_WAIT_L(8); PG8_BAR; PG8_WAIT_L(0); do { if constexpr (FP8) PG8_MMA8(0, 0, At, B0); else PG8_MMA(0, 0, At, B0); } while (0); PG8_BAR; PG8_SCHED;
            PG8_LDB(B1, 0, 1); PG8_STAGE(PG8_SB(0, 0), b2, voffB);
            PG8_BAR; PG8_WAIT_L(0); do { if constexpr (FP8) PG8_MMA8(0, 1, At, B1); else PG8_MMA(0, 1, At, B1); } while (0); PG8_BAR;
            PG8_LDA(At, 0, 1); PG8_STAGE(PG8_SA(0, 0), a2, voffA);
            PG8_BAR; PG8_WAIT_L(0); do { if constexpr (FP8) PG8_MMA8(1, 0, At, B0); else PG8_MMA(1, 0, At, B0); } while (0); PG8_BAR; PG8_SCHED;
            PG8_STAGE(PG8_SB(0, 1), b2 + hstep, voffB);
            PG8_WAIT_V(6); PG8_BAR; do { if constexpr (FP8) PG8_MMA8(1, 1, At, B1); else PG8_MMA(1, 1, At, B1); } while (0); PG8_BAR;
            PG8_LDB(B0, 1, 0); PG8_SCHED; PG8_LDA(At, 1, 0); PG8_STAGE(PG8_SA(0, 1), a2 + hstep, voffA);
            PG8_WAIT_L(8); PG8_BAR; PG8_WAIT_L(0); do { if constexpr (FP8) PG8_MMA8(0, 0, At, B0); else PG8_MMA(0, 0, At, B0); } while (0); PG8_BAR; PG8_SCHED;
            PG8_LDB(B1, 1, 1); PG8_STAGE(PG8_SB(1, 0), b3, voffB);
            PG8_BAR; PG8_WAIT_L(0); do { if constexpr (FP8) PG8_MMA8(0, 1, At, B1); else PG8_MMA(0, 1, At, B1); } while (0); PG8_BAR;
            PG8_LDA(At, 1, 1); PG8_STAGE(PG8_SA(1, 0), a3, voffA);
            PG8_BAR; PG8_WAIT_L(0); do { if constexpr (FP8) PG8_MMA8(1, 0, At, B0); else PG8_MMA(1, 0, At, B0); } while (0); PG8_BAR; PG8_SCHED;
            PG8_STAGE(PG8_SB(1, 1), b3 + hstep, voffB);
            PG8_WAIT_V(6); PG8_BAR; do { if constexpr (FP8) PG8_MMA8(1, 1, At, B1); else PG8_MMA(1, 1, At, B1); } while (0); PG8_BAR;
        }
        if constexpr (FP8) PG8_MMA8_DRAIN();
        if constexpr (!Epi::AFTER_DRAIN) { E(acc, cur, wr, wc, fr, fq); S.done(cur); }
        if (!has_next) break;
#pragma unroll
        for (int a = 0; a < 2; ++a)
#pragma unroll
            for (int b = 0; b < 2; ++b)
#pragma unroll
                for (int m = 0; m < 4; ++m)
#pragma unroll
                    for (int n = 0; n < 2; ++n) acc[a][b][m][n] = (f32x4){0.f, 0.f, 0.f, 0.f};
        cur = nxt; cA = nA; cB = nB; ++ui;
    }
    PG8_WAIT_V(0);
    if (wr == 0) PG8_BAR;
    PG8_BAR;
    if constexpr (Epi::AFTER_DRAIN) { E.fused(acc, cur, wr, wc, fr, fq, lds, wid, lane); S.done(cur); }
#undef PG8_SA
#undef PG8_SB
#undef PG8_STAGE
#undef PG8_LDA
#undef PG8_LDH
#undef PG8_HALF
#undef PG8_LDB
#undef PG8_MMA
#undef PG8_MMA8
#undef PG8_MMA8_DRAIN
#undef PG8_WAIT_V
#undef PG8_WAIT_L
#undef PG8_BAR
#undef PG8_SCHED
}
}

struct Frame {
    LAS unsigned char* lds;
    int tid, lane, wave, vcu, G;
    const float* const __attribute__((address_space(4)))* in;
    float* out; unsigned char* ws;
};
enum { I_X = 0, I_C, I_CTX, I_CCTX, I_WMOD, I_BMOD, I_LNG, I_LNB, I_AWIN, I_ABG, I_ANG, I_AWOUT, I_BWIN, I_BBIN, I_BLNG, I_BLNB, I_BWS, I_BBS, I_BWOUT,
       I_CWQKV, I_CQG, I_CKG, I_CWOUT, I_PWQ, I_PK1, I_PK2, I_PU, I_PV };

template <int CTRL> __device__ __forceinline__ float dpp_mov(float v) { return __builtin_bit_cast(float, __builtin_amdgcn_update_dpp(0, __builtin_bit_cast(int, v), CTRL, 0xf, 0xf, false)); }
__device__ __forceinline__ float row16_sum(float v) {
    v += dpp_mov<0x128>(v);
    v += dpp_mov<0x124>(v);
    v += dpp_mov<0x122>(v);
    v += dpp_mov<0x121>(v);
    return v;
}
__device__ __forceinline__ float row16_max(float v) {
    v = fmaxf(v, dpp_mov<0x128>(v)); v = fmaxf(v, dpp_mov<0x124>(v)); v = fmaxf(v, dpp_mov<0x122>(v)); v = fmaxf(v, dpp_mov<0x121>(v));
    return v;
}
__device__ __forceinline__ float rl(float v, int l) { return __builtin_bit_cast(float, __builtin_amdgcn_readlane(__builtin_bit_cast(int, v), l)); }
__device__ __forceinline__ float wsum(float v) { v = row16_sum(v); return (rl(v, 0) + rl(v, 16)) + (rl(v, 32) + rl(v, 48)); }

__device__ __forceinline__ const float* mod_row(const Frame& F, int layer, int row) {
    const int b9 = row < TL ? (row >> 12) : 8;
    return (const float*)(F.ws + WS_MOD) + (size_t)(layer * 9 + b9) * NMOD;
}

__device__ __forceinline__ void p0_transpose_item(const float* W, int ldw, int K, int nblk, unsigned char* WT, LAS float* scr, int item, int lane) {
    const int kb = item / nblk, nb = item % nblk, k0 = 64 * kb, n0 = 32 * nb;
    f32x4 t[8];
#pragma unroll
    for (int i = 0; i < 8; ++i) t[i] = *(const f32x4*)(W + (size_t)(k0 + 8 * i + (lane >> 3)) * ldw + n0 + 4 * (lane & 7));
#pragma unroll
    for (int i = 0; i < 8; ++i) { LAS float* d = scr + (8 * i + (lane >> 3)) * 33 + 4 * (lane & 7); d[0] = t[i][0] * WSCALE; d[1] = t[i][1] * WSCALE; d[2] = t[i][2] * WSCALE; d[3] = t[i][3] * WSCALE; }
    LDS_WAIT(); asm volatile("" ::: "memory");
    const int c = lane & 7;
#pragma unroll
    for (int j = 0; j < 4; ++j) { const int n = (lane >> 3) + 8 * j; const LAS float* s = scr + (8 * c) * 33 + n;
        v2u o; o.x = pk4_fp8(s[0 * 33], s[1 * 33], s[2 * 33], s[3 * 33]); o.y = pk4_fp8(s[4 * 33], s[5 * 33], s[6 * 33], s[7 * 33]);
        *(v2u*)(WT + (size_t)(n0 + n) * K + k0 + 8 * c) = o; }
    LDS_WAIT(); asm volatile("" ::: "memory");
}
__device__ __forceinline__ void p0_transpose_item_bf16(const float* W, int ldw, int K, int nblk, bf16* WT, LAS float* scr, int item, int lane) {
    const int kb = item / nblk, nb = item % nblk, k0 = 64 * kb, n0 = 32 * nb;
    f32x4 t[8];
#pragma unroll
    for (int i = 0; i < 8; ++i) t[i] = *(const f32x4*)(W + (size_t)(k0 + 8 * i + (lane >> 3)) * ldw + n0 + 4 * (lane & 7));
#pragma unroll
    for (int i = 0; i < 8; ++i) { LAS float* d = scr + (8 * i + (lane >> 3)) * 33 + 4 * (lane & 7); d[0] = t[i][0]; d[1] = t[i][1]; d[2] = t[i][2]; d[3] = t[i][3]; }
    LDS_WAIT(); asm volatile("" ::: "memory");
    const int c = lane & 7;
#pragma unroll
    for (int j = 0; j < 4; ++j) { const int n = (lane >> 3) + 8 * j; const LAS float* s = scr + (8 * c) * 33 + n;
        v4u o; o.x = cvt_pk_bf16(s[0 * 33], s[1 * 33]); o.y = cvt_pk_bf16(s[2 * 33], s[3 * 33]); o.z = cvt_pk_bf16(s[4 * 33], s[5 * 33]); o.w = cvt_pk_bf16(s[6 * 33], s[7 * 33]);
        *(v4u*)(WT + (size_t)(n0 + n) * K + k0 + 8 * c) = o; }
    LDS_WAIT(); asm volatile("" ::: "memory");
}
__device__ __forceinline__ void cvt_linear(const float* src, bf16* dst, size_t n8, size_t i0, size_t stride) {
    for (size_t i = i0; i < n8; i += stride) {
        const f32x4 a = *(const f32x4*)(src + i * 8), b = *(const f32x4*)(src + i * 8 + 4);
        v4u o; o.x = cvt_pk_bf16(a[0], a[1]); o.y = cvt_pk_bf16(a[2], a[3]); o.z = cvt_pk_bf16(b[0], b[1]); o.w = cvt_pk_bf16(b[2], b[3]);
        *(v4u*)(dst + i * 8) = o;
    }
}
__device__ __forceinline__ void p0_prologue(Frame& F) {
    {
        LAS float* sc = (LAS float*)F.lds;
        LAS float* part = (LAS float*)(F.lds + 9 * 2048 * 4);
        for (int i = F.tid; i < 9 * 2048; i += NTHR) { const int r = i >> 11, k = i & 2047; const float c = r < 8 ? F.in[I_C][r * D + k] : F.in[I_CCTX][k]; sc[i] = silu(c); }
        __syncthreads();
        float* MOD = (float*)(F.ws + WS_MOD);
        for (int item = F.vcu; item < 4 * 192; item += F.G) {
            const int l = item / 192, cg = item % 192, c = cg * 64 + F.lane;
            const float* Wm = F.in[I_WMOD] + ((size_t)l * D + F.wave * 256) * NMOD + c;
            float acc[9];
#pragma unroll
            for (int r = 0; r < 9; ++r) acc[r] = 0.f;
            for (int k0 = 0; k0 < 256; k0 += 32) {
                float w[32];
#pragma unroll
                for (int u = 0; u < 32; ++u) w[u] = Wm[(size_t)(k0 + u) * NMOD];
#pragma unroll
                for (int u = 0; u < 32; ++u)
#pragma unroll
                    for (int r = 0; r < 9; ++r) acc[r] += sc[r * 2048 + F.wave * 256 + k0 + u] * w[u];
            }
#pragma unroll
            for (int r = 0; r < 9; ++r) part[(F.wave * 9 + r) * 64 + F.lane] = acc[r];
            __syncthreads();
            for (int i = F.tid; i < 9 * 64; i += NTHR) { const int r = i >> 6, ln = i & 63; float s = 0.f;
#pragma unroll
                for (int w = 0; w < 8; ++w) s += part[(w * 9 + r) * 64 + ln];
                MOD[(size_t)(l * 9 + r) * NMOD + cg * 64 + ln] = s + F.in[I_BMOD][l * NMOD + cg * 64 + ln]; }
            __syncthreads();
        }
    }
    {
        LAS float* scr = (LAS float*)(F.lds + F.wave * 16384);
        const int gw = F.vcu * NWAVES + F.wave, NGW = F.G * NWAVES;
        unsigned char* WT = F.ws + WS_WT;
        constexpr int I_A = 32 * 192, I_SQ = 32 * 64, I_BI = 32 * 256, I_BO = 64 * 64, I_CQ = 32 * 96;
        constexpr int NITEMS = 2 * I_A + 2 * I_SQ + I_BI + I_BO + I_CQ + I_SQ + 4 * I_SQ;
        for (int it = gw; it < NITEMS; it += NGW) {
            int r = it;
            if (r < 2 * I_A) { const int j = r / I_A; p0_transpose_item(F.in[I_AWIN] + (size_t)j * D * A_IN, A_IN, D, 192, WT + WT_AIN + (size_t)j * A_INP * D, scr, r % I_A, F.lane); continue; } r -= 2 * I_A;
            if (r < 2 * I_SQ) { const int j = r / I_SQ; p0_transpose_item(F.in[I_AWOUT] + (size_t)j * D * D, D, D, 64, WT + WT_AOUT + (size_t)j * D * D, scr, r % I_SQ, F.lane); continue; } r -= 2 * I_SQ;
            if (r < I_BI) { p0_transpose_item(F.in[I_BWIN], 8192, D, 256, WT + WT_BIN, scr, r, F.lane); continue; } r -= I_BI;
            if (r < I_BO) { p0_transpose_item(F.in[I_BWOUT], D, 4096, 64, WT + WT_BOUT, scr, r, F.lane); continue; } r -= I_BO;
            if (r < I_CQ) { p0_transpose_item(F.in[I_CWQKV], C_QKV, D, 96, WT + WT_CQKV, scr, r, F.lane); continue; } r -= I_CQ;
            if (r < I_SQ) { p0_transpose_item(F.in[I_CWOUT], D, D, 64, WT + WT_COUT, scr, r, F.lane); continue; } r -= I_SQ;
            { const int j = r / I_SQ;
              if ((PQ_FP8_MASK >> j) & 1) p0_transpose_item(F.in[I_PWQ] + (size_t)j * D * D, D, D, 64, WT + WT_PQ + (size_t)j * D * D * 2, scr, r % I_SQ, F.lane);
              else p0_transpose_item_bf16(F.in[I_PWQ] + (size_t)j * D * D, D, D, 64, (bf16*)(WT + WT_PQ) + (size_t)j * D * D, scr, r % I_SQ, F.lane); }
        }
        const size_t gt = (size_t)F.vcu * NTHR + F.tid, GT = (size_t)F.G * NTHR;
        for (size_t i = gt; i < (size_t)2 * 256 * D; i += GT) {
            const int j = (int)(i / (256 * D)), rem = (int)(i % (256 * D)), n = rem / D, k = rem % D;
            const float v = n < 16 ? F.in[I_AWIN][((size_t)j * D + k) * A_IN + 6144 + n] : 0.f;
            WT[WT_AIN + ((size_t)j * A_INP + 6144 + n) * D + k] = (unsigned char)(__builtin_amdgcn_cvt_pk_fp8_f32(v * WSCALE, 0.f, 0, false) & 0xff);
        }
        for (int r0 = gw; r0 < 2 * 4 * P_E; r0 += 2 * NGW) {
            f32x4 v[2][8];
#pragma unroll
            for (int h = 0; h < 2; ++h) { const int r = r0 + h * NGW, tb = r >= 4 * P_E, rr = r - tb * 4 * P_E;
                const float* src = F.in[tb ? I_PV : I_PU] + (size_t)rr * D + 4 * F.lane;
#pragma unroll
                for (int q = 0; q < 8; ++q) v[h][q] = *(const f32x4*)(src + 256 * q); }
#pragma unroll
            for (int h = 0; h < 2; ++h) { const int r = r0 + h * NGW, tb = r >= 4 * P_E, rr = r - tb * 4 * P_E;
                float mx = 0.f;
#pragma unroll
                for (int q = 0; q < 8; ++q) { const f32x4 a = __builtin_elementwise_abs(v[h][q]); mx = fmaxf(mx, fmaxf(fmaxf(a[0], a[1]), fmaxf(a[2], a[3]))); }
                mx = row16_max(mx); mx = fmaxf(fmaxf(rl(mx, 0), rl(mx, 16)), fmaxf(rl(mx, 32), rl(mx, 48)));
                const float sc = mx > 0.f ? 6.0f / mx : 1.0f;
                v4u o;
#pragma unroll
                for (int d = 0; d < 4; ++d) { unsigned w = 0u; const f32x4 x0 = v[h][2 * d] * sc, x1 = v[h][2 * d + 1] * sc;
                    w = __builtin_amdgcn_cvt_scalef32_pk_fp4_f32(w, x0[0], x0[1], 1.0f, 0); w = __builtin_amdgcn_cvt_scalef32_pk_fp4_f32(w, x0[2], x0[3], 1.0f, 1);
                    w = __builtin_amdgcn_cvt_scalef32_pk_fp4_f32(w, x1[0], x1[1], 1.0f, 2); w = __builtin_amdgcn_cvt_scalef32_pk_fp4_f32(w, x1[2], x1[3], 1.0f, 3); o[d] = w; }
                if (tb) *(v4u*)(F.ws + WS_PV8 + (size_t)rr * (D / 2) + 16 * F.lane) = o;
                else { unsigned char* ur = F.ws + WS_PU8 + (size_t)rr * (D / 2) + 2 * F.lane;
#pragma unroll
                    for (int d = 0; d < 4; ++d) { *(unsigned short*)(ur + 128 * (2 * d)) = (unsigned short)(o[d] & 0xffffu); *(unsigned short*)(ur + 128 * (2 * d + 1)) = (unsigned short)(o[d] >> 16); } }
                if (F.lane == 0) ((float*)(F.ws + WS_SC))[(size_t)tb * 4 * P_E + rr] = 1.0f / sc; }
        }
        cvt_linear(F.in[I_PK1], (bf16*)(F.ws + WS_K12), (size_t)4 * 128 * 128 / 8, gt, GT);
        cvt_linear(F.in[I_PK2], (bf16*)(F.ws + WS_K12) + 4 * 128 * 128, (size_t)4 * 128 * 128 / 8, gt, GT);
        cvt_linear(F.in[I_BWS], (bf16*)(F.ws + WS_WS), (size_t)8 * 128 * 128 / 8, gt, GT);
    }
}

template <int L> __device__ __forceinline__ const float* x_row(const Frame& F, int row) {
    if (L == 0) return row < TL ? F.in[I_X] + (size_t)row * D : F.in[I_CTX] + (size_t)(row - TL) * D;
    return (const float*)(F.ws + WS_X) + (size_t)row * D;
}
template <int L> __device__ __forceinline__ f32x4 load_x4(const Frame& F, int row, int e) {
    if (L == 0) return *(const f32x4*)(x_row<0>(F, row) + e);
    const v2u p = *(const v2u*)((const bf16*)(F.ws + WS_X) + (size_t)row * D + e);
    return (f32x4){bf_lo(p.x), bf_hi(p.x), bf_lo(p.y), bf_hi(p.y)};
}
__device__ __forceinline__ void store_x4(const Frame& F, int row, int e, f32x4 v) { v2u o; o.x = cvt_pk_bf16(v[0], v[1]); o.y = cvt_pk_bf16(v[2], v[3]); *(v2u*)((bf16*)(F.ws + WS_X) + (size_t)row * D + e) = o; }
__device__ __forceinline__ void p0b_modulate(Frame& F) {
    const int gw = F.vcu * NWAVES + F.wave, NGW = F.G * NWAVES;
    for (int row = gw; row < T; row += NGW) {
        const float* xr = x_row<0>(F, row); const float* md = mod_row(F, 0, row);
        unsigned char* hr = F.ws + WS_H + (size_t)row * D;
#pragma unroll
        for (int j = 0; j < 8; ++j) { const int e = 4 * F.lane + 256 * j;
            const f32x4 x = *(const f32x4*)(xr + e), sh = *(const f32x4*)(md + e), scl = *(const f32x4*)(md + D + e);
            const f32x4 h = x * (scl + 1.0f) + sh;
            *(unsigned*)(hr + e) = pk4_fp8(h[0], h[1], h[2], h[3]); }
    }
}

__device__ __forceinline__ void ln_rows(f32x4 (&t)[8], const float* g, const float* b, int lane) {
    float s = 0.f;
#pragma unroll
    for (int j = 0; j < 8; ++j) s += (t[j][0] + t[j][1]) + (t[j][2] + t[j][3]);
    const float mean = wsum(s) * (1.0f / D); float q = 0.f;
#pragma unroll
    for (int j = 0; j < 8; ++j) { t[j] = t[j] - mean; q += (t[j][0] * t[j][0] + t[j][1] * t[j][1]) + (t[j][2] * t[j][2] + t[j][3] * t[j][3]); }
    const float rstd = 1.0f / sqrtf(wsum(q) * (1.0f / D) + LN_EPS);
#pragma unroll
    for (int j = 0; j < 8; ++j) { const int e = 4 * lane + 256 * j; t[j] = t[j] * rstd * *(const f32x4*)(g + e) + *(const f32x4*)(b + e); }
}

template <int L> __device__ __forceinline__ void ln1_phase(Frame& F, int M) {
    const int gw = F.vcu * NWAVES + F.wave, NGW = F.G * NWAVES;
    const float* lg = F.in[I_LNG] + (size_t)(L * 2 + 0) * D; const float* lb = F.in[I_LNB] + (size_t)(L * 2 + 0) * D;
    for (int row = gw; row < M; row += NGW) {
        const float* md = mod_row(F, L, row);
        const bf16* yr = (const bf16*)(F.ws + WS_Y) + (size_t)row * D;
        bf16* hr = (bf16*)(F.ws + WS_Y) + (size_t)row * D;
        f32x4 t[8];
#pragma unroll
        for (int j = 0; j < 8; ++j) { const int e = 4 * F.lane + 256 * j;
            const f32x4 x = load_x4<L>(F, row, e), gt = *(const f32x4*)(md + 2 * D + e); const v2u y = *(const v2u*)(yr + e);
            t[j] = x * ALPHA + gt * (f32x4){bf_lo(y.x), bf_hi(y.x), bf_lo(y.y), bf_hi(y.y)}; }
        ln_rows(t, lg, lb, F.lane);
#pragma unroll
        for (int j = 0; j < 8; ++j) { const int e = 4 * F.lane + 256 * j;
            store_x4(F, row, e, t[j]);
            const f32x4 h = t[j] * (*(const f32x4*)(md + 4 * D + e) + 1.0f) + *(const f32x4*)(md + 3 * D + e);
            v2u o; o.x = cvt_pk_bf16(h[0], h[1]); o.y = cvt_pk_bf16(h[2], h[3]); *(v2u*)(hr + e) = o;
            if ((PQ_FP8_MASK >> L) & 1) *(unsigned*)(F.ws + WS_H + (size_t)row * D + e) = pk4_fp8(h[0], h[1], h[2], h[3]); }
    }
}

__device__ __forceinline__ unsigned f2mono(float f) { const unsigned b = __float_as_uint(f); return (b & 0x80000000u) ? ~b : (b | 0x80000000u); }
__device__ __forceinline__ float mono2f(unsigned m) { return __uint_as_float((m & 0x80000000u) ? (m & 0x7fffffffu) : ~m); }
__device__ __forceinline__ void ins16(unsigned (&top)[16], unsigned x) {
#pragma unroll
    for (int j = 0; j < 16; ++j) { const unsigned hi = top[j] > x ? top[j] : x; x = top[j] > x ? x : top[j]; top[j] = hi; }
}
#define TK_CE(A_, B_) { const unsigned hi_ = (A_) > (B_) ? (A_) : (B_), lo_ = (A_) > (B_) ? (B_) : (A_); (A_) = hi_; (B_) = lo_; }
__device__ __forceinline__ void sort16_desc(unsigned (&v)[16]) {
#pragma unroll
    for (int k = 2; k <= 16; k <<= 1)
#pragma unroll
        for (int j = k >> 1; j > 0; j >>= 1)
#pragma unroll
            for (int i = 0; i < 16; ++i) { const int l = i ^ j; if (l > i) { if ((i & k) == 0) TK_CE(v[i], v[l]) else TK_CE(v[l], v[i]) } }
}
__device__ __forceinline__ void merge16_desc(unsigned (&top)[16], const unsigned (&s)[16]) {
#pragma unroll
    for (int i = 0; i < 16; ++i) top[i] = top[i] > s[15 - i] ? top[i] : s[15 - i];
#pragma unroll
    for (int j = 8; j > 0; j >>= 1)
#pragma unroll
        for (int i = 0; i < 16; ++i) { const int l = i ^ j; if (l > i) TK_CE(top[i], top[l]) }
}
template <int L> __device__ __forceinline__ void peer_topk_phase(Frame& F, int M) {
    const bf16* Q = (const bf16*)(F.ws + WS_Z);
    const bf16* K1 = (const bf16*)(F.ws + WS_K12) + (size_t)L * 128 * 128;
    const bf16* K2 = (const bf16*)(F.ws + WS_K12) + (size_t)(4 + L) * 128 * 128;
    int* IDX = (int*)(F.ws + WS_IDX); float* PG = (float*)(F.ws + WS_PG);
    LAS float* S1 = (LAS float*)F.lds;
    LAS float* S2 = S1 + 128 * 129;
    LAS unsigned* TK = (LAS unsigned*)(S2 + 128 * 129);
    const int fr = F.lane & 15, fq = F.lane >> 4;
    const int nunits = (M / 128) * P_HEADS;
    const int kbg = F.wave & 1, tbg = F.wave >> 1;
    bf16x8 kf1[4][4], kf2[4][4];
#pragma unroll
    for (int kk = 0; kk < 4; ++kk) { const int kb = 4 * kbg + kk;
        const bf16* k1p = K1 + (size_t)(kb * 16 + fr) * 128 + fq * 8; const bf16* k2p = K2 + (size_t)(kb * 16 + fr) * 128 + fq * 8;
#pragma unroll
        for (int ks = 0; ks < 4; ++ks) { kf1[kk][ks] = *(const bf16x8*)(k1p + ks * 32); kf2[kk][ks] = *(const bf16x8*)(k2p + ks * 32); } }
    for (int u = F.vcu; u < nunits; u += F.G) {
        const int tile = u >> 3, hd = u & 7, row0 = tile * 128;
#ifdef TK_DBL_MFMA
        for (int rr_ = 0; rr_ < 2; ++rr_)
#endif
        {
#pragma unroll
            for (int tt = 0; tt < 2; ++tt) { const int tb = 2 * tbg + tt;
                const bf16* qp = Q + (size_t)(row0 + tb * 16 + fr) * D + hd * 256 + fq * 8;
                bf16x8 a1[4], a2[4];
#pragma unroll
                for (int ks = 0; ks < 4; ++ks) { a1[ks] = *(const bf16x8*)(qp + ks * 32); a2[ks] = *(const bf16x8*)(qp + 128 + ks * 32); }
#pragma unroll
                for (int kk = 0; kk < 4; ++kk) { const int kb = 4 * kbg + kk;
                    f32x4 c1 = zero4(), c2 = zero4();
#pragma unroll
                    for (int ks = 0; ks < 4; ++ks) {
                        c1 = __builtin_amdgcn_mfma_f32_16x16x32_bf16(a1[ks], kf1[kk][ks], c1, 0, 0, 0);
                        c2 = __builtin_amdgcn_mfma_f32_16x16x32_bf16(a2[ks], kf2[kk][ks], c2, 0, 0, 0);
                    }
#pragma unroll
                    for (int j = 0; j < 4; ++j) { const int t = tb * 16 + 4 * fq + j; S1[t * 129 + kb * 16 + fr] = c1[j]; S2[t * 129 + kb * 16 + fr] = c2[j]; }
                }
            }
        }
        __syncthreads();
        {
            int tid_l = F.tid; asm volatile("" : "+v"(tid_l));
            const int t = tid_l & 127, which = (tid_l >> 7) & 1, half = tid_l >> 8;
            LAS float* sr = (which ? S2 : S1) + t * 129 + 64 * half;
            unsigned top[16];
#pragma unroll
            for (int j = 0; j < 16; ++j) top[j] = (f2mono(sr[j]) & ~0x7fu) | (unsigned)(127 - (64 * half + j));
            sort16_desc(top);
#pragma unroll 1
            for (int g = 1; g < 4; ++g) { unsigned v[16];
#pragma unroll
                for (int j = 0; j < 16; ++j) v[j] = (f2mono(sr[16 * g + j]) & ~0x7fu) | (unsigned)(127 - (64 * half + 16 * g + j));
                sort16_desc(v); merge16_desc(top, v); }
            if (half) {
#pragma unroll
                for (int j = 0; j < 16; ++j) ((LAS unsigned*)sr)[j] = top[j];
            }
            __syncthreads();
            if (!half) {
                const LAS unsigned* pr = (const LAS unsigned*)(sr + 64);
                unsigned ot[16];
#pragma unroll
                for (int j = 0; j < 16; ++j) ot[j] = pr[j];
                merge16_desc(top, ot);
#pragma unroll
                for (int j = 0; j < 16; ++j) TK[(which * 128 + t) * 17 + j] = top[j];
            }
        }
        __syncthreads();
#ifdef TK_DBL_COMB
        for (int rr_ = 0; rr_ < 2; ++rr_)
#endif
        if (F.tid < 128) {
            const int t = F.tid;
            const LAS unsigned* t1 = TK + t * 17; const LAS unsigned* t2 = TK + (128 + t) * 17;
            float v2[16];
#pragma unroll
            for (int j = 0; j < 16; ++j) v2[j] = mono2f((t2[j] & ~0x7fu) | 0x40u);
#define TK_V1(A_) mono2f((t1[A_] & ~0x7fu) | 0x40u)
#define TK_KEY(VA_, A_, B_) ((f2mono((VA_) + v2[B_]) & ~0xffu) | (unsigned)(255 - ((A_) * 16 + (B_))))
            unsigned top[16];
            { unsigned grp[16];
              const float va0 = TK_V1(0);
              grp[0] = TK_KEY(va0, 0, 0);
              grp[1] = TK_KEY(va0, 0, 1);
              grp[2] = TK_KEY(va0, 0, 2);
              grp[3] = TK_KEY(va0, 0, 3);
              grp[4] = TK_KEY(va0, 0, 4);
              grp[5] = TK_KEY(va0, 0, 5);
              grp[6] = TK_KEY(va0, 0, 6);
              grp[7] = TK_KEY(va0, 0, 7);
              grp[8] = TK_KEY(va0, 0, 8);
              grp[9] = TK_KEY(va0, 0, 9);
              grp[10] = TK_KEY(va0, 0, 10);
              grp[11] = TK_KEY(va0, 0, 11);
              grp[12] = TK_KEY(va0, 0, 12);
              grp[13] = TK_KEY(va0, 0, 13);
              grp[14] = TK_KEY(va0, 0, 14);
              grp[15] = TK_KEY(va0, 0, 15);
              sort16_desc(grp);
#pragma unroll
              for (int j = 0; j < 16; ++j) top[j] = grp[j]; }
            __builtin_amdgcn_sched_barrier(0);
            { unsigned grp[16];
              const float va1 = TK_V1(1);
              const float va2 = TK_V1(2);
              const float va3 = TK_V1(3);
              grp[0] = TK_KEY(va1, 1, 0);
              grp[1] = TK_KEY(va1, 1, 1);
              grp[2] = TK_KEY(va1, 1, 2);
              grp[3] = TK_KEY(va1, 1, 3);
              grp[4] = TK_KEY(va1, 1, 4);
              grp[5] = TK_KEY(va1, 1, 5);
              grp[6] = TK_KEY(va1, 1, 6);
              grp[7] = TK_KEY(va1, 1, 7);
              grp[8] = TK_KEY(va2, 2, 0);
              grp[9] = TK_KEY(va2, 2, 1);
              grp[10] = TK_KEY(va2, 2, 2);
              grp[11] = TK_KEY(va2, 2, 3);
              grp[12] = TK_KEY(va2, 2, 4);
              grp[13] = TK_KEY(va3, 3, 0);
              grp[14] = TK_KEY(va3, 3, 1);
              grp[15] = TK_KEY(va3, 3, 2);
              sort16_desc(grp);
              merge16_desc(top, grp); }
            __builtin_amdgcn_sched_barrier(0);
            { unsigned grp[16];
              const float va3 = TK_V1(3);
              const float va4 = TK_V1(4);
              const float va5 = TK_V1(5);
              const float va6 = TK_V1(6);
              const float va7 = TK_V1(7);
              const float va8 = TK_V1(8);
              const float va9 = TK_V1(9);
              const float va10 = TK_V1(10);
              const float va11 = TK_V1(11);
              const float va12 = TK_V1(12);
              const float va13 = TK_V1(13);
              grp[0] = TK_KEY(va3, 3, 3);
              grp[1] = TK_KEY(va4, 4, 0);
              grp[2] = TK_KEY(va4, 4, 1);
              grp[3] = TK_KEY(va4, 4, 2);
              grp[4] = TK_KEY(va5, 5, 0);
              grp[5] = TK_KEY(va5, 5, 1);
              grp[6] = TK_KEY(va6, 6, 0);
              grp[7] = TK_KEY(va6, 6, 1);
              grp[8] = TK_KEY(va7, 7, 0);
              grp[9] = TK_KEY(va7, 7, 1);
              grp[10] = TK_KEY(va8, 8, 0);
              grp[11] = TK_KEY(va9, 9, 0);
              grp[12] = TK_KEY(va10, 10, 0);
              grp[13] = TK_KEY(va11, 11, 0);
              grp[14] = TK_KEY(va12, 12, 0);
              grp[15] = TK_KEY(va13, 13, 0);
              sort16_desc(grp);
              merge16_desc(top, grp); }
            __builtin_amdgcn_sched_barrier(0);
            ins16(top, TK_KEY(TK_V1(14), 14, 0));
            ins16(top, TK_KEY(TK_V1(15), 15, 0));
#undef TK_KEY
#undef TK_V1
            float sc[16], es = 0.f;
#pragma unroll
            for (int j = 0; j < 16; ++j) sc[j] = mono2f((top[j] & ~0xffu) | 0x80u);
            const float smx = sc[0];
#pragma unroll
            for (int j = 0; j < 16; ++j) { sc[j] = __expf(sc[j] - smx); es += sc[j]; }
            const float inv = 1.0f / es;
            const size_t ob = (size_t)(row0 + t) * 128 + hd * 16;
#pragma unroll
            for (int j = 0; j < 16; ++j) { const int ci = 255 - (int)(top[j] & 0xffu), a = ci >> 4, b = ci & 15;
                const int i1 = 127 - (int)(t1[a] & 0x7fu), i2 = 127 - (int)(t2[b] & 0x7fu);
                IDX[ob + j] = i1 * 128 + i2; PG[ob + j] = sc[j] * inv; }
        }
        __syncthreads();
    }
}

constexpr int P3B = 8;
struct RowBatch { v4u r[P3B]; };
__device__ __forceinline__ void p3_load_batch(RowBatch& B, const char* tab, int ev, int lane0, int lo16) {
#pragma unroll
    for (int q = 0; q < P3B; ++q) { const int e = __builtin_amdgcn_readlane(ev, lane0 + q); B.r[q] = *(const v4u*)(tab + (size_t)e * (D / 2) + lo16); }
}
__device__ __forceinline__ float dot32_fp4(const v4u w, const f32x2* h) {
    f32x2 s = {0.f, 0.f};
#pragma unroll
    for (int d = 0; d < 4; ++d) {
#define P3_D(b) { const f32x2 p = __builtin_amdgcn_cvt_scalef32_pk_f32_fp4(w[d], 1.0f, b); s = __builtin_elementwise_fma(p, h[4 * d + b], s); }
        P3_D(0) P3_D(1) P3_D(2) P3_D(3)
#undef P3_D
    }
    return s[0] + s[1];
}
__device__ __forceinline__ void axpy32_fp4(const v4u w, float hk, f32x2* acc) {
    const f32x2 hk2 = {hk, hk};
#pragma unroll
    for (int d = 0; d < 4; ++d) {
#define P3_A(b) { const f32x2 p = __builtin_amdgcn_cvt_scalef32_pk_f32_fp4(w[d], 1.0f, b); acc[4 * d + b] = __builtin_elementwise_fma(hk2, p, acc[4 * d + b]); }
        P3_A(0) P3_A(1) P3_A(2) P3_A(3)
#undef P3_A
    }
}
__device__ __forceinline__ float reduce8(const float* d, int lane) {
    const bool b0 = lane & 1, b1 = lane & 2, b2 = lane & 4;
    float s1[4], s2[2];
#pragma unroll
    for (int j = 0; j < 4; ++j) { const float keep = b0 ? d[2 * j + 1] : d[2 * j], send = b0 ? d[2 * j] : d[2 * j + 1]; s1[j] = keep + dpp_mov<0xB1>(send); }
#pragma unroll
    for (int j = 0; j < 2; ++j) { const float keep = b1 ? s1[2 * j + 1] : s1[2 * j], send = b1 ? s1[2 * j] : s1[2 * j + 1]; s2[j] = keep + dpp_mov<0x4E>(send); }
    const float keep = b2 ? s2[1] : s2[0], send = b2 ? s2[0] : s2[1];
    float s3 = keep + dpp_mov<0x124>(send);
    s3 += dpp_mov<0x128>(s3);
    s3 += __shfl_xor(s3, 16); s3 += __shfl_xor(s3, 32);
    return s3;
}
template <int L> __device__ __forceinline__ void peer_u_phase(Frame& F, int M) {
    const int gw = F.vcu * NWAVES + F.wave, NGW = F.G * NWAVES;
    const char* PU = (const char*)(F.ws + WS_PU8) + (size_t)L * P_E * (D / 2); const char* PV = (const char*)(F.ws + WS_PV8) + (size_t)L * P_E * (D / 2);
    const float* SCU = (const float*)(F.ws + WS_SC) + (size_t)L * P_E; const float* SCV = (const float*)(F.ws + WS_SC) + (size_t)(4 + L) * P_E;
    const int* IDX = (const int*)(F.ws + WS_IDX); const float* PG = (const float*)(F.ws + WS_PG);
    const float* lg = F.in[I_LNG] + (size_t)(L * 2 + 1) * D; const float* lb = F.in[I_LNB] + (size_t)(L * 2 + 1) * D;
    for (int row = gw; row < M; row += NGW) {
        int lane_l = F.lane; asm volatile("" : "+v"(lane_l));
        const int lane = lane_l, lo16 = lane * 16;
        const int e0 = IDX[(size_t)row * 128 + lane], e1 = IDX[(size_t)row * 128 + 64 + lane];
        const float g0 = PG[(size_t)row * 128 + lane], g1 = PG[(size_t)row * 128 + 64 + lane];
        const float su0 = SCU[e0], su1 = SCU[e1], sv0 = SCV[e0], sv1 = SCV[e1];
        f32x2 hx[16];
        { const bf16* hr0 = (const bf16*)(F.ws + WS_Y) + (size_t)row * D + 4 * lane;
#pragma unroll
          for (int q = 0; q < 8; ++q) { const v2u hp = *(const v2u*)(hr0 + 256 * q); hx[2 * q] = (f32x2){bf_lo(hp.x), bf_hi(hp.x)}; hx[2 * q + 1] = (f32x2){bf_lo(hp.y), bf_hi(hp.y)}; } }
        float a0, a1;
        {
            LAS unsigned char* wl = F.lds + F.wave * 13568;
            LAS unsigned char* HI = wl + 8448;
#pragma unroll
            for (int q = 0; q < 8; ++q) {
                const f32x2 p0 = hx[2 * q], p1 = hx[2 * q + 1];
                int hi = __builtin_amdgcn_cvt_pk_fp8_f32(p0[0], p0[1], 0, false); hi = __builtin_amdgcn_cvt_pk_fp8_f32(p1[0], p1[1], hi, true);
                const f32x2 b0 = __builtin_amdgcn_cvt_pk_f32_fp8(hi, false), b1 = __builtin_amdgcn_cvt_pk_f32_fp8(hi, true);
                const f32x2 r0 = (p0 - b0) * 16.0f, r1 = (p1 - b1) * 16.0f;
                int lo = __builtin_amdgcn_cvt_pk_fp8_f32(r0[0], r0[1], 0, false); lo = __builtin_amdgcn_cvt_pk_fp8_f32(r1[0], r1[1], lo, true);
                *(LAS int*)(HI + 4 * lane + 256 * q) = hi; *(LAS int*)(HI + 2048 + 4 * lane + 256 * q) = lo;
            }
            asm volatile("" ::: "memory");
            const int n16 = lane & 15, kq = lane >> 4, hl = lane >> 5, l31 = lane & 31;
            const LAS unsigned char* bp = HI + (n16 == 1 ? 2048 : 0) + 16 * kq;
            LAS unsigned char* tw = wl + hl * 528 + 16 * l31;
            const LAS unsigned char* tr = wl + n16 * 528 + 16 * kq;
            f32x4 acc[8];
#pragma unroll
            for (int rb = 0; rb < 8; ++rb) acc[rb] = zero4();
            v4u R[2][8]; v8i_t Bk[8];
            int e0b = e0, e1b = e1;
#define UL_LOAD(S_) do { _Pragma("unroll") for (int i = 0; i < 8; ++i) { const int sa_ = 16 * ((S_) & 7) + 2 * i; \
                const int es_ = ((S_) >> 3) ? (((S_) & 7) < 4 ? e0b : e1b) : (((S_) & 7) < 4 ? e0 : e1); const int ia_ = __builtin_amdgcn_readlane(es_, sa_ & 63), ib_ = __builtin_amdgcn_readlane(es_, (sa_ + 1) & 63); \
                const int id_ = hl ? ib_ : ia_; R[(S_) & 1][i] = *(const v4u*)(PU + (size_t)id_ * (D / 2) + 512 * ((S_) >> 3) + 16 * l31); } } while (0)
#define UL_WRITE(S_) do { _Pragma("unroll") for (int i = 0; i < 8; ++i) *(LAS v4u*)(tw + 2 * i * 528) = R[(S_) & 1][i]; } while (0)
#define UL_MMA(S_) do { if (((S_) & 7) == 0) { _Pragma("unroll") for (int ml = 0; ml < 8; ++ml) { const v4u x0 = *(const LAS v4u*)(bp + 128 * (8 * ((S_) >> 3) + ml)), x1 = *(const LAS v4u*)(bp + 128 * (8 * ((S_) >> 3) + ml) + 64); \
                    Bk[ml] = (v8i_t){(int)x0.x, (int)x0.y, (int)x0.z, (int)x0.w, (int)x1.x, (int)x1.y, (int)x1.z, (int)x1.w}; } } \
                _Pragma("unroll") for (int ml = 0; ml < 8; ++ml) { const v4u w = *(const LAS v4u*)(tr + 64 * ml); \
                    acc[(S_) & 7] = __builtin_amdgcn_mfma_scale_f32_16x16x128_f8f6f4((v8i_t){(int)w.x, (int)w.y, (int)w.z, (int)w.w, 0, 0, 0, 0}, Bk[ml], acc[(S_) & 7], 4, 0, 0, 0x7f7f7f7f, 0, 0x7f7f7f7f); } } while (0)
            UL_LOAD(0); __builtin_amdgcn_sched_barrier(0);
#pragma unroll
            for (int s = 0; s < 16; ++s) {
                if (s + 1 == 8) asm volatile("" : "+v"(e0b), "+v"(e1b));
                if (s + 1 < 16) UL_LOAD(s + 1);
                __builtin_amdgcn_sched_barrier(0);
                UL_WRITE(s); __builtin_amdgcn_sched_barrier(0);
                UL_MMA(s); __builtin_amdgcn_sched_barrier(0);
            }
#undef UL_LOAD
#undef UL_WRITE
#undef UL_MMA
            asm volatile("s_nop 15\n\ts_nop 15" : "+v"(acc[0]), "+v"(acc[1]), "+v"(acc[2]), "+v"(acc[3]), "+v"(acc[4]), "+v"(acc[5]), "+v"(acc[6]), "+v"(acc[7]));
            LAS float* SS = (LAS float*)(wl + 12544);
            if (n16 < 2) {
#pragma unroll
                for (int rb = 0; rb < 8; ++rb) *(LAS f32x4*)(SS + n16 * 128 + 16 * rb + 4 * kq) = acc[rb]; }
            asm volatile("" ::: "memory");
            a0 = SS[lane] + SS[128 + lane] * 0.0625f; a1 = SS[64 + lane] + SS[192 + lane] * 0.0625f;
            asm volatile("" ::: "memory");
        }
        float* HC = (float*)(F.ws + WS_Z) + (size_t)row * 128;
        HC[lane] = gelu_tanh(a0 * su0) * g0 * sv0; HC[64 + lane] = gelu_tanh(a1 * su1) * g1 * sv1;
    }
}
template <int L> __device__ __forceinline__ void peer_v_phase(Frame& F, int M) {
    const int gw = F.vcu * NWAVES + F.wave, NGW = F.G * NWAVES;
    const char* PU = (const char*)(F.ws + WS_PU8) + (size_t)L * P_E * (D / 2); const char* PV = (const char*)(F.ws + WS_PV8) + (size_t)L * P_E * (D / 2);
    const float* SCU = (const float*)(F.ws + WS_SC) + (size_t)L * P_E; const float* SCV = (const float*)(F.ws + WS_SC) + (size_t)(4 + L) * P_E;
    const int* IDX = (const int*)(F.ws + WS_IDX); const float* PG = (const float*)(F.ws + WS_PG);
    const float* lg = F.in[I_LNG] + (size_t)(L * 2 + 1) * D; const float* lb = F.in[I_LNB] + (size_t)(L * 2 + 1) * D;
    for (int row = gw; row < M; row += NGW) {
        int lane_l = F.lane; asm volatile("" : "+v"(lane_l));
        const int lane = lane_l, lo16 = lane * 16;
        const int e0 = IDX[(size_t)row * 128 + lane], e1 = IDX[(size_t)row * 128 + 64 + lane];
        RowBatch A, Bb;
        constexpr int NB3 = 128 / P3B;
        p3_load_batch(A, PV, e0, 0, lo16);
        const float h0 = ((const float*)(F.ws + WS_Z))[(size_t)row * 128 + lane], h1 = ((const float*)(F.ws + WS_Z))[(size_t)row * 128 + 64 + lane];
        f32x2 acc[16];
#pragma unroll
        for (int j = 0; j < 16; ++j) acc[j] = (f32x2){0.f, 0.f};
#define P3_AXPY(BUF, KB) do { _Pragma("unroll") for (int q = 0; q < P3B; ++q) { const int k = (KB) + q; const float hk = rl(k < 64 ? h0 : h1, k & 63); axpy32_fp4(BUF.r[q], hk, acc); } } while (0)
        for (int bb = 0; bb < NB3; bb += 2) {
            p3_load_batch(Bb, PV, (bb + 1) * P3B < 64 ? e0 : e1, (P3B * (bb + 1)) & 63, lo16);
            P3_AXPY(A, P3B * bb);
            if (bb + 2 < NB3) p3_load_batch(A, PV, (bb + 2) * P3B < 64 ? e0 : e1, (P3B * (bb + 2)) & 63, lo16);
            P3_AXPY(Bb, P3B * bb + P3B);
        }
#undef P3_AXPY
        int lane2 = lane_l; asm volatile("" : "+v"(lane2) : "v"(acc[0]), "v"(acc[15]));
        const bf16* xr = (const bf16*)(F.ws + WS_X) + (size_t)row * D + 4 * lane2; const float* md = mod_row(F, L, row) + 4 * lane2;
        float s = 0.f;
#pragma unroll
        for (int q = 0; q < 8; ++q) { const v2u xp = *(const v2u*)(xr + 256 * q); const f32x4 xa = {bf_lo(xp.x), bf_hi(xp.x), bf_lo(xp.y), bf_hi(xp.y)}, ga = *(const f32x4*)(md + 5 * D + 256 * q);
#pragma unroll
            for (int j = 0; j < 4; ++j) { float v = acc[2 * q + (j >> 1)][j & 1]; v = ALPHA * xa[j] + ga[j] * v; acc[2 * q + (j >> 1)][j & 1] = v; s += v; } }
        const float mean = wsum(s) * (1.0f / D); float qv = 0.f;
#pragma unroll
        for (int j = 0; j < 16; ++j) { acc[j] = acc[j] - mean; qv += acc[j][0] * acc[j][0] + acc[j][1] * acc[j][1]; }
        const float rstd = 1.0f / sqrtf(wsum(qv) * (1.0f / D) + LN_EPS);
        float* xo = F.out + (size_t)row * D + 4 * lane2; bf16* xb = (bf16*)(F.ws + WS_X) + (size_t)row * D + 4 * lane2;
        unsigned char* ho = F.ws + WS_H + (size_t)row * D + 4 * lane2;
        const float* mdn = mod_row(F, (L + 1) & 3, row) + 4 * lane2;
#pragma unroll
        for (int q = 0; q < 8; ++q) { const int o = 256 * q; const f32x4 wa = *(const f32x4*)(lg + 4 * lane2 + o), ba = *(const f32x4*)(lb + 4 * lane2 + o);
            f32x4 oa;
#pragma unroll
            for (int j = 0; j < 4; ++j) oa[j] = acc[2 * q + (j >> 1)][j & 1] * rstd * wa[j] + ba[j];
            if (L == DEPTH - 1) *(f32x4*)(xo + o) = oa; else { v2u xw; xw.x = cvt_pk_bf16(oa[0], oa[1]); xw.y = cvt_pk_bf16(oa[2], oa[3]); *(v2u*)(xb + o) = xw; }
            if (L < DEPTH - 1) { const f32x4 sa = *(const f32x4*)(mdn + o), ca = *(const f32x4*)(mdn + D + o); const f32x4 ha = oa * (ca + 1.0f) + sa;
                *(unsigned*)(ho + o) = pk4_fp8(ha[0], ha[1], ha[2], ha[3]); } }
    }
}

constexpr int MP = 272;
constexpr int ML_QH = 0, ML_KH = 128 * MP, ML_VT = 2 * 128 * MP, ML_VW = 3 * 128 * MP, ML_GA = 4 * 128 * MP;
__device__ __forceinline__ s16x4 tr_read(LAS unsigned char* p) { return __builtin_amdgcn_ds_read_tr16_b64_v4i16((LAS s16x4*)p); }
__device__ __forceinline__ bf16x8 cat8(s16x4 a, s16x4 b) { return (bf16x8){a[0], a[1], a[2], a[3], b[0], b[1], b[2], b[3]}; }

template <int L> __device__ __forceinline__ void mlstm_scan_phase(Frame& F) {
    constexpr int J = L / 3;
    LAS unsigned char* lds = F.lds;
    LAS float* GA = (LAS float*)(lds + ML_GA);
    LAS float* gA = GA, *gMM = GA + 128, *gWI = GA + 256, *gEN = GA + 384, *gWS = GA + 512, *gNQ = GA + 640, *gHD = GA + 768;
    LAS float* gN = GA + 896;
    LAS float* gRS2 = GA + 896 + 512 + 16;
    const bf16* Zq = (const bf16*)(F.ws + WS_Z + ZQ); const bf16* Zk = (const bf16*)(F.ws + WS_Z + ZK); const bf16* Zv = (const bf16*)(F.ws + WS_Z + ZV);
    const float* G16 = (const float*)(F.ws + WS_GATE); const float* bg = F.in[I_ABG] + J * 16;
    const int tid0 = F.tid, w = F.wave;
    for (int unit = F.vcu; unit < 256; unit += F.G) {
        const int chain = unit >> 2, vs = unit & 3, dir = chain & 1, hd = (chain >> 1) & 3, b = chain >> 3;
        bf16* HO = (bf16*)(F.ws + (dir ? WS_Y : WS_H));
        float* GPa = (float*)(F.ws + WS_GP) + (size_t)unit * (3 * 34 * 128); float* GPb = GPa + 34 * 128; float* GPp = GPb + 34 * 128;
#define CBASE(jc_) ((jc_) < 2 ? TL + b * CL + (dir ? 1 - (jc_) : (jc_)) * 128 : b * SEQ + (dir ? 33 - (jc_) : (jc_) - 2) * 128)
        for (int jc = w; jc < 34; jc += NWAVES) {
            const int base = CBASE(jc); const int lane = tid0 & 63;
            const int s0 = 2 * lane, s1 = 2 * lane + 1;
            const float* g0 = G16 + (size_t)(base + (dir ? 127 - s0 : s0)) * 16; const float* g1 = G16 + (size_t)(base + (dir ? 127 - s1 : s1)) * 16;
            const int ci = dir * 8 + hd, cf = dir * 8 + 4 + hd;
            float li0 = g0[ci] + bg[ci], li1 = g1[ci] + bg[ci], gf0 = g0[cf] + bg[cf], gf1 = g1[cf] + bg[cf];
            li0 = 15.f * tanhf(li0 * (1.f / 15.f)); li1 = 15.f * tanhf(li1 * (1.f / 15.f)); gf0 = 15.f * tanhf(gf0 * (1.f / 15.f)); gf1 = 15.f * tanhf(gf1 * (1.f / 15.f));
            const float lf0 = fminf(gf0, 0.f) - log1pf(__expf(-fabsf(gf0))), lf1 = fminf(gf1, 0.f) - log1pf(__expf(-fabsf(gf1)));
            float p = lf0 + lf1;
#pragma unroll
            for (int o = 1; o < 64; o <<= 1) { const float t = __shfl_up(p, o); if (lane >= o) p += t; }
            const float b1 = p, b0 = p - lf1;
            const float a0 = li0 - b0, a1 = li1 - b1;
            float pm = fmaxf(a0, a1);
#pragma unroll
            for (int o = 1; o < 64; o <<= 1) { const float t = __shfl_up(pm, o); if (lane >= o) pm = fmaxf(pm, t); }
            float pe = __shfl_up(pm, 1); if (lane == 0) pe = -3.0e38f;
            *(f32x2*)(GPa + jc * 128 + s0) = (f32x2){a0, a1}; *(f32x2*)(GPb + jc * 128 + s0) = (f32x2){b0, b1}; *(f32x2*)(GPp + jc * 128 + s0) = (f32x2){fmaxf(pe, a0), pm};
        }
        f32x4 C[16];
#pragma unroll
        for (int i = 0; i < 16; ++i) C[i] = zero4();
        for (int i = tid0; i < 512; i += NTHR) gN[i] = 0.f;
        __syncthreads();
        float m = 0.f;
        v4u PQ[4], PK[4], PV[4]; float pa[4]; float pe_a, pe_b, pe_p, pl_b, pl_p;
#define LOAD_QK(jc_, hf_) do { int t_ = tid0; asm volatile("" : "+v"(t_)); const int base_ = CBASE(jc_); const size_t r0_ = (size_t)(base_ + (dir ? 127 - (t_ >> 4) : (t_ >> 4))); const long rs_ = dir ? -32 : 32; \
            const bf16* qp_ = Zq + r0_ * 1024 + hd * 256 + (hf_) * 128 + (t_ & 15) * 8; const bf16* kp_ = Zk + r0_ * 1024 + hd * 256 + (hf_) * 128 + (t_ & 15) * 8; \
            _Pragma("unroll") for (int i = 0; i < 4; ++i) { PQ[i] = *(const v4u*)(qp_ + (long)i * rs_ * 1024); PK[i] = *(const v4u*)(kp_ + (long)i * rs_ * 1024); } } while (0)
#define LOAD_V(jc_) do { int t_ = tid0; asm volatile("" : "+v"(t_)); const int base_ = CBASE(jc_); const size_t r0_ = (size_t)(base_ + (dir ? 127 - (t_ >> 4) : (t_ >> 4))); const long rs_ = dir ? -32 : 32; \
            const bf16* vp_ = Zv + r0_ * 2048 + hd * 512 + vs * 128 + (t_ & 15) * 8; \
            _Pragma("unroll") for (int i = 0; i < 4; ++i) { PV[i] = *(const v4u*)(vp_ + (long)i * rs_ * 2048); pa[i] = GPa[(jc_) * 128 + (t_ >> 4) + 32 * i]; } } while (0)
#define LOAD_G(jc_) do { int t_ = tid0; asm volatile("" : "+v"(t_)); const int o_ = (jc_) * 128 + (t_ & 127); pe_a = GPa[o_]; pe_b = GPb[o_]; pe_p = GPp[o_]; pl_b = GPb[(jc_) * 128 + 127]; pl_p = GPp[(jc_) * 128 + 127]; } while (0)
        LOAD_QK(0, 0); LOAD_V(0); LOAD_G(0);
        for (int jc = 0; jc < 34; ++jc) {
            const int base = CBASE(jc);
#define ROWMAP(r) (base + (dir ? 127 - (r) : (r)))
            LAS float* Ncur = gN + (jc & 1) * 256; LAS float* Nnxt = gN + ((jc & 1) ^ 1) * 256;
            int tid_l = tid0; asm volatile("" : "+v"(tid_l));
            const int tid = tid_l, lane = tid & 63, fr = lane & 15, fq = lane >> 4;
            int X1 = fr * MP + 16 * fq, X2 = fr * MP + 8 * fq, X3 = (8 * fq + (fr >> 2)) * MP + 8 * (fr & 3), XS = (tid >> 4) * MP + (tid & 15) * 16, X4 = 32 * fq;
            asm volatile("" : "+v"(X1), "+v"(X2), "+v"(X3), "+v"(XS), "+v"(X4));
            const int X1w = X1 + 16 * w * MP, X2w = X2 + 16 * w * MP, X3w = X3 + 32 * w;
            const float M127 = __builtin_bit_cast(float, __builtin_amdgcn_readfirstlane(__builtin_bit_cast(int, fmaxf(m, pl_p))));
            const float decay = __builtin_bit_cast(float, __builtin_amdgcn_readfirstlane(__builtin_bit_cast(int, __expf(m - M127))));
            if (tid < 128) { const float Mt = fmaxf(m, pe_p);
                gA[tid] = pe_a; gMM[tid] = Mt; gWI[tid] = __expf(m - Mt); gEN[tid] = __expf(-pe_b - Mt); gWS[tid] = __expf(pe_a - M127) * 0.0625f; }
            m = __builtin_bit_cast(float, __builtin_amdgcn_readfirstlane(__builtin_bit_cast(int, pl_b + M127)));
            f32x4 Sacc[5], CQ[8]; v2u SP[5]; float rsum = 0.f; const int lo_own = w >= 5 ? w - 4 : 0;
#pragma unroll
            for (int i = 0; i < 8; ++i) { if (i < 5) Sacc[i] = zero4(); CQ[i] = zero4(); }
#pragma unroll
            for (int hf = 0; hf < 2; ++hf) {
#pragma unroll
                for (int i = 0; i < 4; ++i) { *(LAS v4u*)(lds + ML_QH + XS + i * 32 * MP) = PQ[i]; *(LAS v4u*)(lds + ML_KH + XS + i * 32 * MP) = PK[i]; }
                if (hf == 0) {
#pragma unroll
                    for (int i = 0; i < 4; ++i) {
                        const v4u v = PV[i]; const float ws = __expf(pa[i] - M127) * 0.0625f;
                        *(LAS v4u*)(lds + ML_VT + XS + i * 32 * MP) = v;
                        v4u o; o.x = cvt_pk_bf16(bf_lo(v.x) * ws, bf_hi(v.x) * ws); o.y = cvt_pk_bf16(bf_lo(v.y) * ws, bf_hi(v.y) * ws);
                        o.z = cvt_pk_bf16(bf_lo(v.z) * ws, bf_hi(v.z) * ws); o.w = cvt_pk_bf16(bf_lo(v.w) * ws, bf_hi(v.w) * ws);
                        *(LAS v4u*)(lds + ML_VW + XS + i * 32 * MP) = o; }
                }
                __syncthreads();
                if (hf == 0) { LOAD_QK(jc, 1); }
                else if (jc < 33) { LOAD_QK(jc + 1, 0); }
#pragma unroll
                for (int i = 0; i < 5; ++i) {
                    const bool own = i <= w - lo_own; const int tbi = own ? w : 7 - w, sbi = own ? lo_own + i : i - (w + 1);
                    if (own || (w < 3 && sbi < 3 - w)) {
#pragma unroll
                        for (int ks = 0; ks < 4; ++ks) { const bf16x8 kf = *(const LAS bf16x8*)(lds + ML_KH + X1 + sbi * 16 * MP + ks * 64); const bf16x8 qf = *(const LAS bf16x8*)(lds + ML_QH + X1 + tbi * 16 * MP + ks * 64);
                            Sacc[i] = __builtin_amdgcn_mfma_f32_16x16x32_bf16(kf, qf, Sacc[i], 0, 0, 0); }
                    }
                }
                if (hf == 1) {
                    float rs_own = 0.f, rs_help = 0.f;
#pragma unroll
                    for (int i = 0; i < 5; ++i) {
                        const bool own = i <= w - lo_own; const int tbi = own ? w : 7 - w, sbi = own ? lo_own + i : i - (w + 1);
                        v2u o; o.x = 0u; o.y = 0u;
                        if (own || (w < 3 && sbi < 3 - w)) { const int t = 16 * tbi + fr; const float Mt = gMM[t]; float v[4], rs = 0.f;
#pragma unroll
                            for (int j = 0; j < 4; ++j) { const int sidx = 16 * sbi + 4 * fq + j; v[j] = (sidx <= t) ? Sacc[i][j] * 0.0625f * __expf(gA[sidx] - Mt) : 0.f; rs += v[j]; }
                            o.x = cvt_pk_bf16(v[0], v[1]); o.y = cvt_pk_bf16(v[2], v[3]);
                            if (own) rs_own += rs; else rs_help += rs; }
                        SP[i] = o;
                    }
                    rs_own += __shfl_xor(rs_own, 16); rs_own += __shfl_xor(rs_own, 32); rs_help += __shfl_xor(rs_help, 16); rs_help += __shfl_xor(rs_help, 32);
                    rsum = rs_own;
                    if (w < 3 && fq == 0) gRS2[16 * (7 - w) + fr] = rs_help;
                }
                __builtin_amdgcn_sched_barrier(0);
#pragma unroll
                for (int tb = 0; tb < 8; ++tb) {
#pragma unroll
                    for (int k2 = 0; k2 < 4; ++k2) {
                        const f32x4 c0 = C[hf * 8 + 2 * k2], c1 = C[hf * 8 + 2 * k2 + 1];
                        v4u pk; pk.x = cvt_pk_bf16(c0[0], c0[1]); pk.y = cvt_pk_bf16(c0[2], c0[3]); pk.z = cvt_pk_bf16(c1[0], c1[1]); pk.w = cvt_pk_bf16(c1[2], c1[3]);
                        const s16x4 qa = *(const LAS s16x4*)(lds + ML_QH + X2 + tb * 16 * MP + k2 * 64), qb = *(const LAS s16x4*)(lds + ML_QH + X2 + tb * 16 * MP + k2 * 64 + 32);
                        CQ[tb] = __builtin_amdgcn_mfma_f32_16x16x32_bf16(cat8(qa, qb), __builtin_bit_cast(bf16x8, pk), CQ[tb], 0, 0, 0); }
                }
                __builtin_amdgcn_sched_barrier(0);
                {
                    f32x4 nacc = zero4();
#pragma unroll
                    for (int ks = 0; ks < 4; ++ks) {
                        const LAS float* np = (const LAS float*)((LAS unsigned char*)Ncur + X4 + hf * 512 + ks * 128);
                        const f32x4 n0 = *(const LAS f32x4*)np, n1 = *(const LAS f32x4*)(np + 4);
                        v4u pk; pk.x = cvt_pk_bf16(n0[0], n0[1]); pk.y = cvt_pk_bf16(n0[2], n0[3]); pk.z = cvt_pk_bf16(n1[0], n1[1]); pk.w = cvt_pk_bf16(n1[2], n1[3]);
                        const bf16x8 qf = *(const LAS bf16x8*)(lds + ML_QH + X1w + ks * 64);
                        nacc = __builtin_amdgcn_mfma_f32_16x16x32_bf16(qf, __builtin_bit_cast(bf16x8, pk), nacc, 0, 0, 0); }
                    if (fr == 0) {
#pragma unroll
                        for (int j = 0; j < 4; ++j) { const int t = 16 * w + 4 * fq + j; gNQ[t] = (hf == 0 ? 0.f : gNQ[t]) + nacc[j]; } }
                }
                __builtin_amdgcn_sched_barrier(0);
#pragma unroll
                for (int dt = 0; dt < 8; ++dt) {
                    f32x4 acc = C[hf * 8 + dt] * decay;
#pragma unroll
                    for (int ss = 0; ss < 4; ++ss) { LAS unsigned char* p = lds + ML_KH + X3 + ss * 32 * MP + dt * 32; LAS unsigned char* pw = lds + ML_VW + X3w + ss * 32 * MP;
                        acc = __builtin_amdgcn_mfma_f32_16x16x32_bf16(cat8(tr_read(p), tr_read(p + 4 * MP)), cat8(tr_read(pw), tr_read(pw + 4 * MP)), acc, 0, 0, 0); }
                    C[hf * 8 + dt] = acc;
                }
                __builtin_amdgcn_sched_barrier(0);
                {
                    f32x4 nacc = zero4();
#pragma unroll
                    for (int ss = 0; ss < 4; ++ss) {
                        const LAS float* wp = (const LAS float*)((LAS unsigned char*)gWS + X4 + ss * 128);
                        const f32x4 w0 = *(const LAS f32x4*)wp, w1 = *(const LAS f32x4*)(wp + 4);
                        v4u pk; pk.x = cvt_pk_bf16(w0[0], w0[1]); pk.y = cvt_pk_bf16(w0[2], w0[3]); pk.z = cvt_pk_bf16(w1[0], w1[1]); pk.w = cvt_pk_bf16(w1[2], w1[3]);
                        LAS unsigned char* p = lds + ML_KH + X3w + ss * 32 * MP;
                        nacc = __builtin_amdgcn_mfma_f32_16x16x32_bf16(cat8(tr_read(p), tr_read(p + 4 * MP)), __builtin_bit_cast(bf16x8, pk), nacc, 0, 0, 0); }
                    if (fr == 0) {
#pragma unroll
                        for (int j = 0; j < 4; ++j) { const int dl = hf * 128 + 16 * w + 4 * fq + j; Nnxt[dl] = decay * Ncur[dl] + nacc[j]; } }
                }
                __syncthreads();
            }
            {
#pragma unroll
                for (int i = 0; i < 5; ++i) {
                    const bool own = i <= w - lo_own; const int tbi = own ? w : 7 - w, sbi = own ? lo_own + i : i - (w + 1);
                    if (own || (w < 3 && sbi < 3 - w)) *(LAS v2u*)(lds + ML_QH + X2 + tbi * 16 * MP + sbi * 32) = SP[i];
                }
                for (int sb = w + 1; sb < 8; ++sb) { v2u z; z.x = 0u; z.y = 0u; *(LAS v2u*)(lds + ML_QH + X2w + sb * 32) = z; }
                const int t = 16 * w + fr;
                if (fq == 0) { const float den = gWI[t] * gNQ[t] + rsum + (w >= 5 ? gRS2[t] : 0.f); gHD[t] = 1.0f / fmaxf(fabsf(den), gEN[t]); }
            }
            __syncthreads();
            {
                bf16x8 vf[4];
#pragma unroll
                for (int ss = 0; ss < 4; ++ss) { LAS unsigned char* p = lds + ML_VT + X3w + ss * 32 * MP; vf[ss] = cat8(tr_read(p), tr_read(p + 4 * MP)); }
                if (jc < 33) { LOAD_V(jc + 1); LOAD_G(jc + 1); }
                bf16* hop = HO + (size_t)ROWMAP(4 * fq) * D + hd * 512 + vs * 128 + 16 * w + fr; const long hstep = dir ? -(long)D : (long)D;
#pragma unroll
                for (int tb = 0; tb < 8; ++tb) {
                    f32x4 acc;
#pragma unroll
                    for (int j = 0; j < 4; ++j) acc[j] = CQ[tb][j] * gWI[16 * tb + 4 * fq + j];
#pragma unroll
                    for (int ss = 0; ss < 4; ++ss) { const bf16x8 sf = *(const LAS bf16x8*)(lds + ML_QH + X1 + tb * 16 * MP + ss * 64);
                        acc = __builtin_amdgcn_mfma_f32_16x16x32_bf16(sf, vf[ss], acc, 0, 0, 0); }
#pragma unroll
                    for (int j = 0; j < 4; ++j) { const float h = acc[j] * gHD[16 * tb + 4 * fq + j];
                        hop[(long)(16 * tb + j) * hstep] = (bf16)(cvt_pk_bf16(h, 0.f) & 0xffffu); }
                }
            }
            __syncthreads();
#undef ROWMAP
        }
#undef LOAD_QK
#undef LOAD_V
#undef LOAD_G
#undef CBASE
    }
}

template <int L> __device__ __forceinline__ void mlstm_post_phase(Frame& F, int M) {
    constexpr int J = L / 3;
    const int gw = F.vcu * NWAVES + F.wave, NGW = F.G * NWAVES;
    const float* ng = F.in[I_ANG] + (size_t)J * D;
    for (int row = gw; row < M; row += NGW) {
        const bf16* hf = (const bf16*)(F.ws + WS_H) + (size_t)row * D; const bf16* hb = (const bf16*)(F.ws + WS_Y) + (size_t)row * D;
        const bf16* orow = (const bf16*)(F.ws + WS_Z + ZO) + (size_t)row * D; unsigned char* g = F.ws + WS_Z + ZG + (size_t)row * D;
        f32x4 t[8]; float ss[4];
#pragma unroll
        for (int j = 0; j < 8; ++j) { const int e = 4 * F.lane + 256 * j; const v2u a = *(const v2u*)(hf + e), b = *(const v2u*)(hb + e);
            t[j] = (f32x4){bf_lo(a.x) + bf_lo(b.x), bf_hi(a.x) + bf_hi(b.x), bf_lo(a.y) + bf_lo(b.y), bf_hi(a.y) + bf_hi(b.y)}; }
#pragma unroll
        for (int h = 0; h < 4; ++h) { float q = 0.f;
#pragma unroll
            for (int jj = 0; jj < 2; ++jj) { const f32x4 v = t[2 * h + jj]; q += (v[0] * v[0] + v[1] * v[1]) + (v[2] * v[2] + v[3] * v[3]); }
            ss[h] = 1.0f / sqrtf(wsum(q) * (1.0f / A_DV) + LN_EPS); }
#pragma unroll
        for (int j = 0; j < 8; ++j) { const int e = 4 * F.lane + 256 * j; const v2u ov = *(const v2u*)(orow + e); const f32x4 gn = *(const f32x4*)(ng + e);
            const float o0 = bf_lo(ov.x), o1 = bf_hi(ov.x), o2 = bf_lo(ov.y), o3 = bf_hi(ov.y); const float r = ss[j >> 1];
            const float y0 = t[j][0] * r * gn[0] / (1.0f + __expf(-o0)), y1 = t[j][1] * r * gn[1] / (1.0f + __expf(-o1));
            const float y2 = t[j][2] * r * gn[2] / (1.0f + __expf(-o2)), y3 = t[j][3] * r * gn[3] / (1.0f + __expf(-o3));
            *(unsigned*)(g + e) = pk4_fp8(y0, y1, y2, y3); }
    }
}

__device__ __forceinline__ void gmlp_stats_phase(Frame& F, int M) {
    const int gw = F.vcu * NWAVES + F.wave, NGW = F.G * NWAVES;
    float* ST = (float*)(F.ws + WS_STAT);
    for (int row = gw; row < M; row += NGW) {
        const bf16* vr = (const bf16*)(F.ws + WS_Z + ZVV) + (size_t)row * 4096;
        v4u x[8]; float s = 0.f;
#pragma unroll
        for (int j = 0; j < 8; ++j) { x[j] = *(const v4u*)(vr + 8 * F.lane + 512 * j);
            s += (bf_lo(x[j].x) + bf_hi(x[j].x)) + (bf_lo(x[j].y) + bf_hi(x[j].y)) + (bf_lo(x[j].z) + bf_hi(x[j].z)) + (bf_lo(x[j].w) + bf_hi(x[j].w)); }
        const float mean = wsum(s) * (1.0f / 4096.f); float q = 0.f;
#pragma unroll
        for (int j = 0; j < 8; ++j) { float d;
            d = bf_lo(x[j].x) - mean; q += d * d; d = bf_hi(x[j].x) - mean; q += d * d; d = bf_lo(x[j].y) - mean; q += d * d; d = bf_hi(x[j].y) - mean; q += d * d;
            d = bf_lo(x[j].z) - mean; q += d * d; d = bf_hi(x[j].z) - mean; q += d * d; d = bf_lo(x[j].w) - mean; q += d * d; d = bf_hi(x[j].w) - mean; q += d * d; }
        const float rstd = 1.0f / sqrtf(wsum(q) * (1.0f / 4096.f) + LN_EPS);
        if (F.lane == 0) { ST[(size_t)row * 2] = mean; ST[(size_t)row * 2 + 1] = rstd; }
    }
}
__device__ __forceinline__ void gmlp_spatial_phase(Frame& F, int M) {
    LAS unsigned char* lds = F.lds;
    constexpr int GW_W = 0, GW_V = 128 * MP, GW_O = 2 * 128 * MP;
    const bf16* WS = (const bf16*)(F.ws + WS_WS); const float* ST = (const float*)(F.ws + WS_STAT);
    const bf16* U = (const bf16*)(F.ws + WS_Z + ZU); const bf16* V = (const bf16*)(F.ws + WS_Z + ZVV);
    const float* lng = F.in[I_BLNG]; const float* lnb = F.in[I_BLNB]; const float* bs = F.in[I_BBS];
    const int w = F.wave;
    const int nunits = (M / 128) * B_GROUPS;
    for (int u = F.vcu; u < nunits; u += F.G) {
        int tid_l = F.tid; asm volatile("" : "+v"(tid_l));
        const int tid = tid_l, lane = tid & 63, fr = lane & 15, fq = lane >> 4;
        const int chunk = u >> 3, g = u & 7, row0 = chunk * 128;
        const int et = tid >> 2, ec = tid & 3;
        v4u wreg[4], vreg[4][4]; float mean[4], rstd[4];
#pragma unroll
        for (int i = 0; i < 4; ++i) { const int c = tid + 512 * i, r = c >> 4, cc = c & 15;
            wreg[i] = *(const v4u*)(WS + (size_t)g * 16384 + r * 128 + cc * 8);
            mean[i] = ST[(size_t)(row0 + r) * 2]; rstd[i] = ST[(size_t)(row0 + r) * 2 + 1];
#pragma unroll
            for (int dq = 0; dq < 4; ++dq) vreg[dq][i] = *(const v4u*)(V + (size_t)(row0 + r) * 4096 + g * 512 + dq * 128 + cc * 8); }
        const float bst = bs[g * 128 + et];
#pragma unroll
        for (int i = 0; i < 4; ++i) { const int c = tid + 512 * i, r = c >> 4, cc = c & 15; *(LAS v4u*)(lds + GW_W + r * MP + cc * 16) = wreg[i]; }
#pragma unroll
        for (int dq = 0; dq < 4; ++dq) {
            const int col0 = g * 512 + dq * 128;
#pragma unroll
            for (int i = 0; i < 4; ++i) { const int c = tid + 512 * i, r = c >> 4, cc = c & 15;
                const v4u v = vreg[dq][i]; const float mn = mean[i], rs = rstd[i];
                const f32x4 ga = *(const f32x4*)(lng + col0 + cc * 8), gb = *(const f32x4*)(lng + col0 + cc * 8 + 4), ba = *(const f32x4*)(lnb + col0 + cc * 8), bb = *(const f32x4*)(lnb + col0 + cc * 8 + 4);
                v4u o;
                o.x = cvt_pk_bf16((bf_lo(v.x) - mn) * rs * ga[0] + ba[0], (bf_hi(v.x) - mn) * rs * ga[1] + ba[1]);
                o.y = cvt_pk_bf16((bf_lo(v.y) - mn) * rs * ga[2] + ba[2], (bf_hi(v.y) - mn) * rs * ga[3] + ba[3]);
                o.z = cvt_pk_bf16((bf_lo(v.z) - mn) * rs * gb[0] + bb[0], (bf_hi(v.z) - mn) * rs * gb[1] + bb[1]);
                o.w = cvt_pk_bf16((bf_lo(v.w) - mn) * rs * gb[2] + bb[2], (bf_hi(v.w) - mn) * rs * gb[3] + bb[3]);
                *(LAS v4u*)(lds + GW_V + r * MP + cc * 16) = o; }
            __syncthreads();
            v4u ureg[4];
            { const bf16* up = U + (size_t)(row0 + et) * 4096 + col0 + 32 * ec;
#pragma unroll
              for (int k = 0; k < 4; ++k) ureg[k] = *(const v4u*)(up + 8 * k); }
            bf16x8 wf[4];
#pragma unroll
            for (int ss = 0; ss < 4; ++ss) wf[ss] = *(const LAS bf16x8*)(lds + GW_W + (16 * w + fr) * MP + (32 * ss + 8 * fq) * 2);
#pragma unroll
            for (int db = 0; db < 8; ++db) {
                f32x4 acc = zero4();
#pragma unroll
                for (int ss = 0; ss < 4; ++ss) { LAS unsigned char* p = lds + GW_V + (32 * ss + 8 * fq + (fr >> 2)) * MP + (16 * db + 4 * (fr & 3)) * 2;
                    acc = __builtin_amdgcn_mfma_f32_16x16x32_bf16(cat8(tr_read(p), tr_read(p + 4 * MP)), wf[ss], acc, 0, 0, 0); }
                v2u o; o.x = cvt_pk_bf16(acc[0], acc[1]); o.y = cvt_pk_bf16(acc[2], acc[3]);
                *(LAS v2u*)(lds + GW_O + (16 * w + fr) * MP + (16 * db + 4 * fq) * 2) = o;
            }
            __syncthreads();
            { const LAS unsigned char* op = lds + GW_O + et * MP + 64 * ec;
              unsigned char* hp = F.ws + WS_H + (size_t)(row0 + et) * 4096 + col0 + 32 * ec;
              v4u out[2];
#pragma unroll
              for (int k = 0; k < 4; ++k) { const v4u sv = *(const LAS v4u*)(op + 16 * k); const v4u uv = ureg[k];
                  const unsigned lo = pk4_fp8(bf_lo(uv.x) * (bf_lo(sv.x) + bst), bf_hi(uv.x) * (bf_hi(sv.x) + bst), bf_lo(uv.y) * (bf_lo(sv.y) + bst), bf_hi(uv.y) * (bf_hi(sv.y) + bst));
                  const unsigned hi = pk4_fp8(bf_lo(uv.z) * (bf_lo(sv.z) + bst), bf_hi(uv.z) * (bf_hi(sv.z) + bst), bf_lo(uv.w) * (bf_lo(sv.w) + bst), bf_hi(uv.w) * (bf_hi(sv.w) + bst));
                  out[k >> 1][2 * (k & 1)] = lo; out[k >> 1][2 * (k & 1) + 1] = hi; }
              *(v4u*)hp = out[0]; *(v4u*)(hp + 16) = out[1]; }
        }
        __syncthreads();
    }
}

namespace att {
using bf16 = unsigned short;
constexpr int   D = 128, NW = 8, QBLK = 32, KVBLK = 64;
constexpr float SCALE = 0.088388347648318440f;
constexpr float THR = 8.f;
constexpr int SDEPTH = 2;
constexpr int LDQ = 2048, LDK = 512, LDO = 2048;
constexpr size_t SHM_V = KVBLK * D * 2, SHM_K = KVBLK * D * 2, SHM_ATTN = 2 * SHM_V + 2 * SHM_K + NW * 64 * 4;
using bf16x8 = __attribute__((ext_vector_type(8))) short;
using s16x4  = __attribute__((ext_vector_type(4))) short;
using f32x16 = __attribute__((ext_vector_type(16))) float;
using f32x8  = __attribute__((ext_vector_type(8))) float;
using u32x4  = __attribute__((ext_vector_type(4))) unsigned;
#define KSWZ(row, colB) ((row) * 256 + ((colB) ^ (((row) & 7) << 4)))
#define SBAR() __builtin_amdgcn_sched_barrier(0)
__device__ __forceinline__ int crow(int r, int hi) { return (r & 3) + 8 * (r >> 2) + 4 * hi; }
__device__ __forceinline__ unsigned cvtpk(float lo, float hi) { return ::cvt_pk_bf16(lo, hi); }
template <typename TIn> struct Stage;
template <> struct Stage<bf16>  { using T = bf16x8;
  __device__ static __forceinline__ T ld8(const bf16* p) { return *reinterpret_cast<const bf16x8*>(p); }
  __device__ static __forceinline__ bf16x8 tobf(T x) { return x; } };
__device__ __forceinline__ void partialSM(f32x16& p0, f32x16& p1, float& m_reg, float& mn, float& alpha) {
  constexpr float C = SCALE * 1.4426950408889634f;
  float pmax = p0[0]; for (int r = 1; r < 16; ++r) pmax = fmaxf(pmax, p0[r]); for (int r = 0; r < 16; ++r) pmax = fmaxf(pmax, p1[r]);
  { auto rr = __builtin_amdgcn_permlane32_swap(__float_as_uint(pmax), __float_as_uint(pmax), false, false);
    pmax = fmaxf(__uint_as_float(rr[0]), __uint_as_float(rr[1])); }
  if (__builtin_expect(__all(pmax - m_reg <= THR / SCALE), 1)) { mn = m_reg; alpha = 1.f; }
  else { mn = fmaxf(m_reg, pmax); alpha = __builtin_amdgcn_exp2f((m_reg - mn) * C); m_reg = mn; }
  float mnC = -mn * C;
  for (int r = 0; r < 16; ++r) p0[r] = fmaf(p0[r], C, mnC); for (int r = 0; r < 16; ++r) p1[r] = fmaf(p1[r], C, mnC);
  for (int r = 0; r < 16; ++r) p0[r] = __builtin_amdgcn_exp2f(p0[r]);
}
__device__ __forceinline__ void finishSM(f32x16& p0, f32x16& p1, float alpha, float& l_reg, bf16x8& pa0, bf16x8& pa1, bf16x8& pa2, bf16x8& pa3) {
  for (int r = 0; r < 16; ++r) p1[r] = __builtin_amdgcn_exp2f(p1[r]);
  float ps = 0; for (int r = 0; r < 16; ++r) ps += p0[r]; for (int r = 0; r < 16; ++r) ps += p1[r];
  { auto rr = __builtin_amdgcn_permlane32_swap(__float_as_uint(ps), __float_as_uint(ps), false, false);
    ps = __uint_as_float(rr[0]) + __uint_as_float(rr[1]); }
  l_reg = l_reg * alpha + ps;
#define PK4(P, BASE, OUT) do { unsigned a0 = cvtpk(P[BASE + 0], P[BASE + 1]), a1 = cvtpk(P[BASE + 2], P[BASE + 3]);   \
    unsigned b0 = cvtpk(P[BASE + 4], P[BASE + 5]), b1 = cvtpk(P[BASE + 6], P[BASE + 7]);                              \
    auto r0 = __builtin_amdgcn_permlane32_swap(a0, b0, false, false); auto r1 = __builtin_amdgcn_permlane32_swap(a1, b1, false, false); \
    u32x4 w = {r0[0], r1[0], r0[1], r1[1]}; OUT = *reinterpret_cast<bf16x8*>(&w); } while (0)
  PK4(p0, 0, pa0); PK4(p0, 8, pa1); PK4(p1, 0, pa2); PK4(p1, 8, pa3);
#undef PK4
}
__device__ __forceinline__ void qkt(f32x16& p0, f32x16& p1, const bf16* Ks, const bf16x8* qr, int r32, int hi) {
  p0 = f32x16{}; p1 = f32x16{};
  for (int d0 = 0; d0 < 8; ++d0) { int cb = (d0 * 16 + hi * 8) * 2;
    bf16x8 b0 = *reinterpret_cast<const bf16x8*>((const char*)Ks + KSWZ(r32, cb));
    bf16x8 b1 = *reinterpret_cast<const bf16x8*>((const char*)Ks + KSWZ(32 + r32, cb));
    p0 = __builtin_amdgcn_mfma_f32_32x32x16_bf16(b0, qr[d0], p0, 0, 0, 0);
    p1 = __builtin_amdgcn_mfma_f32_32x32x16_bf16(b1, qr[d0], p1, 0, 0, 0); }
}
__device__ __forceinline__ int v_st(int k, int c) { const int kk = (k & ~0xC) | ((k & 4) << 1) | ((k & 8) >> 1); return ((kk >> 3) * 4 + (c >> 5)) * 512 + ((kk & 7) * 32 + (c & 31)) * 2; }
__device__ __forceinline__ int v_rd_base(int lane) { return ((lane & 3) << 3) | (((lane >> 2) & 3) << 6) | (((lane >> 4) & 1) << 5) | (((lane >> 5) & 1) << 8); }
constexpr int v_rd_off(int d0, int ks, int half) { return d0 * 512 + ks * 4096 + half * 2048; }
template <int OFF> __device__ __forceinline__ s16x4 tr_read(int vb) {
  return __builtin_amdgcn_ds_read_tr16_b64_v4i16((__attribute__((address_space(3))) s16x4*)(unsigned long)(unsigned)(vb + OFF));
}
template <int D0> __device__ __forceinline__ void pv_one(f32x16& od, int vb, bf16x8 pa0, bf16x8 pa1, bf16x8 pa2, bf16x8 pa3) {
  const s16x4 l0 = tr_read<v_rd_off(D0, 0, 0)>(vb), h0 = tr_read<v_rd_off(D0, 0, 1)>(vb), l1 = tr_read<v_rd_off(D0, 1, 0)>(vb), h1 = tr_read<v_rd_off(D0, 1, 1)>(vb);
  const s16x4 l2 = tr_read<v_rd_off(D0, 2, 0)>(vb), h2 = tr_read<v_rd_off(D0, 2, 1)>(vb), l3 = tr_read<v_rd_off(D0, 3, 0)>(vb), h3 = tr_read<v_rd_off(D0, 3, 1)>(vb);
#define PK(L, H) (bf16x8){L[0], L[1], L[2], L[3], H[0], H[1], H[2], H[3]}
  od = __builtin_amdgcn_mfma_f32_32x32x16_bf16(pa0, PK(l0, h0), od, 0, 0, 0);
  od = __builtin_amdgcn_mfma_f32_32x32x16_bf16(pa1, PK(l1, h1), od, 0, 0, 0);
  od = __builtin_amdgcn_mfma_f32_32x32x16_bf16(pa2, PK(l2, h2), od, 0, 0, 0);
  od = __builtin_amdgcn_mfma_f32_32x32x16_bf16(pa3, PK(l3, h3), od, 0, 0, 0);
#undef PK
}
__device__ __forceinline__ void pv_d0(f32x16* o, int vb, bf16x8 pa0, bf16x8 pa1, bf16x8 pa2, bf16x8 pa3) {
  pv_one<0>(o[0], vb, pa0, pa1, pa2, pa3); pv_one<1>(o[1], vb, pa0, pa1, pa2, pa3); pv_one<2>(o[2], vb, pa0, pa1, pa2, pa3); pv_one<3>(o[3], vb, pa0, pa1, pa2, pa3);
}

template <typename TQ>
__device__ __forceinline__ void attn_dense_body(const TQ* __restrict__ Qb, const bf16* __restrict__ Kh, const bf16* __restrict__ Vh,
                                                unsigned char* __restrict__ Ob, int seq, char* lds, int tid_in) {
  using St = Stage<bf16>; using SQ = Stage<TQ>;
  const int tid = tid_in, wid = tid >> 6, lane = tid & 63, r32 = lane & 31, hi = lane >> 5;
  bf16* V_lds = (bf16*)lds; bf16* K_lds = (bf16*)(lds + 2 * SHM_V);
  float* ws = (float*)(lds + 2 * SHM_V + 2 * SHM_K) + wid * 64; float* li_l = ws; float* al_l = ws + 32;
  float m_reg = -1e30f, l_reg = 0; f32x16 o[4] = {}; bf16x8 qr[8];
  const TQ* Qw = Qb + (long)(wid * QBLK + r32) * LDQ + hi * 8;
#pragma unroll
  for (int d0 = 0; d0 < 8; ++d0) qr[d0] = SQ::tobf(SQ::ld8(Qw + d0 * 16));
  const int sr = tid >> 4, sc = (tid & 15) * 8, vst0 = v_st(sr, sc), vst1 = v_st(32 + sr, sc);
  const int vb0 = (int)(uintptr_t)V_lds + v_rd_base(lane);
  struct { typename St::T vs0, vs1, ks0, ks1; } sr_[SDEPTH];
#define SLOAD(i, k0) do { sr_[i].vs0 = St::ld8(&Vh[(long)((k0) + sr) * LDK + sc]); sr_[i].vs1 = St::ld8(&Vh[(long)((k0) + 32 + sr) * LDK + sc]); \
    sr_[i].ks0 = St::ld8(&Kh[(long)((k0) + sr) * LDK + sc]); sr_[i].ks1 = St::ld8(&Kh[(long)((k0) + 32 + sr) * LDK + sc]); } while (0)
#define SWRITE(b, i) do { *(bf16x8*)((char*)V_lds + (b) * SHM_V + vst0) = St::tobf(sr_[i].vs0);          \
    *(bf16x8*)((char*)V_lds + (b) * SHM_V + vst1) = St::tobf(sr_[i].vs1); int kc = sc * 2;               \
    *(bf16x8*)((char*)K_lds + (b) * SHM_K + KSWZ(sr, kc)) = St::tobf(sr_[i].ks0);                       \
    *(bf16x8*)((char*)K_lds + (b) * SHM_K + KSWZ(32 + sr, kc)) = St::tobf(sr_[i].ks1); } while (0)
#define SWAIT() do { if constexpr (SDEPTH == 2) asm volatile("s_waitcnt vmcnt(4)" ::: "memory"); else asm volatile("s_waitcnt vmcnt(0)" ::: "memory"); } while (0)
#define RESC(a) do { if (__any((a) < 1.f)) { if (hi == 0) al_l[r32] = (a); asm volatile("s_waitcnt lgkmcnt(0)" ::: "memory"); \
    for (int d = 0; d < 4; ++d) for (int r = 0; r < 16; ++r) o[d][r] *= al_l[crow(r, hi)]; } } while (0)
  f32x16 pA0, pA1, pB0, pB1; float mnA, mnB, alA, alB; bf16x8 pa0, pa1, pa2, pa3; const int NT = seq / KVBLK;
  constexpr int SE = 0, SO = SDEPTH - 1;
  SLOAD(SE, 0); asm volatile("s_waitcnt vmcnt(0)" ::: "memory"); SWRITE(0, SE); __syncthreads();
  qkt(pA0, pA1, K_lds, qr, r32, hi); partialSM(pA0, pA1, m_reg, mnA, alA);
  SLOAD(SO, KVBLK); if constexpr (SDEPTH == 2) { if (2 < NT) SLOAD(SE, 2 * KVBLK); }
  SWAIT(); SWRITE(1, SO); __syncthreads();
  for (int j = 1; j + 1 < NT; j += 2) {
    SBAR(); qkt(pB0, pB1, (bf16*)((char*)K_lds + SHM_K), qr, r32, hi);
    finishSM(pA0, pA1, alA, l_reg, pa0, pa1, pa2, pa3); SBAR();
    SLOAD(SO, (j + SDEPTH) * KVBLK); SBAR();
    pv_d0(o, vb0, pa0, pa1, pa2, pa3); partialSM(pB0, pB1, m_reg, mnB, alB);
    __syncthreads(); SWAIT(); SWRITE(0, SE);
    RESC(alB); __syncthreads();
    SBAR(); qkt(pA0, pA1, K_lds, qr, r32, hi);
    finishSM(pB0, pB1, alB, l_reg, pa0, pa1, pa2, pa3); SBAR();
    if (SDEPTH == 1 || j + 3 < NT) SLOAD(SE, (j + 1 + SDEPTH) * KVBLK); SBAR();
    pv_d0(o, vb0 + (int)SHM_V, pa0, pa1, pa2, pa3); partialSM(pA0, pA1, m_reg, mnA, alA);
    __syncthreads(); SWAIT(); SWRITE(1, SO);
    RESC(alA); __syncthreads();
  }
  SBAR(); qkt(pB0, pB1, (bf16*)((char*)K_lds + SHM_K), qr, r32, hi);
  finishSM(pA0, pA1, alA, l_reg, pa0, pa1, pa2, pa3); SBAR();
  pv_d0(o, vb0, pa0, pa1, pa2, pa3); partialSM(pB0, pB1, m_reg, mnB, alB);
  __syncthreads(); RESC(alB);
  finishSM(pB0, pB1, alB, l_reg, pa0, pa1, pa2, pa3); SBAR();
  pv_d0(o, vb0 + (int)SHM_V, pa0, pa1, pa2, pa3);
  if (hi == 0) li_l[r32] = l_reg; asm volatile("s_waitcnt lgkmcnt(0)" ::: "memory");
  float rli[16];
#pragma unroll
  for (int r = 0; r < 16; ++r) rli[r] = __builtin_amdgcn_rcpf(li_l[crow(r, hi)]);
  unsigned char* Ow = Ob + (long)(wid * QBLK) * LDO;
#pragma unroll
  for (int r = 0; r < 16; ++r) { int orow = crow(r, hi);
    for (int d0 = 0; d0 < 4; ++d0) Ow[(long)orow * LDO + d0 * 32 + r32] = (unsigned char)(__builtin_amdgcn_cvt_pk_fp8_f32(o[d0][r] * rli[r], 0.f, 0, false) & 0xff); }
#undef SLOAD
#undef SWRITE
#undef SWAIT
#undef RESC
}
}

constexpr size_t WS_ROPE = WS_STAT + 512 * 1024;
__device__ __forceinline__ void rope_table(Frame& F) {
    float* R = (float*)(F.ws + WS_ROPE);
    const int i = F.vcu * NTHR + F.tid;
    if (i < 64 * 32) { const int pos = i >> 5, fi = i & 31; const float fr = powf(10000.0f, -(float)fi / 32.0f); const float ang = (float)pos * fr; R[2 * i] = cosf(ang); R[2 * i + 1] = sinf(ang); }
}
__device__ __forceinline__ v4u normrope_seg(const bf16* src, const float* g, const float* R, bool rope, int rowpos, int colpos, int lane) {
    const v4u x = *(const v4u*)(src + 8 * lane);
    float v[8] = {bf_lo(x.x), bf_hi(x.x), bf_lo(x.y), bf_hi(x.y), bf_lo(x.z), bf_hi(x.z), bf_lo(x.w), bf_hi(x.w)};
    float q = 0.f;
#pragma unroll
    for (int i = 0; i < 8; ++i) q += v[i] * v[i];
    const float rstd = 1.0f / sqrtf(row16_sum(q) * (1.0f / 128.f) + LN_EPS);
    const int d0 = 8 * (lane & 15);
    const f32x4 ga = *(const f32x4*)(g + d0), gb = *(const f32x4*)(g + d0 + 4);
#pragma unroll
    for (int i = 0; i < 4; ++i) { v[i] *= rstd * ga[i]; v[4 + i] *= rstd * gb[i]; }
    if (rope) {
        const int pos = ((lane & 15) >> 3) ? colpos : rowpos; const bool hi = (lane & 7) >= 4; const int f0 = 8 * (lane & 3);
#pragma unroll
        for (int i = 0; i < 8; ++i) { const float p = __shfl_xor(v[i], 4); const float cs = R[(pos * 32 + f0 + i) * 2], sn = R[(pos * 32 + f0 + i) * 2 + 1];
            v[i] = hi ? (p * sn + v[i] * cs) : (v[i] * cs - p * sn); }
    }
    v4u o; o.x = cvt_pk_bf16(v[0], v[1]); o.y = cvt_pk_bf16(v[2], v[3]); o.z = cvt_pk_bf16(v[4], v[5]); o.w = cvt_pk_bf16(v[6], v[7]);
    return o;
}
__device__ __forceinline__ void attn_prep_phase(Frame& F) {
    const int gw = F.vcu * NWAVES + F.wave, NGW = F.G * NWAVES;
    const float* R = (const float*)(F.ws + WS_ROPE);
    const float* qg = F.in[I_CQG]; const float* kg = F.in[I_CKG];
    for (int row = gw; row < T; row += NGW) {
        const bool lat = row < TL; const int b = lat ? (row >> 12) : ((row - TL) >> 8); const int s = lat ? (row & 4095) : 0;
        const int rp = s >> 6, cp = s & 63; const int kvrow = lat ? (b * SKV + s) : (b * SKV + SEQ + ((row - TL) & 255));
        bf16* q = (bf16*)(F.ws + WS_Z + ZAQ) + (size_t)row * 2048;
#pragma unroll
        for (int p = 0; p < 4; ++p) { const v4u o = normrope_seg(q + 512 * p, qg, R, lat, rp, cp, F.lane); *(v4u*)(q + 512 * p + 8 * F.lane) = o; }
        const bf16* k = (const bf16*)(F.ws + WS_Z + ZAK) + (size_t)row * 512; const bf16* v = (const bf16*)(F.ws + WS_Z + ZAV) + (size_t)row * 512;
        const v4u ko = normrope_seg(k, kg, R, lat, rp, cp, F.lane);
        *(v4u*)((bf16*)(F.ws + WS_Z + ZKC) + (size_t)kvrow * 512 + 8 * F.lane) = ko;
        *(v4u*)((bf16*)(F.ws + WS_Z + ZVC) + (size_t)kvrow * 512 + 8 * F.lane) = *(const v4u*)(v + 8 * F.lane);
    }
}
__device__ __forceinline__ void attn_phase(Frame& F, char* lds, bool need_ctx) {
    const bf16* Q = (const bf16*)(F.ws + WS_Z + ZAQ); const bf16* KC = (const bf16*)(F.ws + WS_Z + ZKC); const bf16* VC = (const bf16*)(F.ws + WS_Z + ZVC);
    unsigned char* O = F.ws + WS_H;
    const int nunits = 2048 + (need_ctx ? 128 : 0);
    for (int u = F.vcu; u < nunits; u += F.G) {
        const bf16 *qp, *kp, *vp; unsigned char* op; int seq;
        if (u < 2048) { const int qb = u & 15, h = (u >> 4) & 15, b = u >> 8; const size_t qrow = (size_t)b * SEQ + qb * 256;
            qp = Q + qrow * 2048 + h * 128; kp = KC + (size_t)b * SKV * 512 + (h >> 2) * 128; vp = VC + (size_t)b * SKV * 512 + (h >> 2) * 128; op = O + qrow * 2048 + h * 128; seq = SKV;
        } else { const int uu = u - 2048, h = uu & 15, b = uu >> 4; const size_t qrow = (size_t)TL + b * CL;
            qp = Q + qrow * 2048 + h * 128; kp = KC + ((size_t)b * SKV + SEQ) * 512 + (h >> 2) * 128; vp = VC + ((size_t)b * SKV + SEQ) * 512 + (h >> 2) * 128; op = O + qrow * 2048 + h * 128; seq = CL; }
        int tid_l = threadIdx.x; asm volatile("" : "+v"(tid_l));
        att::attn_dense_body<bf16>(qp, kp, vp, op, seq, lds, tid_l);
        __syncthreads();
    }
}

#ifndef MK_N_LAUNCHES
#define MK_N_LAUNCHES 1
#endif
constexpr int NPH = 2 + 8 * DEPTH;
struct Args { const float* in[28]; float* out; unsigned char* ws; int ph_lo, ph_hi; };

typedef pg8::EpiSeg<0> EpiPlain;
__device__ __forceinline__ EpiPlain epi_plain(bf16* o, int ld) { EpiPlain E; E.base = (unsigned char*)o; E.ld = ld; E.bias = nullptr; E.gates = nullptr; E.oscale = 1.0f / WSCALE; return E; }


__global__ void __launch_bounds__(NTHR, 2) fwd_kernel(Args args) {
    extern __shared__ __attribute__((aligned(16))) unsigned char lds_raw[];
    Frame F;
    F.lds = (LAS unsigned char*)lds_raw;
    F.tid = threadIdx.x; F.lane = F.tid & 63; F.wave = __builtin_amdgcn_readfirstlane(F.tid >> 6);
    F.G = gridDim.x; { const int bx = blockIdx.x; F.vcu = (F.G % 8 == 0) ? (bx % 8) * (F.G / 8) + bx / 8 : bx; }
    typedef const Args __attribute__((address_space(4)))* KArgs;
    KArgs ka = (KArgs)__builtin_amdgcn_kernarg_segment_ptr();
    F.in = ka->in; F.out = ka->out; F.ws = ka->ws;
    volatile LAS unsigned* MISC = (volatile LAS unsigned*)(F.lds + MISC_OFF);
    for (int u = F.tid; u < (LDS_BYTES - MISC_OFF) / 4; u += NTHR) MISC[u] = 0u;
    __syncthreads();
    const int lo = ka->ph_lo, hi = ka->ph_hi;
    unsigned* barw = (unsigned*)(F.ws + WS_CTL) + CW_BAR;
    XcdBarrier bar; bar.bar = barw; bar.x = 0; bar.st = nullptr;
    if (hi - lo > 1) bar = xcd_barrier_post(barw, MISC + 8);
#ifdef ONLY_PHASE
#define IN(k) ((k) == ONLY_PHASE && lo <= (k) && (k) < hi)
#else
#define IN(k) (lo <= (k) && (k) < hi)
#endif
#define SEAM(k) do { if (IN(k) && IN((k) + 1)) xcd_barrier(bar); } while (0)
#define RELANE() do { int t_ = threadIdx.x; asm volatile("" : "+v"(t_)); F.tid = t_; F.lane = t_ & 63; KArgs k_ = ka; asm volatile("" : "+s"(k_)); F.in = k_->in; F.out = k_->out; F.ws = k_->ws; } while (0)
#define WT (F.ws + WS_WT)
#define Hb ((bf16*)(F.ws + WS_H))
#define Yb ((bf16*)(F.ws + WS_Y))
#define Zb ((bf16*)(F.ws + WS_Z))

    if (IN(0)) { RELANE(); p0_prologue(F); rope_table(F); } SEAM(0);
    if (IN(1)) { RELANE(); p0b_modulate(F); } SEAM(1);

#define GEMM_PHASE16(EPI, Aptr, Bptr, M_, N_, K_) do { pg8::Gemm g{(const bf16*)(Aptr), (const bf16*)(Bptr), (M_), (N_), (K_)}; pg8::StaticOrder S; S.init((M_), (N_), F.G, (int)blockIdx.x); \
        pg8::gemm_phase<false>(F.lds, g, S, (EPI)); } while (0)
#define GEMM_PHASE(EPI, Aptr, Bptr, M_, N_, K_) do { pg8::Gemm g{(const bf16*)(Aptr), (const bf16*)(Bptr), (M_), (N_), (K_) / 2}; pg8::StaticOrder S; S.init((M_), (N_), F.G, (int)blockIdx.x); \
        pg8::gemm_phase<true>(F.lds, g, S, (EPI)); } while (0)
#define PEER_PHASES(L, PB, M_) do { \
        if (IN((PB) + 4)) { RELANE(); ln1_phase<L>(F, (M_)); } SEAM((PB) + 4); \
        if (IN((PB) + 5)) { RELANE(); EpiPlain E = epi_plain(Zb, 2048); \
            if ((PQ_FP8_MASK >> (L)) & 1) { GEMM_PHASE(E, Hb, WT + WT_PQ + (size_t)(L) * D * D * 2, (M_), 2048, 2048); } \
            else { E.oscale = 1.0f; GEMM_PHASE16(E, Yb, WT + WT_PQ + (size_t)(L) * D * D * 2, (M_), 2048, 2048); } } SEAM((PB) + 5); \
        if (IN((PB) + 6)) { RELANE(); peer_topk_phase<L>(F, (M_)); } SEAM((PB) + 6); \
        if (IN((PB) + 7)) { RELANE(); peer_u_phase<L>(F, (M_)); if (hi - lo > 1) xcd_barrier(bar); RELANE(); peer_v_phase<L>(F, (M_)); } SEAM((PB) + 7); } while (0)
#define MLSTM_PHASES(L, PB, M_) do { \
        if (IN((PB) + 0)) { RELANE(); pg8::EpiSeg<1> E; E.base = F.ws + WS_Z; E.ld = 0; E.bias = nullptr; E.gates = (float*)(F.ws + WS_GATE); E.oscale = 1.0f / WSCALE; \
            GEMM_PHASE(E, Hb, WT + WT_AIN + (size_t)((L) / 3) * A_INP * D, T, A_INP, 2048); } SEAM((PB) + 0); \
        if (IN((PB) + 1)) { RELANE(); mlstm_scan_phase<L>(F); } SEAM((PB) + 1); \
        if (IN((PB) + 2)) { RELANE(); mlstm_post_phase<L>(F, (M_)); } SEAM((PB) + 2); \
        if (IN((PB) + 3)) { RELANE(); EpiPlain E = epi_plain(Yb, 2048); GEMM_PHASE(E, F.ws + WS_Z + ZG, WT + WT_AOUT + (size_t)((L) / 3) * D * D, (M_), 2048, 2048); } SEAM((PB) + 3); } while (0)

    MLSTM_PHASES(0, 2, T);
    PEER_PHASES(0, 2, T);
    if (IN(10)) { RELANE(); pg8::EpiSeg<2> E; E.base = F.ws + WS_Z; E.ld = 0; E.bias = F.in[I_BBIN]; E.gates = nullptr; E.oscale = 1.0f / WSCALE; GEMM_PHASE(E, Hb, WT + WT_BIN, T, 8192, 2048); } SEAM(10);
    if (IN(11)) { RELANE(); gmlp_stats_phase(F, T); } SEAM(11);
    if (IN(12)) { RELANE(); gmlp_spatial_phase(F, T); } SEAM(12);
    if (IN(13)) { RELANE(); EpiPlain E = epi_plain(Yb, 2048); GEMM_PHASE(E, Hb, WT + WT_BOUT, T, 2048, 4096); } SEAM(13);
    PEER_PHASES(1, 10, T);
    if (IN(18)) { RELANE(); pg8::EpiSeg<3> E; E.base = F.ws + WS_Z; E.ld = 0; E.bias = nullptr; E.gates = nullptr; E.oscale = 1.0f / WSCALE; GEMM_PHASE(E, Hb, WT + WT_CQKV, T, C_QKV, 2048); } SEAM(18);
    if (IN(19)) { RELANE(); attn_prep_phase(F); } SEAM(19);
    if (IN(20)) { RELANE(); attn_phase(F, (char*)lds_raw, true); } SEAM(20);
    if (IN(21)) { RELANE(); EpiPlain E = epi_plain(Yb, 2048); GEMM_PHASE(E, Hb, WT + WT_COUT, T, 2048, 2048); } SEAM(21);
    PEER_PHASES(2, 18, T);
    MLSTM_PHASES(3, 26, TL);
    PEER_PHASES(3, 26, TL);
#undef IN
#undef SEAM
#undef WT
#undef Hb
#undef Yb
#undef Zb
}


extern "C" void kernel_launch(void* const* d_in, const int* in_sizes, int n_in, void* d_out, int out_size, void* d_ws, size_t ws_size, hipStream_t stream) {
    static int grid = 0;
    if (grid == 0) {
        if (n_in != 28 || out_size != TL * D || ws_size < WS_END) { fprintf(stderr, "kernel_launch: unexpected shapes: n_in %d out %d ws %zu (need %zu)\n", n_in, out_size, ws_size, (size_t)WS_END); grid = -1; return; }
        int dev = 0, cus = 0, per_cu = 0;
        if (hipGetDevice(&dev) != hipSuccess || hipDeviceGetAttribute(&cus, hipDeviceAttributeMultiprocessorCount, dev) != hipSuccess) { grid = -1; return; }
        if (hipFuncSetAttribute((const void*)fwd_kernel, hipFuncAttributeMaxDynamicSharedMemorySize, LDS_BYTES) != hipSuccess) { fprintf(stderr, "kernel_launch: hipFuncSetAttribute failed\n"); grid = -1; return; }
        if (hipOccupancyMaxActiveBlocksPerMultiprocessor(&per_cu, (const void*)fwd_kernel, NTHR, LDS_BYTES) != hipSuccess || per_cu < 1) { fprintf(stderr, "kernel_launch: occupancy query says %d\n", per_cu); }
        (void)hipGetLastError();
        grid = cus;
    }
    if (grid < 0) return;
    if (hipMemsetAsync((char*)d_ws + WS_CTL, 0, CTL_ZERO_BYTES, stream) != hipSuccess) return;
    Args a{};
    for (int i = 0; i < 28; ++i) a.in[i] = (const float*)d_in[i];
    a.out = (float*)d_out; a.ws = (unsigned char*)d_ws;
#if MK_N_LAUNCHES == 1
    a.ph_lo = 0; a.ph_hi = NPH;
    hipLaunchKernelGGL(fwd_kernel, dim3(grid), dim3(NTHR), LDS_BYTES, stream, a);
#else
    for (int k = 0; k < NPH; ++k) { a.ph_lo = k; a.ph_hi = k + 1; hipLaunchKernelGGL(fwd_kernel, dim3(grid), dim3(NTHR), LDS_BYTES, stream, a); }
#endif
    const hipError_t le = hipPeekAtLastError();
    if (le != hipSuccess) fprintf(stderr, "kernel_launch: launch failed: %s\n", hipGetErrorName(le));
}
```

```cpp
#include <hip/hip_runtime.h>
#include <cstdio>
#include <cstdint>

#define GAS __attribute__((address_space(1)))
#define LAS __attribute__((address_space(3)))
typedef unsigned short bf16;
typedef unsigned v4u __attribute__((ext_vector_type(4)));
typedef unsigned v2u __attribute__((ext_vector_type(2)));
typedef float f32x4 __attribute__((ext_vector_type(4)));
typedef float f32x2 __attribute__((ext_vector_type(2)));
typedef short bf16x8 __attribute__((ext_vector_type(8)));
typedef short s16x4 __attribute__((ext_vector_type(4)));
typedef int v8i_t __attribute__((ext_vector_type(8)));
typedef int v4i_t __attribute__((ext_vector_type(4)));
#define LDS_WAIT() asm volatile("s_waitcnt lgkmcnt(0)" ::: "memory")
#define VM_WAIT() asm volatile("s_waitcnt vmcnt(0)" ::: "memory")

constexpr int D = 2048, NB = 8, SEQ = 4096, CL = 256, DEPTH = 4;
constexpr int TL = NB * SEQ, TC = NB * CL, T = TL + TC;
constexpr int NMOD = 6 * D;
constexpr float ALPHA = 1.681792830507429f;
constexpr float LN_EPS = 1e-6f;
constexpr int A_HEADS = 4, A_DV = 512, A_DK = 256, A_CHUNK = 128, A_IN = 6160, A_INP = 6400;
constexpr int B_INNER = 4096, B_GROUPS = 8;
constexpr int C_HEADS = 16, C_KV = 4, C_HD = 128, C_QKV = 3072, SKV = SEQ + CL;
constexpr int P_HEADS = 8, P_NK = 128, P_TOPK = 16, P_E = 16384;
constexpr int NWAVES = 8, NTHR = 512;

constexpr size_t MiB = 1u << 20;
constexpr size_t WS_CTL = 0, CTL_ZERO_BYTES = 1 * MiB;
constexpr size_t WS_MOD = 1 * MiB;
constexpr size_t WS_STAT = 3 * MiB;
constexpr size_t WS_GATE = 4 * MiB;
constexpr size_t WS_K12 = 7 * MiB;
constexpr size_t WS_WS = 8 * MiB;
constexpr size_t WS_WT = 9 * MiB;
constexpr size_t WT_AIN = 0, WT_AOUT = WT_AIN + (size_t)2 * A_INP * D, WT_BIN = WT_AOUT + (size_t)2 * D * D, WT_BOUT = WT_BIN + (size_t)8192 * D,
                 WT_CQKV = WT_BOUT + (size_t)D * 4096, WT_COUT = WT_CQKV + (size_t)C_QKV * D, WT_PQ = WT_COUT + (size_t)D * D, WT_END = WT_PQ + (size_t)4 * D * D * 2;
constexpr int PQ_FP8_MASK = 0x3;
constexpr float WSCALE = 64.0f;
constexpr size_t WS_PU8 = 192 * MiB;
constexpr size_t WS_PV8 = WS_PU8 + (size_t)4 * P_E * D;
constexpr size_t WS_SC = WS_PV8 + (size_t)4 * P_E * D;
constexpr size_t WS_X = WS_SC + 1 * MiB;
constexpr size_t WS_GP = WS_X + (size_t)T * D * 2;
constexpr size_t WS_H = WS_X + (size_t)T * D * 4;
constexpr size_t WS_Y = WS_H + (size_t)T * D * 2;
constexpr size_t WS_Z = WS_Y + (size_t)T * D * 2;
constexpr size_t WS_IDX = WS_Z + (size_t)T * 8192 * 2;
constexpr size_t WS_PG = WS_IDX + (size_t)T * 128 * 4;
constexpr size_t WS_END = WS_PG + (size_t)T * 128 * 4;
static_assert(WS_WT + WT_END <= WS_PU8, "weights fit");
constexpr size_t ZQ = 0, ZK = (size_t)T * 1024 * 2, ZV = ZK + (size_t)T * 1024 * 2, ZO = ZV + (size_t)T * 2048 * 2, ZG = 0;
constexpr size_t ZU = 0, ZVV = (size_t)T * 4096 * 2;
constexpr size_t ZAQ = 0, ZAK = (size_t)T * 2048 * 2, ZAV = ZAK + (size_t)T * 512 * 2, ZKC = ZAV + (size_t)T * 512 * 2, ZVC = ZKC + (size_t)NB * SKV * 512 * 2;
constexpr int CW_BAR = 4096;

constexpr int LDS_BYTES = 155648;
constexpr int MISC_OFF = 151552;

typedef __bf16 bf16x2_t __attribute__((ext_vector_type(2)));
__device__ __forceinline__ unsigned cvt_pk_bf16(float lo, float hi) { const f32x2 v = {lo, hi}; return __builtin_bit_cast(unsigned, __builtin_convertvector(v, bf16x2_t)); }
__device__ __forceinline__ unsigned pk4_fp8(float a, float b, float c, float d) { int w = __builtin_amdgcn_cvt_pk_fp8_f32(a, b, 0, false); return (unsigned)__builtin_amdgcn_cvt_pk_fp8_f32(c, d, w, true); }
typedef float f32x16_t __attribute__((ext_vector_type(16)));
__device__ __forceinline__ f32x4 zero4() { f32x4 z = {0.f, 0.f, 0.f, 0.f}; asm volatile("" : "+v"(z)); return z; }
__device__ __forceinline__ f32x16_t zero16() { f32x16_t z = {}; asm volatile("" : "+v"(z)); return z; }
__device__ __forceinline__ float bf_lo(unsigned u) { return __uint_as_float(u << 16); }
__device__ __forceinline__ float bf_hi(unsigned u) { return __uint_as_float(u & 0xffff0000u); }
__device__ __forceinline__ float bf2f(bf16 b) { return __uint_as_float(((unsigned)b) << 16); }
__device__ __forceinline__ float wave_sum(float v) {
#pragma unroll
    for (int o = 1; o < 64; o <<= 1) v += __shfl_xor(v, o);
    return v;
}
__device__ __forceinline__ float wave_max(float v) {
#pragma unroll
    for (int o = 1; o < 64; o <<= 1) v = fmaxf(v, __shfl_xor(v, o));
    return v;
}
__device__ __forceinline__ float fast_exp(float x) { return __builtin_amdgcn_exp2f(x * 1.4426950408889634f); }
__device__ __forceinline__ float gelu_tanh(float x) {
    const float u = 0.7978845608028654f * (x + 0.044715f * x * x * x);
    const float e = __builtin_amdgcn_exp2f(-2.0f * 1.4426950408889634f * u);
    return x * __builtin_amdgcn_rcpf(1.0f + e);
}
__device__ __forceinline__ float silu(float x) { return x / (1.0f + __expf(-x)); }

#define XB_TMO      128
#define XB_XCNT(j)  (256  + 64 * (j))
#define XB_XSUB(j)  (1280 + 64 * (j))
#define XB_XGEN(j)  (2304 + 64 * (j))
#define XB_TOP      3328
#define XB_TOPGEN   3392
#define XCD_BAR_WORDS 3456
#define XB_SPIN_CAP (1u << 22)

__device__ __forceinline__ unsigned xb_ld(unsigned* p)              { return __hip_atomic_load(p, __ATOMIC_RELAXED, __HIP_MEMORY_SCOPE_AGENT); }
__device__ __forceinline__ unsigned xb_add(unsigned* p, unsigned v) { return __hip_atomic_fetch_add(p, v, __ATOMIC_RELAXED, __HIP_MEMORY_SCOPE_AGENT); }
__device__ __forceinline__ unsigned xb_xcc_id() { return (unsigned)__builtin_amdgcn_s_getreg((3 << 11) | 20) & 0xFu; }
#define XB_SPIN(cond, bar) do { unsigned _sp = 0; while (cond) { __builtin_amdgcn_s_sleep(1); \
    if ((++_sp & 255u) == 0u) { if (xb_ld(&(bar)[XB_TMO])) break; if (_sp > XB_SPIN_CAP) { atomicAdd(&(bar)[XB_TMO], 1u); break; } } } } while (0)

struct XcdBarrier { unsigned* bar; unsigned x; volatile LAS unsigned* st; };
__device__ __forceinline__ XcdBarrier xcd_barrier_post(unsigned* bar, volatile LAS unsigned* st) {
    XcdBarrier b; b.bar = bar; b.x = xb_xcc_id(); b.st = st;
    if (threadIdx.x == 0) (void)xb_add(&bar[XB_XCNT(b.x)], 1u);
    return b;
}
__device__ __forceinline__ void xcd_barrier_complete(unsigned* bar, unsigned x, unsigned& nloc, unsigned& nx) {
    const unsigned G = gridDim.x * gridDim.y * gridDim.z;
    unsigned sum, cnt, mine, sp = 0u;
    for (;;) {
        sum = 0u; cnt = 0u; mine = 0u;
#pragma unroll
        for (unsigned j = 0; j < 16; ++j) { const unsigned c = xb_ld(&bar[XB_XCNT(j)]); sum += c; cnt += (c > 0u) ? 1u : 0u; mine = (j == x) ? c : mine; }
        if (sum == G) break;
        __builtin_amdgcn_s_sleep(1);
        if ((++sp & 255u) == 0u) { if (xb_ld(&bar[XB_TMO])) break; if (sp > XB_SPIN_CAP) { atomicAdd(&bar[XB_TMO], 1u); break; } }
    }
    nloc = mine > 0u ? mine : 1u; nx = cnt > 0u ? cnt : 1u;
}
__device__ __forceinline__ void xcd_barrier(const XcdBarrier& b) {
    asm volatile("s_waitcnt vmcnt(0)" ::: "memory");
    __syncthreads();
    if (threadIdx.x == 0) {
        unsigned* bar = b.bar;
        __builtin_amdgcn_s_waitcnt(0);
        unsigned nloc = b.st[0], nx = b.st[1];
        if (nloc == 0u) { xcd_barrier_complete(bar, b.x, nloc, nx); b.st[0] = nloc; b.st[1] = nx; }
        const unsigned old = xb_add(&bar[XB_XSUB(b.x)], 1u);
        const unsigned gen = old / nloc;
        if (old + 1u == (gen + 1u) * nloc) {
            __builtin_amdgcn_fence(__ATOMIC_RELEASE, "agent");
            asm volatile("s_waitcnt vmcnt(0)" ::: "memory");
            const unsigned og = xb_add(&bar[XB_TOP], 1u);
            const unsigned tg = og / nx;
            if (og + 1u == (tg + 1u) * nx) xb_add(&bar[XB_TOPGEN], 1u);
            else XB_SPIN(xb_ld(&bar[XB_TOPGEN]) == tg, bar);
            __builtin_amdgcn_fence(__ATOMIC_ACQUIRE, "agent");
            xb_add(&bar[XB_XGEN(b.x)], 1u);
            asm volatile("s_waitcnt vmcnt(0)" ::: "memory");
        } else {
            XB_SPIN(xb_ld(&bar[XB_XGEN(b.x)]) == gen, bar);
            __builtin_amdgcn_fence(__ATOMIC_ACQUIRE, "agent");
            asm volatile("s_waitcnt vmcnt(0)" ::: "memory");
        }
    }
    __syncthreads();
}

namespace pg8 {
#define PG8_LAS __attribute__((address_space(3)))
typedef unsigned short bf16_t;
typedef unsigned u32x4 __attribute__((ext_vector_type(4)));
using ::v4i_t; using ::v8i_t;
constexpr int BM = 256, BK = 64, HALF = 128, HTB = HALF * BK * 2, STAGE_BYTES = 8 * HTB, NXCD = 8, WGM = 8;
__host__ __device__ __forceinline__ int lds_byte(int r, int c) { const int st = (r >> 4) * 2 + (c >> 5), rr = r & 15, cc = c & 31, ob = rr * 64 + cc * 2; return st * 1024 + (ob ^ (((ob >> 9) & 1) << 5)); }
__host__ __device__ __forceinline__ void stage_rc(int b, int& R, int& C) { const int st = b / 1024, sb = b % 1024, swz = sb ^ (((sb >> 9) & 1) << 5); R = (st >> 1) * 16 + swz / 64; C = (st & 1) * 32 + (swz % 64) / 2; }
__host__ __device__ __forceinline__ int perm32(int rho) { const int n = rho >> 4, i = rho & 15; return 8 * (i >> 2) + 4 * n + (i & 3); }
struct Unit { int pm, pn; };
struct Gemm { const bf16_t* A; const bf16_t* Bt; int M, N, K; };
struct StaticOrder {
    int nM, nN, nwg, G, c;
    __host__ __device__ void init(int M, int N, int G_, int c_) { nM = M / BM; nN = N / BM; nwg = nM * nN; G = G_; c = c_; }
    __host__ __device__ bool next(int i, Unit& u) const {
        const long L = (long)i * G + c; if (L >= nwg) return false;
        int wgid = (int)L; { const int q = nwg / NXCD, r = nwg % NXCD, xcd = wgid % NXCD, off = wgid / NXCD; wgid = (xcd < r ? xcd * (q + 1) : r * (q + 1) + (xcd - r) * q) + off; }
        const int nig = WGM * nN, gid = wgid / nig, fm = gid * WGM, gsz = (nM - fm) < WGM ? (nM - fm) : WGM;
        u.pm = fm + ((wgid % nig) % gsz); u.pn = (wgid % nig) / gsz; return true;
    }
    __device__ __forceinline__ void a_ready(const Unit&) const {}
    __device__ __forceinline__ void done(const Unit&) const {}
};
template <int MODE> struct EpiSeg {
    static constexpr bool PERM = true, AFTER_DRAIN = false;
    unsigned char* base; int ld; const float* bias; float* gates; float oscale;
    __device__ __forceinline__ void operator()(const f32x4 (&acc)[2][2][4][2], const Unit& u, int wr, int wc, int fr, int fq) const {
        const int row0 = u.pm * BM + wr * 64 + fr;
        if (MODE == 1 && u.pn >= 24) {
            if (wc == 0 && fq < 2) {
#pragma unroll
                for (int ai = 0; ai < 2; ++ai)
#pragma unroll
                    for (int m = 0; m < 4; ++m) { float* rp = gates + (size_t)(row0 + ai * HALF + m * 16) * 16 + 8 * fq;
                        *(f32x4*)(rp) = acc[ai][0][m][0] * oscale; *(f32x4*)(rp + 4) = acc[ai][0][m][1] * oscale; }
            }
        } else {
        size_t off = 0; int ldc = ld, tb = 0;
        if (MODE == 1) { ldc = u.pn < 8 ? 1024 : 2048; tb = u.pn < 4 ? 0 : u.pn < 8 ? 4 : u.pn < 16 ? 8 : 16; off = u.pn < 4 ? ZQ : u.pn < 8 ? ZK : u.pn < 16 ? ZV : ZO; }
        if (MODE == 2) { ldc = 4096; tb = u.pn < 16 ? 0 : 16; off = u.pn < 16 ? ZU : ZVV; }
        if (MODE == 3) { ldc = u.pn < 8 ? 2048 : 512; tb = u.pn < 8 ? 0 : u.pn < 10 ? 8 : 10; off = u.pn < 8 ? ZAQ : u.pn < 10 ? ZAK : ZAV; }
        bf16_t* ob = (bf16_t*)(base + off);
        const int col0 = (u.pn - tb) * BM + wc * 32 + 8 * fq, bcol0 = u.pn * BM + wc * 32 + 8 * fq;
        f32x4 bv[2][2];
#pragma unroll
        for (int bj = 0; bj < 2; ++bj)
#pragma unroll
            for (int n = 0; n < 2; ++n) bv[bj][n] = (MODE == 2) ? *(const f32x4*)(bias + bcol0 + bj * HALF + 4 * n) : (f32x4){0.f, 0.f, 0.f, 0.f};
        const int lid = fr + 16 * fq, frp = 4 * (lid >> 4) + ((lid >> 2) & 3), fqp = lid & 3, srcl = frp + 16 * fqp;
        const int row0p = row0 - fr + frp, col0p = col0 - 8 * fq + 8 * fqp;
#pragma unroll
        for (int ai = 0; ai < 2; ++ai)
#pragma unroll
            for (int m = 0; m < 4; ++m) { bf16_t* rowp = ob + (size_t)(row0p + ai * HALF + m * 16) * ldc + col0p;
#pragma unroll
                for (int bj = 0; bj < 2; ++bj) { f32x4 v0 = acc[ai][bj][m][0] * oscale + bv[bj][0], v1 = acc[ai][bj][m][1] * oscale + bv[bj][1];
                    if (MODE == 2) {
#pragma unroll
                        for (int j = 0; j < 4; ++j) { v0[j] = gelu_tanh(v0[j]); v1[j] = gelu_tanh(v1[j]); } }
                    u32x4 w; w.x = (unsigned)__shfl((int)cvt_pk_bf16(v0[0], v0[1]), srcl); w.y = (unsigned)__shfl((int)cvt_pk_bf16(v0[2], v0[3]), srcl);
                    w.z = (unsigned)__shfl((int)cvt_pk_bf16(v1[0], v1[1]), srcl); w.w = (unsigned)__shfl((int)cvt_pk_bf16(v1[2], v1[3]), srcl);
                    *(u32x4*)(rowp + bj * HALF) = w; } }
        }
    }
};
template <bool FP8, class Epi, class Sched>
__device__ __forceinline__ void gemm_phase(PG8_LAS unsigned char* lds, const Gemm g, const Sched& S, const Epi& E) {
    const int tid = threadIdx.x, wid = __builtin_amdgcn_readfirstlane(tid >> 6), lane = tid & 63, wr = wid >> 2, wc = wid & 3, fr = lane & 15, fq = lane >> 4;
    const int K = g.K, nt = K / BK;
    unsigned voffA[2], voffB[2];
#pragma unroll
    for (int i = 0; i < 2; ++i) { int R, C; stage_rc(tid * 16 + i * 8192, R, C); const int Rb = Epi::PERM ? ((R & ~31) + perm32(R & 31)) : R;
        voffA[i] = (unsigned)(R * K + C) * 2u; voffB[i] = (unsigned)(Rb * K + C) * 2u; }
    const size_t kstep = (size_t)(BK * 2);
    const size_t hstep = (size_t)HALF * K * 2;
    const size_t tstep = 2 * hstep;
    const unsigned ldsw = (unsigned)wid * 1024u;
    const int aoff = lds_byte(wr * 64 + fr, fq * 8), boff = lds_byte(wc * 32 + fr, fq * 8);
#define PG8_SA(b, h) (((b) * 2 + (h)) * HTB)
#define PG8_SB(b, h) ((4 + (b) * 2 + (h)) * HTB)
#define PG8_STAGE(bufoff, gbase, voff) do { _Pragma("unroll") for (int _i = 0; _i < 2; ++_i) \
        __builtin_amdgcn_global_load_lds((const unsigned*)((const char*)(gbase) + (voff)[_i]), (PG8_LAS unsigned*)(lds + (bufoff) + ldsw + _i * 8192), 16, 0, 0); } while (0)
#define PG8_LDH(dst8, addr) do { const v4i_t lo_ = *(const PG8_LAS v4i_t*)(addr), hi_ = *(const PG8_LAS v4i_t*)((addr) + 1024); dst8 = __builtin_shufflevector(lo_, hi_, 0, 1, 2, 3, 4, 5, 6, 7); } while (0)
#define PG8_LDA(dst, b, h) do { _Pragma("unroll") for (int m = 0; m < 4; ++m) PG8_LDH(dst[m], lds + PG8_SA(b, h) + aoff + m * 2048); } while (0)
#define PG8_LDB(dst, b, h) do { _Pragma("unroll") for (int n = 0; n < 2; ++n) PG8_LDH(dst[n], lds + PG8_SB(b, h) + boff + n * 2048); } while (0)
#define PG8_HALF(v8, k) __builtin_bit_cast(bf16x8, __builtin_shufflevector(v8, v8, 4 * (k), 4 * (k) + 1, 4 * (k) + 2, 4 * (k) + 3))
#define PG8_MMA(ai, bj, At, Bt) do { __builtin_amdgcn_s_setprio(1); _Pragma("unroll") for (int m = 0; m < 4; ++m) _Pragma("unroll") for (int n = 0; n < 2; ++n) { \
        acc[ai][bj][m][n] = __builtin_amdgcn_mfma_f32_16x16x32_bf16(PG8_HALF(Bt[n], 0), PG8_HALF(At[m], 0), acc[ai][bj][m][n], 0, 0, 0); \
        acc[ai][bj][m][n] = __builtin_amdgcn_mfma_f32_16x16x32_bf16(PG8_HALF(Bt[n], 1), PG8_HALF(At[m], 1), acc[ai][bj][m][n], 0, 0, 0); } __builtin_amdgcn_s_setprio(0); } while (0)
#define PG8_MMA8(ai, bj, At, Bt) do { __builtin_amdgcn_s_setprio(1); _Pragma("unroll") for (int m = 0; m < 4; ++m) _Pragma("unroll") for (int n = 0; n < 2; ++n) \
        asm volatile("v_mfma_scale_f32_16x16x128_f8f6f4 %0, %1, %2, %0, %3, %3 op_sel_hi:[0,0,0]" : "+v"(acc[ai][bj][m][n]) : "v"(Bt[n]), "v"(At[m]), "v"(mxs)); __builtin_amdgcn_s_setprio(0); } while (0)
#define PG8_MMA8_DRAIN() asm volatile("s_nop 15\n\ts_nop 15" ::: "memory")
#define PG8_WAIT_V(n) asm volatile("s_waitcnt vmcnt(" #n ")" ::: "memory")
#define PG8_WAIT_L(n) asm volatile("s_waitcnt lgkmcnt(" #n ")" ::: "memory")
#define PG8_BAR __builtin_amdgcn_s_barrier()
#define PG8_SCHED __builtin_amdgcn_sched_barrier(0)
    Unit cur, nxt; int ui = 0;
    if (!S.next(0, cur)) return;
    f32x4 acc[2][2][4][2];
#pragma unroll
    for (int a = 0; a < 2; ++a)
#pragma unroll
        for (int b = 0; b < 2; ++b)
#pragma unroll
            for (int m = 0; m < 4; ++m)
#pragma unroll
                for (int n = 0; n < 2; ++n) acc[a][b][m][n] = (f32x4){0.f, 0.f, 0.f, 0.f};
    v8i_t At[4], B0[2], B1[2]; int mxs = 0x7f7f7f7f; asm volatile("" : "+v"(mxs));
    const char* cA = (const char*)g.A + (size_t)cur.pm * tstep; const char* cB = (const char*)g.Bt + (size_t)cur.pn * tstep;
    S.a_ready(cur);
    PG8_STAGE(PG8_SB(0, 0), cB, voffB); PG8_STAGE(PG8_SA(0, 0), cA, voffA); PG8_STAGE(PG8_SB(0, 1), cB + hstep, voffB); PG8_STAGE(PG8_SA(0, 1), cA + hstep, voffA);
    if (wr == 1) PG8_BAR;
    PG8_WAIT_V(4); PG8_BAR;
    PG8_STAGE(PG8_SB(1, 0), cB + kstep, voffB); PG8_STAGE(PG8_SA(1, 0), cA + kstep, voffA); PG8_STAGE(PG8_SB(1, 1), cB + hstep + kstep, voffB);
    PG8_WAIT_V(6); PG8_BAR;
    for (;;) {
        const bool has_next = S.next(ui + 1, nxt);
        const char* nA = has_next ? (const char*)g.A + (size_t)nxt.pm * tstep : cA; const char* nB = has_next ? (const char*)g.Bt + (size_t)nxt.pn * tstep : cB;
        for (int t = 0; t < nt; t += 2) {
            const bool last = (t == nt - 2);
            const char* a1 = cA + (size_t)(t + 1) * kstep;
            const char* a2 = last ? nA : cA + (size_t)(t + 2) * kstep; const char* b2 = last ? nB : cB + (size_t)(t + 2) * kstep;
            const char* a3 = a2 + kstep; const char* b3 = b2 + kstep;
            if (last && has_next) S.a_ready(nxt);
            PG8_LDB(B0, 0, 0); PG8_SCHED; PG8_LDA(At, 0, 0); PG8_STAGE(PG8_SA(1, 1), a1 + hstep, voffA);
            PG8_WAIT_L(8); PG8_BAR; PG8_WAIT_L(0); do { if constexpr (FP8) PG8_MMA8(0, 0, At, B0); else PG8_MMA(0, 0, At, B0); } while (0); PG8_BAR; PG8_SCHED;
            PG8_LDB(B1, 0, 1); PG8_STAGE(PG8_SB(0, 0), b2, voffB);
            PG8_BAR; PG8_WAIT_L(0); do { if constexpr (FP8) PG8_MMA8(0, 1, At, B1); else PG8_MMA(0, 1, At, B1); } while (0); PG8_BAR;
            PG8_LDA(At, 0, 1); PG8_STAGE(PG8_SA(0, 0), a2, voffA);
            PG8_BAR; PG8_WAIT_L(0); do { if constexpr (FP8) PG8_MMA8(1, 0, At, B0); else PG8_MMA(1, 0, At, B0); } while (0); PG8_BAR; PG8_SCHED;
            PG8_STAGE(PG8_SB(0, 1), b2 + hstep, voffB);
            PG8_WAIT_V(6); PG8_BAR; do { if constexpr (FP8) PG8_MMA8(1, 1, At, B1); else PG8_MMA(1, 1, At, B1); } while (0); PG8_BAR;
            PG8_LDB(B0, 1, 0); PG8_SCHED; PG8_LDA(At, 1, 0); PG8_STAGE(PG8_SA(0, 1), a2 + hstep, voffA);
            PG8_WAIT_L(8); PG8_BAR; PG8_WAIT_L(0); do { if constexpr (FP8) PG8_MMA8(0, 0, At, B0); else PG8_MMA(0, 0, At, B0); } while (0); PG8_BAR; PG8_SCHED;
            PG8_LDB(B1, 1, 1); PG8_STAGE(PG8_SB(1, 0), b3, voffB);
            PG8_BAR; PG8_WAIT_L(0); do { if constexpr (FP8) PG8_MMA8(0, 1, At, B1); else PG8_MMA(0, 1, At, B1); } while (0); PG8_BAR;
            PG8_LDA(At, 1, 1); PG8_STAGE(PG8_SA(1, 0), a3, voffA);
            PG8_BAR; PG8_WAIT_L(0); do { if constexpr (FP8) PG8_MMA8(1, 0, At, B0); else PG8_MMA(1, 0, At, B0); } while (0); PG8_BAR; PG8_SCHED;
            PG8_STAGE(PG8_SB(1, 1), b3 + hstep, voffB);
            PG8_WAIT_V(6); PG8_BAR; do { if constexpr (FP8) PG8_MMA8(1, 1, At, B1); else PG8_MMA(1, 1, At, B1); } while (0); PG8_BAR;
        }
        if constexpr (FP8) PG8_MMA8_DRAIN();
        if constexpr (!Epi::AFTER_DRAIN) { E(acc, cur, wr, wc, fr, fq); S.done(cur); }
        if (!has_next) break;
#pragma unroll
        for (int a = 0; a < 2; ++a)
#pragma unroll
            for (int b = 0; b < 2; ++b)
#pragma unroll
                for (int m = 0; m < 4; ++m)
#pragma unroll
                    for (int n = 0; n < 2; ++n) acc[a][b][m][n] = (f32x4){0.f, 0.f, 0.f, 0.f};
        cur = nxt; cA = nA; cB = nB; ++ui;
    }
    PG8_WAIT_V(0);
    if (wr == 0) PG8_BAR;
    PG8_BAR;
    if constexpr (Epi::AFTER_DRAIN) { E.fused(acc, cur, wr, wc, fr, fq, lds, wid, lane); S.done(cur); }
#undef PG8_SA
#undef PG8_SB
#undef PG8_STAGE
#undef PG8_LDA
#undef PG8_LDH
#undef PG8_HALF
#undef PG8_LDB
#undef PG8_MMA
#undef PG8_MMA8
#undef PG8_MMA8_DRAIN
#undef PG8_WAIT_V
#undef PG8_WAIT_L
#undef PG8_BAR
#undef PG8_SCHED
}
}

struct Frame {
    LAS unsigned char* lds;
    int tid, lane, wave, vcu, G;
    const float* const __attribute__((address_space(4)))* in;
    float* out; unsigned char* ws;
};
enum { I_X = 0, I_C, I_CTX, I_CCTX, I_WMOD, I_BMOD, I_LNG, I_LNB, I_AWIN, I_ABG, I_ANG, I_AWOUT, I_BWIN, I_BBIN, I_BLNG, I_BLNB, I_BWS, I_BBS, I_BWOUT,
       I_CWQKV, I_CQG, I_CKG, I_CWOUT, I_PWQ, I_PK1, I_PK2, I_PU, I_PV };

template <int CTRL> __device__ __forceinline__ float dpp_mov(float v) { return __builtin_bit_cast(float, __builtin_amdgcn_update_dpp(0, __builtin_bit_cast(int, v), CTRL, 0xf, 0xf, false)); }
__device__ __forceinline__ float row16_sum(float v) {
    v += dpp_mov<0x128>(v);
    v += dpp_mov<0x124>(v);
    v += dpp_mov<0x122>(v);
    v += dpp_mov<0x121>(v);
    return v;
}
__device__ __forceinline__ float row16_max(float v) {
    v = fmaxf(v, dpp_mov<0x128>(v)); v = fmaxf(v, dpp_mov<0x124>(v)); v = fmaxf(v, dpp_mov<0x122>(v)); v = fmaxf(v, dpp_mov<0x121>(v));
    return v;
}
__device__ __forceinline__ float rl(float v, int l) { return __builtin_bit_cast(float, __builtin_amdgcn_readlane(__builtin_bit_cast(int, v), l)); }
__device__ __forceinline__ float wsum(float v) { v = row16_sum(v); return (rl(v, 0) + rl(v, 16)) + (rl(v, 32) + rl(v, 48)); }

__device__ __forceinline__ const float* mod_row(const Frame& F, int layer, int row) {
    const int b9 = row < TL ? (row >> 12) : 8;
    return (const float*)(F.ws + WS_MOD) + (size_t)(layer * 9 + b9) * NMOD;
}

__device__ __forceinline__ void p0_transpose_item(const float* W, int ldw, int K, int nblk, unsigned char* WT, LAS float* scr, int item, int lane) {
    const int kb = item / nblk, nb = item % nblk, k0 = 64 * kb, n0 = 32 * nb;
    f32x4 t[8];
#pragma unroll
    for (int i = 0; i < 8; ++i) t[i] = *(const f32x4*)(W + (size_t)(k0 + 8 * i + (lane >> 3)) * ldw + n0 + 4 * (lane & 7));
#pragma unroll
    for (int i = 0; i < 8; ++i) { LAS float* d = scr + (8 * i + (lane >> 3)) * 33 + 4 * (lane & 7); d[0] = t[i][0] * WSCALE; d[1] = t[i][1] * WSCALE; d[2] = t[i][2] * WSCALE; d[3] = t[i][3] * WSCALE; }
    LDS_WAIT(); asm volatile("" ::: "memory");
    const int c = lane & 7;
#pragma unroll
    for (int j = 0; j < 4; ++j) { const int n = (lane >> 3) + 8 * j; const LAS float* s = scr + (8 * c) * 33 + n;
        v2u o; o.x = pk4_fp8(s[0 * 33], s[1 * 33], s[2 * 33], s[3 * 33]); o.y = pk4_fp8(s[4 * 33], s[5 * 33], s[6 * 33], s[7 * 33]);
        *(v2u*)(WT + (size_t)(n0 + n) * K + k0 + 8 * c) = o; }
    LDS_WAIT(); asm volatile("" ::: "memory");
}
__device__ __forceinline__ void p0_transpose_item_bf16(const float* W, int ldw, int K, int nblk, bf16* WT, LAS float* scr, int item, int lane) {
    const int kb = item / nblk, nb = item % nblk, k0 = 64 * kb, n0 = 32 * nb;
    f32x4 t[8];
#pragma unroll
    for (int i = 0; i < 8; ++i) t[i] = *(const f32x4*)(W + (size_t)(k0 + 8 * i + (lane >> 3)) * ldw + n0 + 4 * (lane & 7));
#pragma unroll
    for (int i = 0; i < 8; ++i) { LAS float* d = scr + (8 * i + (lane >> 3)) * 33 + 4 * (lane & 7); d[0] = t[i][0]; d[1] = t[i][1]; d[2] = t[i][2]; d[3] = t[i][3]; }
    LDS_WAIT(); asm volatile("" ::: "memory");
    const int c = lane & 7;
#pragma unroll
    for (int j = 0; j < 4; ++j) { const int n = (lane >> 3) + 8 * j; const LAS float* s = scr + (8 * c) * 33 + n;
        v4u o; o.x = cvt_pk_bf16(s[0 * 33], s[1 * 33]); o.y = cvt_pk_bf16(s[2 * 33], s[3 * 33]); o.z = cvt_pk_bf16(s[4 * 33], s[5 * 33]); o.w = cvt_pk_bf16(s[6 * 33], s[7 * 33]);
        *(v4u*)(WT + (size_t)(n0 + n) * K + k0 + 8 * c) = o; }
    LDS_WAIT(); asm volatile("" ::: "memory");
}
__device__ __forceinline__ void cvt_linear(const float* src, bf16* dst, size_t n8, size_t i0, size_t stride) {
    for (size_t i = i0; i < n8; i += stride) {
        const f32x4 a = *(const f32x4*)(src + i * 8), b = *(const f32x4*)(src + i * 8 + 4);
        v4u o; o.x = cvt_pk_bf16(a[0], a[1]); o.y = cvt_pk_bf16(a[2], a[3]); o.z = cvt_pk_bf16(b[0], b[1]); o.w = cvt_pk_bf16(b[2], b[3]);
        *(v4u*)(dst + i * 8) = o;
    }
}
__device__ __forceinline__ void p0_prologue(Frame& F) {
    {
        LAS float* sc = (LAS float*)F.lds;
        LAS float* part = (LAS float*)(F.lds + 9 * 2048 * 4);
        for (int i = F.tid; i < 9 * 2048; i += NTHR) { const int r = i >> 11, k = i & 2047; const float c = r < 8 ? F.in[I_C][r * D + k] : F.in[I_CCTX][k]; sc[i] = silu(c); }
        __syncthreads();
        float* MOD = (float*)(F.ws + WS_MOD);
        for (int item = F.vcu; item < 4 * 192; item += F.G) {
            const int l = item / 192, cg = item % 192, c = cg * 64 + F.lane;
            const float* Wm = F.in[I_WMOD] + ((size_t)l * D + F.wave * 256) * NMOD + c;
            float acc[9];
#pragma unroll
            for (int r = 0; r < 9; ++r) acc[r] = 0.f;
            for (int k0 = 0; k0 < 256; k0 += 32) {
                float w[32];
#pragma unroll
                for (int u = 0; u < 32; ++u) w[u] = Wm[(size_t)(k0 + u) * NMOD];
#pragma unroll
                for (int u = 0; u < 32; ++u)
#pragma unroll
                    for (int r = 0; r < 9; ++r) acc[r] += sc[r * 2048 + F.wave * 256 + k0 + u] * w[u];
            }
#pragma unroll
            for (int r = 0; r < 9; ++r) part[(F.wave * 9 + r) * 64 + F.lane] = acc[r];
            __syncthreads();
            for (int i = F.tid; i < 9 * 64; i += NTHR) { const int r = i >> 6, ln = i & 63; float s = 0.f;
#pragma unroll
                for (int w = 0; w < 8; ++w) s += part[(w * 9 + r) * 64 + ln];
                MOD[(size_t)(l * 9 + r) * NMOD + cg * 64 + ln] = s + F.in[I_BMOD][l * NMOD + cg * 64 + ln]; }
            __syncthreads();
        }
    }
    {
        LAS float* scr = (LAS float*)(F.lds + F.wave * 16384);
        const int gw = F.vcu * NWAVES + F.wave, NGW = F.G * NWAVES;
        unsigned char* WT = F.ws + WS_WT;
        constexpr int I_A = 32 * 192, I_SQ = 32 * 64, I_BI = 32 * 256, I_BO = 64 * 64, I_CQ = 32 * 96;
        constexpr int NITEMS = 2 * I_A + 2 * I_SQ + I_BI + I_BO + I_CQ + I_SQ + 4 * I_SQ;
        for (int it = gw; it < NITEMS; it += NGW) {
            int r = it;
            if (r < 2 * I_A) { const int j = r / I_A; p0_transpose_item(F.in[I_AWIN] + (size_t)j * D * A_IN, A_IN, D, 192, WT + WT_AIN + (size_t)j * A_INP * D, scr, r % I_A, F.lane); continue; } r -= 2 * I_A;
            if (r < 2 * I_SQ) { const int j = r / I_SQ; p0_transpose_item(F.in[I_AWOUT] + (size_t)j * D * D, D, D, 64, WT + WT_AOUT + (size_t)j * D * D, scr, r % I_SQ, F.lane); continue; } r -= 2 * I_SQ;
            if (r < I_BI) { p0_transpose_item(F.in[I_BWIN], 8192, D, 256, WT + WT_BIN, scr, r, F.lane); continue; } r -= I_BI;
            if (r < I_BO) { p0_transpose_item(F.in[I_BWOUT], D, 4096, 64, WT + WT_BOUT, scr, r, F.lane); continue; } r -= I_BO;
            if (r < I_CQ) { p0_transpose_item(F.in[I_CWQKV], C_QKV, D, 96, WT + WT_CQKV, scr, r, F.lane); continue; } r -= I_CQ;
            if (r < I_SQ) { p0_transpose_item(F.in[I_CWOUT], D, D, 64, WT + WT_COUT, scr, r, F.lane); continue; } r -= I_SQ;
            { const int j = r / I_SQ;
              if ((PQ_FP8_MASK >> j) & 1) p0_transpose_item(F.in[I_PWQ] + (size_t)j * D * D, D, D, 64, WT + WT_PQ + (size_t)j * D * D * 2, scr, r % I_SQ, F.lane);
              else p0_transpose_item_bf16(F.in[I_PWQ] + (size_t)j * D * D, D, D, 64, (bf16*)(WT + WT_PQ) + (size_t)j * D * D, scr, r % I_SQ, F.lane); }
        }
        const size_t gt = (size_t)F.vcu * NTHR + F.tid, GT = (size_t)F.G * NTHR;
        for (size_t i = gt; i < (size_t)2 * 256 * D; i += GT) {
            const int j = (int)(i / (256 * D)), rem = (int)(i % (256 * D)), n = rem / D, k = rem % D;
            const float v = n < 16 ? F.in[I_AWIN][((size_t)j * D + k) * A_IN + 6144 + n] : 0.f;
            WT[WT_AIN + ((size_t)j * A_INP + 6144 + n) * D + k] = (unsigned char)(__builtin_amdgcn_cvt_pk_fp8_f32(v * WSCALE, 0.f, 0, false) & 0xff);
        }
        for (int r0 = gw; r0 < 2 * 4 * P_E; r0 += 2 * NGW) {
            f32x4 v[2][8];
#pragma unroll
            for (int h = 0; h < 2; ++h) { const int r = r0 + h * NGW, tb = r >= 4 * P_E, rr = r - tb * 4 * P_E;
                const float* src = F.in[tb ? I_PV : I_PU] + (size_t)rr * D + 4 * F.lane;
#pragma unroll
                for (int q = 0; q < 8; ++q) v[h][q] = *(const f32x4*)(src + 256 * q); }
#pragma unroll
            for (int h = 0; h < 2; ++h) { const int r = r0 + h * NGW, tb = r >= 4 * P_E, rr = r - tb * 4 * P_E;
                float mx = 0.f;
#pragma unroll
                for (int q = 0; q < 8; ++q) { const f32x4 a = __builtin_elementwise_abs(v[h][q]); mx = fmaxf(mx, fmaxf(fmaxf(a[0], a[1]), fmaxf(a[2], a[3]))); }
                mx = row16_max(mx); mx = fmaxf(fmaxf(rl(mx, 0), rl(mx, 16)), fmaxf(rl(mx, 32), rl(mx, 48)));
                const float sc = mx > 0.f ? 6.0f / mx : 1.0f;
                v4u o;
#pragma unroll
                for (int d = 0; d < 4; ++d) { unsigned w = 0u; const f32x4 x0 = v[h][2 * d] * sc, x1 = v[h][2 * d + 1] * sc;
                    w = __builtin_amdgcn_cvt_scalef32_pk_fp4_f32(w, x0[0], x0[1], 1.0f, 0); w = __builtin_amdgcn_cvt_scalef32_pk_fp4_f32(w, x0[2], x0[3], 1.0f, 1);
                    w = __builtin_amdgcn_cvt_scalef32_pk_fp4_f32(w, x1[0], x1[1], 1.0f, 2); w = __builtin_amdgcn_cvt_scalef32_pk_fp4_f32(w, x1[2], x1[3], 1.0f, 3); o[d] = w; }
                if (tb) *(v4u*)(F.ws + WS_PV8 + (size_t)rr * (D / 2) + 16 * F.lane) = o;
                else { unsigned char* ur = F.ws + WS_PU8 + (size_t)rr * (D / 2) + 2 * F.lane;
#pragma unroll
                    for (int d = 0; d < 4; ++d) { *(unsigned short*)(ur + 128 * (2 * d)) = (unsigned short)(o[d] & 0xffffu); *(unsigned short*)(ur + 128 * (2 * d + 1)) = (unsigned short)(o[d] >> 16); } }
                if (F.lane == 0) ((float*)(F.ws + WS_SC))[(size_t)tb * 4 * P_E + rr] = 1.0f / sc; }
        }
        cvt_linear(F.in[I_PK1], (bf16*)(F.ws + WS_K12), (size_t)4 * 128 * 128 / 8, gt, GT);
        cvt_linear(F.in[I_PK2], (bf16*)(F.ws + WS_K12) + 4 * 128 * 128, (size_t)4 * 128 * 128 / 8, gt, GT);
        cvt_linear(F.in[I_BWS], (bf16*)(F.ws + WS_WS), (size_t)8 * 128 * 128 / 8, gt, GT);
    }
}

template <int L> __device__ __forceinline__ const float* x_row(const Frame& F, int row) {
    if (L == 0) return row < TL ? F.in[I_X] + (size_t)row * D : F.in[I_CTX] + (size_t)(row - TL) * D;
    return (const float*)(F.ws + WS_X) + (size_t)row * D;
}
template <int L> __device__ __forceinline__ f32x4 load_x4(const Frame& F, int row, int e) {
    if (L == 0) return *(const f32x4*)(x_row<0>(F, row) + e);
    const v2u p = *(const v2u*)((const bf16*)(F.ws + WS_X) + (size_t)row * D + e);
    return (f32x4){bf_lo(p.x), bf_hi(p.x), bf_lo(p.y), bf_hi(p.y)};
}
__device__ __forceinline__ void store_x4(const Frame& F, int row, int e, f32x4 v) { v2u o; o.x = cvt_pk_bf16(v[0], v[1]); o.y = cvt_pk_bf16(v[2], v[3]); *(v2u*)((bf16*)(F.ws + WS_X) + (size_t)row * D + e) = o; }
__device__ __forceinline__ void p0b_modulate(Frame& F) {
    const int gw = F.vcu * NWAVES + F.wave, NGW = F.G * NWAVES;
    for (int row = gw; row < T; row += NGW) {
        const float* xr = x_row<0>(F, row); const float* md = mod_row(F, 0, row);
        unsigned char* hr = F.ws + WS_H + (size_t)row * D;
#pragma unroll
        for (int j = 0; j < 8; ++j) { const int e = 4 * F.lane + 256 * j;
            const f32x4 x = *(const f32x4*)(xr + e), sh = *(const f32x4*)(md + e), scl = *(const f32x4*)(md + D + e);
            const f32x4 h = x * (scl + 1.0f) + sh;
            *(unsigned*)(hr + e) = pk4_fp8(h[0], h[1], h[2], h[3]); }
    }
}

__device__ __forceinline__ void ln_rows(f32x4 (&t)[8], const float* g, const float* b, int lane) {
    float s = 0.f;
#pragma unroll
    for (int j = 0; j < 8; ++j) s += (t[j][0] + t[j][1]) + (t[j][2] + t[j][3]);
    const float mean = wsum(s) * (1.0f / D); float q = 0.f;
#pragma unroll
    for (int j = 0; j < 8; ++j) { t[j] = t[j] - mean; q += (t[j][0] * t[j][0] + t[j][1] * t[j][1]) + (t[j][2] * t[j][2] + t[j][3] * t[j][3]); }
    const float rstd = 1.0f / sqrtf(wsum(q) * (1.0f / D) + LN_EPS);
#pragma unroll
    for (int j = 0; j < 8; ++j) { const int e = 4 * lane + 256 * j; t[j] = t[j] * rstd * *(const f32x4*)(g + e) + *(const f32x4*)(b + e); }
}

template <int L> __device__ __forceinline__ void ln1_phase(Frame& F, int M) {
    const int gw = F.vcu * NWAVES + F.wave, NGW = F.G * NWAVES;
    const float* lg = F.in[I_LNG] + (size_t)(L * 2 + 0) * D; const float* lb = F.in[I_LNB] + (size_t)(L * 2 + 0) * D;
    for (int row = gw; row < M; row += NGW) {
        const float* md = mod_row(F, L, row);
        const bf16* yr = (const bf16*)(F.ws + WS_Y) + (size_t)row * D;
        bf16* hr = (bf16*)(F.ws + WS_Y) + (size_t)row * D;
        f32x4 t[8];
#pragma unroll
        for (int j = 0; j < 8; ++j) { const int e = 4 * F.lane + 256 * j;
            const f32x4 x = load_x4<L>(F, row, e), gt = *(const f32x4*)(md + 2 * D + e); const v2u y = *(const v2u*)(yr + e);
            t[j] = x * ALPHA + gt * (f32x4){bf_lo(y.x), bf_hi(y.x), bf_lo(y.y), bf_hi(y.y)}; }
        ln_rows(t, lg, lb, F.lane);
#pragma unroll
        for (int j = 0; j < 8; ++j) { const int e = 4 * F.lane + 256 * j;
            store_x4(F, row, e, t[j]);
            const f32x4 h = t[j] * (*(const f32x4*)(md + 4 * D + e) + 1.0f) + *(const f32x4*)(md + 3 * D + e);
            v2u o; o.x = cvt_pk_bf16(h[0], h[1]); o.y = cvt_pk_bf16(h[2], h[3]); *(v2u*)(hr + e) = o;
            if ((PQ_FP8_MASK >> L) & 1) *(unsigned*)(F.ws + WS_H + (size_t)row * D + e) = pk4_fp8(h[0], h[1], h[2], h[3]); }
    }
}

__device__ __forceinline__ unsigned f2mono(float f) { const unsigned b = __float_as_uint(f); return (b & 0x80000000u) ? ~b : (b | 0x80000000u); }
__device__ __forceinline__ float mono2f(unsigned m) { return __uint_as_float((m & 0x80000000u) ? (m & 0x7fffffffu) : ~m); }
__device__ __forceinline__ void ins16(unsigned (&top)[16], unsigned x) {
#pragma unroll
    for (int j = 0; j < 16; ++j) { const unsigned hi = top[j] > x ? top[j] : x; x = top[j] > x ? x : top[j]; top[j] = hi; }
}
#define TK_CE(A_, B_) { const unsigned hi_ = (A_) > (B_) ? (A_) : (B_), lo_ = (A_) > (B_) ? (B_) : (A_); (A_) = hi_; (B_) = lo_; }
__device__ __forceinline__ void sort16_desc(unsigned (&v)[16]) {
#pragma unroll
    for (int k = 2; k <= 16; k <<= 1)
#pragma unroll
        for (int j = k >> 1; j > 0; j >>= 1)
#pragma unroll
            for (int i = 0; i < 16; ++i) { const int l = i ^ j; if (l > i) { if ((i & k) == 0) TK_CE(v[i], v[l]) else TK_CE(v[l], v[i]) } }
}
__device__ __forceinline__ void merge16_desc(unsigned (&top)[16], const unsigned (&s)[16]) {
#pragma unroll
    for (int i = 0; i < 16; ++i) top[i] = top[i] > s[15 - i] ? top[i] : s[15 - i];
#pragma unroll
    for (int j = 8; j > 0; j >>= 1)
#pragma unroll
        for (int i = 0; i < 16; ++i) { const int l = i ^ j; if (l > i) TK_CE(top[i], top[l]) }
}
template <int L> __device__ __forceinline__ void peer_topk_phase(Frame& F, int M) {
    const bf16* Q = (const bf16*)(F.ws + WS_Z);
    const bf16* K1 = (const bf16*)(F.ws + WS_K12) + (size_t)L * 128 * 128;
    const bf16* K2 = (const bf16*)(F.ws + WS_K12) + (size_t)(4 + L) * 128 * 128;
    int* IDX = (int*)(F.ws + WS_IDX); float* PG = (float*)(F.ws + WS_PG);
    LAS float* S1 = (LAS float*)F.lds;
    LAS float* S2 = S1 + 128 * 129;
    LAS unsigned* TK = (LAS unsigned*)(S2 + 128 * 129);
    const int fr = F.lane & 15, fq = F.lane >> 4;
    const int nunits = (M / 128) * P_HEADS;
    const int kbg = F.wave & 1, tbg = F.wave >> 1;
    bf16x8 kf1[4][4], kf2[4][4];
#pragma unroll
    for (int kk = 0; kk < 4; ++kk) { const int kb = 4 * kbg + kk;
        const bf16* k1p = K1 + (size_t)(kb * 16 + fr) * 128 + fq * 8; const bf16* k2p = K2 + (size_t)(kb * 16 + fr) * 128 + fq * 8;
#pragma unroll
        for (int ks = 0; ks < 4; ++ks) { kf1[kk][ks] = *(const bf16x8*)(k1p + ks * 32); kf2[kk][ks] = *(const bf16x8*)(k2p + ks * 32); } }
    for (int u = F.vcu; u < nunits; u += F.G) {
        const int tile = u >> 3, hd = u & 7, row0 = tile * 128;
#ifdef TK_DBL_MFMA
        for (int rr_ = 0; rr_ < 2; ++rr_)
#endif
        {
#pragma unroll
            for (int tt = 0; tt < 2; ++tt) { const int tb = 2 * tbg + tt;
                const bf16* qp = Q + (size_t)(row0 + tb * 16 + fr) * D + hd * 256 + fq * 8;
                bf16x8 a1[4], a2[4];
#pragma unroll
                for (int ks = 0; ks < 4; ++ks) { a1[ks] = *(const bf16x8*)(qp + ks * 32); a2[ks] = *(const bf16x8*)(qp + 128 + ks * 32); }
#pragma unroll
                for (int kk = 0; kk < 4; ++kk) { const int kb = 4 * kbg + kk;
                    f32x4 c1 = zero4(), c2 = zero4();
#pragma unroll
                    for (int ks = 0; ks < 4; ++ks) {
                        c1 = __builtin_amdgcn_mfma_f32_16x16x32_bf16(a1[ks], kf1[kk][ks], c1, 0, 0, 0);
                        c2 = __builtin_amdgcn_mfma_f32_16x16x32_bf16(a2[ks], kf2[kk][ks], c2, 0, 0, 0);
                    }
#pragma unroll
                    for (int j = 0; j < 4; ++j) { const int t = tb * 16 + 4 * fq + j; S1[t * 129 + kb * 16 + fr] = c1[j]; S2[t * 129 + kb * 16 + fr] = c2[j]; }
                }
            }
        }
        __syncthreads();
        {
            int tid_l = F.tid; asm volatile("" : "+v"(tid_l));
            const int t = tid_l & 127, which = (tid_l >> 7) & 1, half = tid_l >> 8;
            LAS float* sr = (which ? S2 : S1) + t * 129 + 64 * half;
            unsigned top[16];
#pragma unroll
            for (int j = 0; j < 16; ++j) top[j] = (f2mono(sr[j]) & ~0x7fu) | (unsigned)(127 - (64 * half + j));
            sort16_desc(top);
#pragma unroll 1
            for (int g = 1; g < 4; ++g) { unsigned v[16];
#pragma unroll
                for (int j = 0; j < 16; ++j) v[j] = (f2mono(sr[16 * g + j]) & ~0x7fu) | (unsigned)(127 - (64 * half + 16 * g + j));
                sort16_desc(v); merge16_desc(top, v); }
            if (half) {
#pragma unroll
                for (int j = 0; j < 16; ++j) ((LAS unsigned*)sr)[j] = top[j];
            }
            __syncthreads();
            if (!half) {
                const LAS unsigned* pr = (const LAS unsigned*)(sr + 64);
                unsigned ot[16];
#pragma unroll
                for (int j = 0; j < 16; ++j) ot[j] = pr[j];
                merge16_desc(top, ot);
#pragma unroll
                for (int j = 0; j < 16; ++j) TK[(which * 128 + t) * 17 + j] = top[j];
            }
        }
        __syncthreads();
#ifdef TK_DBL_COMB
        for (int rr_ = 0; rr_ < 2; ++rr_)
#endif
        if (F.tid < 128) {
            const int t = F.tid;
            const LAS unsigned* t1 = TK + t * 17; const LAS unsigned* t2 = TK + (128 + t) * 17;
            float v2[16];
#pragma unroll
            for (int j = 0; j < 16; ++j) v2[j] = mono2f((t2[j] & ~0x7fu) | 0x40u);
#define TK_V1(A_) mono2f((t1[A_] & ~0x7fu) | 0x40u)
#define TK_KEY(VA_, A_, B_) ((f2mono((VA_) + v2[B_]) & ~0xffu) | (unsigned)(255 - ((A_) * 16 + (B_))))
            unsigned top[16];
            { unsigned grp[16];
              const float va0 = TK_V1(0);
              grp[0] = TK_KEY(va0, 0, 0);
              grp[1] = TK_KEY(va0, 0, 1);
              grp[2] = TK_KEY(va0, 0, 2);
              grp[3] = TK_KEY(va0, 0, 3);
              grp[4] = TK_KEY(va0, 0, 4);
              grp[5] = TK_KEY(va0, 0, 5);
              grp[6] = TK_KEY(va0, 0, 6);
              grp[7] = TK_KEY(va0, 0, 7);
              grp[8] = TK_KEY(va0, 0, 8);
              grp[9] = TK_KEY(va0, 0, 9);
              grp[10] = TK_KEY(va0, 0, 10);
              grp[11] = TK_KEY(va0, 0, 11);
              grp[12] = TK_KEY(va0, 0, 12);
              grp[13] = TK_KEY(va0, 0, 13);
              grp[14] = TK_KEY(va0, 0, 14);
              grp[15] = TK_KEY(va0, 0, 15);
              sort16_desc(grp);
#pragma unroll
              for (int j = 0; j < 16; ++j) top[j] = grp[j]; }
            __builtin_amdgcn_sched_barrier(0);
            { unsigned grp[16];
              const float va1 = TK_V1(1);
              const float va2 = TK_V1(2);
              const float va3 = TK_V1(3);
              grp[0] = TK_KEY(va1, 1, 0);
              grp[1] = TK_KEY(va1, 1, 1);
              grp[2] = TK_KEY(va1, 1, 2);
              grp[3] = TK_KEY(va1, 1, 3);
              grp[4] = TK_KEY(va1, 1, 4);
              grp[5] = TK_KEY(va1, 1, 5);
              grp[6] = TK_KEY(va1, 1, 6);
              grp[7] = TK_KEY(va1, 1, 7);
              grp[8] = TK_KEY(va2, 2, 0);
              grp[9] = TK_KEY(va2, 2, 1);
              grp[10] = TK_KEY(va2, 2, 2);
              grp[11] = TK_KEY(va2, 2, 3);
              grp[12] = TK_KEY(va2, 2, 4);
              grp[13] = TK_KEY(va3, 3, 0);
              grp[14] = TK_KEY(va3, 3, 1);
              grp[15] = TK_KEY(va3, 3, 2);
              sort16_desc(grp);
              merge16_desc(top, grp); }
            __builtin_amdgcn_sched_barrier(0);
            { unsigned grp[16];
              const float va3 = TK_V1(3);
              const float va4 = TK_V1(4);
              const float va5 = TK_V1(5);
              const float va6 = TK_V1(6);
              const float va7 = TK_V1(7);
              const float va8 = TK_V1(8);
              const float va9 = TK_V1(9);
              const float va10 = TK_V1(10);
              const float va11 = TK_V1(11);
              const float va12 = TK_V1(12);
              const float va13 = TK_V1(13);
              grp[0] = TK_KEY(va3, 3, 3);
              grp[1] = TK_KEY(va4, 4, 0);
              grp[2] = TK_KEY(va4, 4, 1);
              grp[3] = TK_KEY(va4, 4, 2);
              grp[4] = TK_KEY(va5, 5, 0);
              grp[5] = TK_KEY(va5, 5, 1);
              grp[6] = TK_KEY(va6, 6, 0);
              grp[7] = TK_KEY(va6, 6, 1);
              grp[8] = TK_KEY(va7, 7, 0);
              grp[9] = TK_KEY(va7, 7, 1);
              grp[10] = TK_KEY(va8, 8, 0);
              grp[11] = TK_KEY(va9, 9, 0);
              grp[12] = TK_KEY(va10, 10, 0);
              grp[13] = TK_KEY(va11, 11, 0);
              grp[14] = TK_KEY(va12, 12, 0);
              grp[15] = TK_KEY(va13, 13, 0);
              sort16_desc(grp);
              merge16_desc(top, grp); }
            __builtin_amdgcn_sched_barrier(0);
            ins16(top, TK_KEY(TK_V1(14), 14, 0));
            ins16(top, TK_KEY(TK_V1(15), 15, 0));
#undef TK_KEY
#undef TK_V1
            float sc[16], es = 0.f;
#pragma unroll
            for (int j = 0; j < 16; ++j) sc[j] = mono2f((top[j] & ~0xffu) | 0x80u);
            const float smx = sc[0];
#pragma unroll
            for (int j = 0; j < 16; ++j) { sc[j] = __expf(sc[j] - smx); es += sc[j]; }
            const float inv = 1.0f / es;
            const size_t ob = (size_t)(row0 + t) * 128 + hd * 16;
#pragma unroll
            for (int j = 0; j < 16; ++j) { const int ci = 255 - (int)(top[j] & 0xffu), a = ci >> 4, b = ci & 15;
                const int i1 = 127 - (int)(t1[a] & 0x7fu), i2 = 127 - (int)(t2[b] & 0x7fu);
                IDX[ob + j] = i1 * 128 + i2; PG[ob + j] = sc[j] * inv; }
        }
        __syncthreads();
    }
}

constexpr int P3B = 8;
struct RowBatch { v4u r[P3B]; };
__device__ __forceinline__ void p3_load_batch(RowBatch& B, const char* tab, int ev, int lane0, int lo16) {
#pragma unroll
    for (int q = 0; q < P3B; ++q) { const int e = __builtin_amdgcn_readlane(ev, lane0 + q); B.r[q] = *(const v4u*)(tab + (size_t)e * (D / 2) + lo16); }
}
__device__ __forceinline__ float dot32_fp4(const v4u w, const f32x2* h) {
    f32x2 s = {0.f, 0.f};
#pragma unroll
    for (int d = 0; d < 4; ++d) {
#define P3_D(b) { const f32x2 p = __builtin_amdgcn_cvt_scalef32_pk_f32_fp4(w[d], 1.0f, b); s = __builtin_elementwise_fma(p, h[4 * d + b], s); }
        P3_D(0) P3_D(1) P3_D(2) P3_D(3)
#undef P3_D
    }
    return s[0] + s[1];
}
__device__ __forceinline__ void axpy32_fp4(const v4u w, float hk, f32x2* acc) {
    const f32x2 hk2 = {hk, hk};
#pragma unroll
    for (int d = 0; d < 4; ++d) {
#define P3_A(b) { const f32x2 p = __builtin_amdgcn_cvt_scalef32_pk_f32_fp4(w[d], 1.0f, b); acc[4 * d + b] = __builtin_elementwise_fma(hk2, p, acc[4 * d + b]); }
        P3_A(0) P3_A(1) P3_A(2) P3_A(3)
#undef P3_A
    }
}
__device__ __forceinline__ float reduce8(const float* d, int lane) {
    const bool b0 = lane & 1, b1 = lane & 2, b2 = lane & 4;
    float s1[4], s2[2];
#pragma unroll
    for (int j = 0; j < 4; ++j) { const float keep = b0 ? d[2 * j + 1] : d[2 * j], send = b0 ? d[2 * j] : d[2 * j + 1]; s1[j] = keep + dpp_mov<0xB1>(send); }
#pragma unroll
    for (int j = 0; j < 2; ++j) { const float keep = b1 ? s1[2 * j + 1] : s1[2 * j], send = b1 ? s1[2 * j] : s1[2 * j + 1]; s2[j] = keep + dpp_mov<0x4E>(send); }
    const float keep = b2 ? s2[1] : s2[0], send = b2 ? s2[0] : s2[1];
    float s3 = keep + dpp_mov<0x124>(send);
    s3 += dpp_mov<0x128>(s3);
    s3 += __shfl_xor(s3, 16); s3 += __shfl_xor(s3, 32);
    return s3;
}
template <int L> __device__ __forceinline__ void peer_u_phase(Frame& F, int M) {
    const int gw = F.vcu * NWAVES + F.wave, NGW = F.G * NWAVES;
    const char* PU = (const char*)(F.ws + WS_PU8) + (size_t)L * P_E * (D / 2); const char* PV = (const char*)(F.ws + WS_PV8) + (size_t)L * P_E * (D / 2);
    const float* SCU = (const float*)(F.ws + WS_SC) + (size_t)L * P_E; const float* SCV = (const float*)(F.ws + WS_SC) + (size_t)(4 + L) * P_E;
    const int* IDX = (const int*)(F.ws + WS_IDX); const float* PG = (const float*)(F.ws + WS_PG);
    const float* lg = F.in[I_LNG] + (size_t)(L * 2 + 1) * D; const float* lb = F.in[I_LNB] + (size_t)(L * 2 + 1) * D;
    for (int row = gw; row < M; row += NGW) {
        int lane_l = F.lane; asm volatile("" : "+v"(lane_l));
        const int lane = lane_l, lo16 = lane * 16;
        const int e0 = IDX[(size_t)row * 128 + lane], e1 = IDX[(size_t)row * 128 + 64 + lane];
        const float g0 = PG[(size_t)row * 128 + lane], g1 = PG[(size_t)row * 128 + 64 + lane];
        const float su0 = SCU[e0], su1 = SCU[e1], sv0 = SCV[e0], sv1 = SCV[e1];
        f32x2 hx[16];
        { const bf16* hr0 = (const bf16*)(F.ws + WS_Y) + (size_t)row * D + 4 * lane;
#pragma unroll
          for (int q = 0; q < 8; ++q) { const v2u hp = *(const v2u*)(hr0 + 256 * q); hx[2 * q] = (f32x2){bf_lo(hp.x), bf_hi(hp.x)}; hx[2 * q + 1] = (f32x2){bf_lo(hp.y), bf_hi(hp.y)}; } }
        float a0, a1;
        {
            LAS unsigned char* wl = F.lds + F.wave * 13568;
            LAS unsigned char* HI = wl + 8448;
#pragma unroll
            for (int q = 0; q < 8; ++q) {
                const f32x2 p0 = hx[2 * q], p1 = hx[2 * q + 1];
                int hi = __builtin_amdgcn_cvt_pk_fp8_f32(p0[0], p0[1], 0, false); hi = __builtin_amdgcn_cvt_pk_fp8_f32(p1[0], p1[1], hi, true);
                const f32x2 b0 = __builtin_amdgcn_cvt_pk_f32_fp8(hi, false), b1 = __builtin_amdgcn_cvt_pk_f32_fp8(hi, true);
                const f32x2 r0 = (p0 - b0) * 16.0f, r1 = (p1 - b1) * 16.0f;
                int lo = __builtin_amdgcn_cvt_pk_fp8_f32(r0[0], r0[1], 0, false); lo = __builtin_amdgcn_cvt_pk_fp8_f32(r1[0], r1[1], lo, true);
                *(LAS int*)(HI + 4 * lane + 256 * q) = hi; *(LAS int*)(HI + 2048 + 4 * lane + 256 * q) = lo;
            }
            asm volatile("" ::: "memory");
            const int n16 = lane & 15, kq = lane >> 4, hl = lane >> 5, l31 = lane & 31;
            const LAS unsigned char* bp = HI + (n16 == 1 ? 2048 : 0) + 16 * kq;
            LAS unsigned char* tw = wl + hl * 528 + 16 * l31;
            const LAS unsigned char* tr = wl + n16 * 528 + 16 * kq;
            f32x4 acc[8];
#pragma unroll
            for (int rb = 0; rb < 8; ++rb) acc[rb] = zero4();
            v4u R[2][8]; v8i_t Bk[8];
            int e0b = e0, e1b = e1;
#define UL_LOAD(S_) do { _Pragma("unroll") for (int i = 0; i < 8; ++i) { const int sa_ = 16 * ((S_) & 7) + 2 * i; \
                const int es_ = ((S_) >> 3) ? (((S_) & 7) < 4 ? e0b : e1b) : (((S_) & 7) < 4 ? e0 : e1); const int ia_ = __builtin_amdgcn_readlane(es_, sa_ & 63), ib_ = __builtin_amdgcn_readlane(es_, (sa_ + 1) & 63); \
                const int id_ = hl ? ib_ : ia_; R[(S_) & 1][i] = *(const v4u*)(PU + (size_t)id_ * (D / 2) + 512 * ((S_) >> 3) + 16 * l31); } } while (0)
#define UL_WRITE(S_) do { _Pragma("unroll") for (int i = 0; i < 8; ++i) *(LAS v4u*)(tw + 2 * i * 528) = R[(S_) & 1][i]; } while (0)
#define UL_MMA(S_) do { if (((S_) & 7) == 0) { _Pragma("unroll") for (int ml = 0; ml < 8; ++ml) { const v4u x0 = *(const LAS v4u*)(bp + 128 * (8 * ((S_) >> 3) + ml)), x1 = *(const LAS v4u*)(bp + 128 * (8 * ((S_) >> 3) + ml) + 64); \
                    Bk[ml] = (v8i_t){(int)x0.x, (int)x0.y, (int)x0.z, (int)x0.w, (int)x1.x, (int)x1.y, (int)x1.z, (int)x1.w}; } } \
                _Pragma("unroll") for (int ml = 0; ml < 8; ++ml) { const v4u w = *(const LAS v4u*)(tr + 64 * ml); \
                    acc[(S_) & 7] = __builtin_amdgcn_mfma_scale_f32_16x16x128_f8f6f4((v8i_t){(int)w.x, (int)w.y, (int)w.z, (int)w.w, 0, 0, 0, 0}, Bk[ml], acc[(S_) & 7], 4, 0, 0, 0x7f7f7f7f, 0, 0x7f7f7f7f); } } while (0)
            UL_LOAD(0); __builtin_amdgcn_sched_barrier(0);
#pragma unroll
            for (int s = 0; s < 16; ++s) {
                if (s + 1 == 8) asm volatile("" : "+v"(e0b), "+v"(e1b));
                if (s + 1 < 16) UL_LOAD(s + 1);
                __builtin_amdgcn_sched_barrier(0);
                UL_WRITE(s); __builtin_amdgcn_sched_barrier(0);
                UL_MMA(s); __builtin_amdgcn_sched_barrier(0);
            }
#undef UL_LOAD
#undef UL_WRITE
#undef UL_MMA
            asm volatile("s_nop 15\n\ts_nop 15" : "+v"(acc[0]), "+v"(acc[1]), "+v"(acc[2]), "+v"(acc[3]), "+v"(acc[4]), "+v"(acc[5]), "+v"(acc[6]), "+v"(acc[7]));
            LAS float* SS = (LAS float*)(wl + 12544);
            if (n16 < 2) {
#pragma unroll
                for (int rb = 0; rb < 8; ++rb) *(LAS f32x4*)(SS + n16 * 128 + 16 * rb + 4 * kq) = acc[rb]; }
            asm volatile("" ::: "memory");
            a0 = SS[lane] + SS[128 + lane] * 0.0625f; a1 = SS[64 + lane] + SS[192 + lane] * 0.0625f;
            asm volatile("" ::: "memory");
        }
        float* HC = (float*)(F.ws + WS_Z) + (size_t)row * 128;
        HC[lane] = gelu_tanh(a0 * su0) * g0 * sv0; HC[64 + lane] = gelu_tanh(a1 * su1) * g1 * sv1;
    }
}
template <int L> __device__ __forceinline__ void peer_v_phase(Frame& F, int M) {
    const int gw = F.vcu * NWAVES + F.wave, NGW = F.G * NWAVES;
    const char* PU = (const char*)(F.ws + WS_PU8) + (size_t)L * P_E * (D / 2); const char* PV = (const char*)(F.ws + WS_PV8) + (size_t)L * P_E * (D / 2);
    const float* SCU = (const float*)(F.ws + WS_SC) + (size_t)L * P_E; const float* SCV = (const float*)(F.ws + WS_SC) + (size_t)(4 + L) * P_E;
    const int* IDX = (const int*)(F.ws + WS_IDX); const float* PG = (const float*)(F.ws + WS_PG);
    const float* lg = F.in[I_LNG] + (size_t)(L * 2 + 1) * D; const float* lb = F.in[I_LNB] + (size_t)(L * 2 + 1) * D;
    for (int row = gw; row < M; row += NGW) {
        int lane_l = F.lane; asm volatile("" : "+v"(lane_l));
        const int lane = lane_l, lo16 = lane * 16;
        const int e0 = IDX[(size_t)row * 128 + lane], e1 = IDX[(size_t)row * 128 + 64 + lane];
        RowBatch A, Bb;
        constexpr int NB3 = 128 / P3B;
        p3_load_batch(A, PV, e0, 0, lo16);
        const float h0 = ((const float*)(F.ws + WS_Z))[(size_t)row * 128 + lane], h1 = ((const float*)(F.ws + WS_Z))[(size_t)row * 128 + 64 + lane];
        f32x2 acc[16];
#pragma unroll
        for (int j = 0; j < 16; ++j) acc[j] = (f32x2){0.f, 0.f};
#define P3_AXPY(BUF, KB) do { _Pragma("unroll") for (int q = 0; q < P3B; ++q) { const int k = (KB) + q; const float hk = rl(k < 64 ? h0 : h1, k & 63); axpy32_fp4(BUF.r[q], hk, acc); } } while (0)
        for (int bb = 0; bb < NB3; bb += 2) {
            p3_load_batch(Bb, PV, (bb + 1) * P3B < 64 ? e0 : e1, (P3B * (bb + 1)) & 63, lo16);
            P3_AXPY(A, P3B * bb);
            if (bb + 2 < NB3) p3_load_batch(A, PV, (bb + 2) * P3B < 64 ? e0 : e1, (P3B * (bb + 2)) & 63, lo16);
            P3_AXPY(Bb, P3B * bb + P3B);
        }
#undef P3_AXPY
        int lane2 = lane_l; asm volatile("" : "+v"(lane2) : "v"(acc[0]), "v"(acc[15]));
        const bf16* xr = (const bf16*)(F.ws + WS_X) + (size_t)row * D + 4 * lane2; const float* md = mod_row(F, L, row) + 4 * lane2;
        float s = 0.f;
#pragma unroll
        for (int q = 0; q < 8; ++q) { const v2u xp = *(const v2u*)(xr + 256 * q); const f32x4 xa = {bf_lo(xp.x), bf_hi(xp.x), bf_lo(xp.y), bf_hi(xp.y)}, ga = *(const f32x4*)(md + 5 * D + 256 * q);
#pragma unroll
            for (int j = 0; j < 4; ++j) { float v = acc[2 * q + (j >> 1)][j & 1]; v = ALPHA * xa[j] + ga[j] * v; acc[2 * q + (j >> 1)][j & 1] = v; s += v; } }
        const float mean = wsum(s) * (1.0f / D); float qv = 0.f;
#pragma unroll
        for (int j = 0; j < 16; ++j) { acc[j] = acc[j] - mean; qv += acc[j][0] * acc[j][0] + acc[j][1] * acc[j][1]; }
        const float rstd = 1.0f / sqrtf(wsum(qv) * (1.0f / D) + LN_EPS);
        float* xo = F.out + (size_t)row * D + 4 * lane2; bf16* xb = (bf16*)(F.ws + WS_X) + (size_t)row * D + 4 * lane2;
        unsigned char* ho = F.ws + WS_H + (size_t)row * D + 4 * lane2;
        const float* mdn = mod_row(F, (L + 1) & 3, row) + 4 * lane2;
#pragma unroll
        for (int q = 0; q < 8; ++q) { const int o = 256 * q; const f32x4 wa = *(const f32x4*)(lg + 4 * lane2 + o), ba = *(const f32x4*)(lb + 4 * lane2 + o);
            f32x4 oa;
#pragma unroll
            for (int j = 0; j < 4; ++j) oa[j] = acc[2 * q + (j >> 1)][j & 1] * rstd * wa[j] + ba[j];
            if (L == DEPTH - 1) *(f32x4*)(xo + o) = oa; else { v2u xw; xw.x = cvt_pk_bf16(oa[0], oa[1]); xw.y = cvt_pk_bf16(oa[2], oa[3]); *(v2u*)(xb + o) = xw; }
            if (L < DEPTH - 1) { const f32x4 sa = *(const f32x4*)(mdn + o), ca = *(const f32x4*)(mdn + D + o); const f32x4 ha = oa * (ca + 1.0f) + sa;
                *(unsigned*)(ho + o) = pk4_fp8(ha[0], ha[1], ha[2], ha[3]); } }
    }
}

constexpr int MP = 272;
constexpr int ML_QH = 0, ML_KH = 128 * MP, ML_VT = 2 * 128 * MP, ML_VW = 3 * 128 * MP, ML_GA = 4 * 128 * MP;
__device__ __forceinline__ s16x4 tr_read(LAS unsigned char* p) { return __builtin_amdgcn_ds_read_tr16_b64_v4i16((LAS s16x4*)p); }
__device__ __forceinline__ bf16x8 cat8(s16x4 a, s16x4 b) { return (bf16x8){a[0], a[1], a[2], a[3], b[0], b[1], b[2], b[3]}; }

template <int L> __device__ __forceinline__ void mlstm_scan_phase(Frame& F) {
    constexpr int J = L / 3;
    LAS unsigned char* lds = F.lds;
    LAS float* GA = (LAS float*)(lds + ML_GA);
    LAS float* gA = GA, *gMM = GA + 128, *gWI = GA + 256, *gEN = GA + 384, *gWS = GA + 512, *gNQ = GA + 640, *gHD = GA + 768;
    LAS float* gN = GA + 896;
    LAS float* gRS2 = GA + 896 + 512 + 16;
    const bf16* Zq = (const bf16*)(F.ws + WS_Z + ZQ); const bf16* Zk = (const bf16*)(F.ws + WS_Z + ZK); const bf16* Zv = (const bf16*)(F.ws + WS_Z + ZV);
    const float* G16 = (const float*)(F.ws + WS_GATE); const float* bg = F.in[I_ABG] + J * 16;
    const int tid0 = F.tid, w = F.wave;
    for (int unit = F.vcu; unit < 256; unit += F.G) {
        const int chain = unit >> 2, vs = unit & 3, dir = chain & 1, hd = (chain >> 1) & 3, b = chain >> 3;
        bf16* HO = (bf16*)(F.ws + (dir ? WS_Y : WS_H));
        float* GPa = (float*)(F.ws + WS_GP) + (size_t)unit * (3 * 34 * 128); float* GPb = GPa + 34 * 128; float* GPp = GPb + 34 * 128;
#define CBASE(jc_) ((jc_) < 2 ? TL + b * CL + (dir ? 1 - (jc_) : (jc_)) * 128 : b * SEQ + (dir ? 33 - (jc_) : (jc_) - 2) * 128)
        for (int jc = w; jc < 34; jc += NWAVES) {
            const int base = CBASE(jc); const int lane = tid0 & 63;
            const int s0 = 2 * lane, s1 = 2 * lane + 1;
            const float* g0 = G16 + (size_t)(base + (dir ? 127 - s0 : s0)) * 16; const float* g1 = G16 + (size_t)(base + (dir ? 127 - s1 : s1)) * 16;
            const int ci = dir * 8 + hd, cf = dir * 8 + 4 + hd;
            float li0 = g0[ci] + bg[ci], li1 = g1[ci] + bg[ci], gf0 = g0[cf] + bg[cf], gf1 = g1[cf] + bg[cf];
            li0 = 15.f * tanhf(li0 * (1.f / 15.f)); li1 = 15.f * tanhf(li1 * (1.f / 15.f)); gf0 = 15.f * tanhf(gf0 * (1.f / 15.f)); gf1 = 15.f * tanhf(gf1 * (1.f / 15.f));
            const float lf0 = fminf(gf0, 0.f) - log1pf(__expf(-fabsf(gf0))), lf1 = fminf(gf1, 0.f) - log1pf(__expf(-fabsf(gf1)));
            float p = lf0 + lf1;
#pragma unroll
            for (int o = 1; o < 64; o <<= 1) { const float t = __shfl_up(p, o); if (lane >= o) p += t; }
            const float b1 = p, b0 = p - lf1;
            const float a0 = li0 - b0, a1 = li1 - b1;
            float pm = fmaxf(a0, a1);
#pragma unroll
            for (int o = 1; o < 64; o <<= 1) { const float t = __shfl_up(pm, o); if (lane >= o) pm = fmaxf(pm, t); }
            float pe = __shfl_up(pm, 1); if (lane == 0) pe = -3.0e38f;
            *(f32x2*)(GPa + jc * 128 + s0) = (f32x2){a0, a1}; *(f32x2*)(GPb + jc * 128 + s0) = (f32x2){b0, b1}; *(f32x2*)(GPp + jc * 128 + s0) = (f32x2){fmaxf(pe, a0), pm};
        }
        f32x4 C[16];
#pragma unroll
        for (int i = 0; i < 16; ++i) C[i] = zero4();
        for (int i = tid0; i < 512; i += NTHR) gN[i] = 0.f;
        __syncthreads();
        float m = 0.f;
        v4u PQ[4], PK[4], PV[4]; float pa[4]; float pe_a, pe_b, pe_p, pl_b, pl_p;
#define LOAD_QK(jc_, hf_) do { int t_ = tid0; asm volatile("" : "+v"(t_)); const int base_ = CBASE(jc_); const size_t r0_ = (size_t)(base_ + (dir ? 127 - (t_ >> 4) : (t_ >> 4))); const long rs_ = dir ? -32 : 32; \
            const bf16* qp_ = Zq + r0_ * 1024 + hd * 256 + (hf_) * 128 + (t_ & 15) * 8; const bf16* kp_ = Zk + r0_ * 1024 + hd * 256 + (hf_) * 128 + (t_ & 15) * 8; \
            _Pragma("unroll") for (int i = 0; i < 4; ++i) { PQ[i] = *(const v4u*)(qp_ + (long)i * rs_ * 1024); PK[i] = *(const v4u*)(kp_ + (long)i * rs_ * 1024); } } while (0)
#define LOAD_V(jc_) do { int t_ = tid0; asm volatile("" : "+v"(t_)); const int base_ = CBASE(jc_); const size_t r0_ = (size_t)(base_ + (dir ? 127 - (t_ >> 4) : (t_ >> 4))); const long rs_ = dir ? -32 : 32; \
            const bf16* vp_ = Zv + r0_ * 2048 + hd * 512 + vs * 128 + (t_ & 15) * 8; \
            _Pragma("unroll") for (int i = 0; i < 4; ++i) { PV[i] = *(const v4u*)(vp_ + (long)i * rs_ * 2048); pa[i] = GPa[(jc_) * 128 + (t_ >> 4) + 32 * i]; } } while (0)
#define LOAD_G(jc_) do { int t_ = tid0; asm volatile("" : "+v"(t_)); const int o_ = (jc_) * 128 + (t_ & 127); pe_a = GPa[o_]; pe_b = GPb[o_]; pe_p = GPp[o_]; pl_b = GPb[(jc_) * 128 + 127]; pl_p = GPp[(jc_) * 128 + 127]; } while (0)
        LOAD_QK(0, 0); LOAD_V(0); LOAD_G(0);
        for (int jc = 0; jc < 34; ++jc) {
            const int base = CBASE(jc);
#define ROWMAP(r) (base + (dir ? 127 - (r) : (r)))
            LAS float* Ncur = gN + (jc & 1) * 256; LAS float* Nnxt = gN + ((jc & 1) ^ 1) * 256;
            int tid_l = tid0; asm volatile("" : "+v"(tid_l));
            const int tid = tid_l, lane = tid & 63, fr = lane & 15, fq = lane >> 4;
            int X1 = fr * MP + 16 * fq, X2 = fr * MP + 8 * fq, X3 = (8 * fq + (fr >> 2)) * MP + 8 * (fr & 3), XS = (tid >> 4) * MP + (tid & 15) * 16, X4 = 32 * fq;
            asm volatile("" : "+v"(X1), "+v"(X2), "+v"(X3), "+v"(XS), "+v"(X4));
            const int X1w = X1 + 16 * w * MP, X2w = X2 + 16 * w * MP, X3w = X3 + 32 * w;
            const float M127 = __builtin_bit_cast(float, __builtin_amdgcn_readfirstlane(__builtin_bit_cast(int, fmaxf(m, pl_p))));
            const float decay = __builtin_bit_cast(float, __builtin_amdgcn_readfirstlane(__builtin_bit_cast(int, __expf(m - M127))));
            if (tid < 128) { const float Mt = fmaxf(m, pe_p);
                gA[tid] = pe_a; gMM[tid] = Mt; gWI[tid] = __expf(m - Mt); gEN[tid] = __expf(-pe_b - Mt); gWS[tid] = __expf(pe_a - M127) * 0.0625f; }
            m = __builtin_bit_cast(float, __builtin_amdgcn_readfirstlane(__builtin_bit_cast(int, pl_b + M127)));
            f32x4 Sacc[5], CQ[8]; v2u SP[5]; float rsum = 0.f; const int lo_own = w >= 5 ? w - 4 : 0;
#pragma unroll
            for (int i = 0; i < 8; ++i) { if (i < 5) Sacc[i] = zero4(); CQ[i] = zero4(); }
#pragma unroll
            for (int hf = 0; hf < 2; ++hf) {
#pragma unroll
                for (int i = 0; i < 4; ++i) { *(LAS v4u*)(lds + ML_QH + XS + i * 32 * MP) = PQ[i]; *(LAS v4u*)(lds + ML_KH + XS + i * 32 * MP) = PK[i]; }
                if (hf == 0) {
#pragma unroll
                    for (int i = 0; i < 4; ++i) {
                        const v4u v = PV[i]; const float ws = __expf(pa[i] - M127) * 0.0625f;
                        *(LAS v4u*)(lds + ML_VT + XS + i * 32 * MP) = v;
                        v4u o; o.x = cvt_pk_bf16(bf_lo(v.x) * ws, bf_hi(v.x) * ws); o.y = cvt_pk_bf16(bf_lo(v.y) * ws, bf_hi(v.y) * ws);
                        o.z = cvt_pk_bf16(bf_lo(v.z) * ws, bf_hi(v.z) * ws); o.w = cvt_pk_bf16(bf_lo(v.w) * ws, bf_hi(v.w) * ws);
                        *(LAS v4u*)(lds + ML_VW + XS + i * 32 * MP) = o; }
                }
                __syncthreads();
                if (hf == 0) { LOAD_QK(jc, 1); }
                else if (jc < 33) { LOAD_QK(jc + 1, 0); }
#pragma unroll
                for (int i = 0; i < 5; ++i) {
                    const bool own = i <= w - lo_own; const int tbi = own ? w : 7 - w, sbi = own ? lo_own + i : i - (w + 1);
                    if (own || (w < 3 && sbi < 3 - w)) {
#pragma unroll
                        for (int ks = 0; ks < 4; ++ks) { const bf16x8 kf = *(const LAS bf16x8*)(lds + ML_KH + X1 + sbi * 16 * MP + ks * 64); const bf16x8 qf = *(const LAS bf16x8*)(lds + ML_QH + X1 + tbi * 16 * MP + ks * 64);
                            Sacc[i] = __builtin_amdgcn_mfma_f32_16x16x32_bf16(kf, qf, Sacc[i], 0, 0, 0); }
                    }
                }
                if (hf == 1) {
                    float rs_own = 0.f, rs_help = 0.f;
#pragma unroll
                    for (int i = 0; i < 5; ++i) {
                        const bool own = i <= w - lo_own; const int tbi = own ? w : 7 - w, sbi = own ? lo_own + i : i - (w + 1);
                        v2u o; o.x = 0u; o.y = 0u;
                        if (own || (w < 3 && sbi < 3 - w)) { const int t = 16 * tbi + fr; const float Mt = gMM[t]; float v[4], rs = 0.f;
#pragma unroll
                            for (int j = 0; j < 4; ++j) { const int sidx = 16 * sbi + 4 * fq + j; v[j] = (sidx <= t) ? Sacc[i][j] * 0.0625f * __expf(gA[sidx] - Mt) : 0.f; rs += v[j]; }
                            o.x = cvt_pk_bf16(v[0], v[1]); o.y = cvt_pk_bf16(v[2], v[3]);
                            if (own) rs_own += rs; else rs_help += rs; }
                        SP[i] = o;
                    }
                    rs_own += __shfl_xor(rs_own, 16); rs_own += __shfl_xor(rs_own, 32); rs_help += __shfl_xor(rs_help, 16); rs_help += __shfl_xor(rs_help, 32);
                    rsum = rs_own;
                    if (w < 3 && fq == 0) gRS2[16 * (7 - w) + fr] = rs_help;
                }
                __builtin_amdgcn_sched_barrier(0);
#pragma unroll
                for (int tb = 0; tb < 8; ++tb) {
#pragma unroll
                    for (int k2 = 0; k2 < 4; ++k2) {
                        const f32x4 c0 = C[hf * 8 + 2 * k2], c1 = C[hf * 8 + 2 * k2 + 1];
                        v4u pk; pk.x = cvt_pk_bf16(c0[0], c0[1]); pk.y = cvt_pk_bf16(c0[2], c0[3]); pk.z = cvt_pk_bf16(c1[0], c1[1]); pk.w = cvt_pk_bf16(c1[2], c1[3]);
                        const s16x4 qa = *(const LAS s16x4*)(lds + ML_QH + X2 + tb * 16 * MP + k2 * 64), qb = *(const LAS s16x4*)(lds + ML_QH + X2 + tb * 16 * MP + k2 * 64 + 32);
                        CQ[tb] = __builtin_amdgcn_mfma_f32_16x16x32_bf16(cat8(qa, qb), __builtin_bit_cast(bf16x8, pk), CQ[tb], 0, 0, 0); }
                }
                __builtin_amdgcn_sched_barrier(0);
                {
                    f32x4 nacc = zero4();
#pragma unroll
                    for (int ks = 0; ks < 4; ++ks) {
                        const LAS float* np = (const LAS float*)((LAS unsigned char*)Ncur + X4 + hf * 512 + ks * 128);
                        const f32x4 n0 = *(const LAS f32x4*)np, n1 = *(const LAS f32x4*)(np + 4);
                        v4u pk; pk.x = cvt_pk_bf16(n0[0], n0[1]); pk.y = cvt_pk_bf16(n0[2], n0[3]); pk.z = cvt_pk_bf16(n1[0], n1[1]); pk.w = cvt_pk_bf16(n1[2], n1[3]);
                        const bf16x8 qf = *(const LAS bf16x8*)(lds + ML_QH + X1w + ks * 64);
                        nacc = __builtin_amdgcn_mfma_f32_16x16x32_bf16(qf, __builtin_bit_cast(bf16x8, pk), nacc, 0, 0, 0); }
                    if (fr == 0) {
#pragma unroll
                        for (int j = 0; j < 4; ++j) { const int t = 16 * w + 4 * fq + j; gNQ[t] = (hf == 0 ? 0.f : gNQ[t]) + nacc[j]; } }
                }
                __builtin_amdgcn_sched_barrier(0);
#pragma unroll
                for (int dt = 0; dt < 8; ++dt) {
                    f32x4 acc = C[hf * 8 + dt] * decay;
#pragma unroll
                    for (int ss = 0; ss < 4; ++ss) { LAS unsigned char* p = lds + ML_KH + X3 + ss * 32 * MP + dt * 32; LAS unsigned char* pw = lds + ML_VW + X3w + ss * 32 * MP;
                        acc = __builtin_amdgcn_mfma_f32_16x16x32_bf16(cat8(tr_read(p), tr_read(p + 4 * MP)), cat8(tr_read(pw), tr_read(pw + 4 * MP)), acc, 0, 0, 0); }
                    C[hf * 8 + dt] = acc;
                }
                __builtin_amdgcn_sched_barrier(0);
                {
                    f32x4 nacc = zero4();
#pragma unroll
                    for (int ss = 0; ss < 4; ++ss) {
                        const LAS float* wp = (const LAS float*)((LAS unsigned char*)gWS + X4 + ss * 128);
                        const f32x4 w0 = *(const LAS f32x4*)wp, w1 = *(const LAS f32x4*)(wp + 4);
                        v4u pk; pk.x = cvt_pk_bf16(w0[0], w0[1]); pk.y = cvt_pk_bf16(w0[2], w0[3]); pk.z = cvt_pk_bf16(w1[0], w1[1]); pk.w = cvt_pk_bf16(w1[2], w1[3]);
                        LAS unsigned char* p = lds + ML_KH + X3w + ss * 32 * MP;
                        nacc = __builtin_amdgcn_mfma_f32_16x16x32_bf16(cat8(tr_read(p), tr_read(p + 4 * MP)), __builtin_bit_cast(bf16x8, pk), nacc, 0, 0, 0); }
                    if (fr == 0) {
#pragma unroll
                        for (int j = 0; j < 4; ++j) { const int dl = hf * 128 + 16 * w + 4 * fq + j; Nnxt[dl] = decay * Ncur[dl] + nacc[j]; } }
                }
                __syncthreads();
            }
            {
#pragma unroll
                for (int i = 0; i < 5; ++i) {
                    const bool own = i <= w - lo_own; const int tbi = own ? w : 7 - w, sbi = own ? lo_own + i : i - (w + 1);
                    if (own || (w < 3 && sbi < 3 - w)) *(LAS v2u*)(lds + ML_QH + X2 + tbi * 16 * MP + sbi * 32) = SP[i];
                }
                for (int sb = w + 1; sb < 8; ++sb) { v2u z; z.x = 0u; z.y = 0u; *(LAS v2u*)(lds + ML_QH + X2w + sb * 32) = z; }
                const int t = 16 * w + fr;
                if (fq == 0) { const float den = gWI[t] * gNQ[t] + rsum + (w >= 5 ? gRS2[t] : 0.f); gHD[t] = 1.0f / fmaxf(fabsf(den), gEN[t]); }
            }
            __syncthreads();
            {
                bf16x8 vf[4];
#pragma unroll
                for (int ss = 0; ss < 4; ++ss) { LAS unsigned char* p = lds + ML_VT + X3w + ss * 32 * MP; vf[ss] = cat8(tr_read(p), tr_read(p + 4 * MP)); }
                if (jc < 33) { LOAD_V(jc + 1); LOAD_G(jc + 1); }
                bf16* hop = HO + (size_t)ROWMAP(4 * fq) * D + hd * 512 + vs * 128 + 16 * w + fr; const long hstep = dir ? -(long)D : (long)D;
#pragma unroll
                for (int tb = 0; tb < 8; ++tb) {
                    f32x4 acc;
#pragma unroll
                    for (int j = 0; j < 4; ++j) acc[j] = CQ[tb][j] * gWI[16 * tb + 4 * fq + j];
#pragma unroll
                    for (int ss = 0; ss < 4; ++ss) { const bf16x8 sf = *(const LAS bf16x8*)(lds + ML_QH + X1 + tb * 16 * MP + ss * 64);
                        acc = __builtin_amdgcn_mfma_f32_16x16x32_bf16(sf, vf[ss], acc, 0, 0, 0); }
#pragma unroll
                    for (int j = 0; j < 4; ++j) { const float h = acc[j] * gHD[16 * tb + 4 * fq + j];
                        hop[(long)(16 * tb + j) * hstep] = (bf16)(cvt_pk_bf16(h, 0.f) & 0xffffu); }
                }
            }
            __syncthreads();
#undef ROWMAP
        }
#undef LOAD_QK
#undef LOAD_V
#undef LOAD_G
#undef CBASE
    }
}

template <int L> __device__ __forceinline__ void mlstm_post_phase(Frame& F, int M) {
    constexpr int J = L / 3;
    const int gw = F.vcu * NWAVES + F.wave, NGW = F.G * NWAVES;
    const float* ng = F.in[I_ANG] + (size_t)J * D;
    for (int row = gw; row < M; row += NGW) {
        const bf16* hf = (const bf16*)(F.ws + WS_H) + (size_t)row * D; const bf16* hb = (const bf16*)(F.ws + WS_Y) + (size_t)row * D;
        const bf16* orow = (const bf16*)(F.ws + WS_Z + ZO) + (size_t)row * D; unsigned char* g = F.ws + WS_Z + ZG + (size_t)row * D;
        f32x4 t[8]; float ss[4];
#pragma unroll
        for (int j = 0; j < 8; ++j) { const int e = 4 * F.lane + 256 * j; const v2u a = *(const v2u*)(hf + e), b = *(const v2u*)(hb + e);
            t[j] = (f32x4){bf_lo(a.x) + bf_lo(b.x), bf_hi(a.x) + bf_hi(b.x), bf_lo(a.y) + bf_lo(b.y), bf_hi(a.y) + bf_hi(b.y)}; }
#pragma unroll
        for (int h = 0; h < 4; ++h) { float q = 0.f;
#pragma unroll
            for (int jj = 0; jj < 2; ++jj) { const f32x4 v = t[2 * h + jj]; q += (v[0] * v[0] + v[1] * v[1]) + (v[2] * v[2] + v[3] * v[3]); }
            ss[h] = 1.0f / sqrtf(wsum(q) * (1.0f / A_DV) + LN_EPS); }
#pragma unroll
        for (int j = 0; j < 8; ++j) { const int e = 4 * F.lane + 256 * j; const v2u ov = *(const v2u*)(orow + e); const f32x4 gn = *(const f32x4*)(ng + e);
            const float o0 = bf_lo(ov.x), o1 = bf_hi(ov.x), o2 = bf_lo(ov.y), o3 = bf_hi(ov.y); const float r = ss[j >> 1];
            const float y0 = t[j][0] * r * gn[0] / (1.0f + __expf(-o0)), y1 = t[j][1] * r * gn[1] / (1.0f + __expf(-o1));
            const float y2 = t[j][2] * r * gn[2] / (1.0f + __expf(-o2)), y3 = t[j][3] * r * gn[3] / (1.0f + __expf(-o3));
            *(unsigned*)(g + e) = pk4_fp8(y0, y1, y2, y3); }
    }
}

__device__ __forceinline__ void gmlp_stats_phase(Frame& F, int M) {
    const int gw = F.vcu * NWAVES + F.wave, NGW = F.G * NWAVES;
    float* ST = (float*)(F.ws + WS_STAT);
    for (int row = gw; row < M; row += NGW) {
        const bf16* vr = (const bf16*)(F.ws + WS_Z + ZVV) + (size_t)row * 4096;
        v4u x[8]; float s = 0.f;
#pragma unroll
        for (int j = 0; j < 8; ++j) { x[j] = *(const v4u*)(vr + 8 * F.lane + 512 * j);
            s += (bf_lo(x[j].x) + bf_hi(x[j].x)) + (bf_lo(x[j].y) + bf_hi(x[j].y)) + (bf_lo(x[j].z) + bf_hi(x[j].z)) + (bf_lo(x[j].w) + bf_hi(x[j].w)); }
        const float mean = wsum(s) * (1.0f / 4096.f); float q = 0.f;
#pragma unroll
        for (int j = 0; j < 8; ++j) { float d;
            d = bf_lo(x[j].x) - mean; q += d * d; d = bf_hi(x[j].x) - mean; q += d * d; d = bf_lo(x[j].y) - mean; q += d * d; d = bf_hi(x[j].y) - mean; q += d * d;
            d = bf_lo(x[j].z) - mean; q += d * d; d = bf_hi(x[j].z) - mean; q += d * d; d = bf_lo(x[j].w) - mean; q += d * d; d = bf_hi(x[j].w) - mean; q += d * d; }
        const float rstd = 1.0f / sqrtf(wsum(q) * (1.0f / 4096.f) + LN_EPS);
        if (F.lane == 0) { ST[(size_t)row * 2] = mean; ST[(size_t)row * 2 + 1] = rstd; }
    }
}
__device__ __forceinline__ void gmlp_spatial_phase(Frame& F, int M) {
    LAS unsigned char* lds = F.lds;
    constexpr int GW_W = 0, GW_V = 128 * MP, GW_O = 2 * 128 * MP;
    const bf16* WS = (const bf16*)(F.ws + WS_WS); const float* ST = (const float*)(F.ws + WS_STAT);
    const bf16* U = (const bf16*)(F.ws + WS_Z + ZU); const bf16* V = (const bf16*)(F.ws + WS_Z + ZVV);
    const float* lng = F.in[I_BLNG]; const float* lnb = F.in[I_BLNB]; const float* bs = F.in[I_BBS];
    const int w = F.wave;
    const int nunits = (M / 128) * B_GROUPS;
    for (int u = F.vcu; u < nunits; u += F.G) {
        int tid_l = F.tid; asm volatile("" : "+v"(tid_l));
        const int tid = tid_l, lane = tid & 63, fr = lane & 15, fq = lane >> 4;
        const int chunk = u >> 3, g = u & 7, row0 = chunk * 128;
        const int et = tid >> 2, ec = tid & 3;
        v4u wreg[4], vreg[4][4]; float mean[4], rstd[4];
#pragma unroll
        for (int i = 0; i < 4; ++i) { const int c = tid + 512 * i, r = c >> 4, cc = c & 15;
            wreg[i] = *(const v4u*)(WS + (size_t)g * 16384 + r * 128 + cc * 8);
            mean[i] = ST[(size_t)(row0 + r) * 2]; rstd[i] = ST[(size_t)(row0 + r) * 2 + 1];
#pragma unroll
            for (int dq = 0; dq < 4; ++dq) vreg[dq][i] = *(const v4u*)(V + (size_t)(row0 + r) * 4096 + g * 512 + dq * 128 + cc * 8); }
        const float bst = bs[g * 128 + et];
#pragma unroll
        for (int i = 0; i < 4; ++i) { const int c = tid + 512 * i, r = c >> 4, cc = c & 15; *(LAS v4u*)(lds + GW_W + r * MP + cc * 16) = wreg[i]; }
#pragma unroll
        for (int dq = 0; dq < 4; ++dq) {
            const int col0 = g * 512 + dq * 128;
#pragma unroll
            for (int i = 0; i < 4; ++i) { const int c = tid + 512 * i, r = c >> 4, cc = c & 15;
                const v4u v = vreg[dq][i]; const float mn = mean[i], rs = rstd[i];
                const f32x4 ga = *(const f32x4*)(lng + col0 + cc * 8), gb = *(const f32x4*)(lng + col0 + cc * 8 + 4), ba = *(const f32x4*)(lnb + col0 + cc * 8), bb = *(const f32x4*)(lnb + col0 + cc * 8 + 4);
                v4u o;
                o.x = cvt_pk_bf16((bf_lo(v.x) - mn) * rs * ga[0] + ba[0], (bf_hi(v.x) - mn) * rs * ga[1] + ba[1]);
                o.y = cvt_pk_bf16((bf_lo(v.y) - mn) * rs * ga[2] + ba[2], (bf_hi(v.y) - mn) * rs * ga[3] + ba[3]);
                o.z = cvt_pk_bf16((bf_lo(v.z) - mn) * rs * gb[0] + bb[0], (bf_hi(v.z) - mn) * rs * gb[1] + bb[1]);
                o.w = cvt_pk_bf16((bf_lo(v.w) - mn) * rs * gb[2] + bb[2], (bf_hi(v.w) - mn) * rs * gb[3] + bb[3]);
                *(LAS v4u*)(lds + GW_V + r * MP + cc * 16) = o; }
            __syncthreads();
            v4u ureg[4];
            { const bf16* up = U + (size_t)(row0 + et) * 4096 + col0 + 32 * ec;
#pragma unroll
              for (int k = 0; k < 4; ++k) ureg[k] = *(const v4u*)(up + 8 * k); }
            bf16x8 wf[4];
#pragma unroll
            for (int ss = 0; ss < 4; ++ss) wf[ss] = *(const LAS bf16x8*)(lds + GW_W + (16 * w + fr) * MP + (32 * ss + 8 * fq) * 2);
#pragma unroll
            for (int db = 0; db < 8; ++db) {
                f32x4 acc = zero4();
#pragma unroll
                for (int ss = 0; ss < 4; ++ss) { LAS unsigned char* p = lds + GW_V + (32 * ss + 8 * fq + (fr >> 2)) * MP + (16 * db + 4 * (fr & 3)) * 2;
                    acc = __builtin_amdgcn_mfma_f32_16x16x32_bf16(cat8(tr_read(p), tr_read(p + 4 * MP)), wf[ss], acc, 0, 0, 0); }
                v2u o; o.x = cvt_pk_bf16(acc[0], acc[1]); o.y = cvt_pk_bf16(acc[2], acc[3]);
                *(LAS v2u*)(lds + GW_O + (16 * w + fr) * MP + (16 * db + 4 * fq) * 2) = o;
            }
            __syncthreads();
            { const LAS unsigned char* op = lds + GW_O + et * MP + 64 * ec;
              unsigned char* hp = F.ws + WS_H + (size_t)(row0 + et) * 4096 + col0 + 32 * ec;
              v4u out[2];
#pragma unroll
              for (int k = 0; k < 4; ++k) { const v4u sv = *(const LAS v4u*)(op + 16 * k); const v4u uv = ureg[k];
                  const unsigned lo = pk4_fp8(bf_lo(uv.x) * (bf_lo(sv.x) + bst), bf_hi(uv.x) * (bf_hi(sv.x) + bst), bf_lo(uv.y) * (bf_lo(sv.y) + bst), bf_hi(uv.y) * (bf_hi(sv.y) + bst));
                  const unsigned hi = pk4_fp8(bf_lo(uv.z) * (bf_lo(sv.z) + bst), bf_hi(uv.z) * (bf_hi(sv.z) + bst), bf_lo(uv.w) * (bf_lo(sv.w) + bst), bf_hi(uv.w) * (bf_hi(sv.w) + bst));
                  out[k >> 1][2 * (k & 1)] = lo; out[k >> 1][2 * (k & 1) + 1] = hi; }
              *(v4u*)hp = out[0]; *(v4u*)(hp + 16) = out[1]; }
        }
        __syncthreads();
    }
}

namespace att {
using bf16 = unsigned short;
constexpr int   D = 128, NW = 8, QBLK = 32, KVBLK = 64;
constexpr float SCALE = 0.088388347648318440f;
constexpr float THR = 8.f;
constexpr int SDEPTH = 2;
constexpr int LDQ = 2048, LDK = 512, LDO = 2048;
constexpr size_t SHM_V = KVBLK * D * 2, SHM_K = KVBLK * D * 2, SHM_ATTN = 2 * SHM_V + 2 * SHM_K + NW * 64 * 4;
using bf16x8 = __attribute__((ext_vector_type(8))) short;
using s16x4  = __attribute__((ext_vector_type(4))) short;
using f32x16 = __attribute__((ext_vector_type(16))) float;
using f32x8  = __attribute__((ext_vector_type(8))) float;
using u32x4  = __attribute__((ext_vector_type(4))) unsigned;
#define KSWZ(row, colB) ((row) * 256 + ((colB) ^ (((row) & 7) << 4)))
#define SBAR() __builtin_amdgcn_sched_barrier(0)
__device__ __forceinline__ int crow(int r, int hi) { return (r & 3) + 8 * (r >> 2) + 4 * hi; }
__device__ __forceinline__ unsigned cvtpk(float lo, float hi) { return ::cvt_pk_bf16(lo, hi); }
template <typename TIn> struct Stage;
template <> struct Stage<bf16>  { using T = bf16x8;
  __device__ static __forceinline__ T ld8(const bf16* p) { return *reinterpret_cast<const bf16x8*>(p); }
  __device__ static __forceinline__ bf16x8 tobf(T x) { return x; } };
__device__ __forceinline__ void partialSM(f32x16& p0, f32x16& p1, float& m_reg, float& mn, float& alpha) {
  constexpr float C = SCALE * 1.4426950408889634f;
  float pmax = p0[0]; for (int r = 1; r < 16; ++r) pmax = fmaxf(pmax, p0[r]); for (int r = 0; r < 16; ++r) pmax = fmaxf(pmax, p1[r]);
  { auto rr = __builtin_amdgcn_permlane32_swap(__float_as_uint(pmax), __float_as_uint(pmax), false, false);
    pmax = fmaxf(__uint_as_float(rr[0]), __uint_as_float(rr[1])); }
  if (__builtin_expect(__all(pmax - m_reg <= THR / SCALE), 1)) { mn = m_reg; alpha = 1.f; }
  else { mn = fmaxf(m_reg, pmax); alpha = __builtin_amdgcn_exp2f((m_reg - mn) * C); m_reg = mn; }
  float mnC = -mn * C;
  for (int r = 0; r < 16; ++r) p0[r] = fmaf(p0[r], C, mnC); for (int r = 0; r < 16; ++r) p1[r] = fmaf(p1[r], C, mnC);
  for (int r = 0; r < 16; ++r) p0[r] = __builtin_amdgcn_exp2f(p0[r]);
}
__device__ __forceinline__ void finishSM(f32x16& p0, f32x16& p1, float alpha, float& l_reg, bf16x8& pa0, bf16x8& pa1, bf16x8& pa2, bf16x8& pa3) {
  for (int r = 0; r < 16; ++r) p1[r] = __builtin_amdgcn_exp2f(p1[r]);
  float ps = 0; for (int r = 0; r < 16; ++r) ps += p0[r]; for (int r = 0; r < 16; ++r) ps += p1[r];
  { auto rr = __builtin_amdgcn_permlane32_swap(__float_as_uint(ps), __float_as_uint(ps), false, false);
    ps = __uint_as_float(rr[0]) + __uint_as_float(rr[1]); }
  l_reg = l_reg * alpha + ps;
#define PK4(P, BASE, OUT) do { unsigned a0 = cvtpk(P[BASE + 0], P[BASE + 1]), a1 = cvtpk(P[BASE + 2], P[BASE + 3]);   \
    unsigned b0 = cvtpk(P[BASE + 4], P[BASE + 5]), b1 = cvtpk(P[BASE + 6], P[BASE + 7]);                              \
    auto r0 = __builtin_amdgcn_permlane32_swap(a0, b0, false, false); auto r1 = __builtin_amdgcn_permlane32_swap(a1, b1, false, false); \
    u32x4 w = {r0[0], r1[0], r0[1], r1[1]}; OUT = *reinterpret_cast<bf16x8*>(&w); } while (0)
  PK4(p0, 0, pa0); PK4(p0, 8, pa1); PK4(p1, 0, pa2); PK4(p1, 8, pa3);
#undef PK4
}
__device__ __forceinline__ void qkt(f32x16& p0, f32x16& p1, const bf16* Ks, const bf16x8* qr, int r32, int hi) {
  p0 = f32x16{}; p1 = f32x16{};
  for (int d0 = 0; d0 < 8; ++d0) { int cb = (d0 * 16 + hi * 8) * 2;
    bf16x8 b0 = *reinterpret_cast<const bf16x8*>((const char*)Ks + KSWZ(r32, cb));
    bf16x8 b1 = *reinterpret_cast<const bf16x8*>((const char*)Ks + KSWZ(32 + r32, cb));
    p0 = __builtin_amdgcn_mfma_f32_32x32x16_bf16(b0, qr[d0], p0, 0, 0, 0);
    p1 = __builtin_amdgcn_mfma_f32_32x32x16_bf16(b1, qr[d0], p1, 0, 0, 0); }
}
__device__ __forceinline__ int v_st(int k, int c) { const int kk = (k & ~0xC) | ((k & 4) << 1) | ((k & 8) >> 1); return ((kk >> 3) * 4 + (c >> 5)) * 512 + ((kk & 7) * 32 + (c & 31)) * 2; }
__device__ __forceinline__ int v_rd_base(int lane) { return ((lane & 3) << 3) | (((lane >> 2) & 3) << 6) | (((lane >> 4) & 1) << 5) | (((lane >> 5) & 1) << 8); }
constexpr int v_rd_off(int d0, int ks, int half) { return d0 * 512 + ks * 4096 + half * 2048; }
template <int OFF> __device__ __forceinline__ s16x4 tr_read(int vb) {
  return __builtin_amdgcn_ds_read_tr16_b64_v4i16((__attribute__((address_space(3))) s16x4*)(unsigned long)(unsigned)(vb + OFF));
}
template <int D0> __device__ __forceinline__ void pv_one(f32x16& od, int vb, bf16x8 pa0, bf16x8 pa1, bf16x8 pa2, bf16x8 pa3) {
  const s16x4 l0 = tr_read<v_rd_off(D0, 0, 0)>(vb), h0 = tr_read<v_rd_off(D0, 0, 1)>(vb), l1 = tr_read<v_rd_off(D0, 1, 0)>(vb), h1 = tr_read<v_rd_off(D0, 1, 1)>(vb);
  const s16x4 l2 = tr_read<v_rd_off(D0, 2, 0)>(vb), h2 = tr_read<v_rd_off(D0, 2, 1)>(vb), l3 = tr_read<v_rd_off(D0, 3, 0)>(vb), h3 = tr_read<v_rd_off(D0, 3, 1)>(vb);
#define PK(L, H) (bf16x8){L[0], L[1], L[2], L[3], H[0], H[1], H[2], H[3]}
  od = __builtin_amdgcn_mfma_f32_32x32x16_bf16(pa0, PK(l0, h0), od, 0, 0, 0);
  od = __builtin_amdgcn_mfma_f32_32x32x16_bf16(pa1, PK(l1, h1), od, 0, 0, 0);
  od = __builtin_amdgcn_mfma_f32_32x32x16_bf16(pa2, PK(l2, h2), od, 0, 0, 0);
  od = __builtin_amdgcn_mfma_f32_32x32x16_bf16(pa3, PK(l3, h3), od, 0, 0, 0);
#undef PK
}
__device__ __forceinline__ void pv_d0(f32x16* o, int vb, bf16x8 pa0, bf16x8 pa1, bf16x8 pa2, bf16x8 pa3) {
  pv_one<0>(o[0], vb, pa0, pa1, pa2, pa3); pv_one<1>(o[1], vb, pa0, pa1, pa2, pa3); pv_one<2>(o[2], vb, pa0, pa1, pa2, pa3); pv_one<3>(o[3], vb, pa0, pa1, pa2, pa3);
}

template <typename TQ>
__device__ __forceinline__ void attn_dense_body(const TQ* __restrict__ Qb, const bf16* __restrict__ Kh, const bf16* __restrict__ Vh,
                                                unsigned char* __restrict__ Ob, int seq, char* lds, int tid_in) {
  using St = Stage<bf16>; using SQ = Stage<TQ>;
  const int tid = tid_in, wid = tid >> 6, lane = tid & 63, r32 = lane & 31, hi = lane >> 5;
  bf16* V_lds = (bf16*)lds; bf16* K_lds = (bf16*)(lds + 2 * SHM_V);
  float* ws = (float*)(lds + 2 * SHM_V + 2 * SHM_K) + wid * 64; float* li_l = ws; float* al_l = ws + 32;
  float m_reg = -1e30f, l_reg = 0; f32x16 o[4] = {}; bf16x8 qr[8];
  const TQ* Qw = Qb + (long)(wid * QBLK + r32) * LDQ + hi * 8;
#pragma unroll
  for (int d0 = 0; d0 < 8; ++d0) qr[d0] = SQ::tobf(SQ::ld8(Qw + d0 * 16));
  const int sr = tid >> 4, sc = (tid & 15) * 8, vst0 = v_st(sr, sc), vst1 = v_st(32 + sr, sc);
  const int vb0 = (int)(uintptr_t)V_lds + v_rd_base(lane);
  struct { typename St::T vs0, vs1, ks0, ks1; } sr_[SDEPTH];
#define SLOAD(i, k0) do { sr_[i].vs0 = St::ld8(&Vh[(long)((k0) + sr) * LDK + sc]); sr_[i].vs1 = St::ld8(&Vh[(long)((k0) + 32 + sr) * LDK + sc]); \
    sr_[i].ks0 = St::ld8(&Kh[(long)((k0) + sr) * LDK + sc]); sr_[i].ks1 = St::ld8(&Kh[(long)((k0) + 32 + sr) * LDK + sc]); } while (0)
#define SWRITE(b, i) do { *(bf16x8*)((char*)V_lds + (b) * SHM_V + vst0) = St::tobf(sr_[i].vs0);          \
    *(bf16x8*)((char*)V_lds + (b) * SHM_V + vst1) = St::tobf(sr_[i].vs1); int kc = sc * 2;               \
    *(bf16x8*)((char*)K_lds + (b) * SHM_K + KSWZ(sr, kc)) = St::tobf(sr_[i].ks0);                       \
    *(bf16x8*)((char*)K_lds + (b) * SHM_K + KSWZ(32 + sr, kc)) = St::tobf(sr_[i].ks1); } while (0)
#define SWAIT() do { if constexpr (SDEPTH == 2) asm volatile("s_waitcnt vmcnt(4)" ::: "memory"); else asm volatile("s_waitcnt vmcnt(0)" ::: "memory"); } while (0)
#define RESC(a) do { if (__any((a) < 1.f)) { if (hi == 0) al_l[r32] = (a); asm volatile("s_waitcnt lgkmcnt(0)" ::: "memory"); \
    for (int d = 0; d < 4; ++d) for (int r = 0; r < 16; ++r) o[d][r] *= al_l[crow(r, hi)]; } } while (0)
  f32x16 pA0, pA1, pB0, pB1; float mnA, mnB, alA, alB; bf16x8 pa0, pa1, pa2, pa3; const int NT = seq / KVBLK;
  constexpr int SE = 0, SO = SDEPTH - 1;
  SLOAD(SE, 0); asm volatile("s_waitcnt vmcnt(0)" ::: "memory"); SWRITE(0, SE); __syncthreads();
  qkt(pA0, pA1, K_lds, qr, r32, hi); partialSM(pA0, pA1, m_reg, mnA, alA);
  SLOAD(SO, KVBLK); if constexpr (SDEPTH == 2) { if (2 < NT) SLOAD(SE, 2 * KVBLK); }
  SWAIT(); SWRITE(1, SO); __syncthreads();
  for (int j = 1; j + 1 < NT; j += 2) {
    SBAR(); qkt(pB0, pB1, (bf16*)((char*)K_lds + SHM_K), qr, r32, hi);
    finishSM(pA0, pA1, alA, l_reg, pa0, pa1, pa2, pa3); SBAR();
    SLOAD(SO, (j + SDEPTH) * KVBLK); SBAR();
    pv_d0(o, vb0, pa0, pa1, pa2, pa3); partialSM(pB0, pB1, m_reg, mnB, alB);
    __syncthreads(); SWAIT(); SWRITE(0, SE);
    RESC(alB); __syncthreads();
    SBAR(); qkt(pA0, pA1, K_lds, qr, r32, hi);
    finishSM(pB0, pB1, alB, l_reg, pa0, pa1, pa2, pa3); SBAR();
    if (SDEPTH == 1 || j + 3 < NT) SLOAD(SE, (j + 1 + SDEPTH) * KVBLK); SBAR();
    pv_d0(o, vb0 + (int)SHM_V, pa0, pa1, pa2, pa3); partialSM(pA0, pA1, m_reg, mnA, alA);
    __syncthreads(); SWAIT(); SWRITE(1, SO);
    RESC(alA); __syncthreads();
  }
  SBAR(); qkt(pB0, pB1, (bf16*)((char*)K_lds + SHM_K), qr, r32, hi);
  finishSM(pA0, pA1, alA, l_reg, pa0, pa1, pa2, pa3); SBAR();
  pv_d0(o, vb0, pa0, pa1, pa2, pa3); partialSM(pB0, pB1, m_reg, mnB, alB);
  __syncthreads(); RESC(alB);
  finishSM(pB0, pB1, alB, l_reg, pa0, pa1, pa2, pa3); SBAR();
  pv_d0(o, vb0 + (int)SHM_V, pa0, pa1, pa2, pa3);
  if (hi == 0) li_l[r32] = l_reg; asm volatile("s_waitcnt lgkmcnt(0)" ::: "memory");
  float rli[16];
#pragma unroll
  for (int r = 0; r < 16; ++r) rli[r] = __builtin_amdgcn_rcpf(li_l[crow(r, hi)]);
  unsigned char* Ow = Ob + (long)(wid * QBLK) * LDO;
#pragma unroll
  for (int r = 0; r < 16; ++r) { int orow = crow(r, hi);
    for (int d0 = 0; d0 < 4; ++d0) Ow[(long)orow * LDO + d0 * 32 + r32] = (unsigned char)(__builtin_amdgcn_cvt_pk_fp8_f32(o[d0][r] * rli[r], 0.f, 0, false) & 0xff); }
#undef SLOAD
#undef SWRITE
#undef SWAIT
#undef RESC
}
}

constexpr size_t WS_ROPE = WS_STAT + 512 * 1024;
__device__ __forceinline__ void rope_table(Frame& F) {
    float* R = (float*)(F.ws + WS_ROPE);
    const int i = F.vcu * NTHR + F.tid;
    if (i < 64 * 32) { const int pos = i >> 5, fi = i & 31; const float fr = powf(10000.0f, -(float)fi / 32.0f); const float ang = (float)pos * fr; R[2 * i] = cosf(ang); R[2 * i + 1] = sinf(ang); }
}
__device__ __forceinline__ v4u normrope_seg(const bf16* src, const float* g, const float* R, bool rope, int rowpos, int colpos, int lane) {
    const v4u x = *(const v4u*)(src + 8 * lane);
    float v[8] = {bf_lo(x.x), bf_hi(x.x), bf_lo(x.y), bf_hi(x.y), bf_lo(x.z), bf_hi(x.z), bf_lo(x.w), bf_hi(x.w)};
    float q = 0.f;
#pragma unroll
    for (int i = 0; i < 8; ++i) q += v[i] * v[i];
    const float rstd = 1.0f / sqrtf(row16_sum(q) * (1.0f / 128.f) + LN_EPS);
    const int d0 = 8 * (lane & 15);
    const f32x4 ga = *(const f32x4*)(g + d0), gb = *(const f32x4*)(g + d0 + 4);
#pragma unroll
    for (int i = 0; i < 4; ++i) { v[i] *= rstd * ga[i]; v[4 + i] *= rstd * gb[i]; }
    if (rope) {
        const int pos = ((lane & 15) >> 3) ? colpos : rowpos; const bool hi = (lane & 7) >= 4; const int f0 = 8 * (lane & 3);
#pragma unroll
        for (int i = 0; i < 8; ++i) { const float p = __shfl_xor(v[i], 4); const float cs = R[(pos * 32 + f0 + i) * 2], sn = R[(pos * 32 + f0 + i) * 2 + 1];
            v[i] = hi ? (p * sn + v[i] * cs) : (v[i] * cs - p * sn); }
    }
    v4u o; o.x = cvt_pk_bf16(v[0], v[1]); o.y = cvt_pk_bf16(v[2], v[3]); o.z = cvt_pk_bf16(v[4], v[5]); o.w = cvt_pk_bf16(v[6], v[7]);
    return o;
}
__device__ __forceinline__ void attn_prep_phase(Frame& F) {
    const int gw = F.vcu * NWAVES + F.wave, NGW = F.G * NWAVES;
    const float* R = (const float*)(F.ws + WS_ROPE);
    const float* qg = F.in[I_CQG]; const float* kg = F.in[I_CKG];
    for (int row = gw; row < T; row += NGW) {
        const bool lat = row < TL; const int b = lat ? (row >> 12) : ((row - TL) >> 8); const int s = lat ? (row & 4095) : 0;
        const int rp = s >> 6, cp = s & 63; const int kvrow = lat ? (b * SKV + s) : (b * SKV + SEQ + ((row - TL) & 255));
        bf16* q = (bf16*)(F.ws + WS_Z + ZAQ) + (size_t)row * 2048;
#pragma unroll
        for (int p = 0; p < 4; ++p) { const v4u o = normrope_seg(q + 512 * p, qg, R, lat, rp, cp, F.lane); *(v4u*)(q + 512 * p + 8 * F.lane) = o; }
        const bf16* k = (const bf16*)(F.ws + WS_Z + ZAK) + (size_t)row * 512; const bf16* v = (const bf16*)(F.ws + WS_Z + ZAV) + (size_t)row * 512;
        const v4u ko = normrope_seg(k, kg, R, lat, rp, cp, F.lane);
        *(v4u*)((bf16*)(F.ws + WS_Z + ZKC) + (size_t)kvrow * 512 + 8 * F.lane) = ko;
        *(v4u*)((bf16*)(F.ws + WS_Z + ZVC) + (size_t)kvrow * 512 + 8 * F.lane) = *(const v4u*)(v + 8 * F.lane);
    }
}
__device__ __forceinline__ void attn_phase(Frame& F, char* lds, bool need_ctx) {
    const bf16* Q = (const bf16*)(F.ws + WS_Z + ZAQ); const bf16* KC = (const bf16*)(F.ws + WS_Z + ZKC); const bf16* VC = (const bf16*)(F.ws + WS_Z + ZVC);
    unsigned char* O = F.ws + WS_H;
    const int nunits = 2048 + (need_ctx ? 128 : 0);
    for (int u = F.vcu; u < nunits; u += F.G) {
        const bf16 *qp, *kp, *vp; unsigned char* op; int seq;
        if (u < 2048) { const int qb = u & 15, h = (u >> 4) & 15, b = u >> 8; const size_t qrow = (size_t)b * SEQ + qb * 256;
            qp = Q + qrow * 2048 + h * 128; kp = KC + (size_t)b * SKV * 512 + (h >> 2) * 128; vp = VC + (size_t)b * SKV * 512 + (h >> 2) * 128; op = O + qrow * 2048 + h * 128; seq = SKV;
        } else { const int uu = u - 2048, h = uu & 15, b = uu >> 4; const size_t qrow = (size_t)TL + b * CL;
            qp = Q + qrow * 2048 + h * 128; kp = KC + ((size_t)b * SKV + SEQ) * 512 + (h >> 2) * 128; vp = VC + ((size_t)b * SKV + SEQ) * 512 + (h >> 2) * 128; op = O + qrow * 2048 + h * 128; seq = CL; }
        int tid_l = threadIdx.x; asm volatile("" : "+v"(tid_l));
        att::attn_dense_body<bf16>(qp, kp, vp, op, seq, lds, tid_l);
        __syncthreads();
    }
}

#ifndef MK_N_LAUNCHES
#define MK_N_LAUNCHES 1
#endif
constexpr int NPH = 2 + 8 * DEPTH;
struct Args { const float* in[28]; float* out; unsigned char* ws; int ph_lo, ph_hi; };

typedef pg8::EpiSeg<0> EpiPlain;
__device__ __forceinline__ EpiPlain epi_plain(bf16* o, int ld) { EpiPlain E; E.base = (unsigned char*)o; E.ld = ld; E.bias = nullptr; E.gates = nullptr; E.oscale = 1.0f / WSCALE; return E; }


__global__ void __launch_bounds__(NTHR, 2) fwd_kernel(Args args) {
    extern __shared__ __attribute__((aligned(16))) unsigned char lds_raw[];
    Frame F;
    F.lds = (LAS unsigned char*)lds_raw;
    F.tid = threadIdx.x; F.lane = F.tid & 63; F.wave = __builtin_amdgcn_readfirstlane(F.tid >> 6);
    F.G = gridDim.x; { const int bx = blockIdx.x; F.vcu = (F.G % 8 == 0) ? (bx % 8) * (F.G / 8) + bx / 8 : bx; }
    typedef const Args __attribute__((address_space(4)))* KArgs;
    KArgs ka = (KArgs)__builtin_amdgcn_kernarg_segment_ptr();
    F.in = ka->in; F.out = ka->out; F.ws = ka->ws;
    volatile LAS unsigned* MISC = (volatile LAS unsigned*)(F.lds + MISC_OFF);
    for (int u = F.tid; u < (LDS_BYTES - MISC_OFF) / 4; u += NTHR) MISC[u] = 0u;
    __syncthreads();
    const int lo = ka->ph_lo, hi = ka->ph_hi;
    unsigned* barw = (unsigned*)(F.ws + WS_CTL) + CW_BAR;
    XcdBarrier bar; bar.bar = barw; bar.x = 0; bar.st = nullptr;
    if (hi - lo > 1) bar = xcd_barrier_post(barw, MISC + 8);
#ifdef ONLY_PHASE
#define IN(k) ((k) == ONLY_PHASE && lo <= (k) && (k) < hi)
#else
#define IN(k) (lo <= (k) && (k) < hi)
#endif
#define SEAM(k) do { if (IN(k) && IN((k) + 1)) xcd_barrier(bar); } while (0)
#define RELANE() do { int t_ = threadIdx.x; asm volatile("" : "+v"(t_)); F.tid = t_; F.lane = t_ & 63; KArgs k_ = ka; asm volatile("" : "+s"(k_)); F.in = k_->in; F.out = k_->out; F.ws = k_->ws; } while (0)
#define WT (F.ws + WS_WT)
#define Hb ((bf16*)(F.ws + WS_H))
#define Yb ((bf16*)(F.ws + WS_Y))
#define Zb ((bf16*)(F.ws + WS_Z))

    if (IN(0)) { RELANE(); p0_prologue(F); rope_table(F); } SEAM(0);
    if (IN(1)) { RELANE(); p0b_modulate(F); } SEAM(1);

#define GEMM_PHASE16(EPI, Aptr, Bptr, M_, N_, K_) do { pg8::Gemm g{(const bf16*)(Aptr), (const bf16*)(Bptr), (M_), (N_), (K_)}; pg8::StaticOrder S; S.init((M_), (N_), F.G, (int)blockIdx.x); \
        pg8::gemm_phase<false>(F.lds, g, S, (EPI)); } while (0)
#define GEMM_PHASE(EPI, Aptr, Bptr, M_, N_, K_) do { pg8::Gemm g{(const bf16*)(Aptr), (const bf16*)(Bptr), (M_), (N_), (K_) / 2}; pg8::StaticOrder S; S.init((M_), (N_), F.G, (int)blockIdx.x); \
        pg8::gemm_phase<true>(F.lds, g, S, (EPI)); } while (0)
#define PEER_PHASES(L, PB, M_) do { \
        if (IN((PB) + 4)) { RELANE(); ln1_phase<L>(F, (M_)); } SEAM((PB) + 4); \
        if (IN((PB) + 5)) { RELANE(); EpiPlain E = epi_plain(Zb, 2048); \
            if ((PQ_FP8_MASK >> (L)) & 1) { GEMM_PHASE(E, Hb, WT + WT_PQ + (size_t)(L) * D * D * 2, (M_), 2048, 2048); } \
            else { E.oscale = 1.0f; GEMM_PHASE16(E, Yb, WT + WT_PQ + (size_t)(L) * D * D * 2, (M_), 2048, 2048); } } SEAM((PB) + 5); \
        if (IN((PB) + 6)) { RELANE(); peer_topk_phase<L>(F, (M_)); } SEAM((PB) + 6); \
        if (IN((PB) + 7)) { RELANE(); peer_u_phase<L>(F, (M_)); if (hi - lo > 1) xcd_barrier(bar); RELANE(); peer_v_phase<L>(F, (M_)); } SEAM((PB) + 7); } while (0)
#define MLSTM_PHASES(L, PB, M_) do { \
        if (IN((PB) + 0)) { RELANE(); pg8::EpiSeg<1> E; E.base = F.ws + WS_Z; E.ld = 0; E.bias = nullptr; E.gates = (float*)(F.ws + WS_GATE); E.oscale = 1.0f / WSCALE; \
            GEMM_PHASE(E, Hb, WT + WT_AIN + (size_t)((L) / 3) * A_INP * D, T, A_INP, 2048); } SEAM((PB) + 0); \
        if (IN((PB) + 1)) { RELANE(); mlstm_scan_phase<L>(F); } SEAM((PB) + 1); \
        if (IN((PB) + 2)) { RELANE(); mlstm_post_phase<L>(F, (M_)); } SEAM((PB) + 2); \
        if (IN((PB) + 3)) { RELANE(); EpiPlain E = epi_plain(Yb, 2048); GEMM_PHASE(E, F.ws + WS_Z + ZG, WT + WT_AOUT + (size_t)((L) / 3) * D * D, (M_), 2048, 2048); } SEAM((PB) + 3); } while (0)

    MLSTM_PHASES(0, 2, T);
    PEER_PHASES(0, 2, T);
    if (IN(10)) { RELANE(); pg8::EpiSeg<2> E; E.base = F.ws + WS_Z; E.ld = 0; E.bias = F.in[I_BBIN]; E.gates = nullptr; E.oscale = 1.0f / WSCALE; GEMM_PHASE(E, Hb, WT + WT_BIN, T, 8192, 2048); } SEAM(10);
    if (IN(11)) { RELANE(); gmlp_stats_phase(F, T); } SEAM(11);
    if (IN(12)) { RELANE(); gmlp_spatial_phase(F, T); } SEAM(12);
    if (IN(13)) { RELANE(); EpiPlain E = epi_plain(Yb, 2048); GEMM_PHASE(E, Hb, WT + WT_BOUT, T, 2048, 4096); } SEAM(13);
    PEER_PHASES(1, 10, T);
    if (IN(18)) { RELANE(); pg8::EpiSeg<3> E; E.base = F.ws + WS_Z; E.ld = 0; E.bias = nullptr; E.gates = nullptr; E.oscale = 1.0f / WSCALE; GEMM_PHASE(E, Hb, WT + WT_CQKV, T, C_QKV, 2048); } SEAM(18);
    if (IN(19)) { RELANE(); attn_prep_phase(F); } SEAM(19);
    if (IN(20)) { RELANE(); attn_phase(F, (char*)lds_raw, true); } SEAM(20);
    if (IN(21)) { RELANE(); EpiPlain E = epi_plain(Yb, 2048); GEMM_PHASE(E, Hb, WT + WT_COUT, T, 2048, 2048); } SEAM(21);
    PEER_PHASES(2, 18, T);
    MLSTM_PHASES(3, 26, TL);
    PEER_PHASES(3, 26, TL);
#undef IN
#undef SEAM
#undef WT
#undef Hb
#undef Yb
#undef Zb
}


extern "C" void kernel_launch(void* const* d_in, const int* in_sizes, int n_in, void* d_out, int out_size, void* d_ws, size_t ws_size, hipStream_t stream) {
    static int grid = 0;
    if (grid == 0) {
        if (n_in != 28 || out_size != TL * D || ws_size < WS_END) { fprintf(stderr, "kernel_launch: unexpected shapes: n_in %d out %d ws %zu (need %zu)\n", n_in, out_size, ws_size, (size_t)WS_END); grid = -1; return; }
        int dev = 0, cus = 0, per_cu = 0;
        if (hipGetDevice(&dev) != hipSuccess || hipDeviceGetAttribute(&cus, hipDeviceAttributeMultiprocessorCount, dev) != hipSuccess) { grid = -1; return; }
        if (hipFuncSetAttribute((const void*)fwd_kernel, hipFuncAttributeMaxDynamicSharedMemorySize, LDS_BYTES) != hipSuccess) { fprintf(stderr, "kernel_launch: hipFuncSetAttribute failed\n"); grid = -1; return; }
        if (hipOccupancyMaxActiveBlocksPerMultiprocessor(&per_cu, (const void*)fwd_kernel, NTHR, LDS_BYTES) != hipSuccess || per_cu < 1) { fprintf(stderr, "kernel_launch: occupancy query says %d\n", per_cu); }
        (void)hipGetLastError();
        grid = cus;
    }
    if (grid < 0) return;
    if (hipMemsetAsync((char*)d_ws + WS_CTL, 0, CTL_ZERO_BYTES, stream) != hipSuccess) return;
    Args a{};
    for (int i = 0; i < 28; ++i) a.in[i] = (const float*)d_in[i];
    a.out = (float*)d_out; a.ws = (unsigned char*)d_ws;
#if MK_N_LAUNCHES == 1
    a.ph_lo = 0; a.ph_hi = NPH;
    hipLaunchKernelGGL(fwd_kernel, dim3(grid), dim3(NTHR), LDS_BYTES, stream, a);
#else
    for (int k = 0; k < NPH; ++k) { a.ph_lo = k; a.ph_hi = k + 1; hipLaunchKernelGGL(fwd_kernel, dim3(grid), dim3(NTHR), LDS_BYTES, stream, a); }
#endif
    const hipError_t le = hipPeekAtLastError();
    if (le != hipSuccess) fprintf(stderr, "kernel_launch: launch failed: %s\n", hipGetErrorName(le));
}
```

```cpp
#include <hip/hip_runtime.h>
#include <cstdio>
#include <cstdint>

#define GAS __attribute__((address_space(1)))
#define LAS __attribute__((address_space(3)))
typedef unsigned short bf16;
typedef unsigned v4u __attribute__((ext_vector_type(4)));
typedef unsigned v2u __attribute__((ext_vector_type(2)));
typedef float f32x4 __attribute__((ext_vector_type(4)));
typedef float f32x2 __attribute__((ext_vector_type(2)));
typedef short bf16x8 __attribute__((ext_vector_type(8)));
typedef short s16x4 __attribute__((ext_vector_type(4)));
typedef int v8i_t __attribute__((ext_vector_type(8)));
typedef int v4i_t __attribute__((ext_vector_type(4)));
#define LDS_WAIT() asm volatile("s_waitcnt lgkmcnt(0)" ::: "memory")
#define VM_WAIT() asm volatile("s_waitcnt vmcnt(0)" ::: "memory")

constexpr int D = 2048, NB = 8, SEQ = 4096, CL = 256, DEPTH = 4;
constexpr int TL = NB * SEQ, TC = NB * CL, T = TL + TC;
constexpr int NMOD = 6 * D;
constexpr float ALPHA = 1.681792830507429f;
constexpr float LN_EPS = 1e-6f;
constexpr int A_HEADS = 4, A_DV = 512, A_DK = 256, A_CHUNK = 128, A_IN = 6160, A_INP = 6400;
constexpr int B_INNER = 4096, B_GROUPS = 8;
constexpr int C_HEADS = 16, C_KV = 4, C_HD = 128, C_QKV = 3072, SKV = SEQ + CL;
constexpr int P_HEADS = 8, P_NK = 128, P_TOPK = 16, P_E = 16384;
constexpr int NWAVES = 8, NTHR = 512;

constexpr size_t MiB = 1u << 20;
constexpr size_t WS_CTL = 0, CTL_ZERO_BYTES = 1 * MiB;
constexpr size_t WS_MOD = 1 * MiB;
constexpr size_t WS_STAT = 3 * MiB;
constexpr size_t WS_GATE = 4 * MiB;
constexpr size_t WS_K12 = 7 * MiB;
constexpr size_t WS_WS = 8 * MiB;
constexpr size_t WS_WT = 9 * MiB;
constexpr size_t WT_AIN = 0, WT_AOUT = WT_AIN + (size_t)2 * A_INP * D, WT_BIN = WT_AOUT + (size_t)2 * D * D, WT_BOUT = WT_BIN + (size_t)8192 * D,
                 WT_CQKV = WT_BOUT + (size_t)D * 4096, WT_COUT = WT_CQKV + (size_t)C_QKV * D, WT_PQ = WT_COUT + (size_t)D * D, WT_END = WT_PQ + (size_t)4 * D * D * 2;
constexpr int PQ_FP8_MASK = 0x3;
constexpr float WSCALE = 64.0f;
constexpr size_t WS_PU8 = 192 * MiB;
constexpr size_t WS_PV8 = WS_PU8 + (size_t)4 * P_E * D;
constexpr size_t WS_SC = WS_PV8 + (size_t)4 * P_E * D;
constexpr size_t WS_X = WS_SC + 1 * MiB;
constexpr size_t WS_GP = WS_X + (size_t)T * D * 2;
constexpr size_t WS_H = WS_X + (size_t)T * D * 4;
constexpr size_t WS_Y = WS_H + (size_t)T * D * 2;
constexpr size_t WS_Z = WS_Y + (size_t)T * D * 2;
constexpr size_t WS_IDX = WS_Z + (size_t)T * 8192 * 2;
constexpr size_t WS_PG = WS_IDX + (size_t)T * 128 * 4;
constexpr size_t WS_END = WS_PG + (size_t)T * 128 * 4;
static_assert(WS_WT + WT_END <= WS_PU8, "weights fit");
constexpr size_t ZQ = 0, ZK = (size_t)T * 1024 * 2, ZV = ZK + (size_t)T * 1024 * 2, ZO = ZV + (size_t)T * 2048 * 2, ZG = 0;
constexpr size_t ZU = 0, ZVV = (size_t)T * 4096 * 2;
constexpr size_t ZAQ = 0, ZAK = (size_t)T * 2048 * 2, ZAV = ZAK + (size_t)T * 512 * 2, ZKC = ZAV + (size_t)T * 512 * 2, ZVC = ZKC + (size_t)NB * SKV * 512 * 2;
constexpr int CW_BAR = 4096;

constexpr int LDS_BYTES = 155648;
constexpr int MISC_OFF = 151552;

typedef __bf16 bf16x2_t __attribute__((ext_vector_type(2)));
__device__ __forceinline__ unsigned cvt_pk_bf16(float lo, float hi) { const f32x2 v = {lo, hi}; return __builtin_bit_cast(unsigned, __builtin_convertvector(v, bf16x2_t)); }
__device__ __forceinline__ unsigned pk4_fp8(float a, float b, float c, float d) { int w = __builtin_amdgcn_cvt_pk_fp8_f32(a, b, 0, false); return (unsigned)__builtin_amdgcn_cvt_pk_fp8_f32(c, d, w, true); }
typedef float f32x16_t __attribute__((ext_vector_type(16)));
__device__ __forceinline__ f32x4 zero4() { f32x4 z = {0.f, 0.f, 0.f, 0.f}; asm volatile("" : "+v"(z)); return z; }
__device__ __forceinline__ f32x16_t zero16() { f32x16_t z = {}; asm volatile("" : "+v"(z)); return z; }
__device__ __forceinline__ float bf_lo(unsigned u) { return __uint_as_float(u << 16); }
__device__ __forceinline__ float bf_hi(unsigned u) { return __uint_as_float(u & 0xffff0000u); }
__device__ __forceinline__ float bf2f(bf16 b) { return __uint_as_float(((unsigned)b) << 16); }
__device__ __forceinline__ float wave_sum(float v) {
#pragma unroll
    for (int o = 1; o < 64; o <<= 1) v += __shfl_xor(v, o);
    return v;
}
__device__ __forceinline__ float wave_max(float v) {
#pragma unroll
    for (int o = 1; o < 64; o <<= 1) v = fmaxf(v, __shfl_xor(v, o));
    return v;
}
__device__ __forceinline__ float fast_exp(float x) { return __builtin_amdgcn_exp2f(x * 1.4426950408889634f); }
__device__ __forceinline__ float gelu_tanh(float x) {
    const float u = 0.7978845608028654f * (x + 0.044715f * x * x * x);
    const float e = __builtin_amdgcn_exp2f(-2.0f * 1.4426950408889634f * u);
    return x * __builtin_amdgcn_rcpf(1.0f + e);
}
__device__ __forceinline__ float silu(float x) { return x / (1.0f + __expf(-x)); }

#define XB_TMO      128
#define XB_XCNT(j)  (256  + 64 * (j))
#define XB_XSUB(j)  (1280 + 64 * (j))
#define XB_XGEN(j)  (2304 + 64 * (j))
#define XB_TOP      3328
#define XB_TOPGEN   3392
#define XCD_BAR_WORDS 3456
#define XB_SPIN_CAP (1u << 22)

__device__ __forceinline__ unsigned xb_ld(unsigned* p)              { return __hip_atomic_load(p, __ATOMIC_RELAXED, __HIP_MEMORY_SCOPE_AGENT); }
__device__ __forceinline__ unsigned xb_add(unsigned* p, unsigned v) { return __hip_atomic_fetch_add(p, v, __ATOMIC_RELAXED, __HIP_MEMORY_SCOPE_AGENT); }
__device__ __forceinline__ unsigned xb_xcc_id() { return (unsigned)__builtin_amdgcn_s_getreg((3 << 11) | 20) & 0xFu; }
#define XB_SPIN(cond, bar) do { unsigned _sp = 0; while (cond) { __builtin_amdgcn_s_sleep(1); \
    if ((++_sp & 255u) == 0u) { if (xb_ld(&(bar)[XB_TMO])) break; if (_sp > XB_SPIN_CAP) { atomicAdd(&(bar)[XB_TMO], 1u); break; } } } } while (0)

struct XcdBarrier { unsigned* bar; unsigned x; volatile LAS unsigned* st; };
__device__ __forceinline__ XcdBarrier xcd_barrier_post(unsigned* bar, volatile LAS unsigned* st) {
    XcdBarrier b; b.bar = bar; b.x = xb_xcc_id(); b.st = st;
    if (threadIdx.x == 0) (void)xb_add(&bar[XB_XCNT(b.x)], 1u);
    return b;
}
__device__ __forceinline__ void xcd_barrier_complete(unsigned* bar, unsigned x, unsigned& nloc, unsigned& nx) {
    const unsigned G = gridDim.x * gridDim.y * gridDim.z;
    unsigned sum, cnt, mine, sp = 0u;
    for (;;) {
        sum = 0u; cnt = 0u; mine = 0u;
#pragma unroll
        for (unsigned j = 0; j < 16; ++j) { const unsigned c = xb_ld(&bar[XB_XCNT(j)]); sum += c; cnt += (c > 0u) ? 1u : 0u; mine = (j == x) ? c : mine; }
        if (sum == G) break;
        __builtin_amdgcn_s_sleep(1);
        if ((++sp & 255u) == 0u) { if (xb_ld(&bar[XB_TMO])) break; if (sp > XB_SPIN_CAP) { atomicAdd(&bar[XB_TMO], 1u); break; } }
    }
    nloc = mine > 0u ? mine : 1u; nx = cnt > 0u ? cnt : 1u;
}
__device__ __forceinline__ void xcd_barrier(const XcdBarrier& b) {
    asm volatile("s_waitcnt vmcnt(0)" ::: "memory");
    __syncthreads();
    if (threadIdx.x == 0) {
        unsigned* bar = b.bar;
        __builtin_amdgcn_s_waitcnt(0);
        unsigned nloc = b.st[0], nx = b.st[1];
        if (nloc == 0u) { xcd_barrier_complete(bar, b.x, nloc, nx); b.st[0] = nloc; b.st[1] = nx; }
        const unsigned old = xb_add(&bar[XB_XSUB(b.x)], 1u);
        const unsigned gen = old / nloc;
        if (old + 1u == (gen + 1u) * nloc) {
            __builtin_amdgcn_fence(__ATOMIC_RELEASE, "agent");
            asm volatile("s_waitcnt vmcnt(0)" ::: "memory");
            const unsigned og = xb_add(&bar[XB_TOP], 1u);
            const unsigned tg = og / nx;
            if (og + 1u == (tg + 1u) * nx) xb_add(&bar[XB_TOPGEN], 1u);
            else XB_SPIN(xb_ld(&bar[XB_TOPGEN]) == tg, bar);
            __builtin_amdgcn_fence(__ATOMIC_ACQUIRE, "agent");
            xb_add(&bar[XB_XGEN(b.x)], 1u);
            asm volatile("s_waitcnt vmcnt(0)" ::: "memory");
        } else {
            XB_SPIN(xb_ld(&bar[XB_XGEN(b.x)]) == gen, bar);
            __builtin_amdgcn_fence(__ATOMIC_ACQUIRE, "agent");
            asm volatile("s_waitcnt vmcnt(0)" ::: "memory");
        }
    }
    __syncthreads();
}

namespace pg8 {
#define PG8_LAS __attribute__((address_space(3)))
typedef unsigned short bf16_t;
typedef unsigned u32x4 __attribute__((ext_vector_type(4)));
using ::v4i_t; using ::v8i_t;
constexpr int BM = 256, BK = 64, HALF = 128, HTB = HALF * BK * 2, STAGE_BYTES = 8 * HTB, NXCD = 8, WGM = 8;
__host__ __device__ __forceinline__ int lds_byte(int r, int c) { const int st = (r >> 4) * 2 + (c >> 5), rr = r & 15, cc = c & 31, ob = rr * 64 + cc * 2; return st * 1024 + (ob ^ (((ob >> 9) & 1) << 5)); }
__host__ __device__ __forceinline__ void stage_rc(int b, int& R, int& C) { const int st = b / 1024, sb = b % 1024, swz = sb ^ (((sb >> 9) & 1) << 5); R = (st >> 1) * 16 + swz / 64; C = (st & 1) * 32 + (swz % 64) / 2; }
__host__ __device__ __forceinline__ int perm32(int rho) { const int n = rho >> 4, i = rho & 15; return 8 * (i >> 2) + 4 * n + (i & 3); }
struct Unit { int pm, pn; };
struct Gemm { const bf16_t* A; const bf16_t* Bt; int M, N, K; };
struct StaticOrder {
    int nM, nN, nwg, G, c;
    __host__ __device__ void init(int M, int N, int G_, int c_) { nM = M / BM; nN = N / BM; nwg = nM * nN; G = G_; c = c_; }
    __host__ __device__ bool next(int i, Unit& u) const {
        const long L = (long)i * G + c; if (L >= nwg) return false;
        int wgid = (int)L; { const int q = nwg / NXCD, r = nwg % NXCD, xcd = wgid % NXCD, off = wgid / NXCD; wgid = (xcd < r ? xcd * (q + 1) : r * (q + 1) + (xcd - r) * q) + off; }
        const int nig = WGM * nN, gid = wgid / nig, fm = gid * WGM, gsz = (nM - fm) < WGM ? (nM - fm) : WGM;
        u.pm = fm + ((wgid % nig) % gsz); u.pn = (wgid % nig) / gsz; return true;
    }
    __device__ __forceinline__ void a_ready(const Unit&) const {}
    __device__ __forceinline__ void done(const Unit&) const {}
};
template <int MODE> struct EpiSeg {
    static constexpr bool PERM = true, AFTER_DRAIN = false;
    unsigned char* base; int ld; const float* bias; float* gates; float oscale;
    __device__ __forceinline__ void operator()(const f32x4 (&acc)[2][2][4][2], const Unit& u, int wr, int wc, int fr, int fq) const {
        const int row0 = u.pm * BM + wr * 64 + fr;
        if (MODE == 1 && u.pn >= 24) {
            if (wc == 0 && fq < 2) {
#pragma unroll
                for (int ai = 0; ai < 2; ++ai)
#pragma unroll
                    for (int m = 0; m < 4; ++m) { float* rp = gates + (size_t)(row0 + ai * HALF + m * 16) * 16 + 8 * fq;
                        *(f32x4*)(rp) = acc[ai][0][m][0] * oscale; *(f32x4*)(rp + 4) = acc[ai][0][m][1] * oscale; }
            }
        } else {
        size_t off = 0; int ldc = ld, tb = 0;
        if (MODE == 1) { ldc = u.pn < 8 ? 1024 : 2048; tb = u.pn < 4 ? 0 : u.pn < 8 ? 4 : u.pn < 16 ? 8 : 16; off = u.pn < 4 ? ZQ : u.pn < 8 ? ZK : u.pn < 16 ? ZV : ZO; }
        if (MODE == 2) { ldc = 4096; tb = u.pn < 16 ? 0 : 16; off = u.pn < 16 ? ZU : ZVV; }
        if (MODE == 3) { ldc = u.pn < 8 ? 2048 : 512; tb = u.pn < 8 ? 0 : u.pn < 10 ? 8 : 10; off = u.pn < 8 ? ZAQ : u.pn < 10 ? ZAK : ZAV; }
        bf16_t* ob = (bf16_t*)(base + off);
        const int col0 = (u.pn - tb) * BM + wc * 32 + 8 * fq, bcol0 = u.pn * BM + wc * 32 + 8 * fq;
        f32x4 bv[2][2];
#pragma unroll
        for (int bj = 0; bj < 2; ++bj)
#pragma unroll
            for (int n = 0; n < 2; ++n) bv[bj][n] = (MODE == 2) ? *(const f32x4*)(bias + bcol0 + bj * HALF + 4 * n) : (f32x4){0.f, 0.f, 0.f, 0.f};
        const int lid = fr + 16 * fq, frp = 4 * (lid >> 4) + ((lid >> 2) & 3), fqp = lid & 3, srcl = frp + 16 * fqp;
        const int row0p = row0 - fr + frp, col0p = col0 - 8 * fq + 8 * fqp;
#pragma unroll
        for (int ai = 0; ai < 2; ++ai)
#pragma unroll
            for (int m = 0; m < 4; ++m) { bf16_t* rowp = ob + (size_t)(row0p + ai * HALF + m * 16) * ldc + col0p;
#pragma unroll
                for (int bj = 0; bj < 2; ++bj) { f32x4 v0 = acc[ai][bj][m][0] * oscale + bv[bj][0], v1 = acc[ai][bj][m][1] * oscale + bv[bj][1];
                    if (MODE == 2) {
#pragma unroll
                        for (int j = 0; j < 4; ++j) { v0[j] = gelu_tanh(v0[j]); v1[j] = gelu_tanh(v1[j]); } }
                    u32x4 w; w.x = (unsigned)__shfl((int)cvt_pk_bf16(v0[0], v0[1]), srcl); w.y = (unsigned)__shfl((int)cvt_pk_bf16(v0[2], v0[3]), srcl);
                    w.z = (unsigned)__shfl((int)cvt_pk_bf16(v1[0], v1[1]), srcl); w.w = (unsigned)__shfl((int)cvt_pk_bf16(v1[2], v1[3]), srcl);
                    *(u32x4*)(rowp + bj * HALF) = w; } }
        }
    }
};
template <bool FP8, class Epi, class Sched>
__device__ __forceinline__ void gemm_phase(PG8_LAS unsigned char* lds, const Gemm g, const Sched& S, const Epi& E) {
    const int tid = threadIdx.x, wid = __builtin_amdgcn_readfirstlane(tid >> 6), lane = tid & 63, wr = wid >> 2, wc = wid & 3, fr = lane & 15, fq = lane >> 4;
    const int K = g.K, nt = K / BK;
    unsigned voffA[2], voffB[2];
#pragma unroll
    for (int i = 0; i < 2; ++i) { int R, C; stage_rc(tid * 16 + i * 8192, R, C); const int Rb = Epi::PERM ? ((R & ~31) + perm32(R & 31)) : R;
        voffA[i] = (unsigned)(R * K + C) * 2u; voffB[i] = (unsigned)(Rb * K + C) * 2u; }
    const size_t kstep = (size_t)(BK * 2);
    const size_t hstep = (size_t)HALF * K * 2;
    const size_t tstep = 2 * hstep;
    const unsigned ldsw = (unsigned)wid * 1024u;
    const int aoff = lds_byte(wr * 64 + fr, fq * 8), boff = lds_byte(wc * 32 + fr, fq * 8);
#define PG8_SA(b, h) (((b) * 2 + (h)) * HTB)
#define PG8_SB(b, h) ((4 + (b) * 2 + (h)) * HTB)
#define PG8_STAGE(bufoff, gbase, voff) do { _Pragma("unroll") for (int _i = 0; _i < 2; ++_i) \
        __builtin_amdgcn_global_load_lds((const unsigned*)((const char*)(gbase) + (voff)[_i]), (PG8_LAS unsigned*)(lds + (bufoff) + ldsw + _i * 8192), 16, 0, 0); } while (0)
#define PG8_LDH(dst8, addr) do { const v4i_t lo_ = *(const PG8_LAS v4i_t*)(addr), hi_ = *(const PG8_LAS v4i_t*)((addr) + 1024); dst8 = __builtin_shufflevector(lo_, hi_, 0, 1, 2, 3, 4, 5, 6, 7); } while (0)
#define PG8_LDA(dst, b, h) do { _Pragma("unroll") for (int m = 0; m < 4; ++m) PG8_LDH(dst[m], lds + PG8_SA(b, h) + aoff + m * 2048); } while (0)
#define PG8_LDB(dst, b, h) do { _Pragma("unroll") for (int n = 0; n < 2; ++n) PG8_LDH(dst[n], lds + PG8_SB(b, h) + boff + n * 2048); } while (0)
#define PG8_HALF(v8, k) __builtin_bit_cast(bf16x8, __builtin_shufflevector(v8, v8, 4 * (k), 4 * (k) + 1, 4 * (k) + 2, 4 * (k) + 3))
#define PG8_MMA(ai, bj, At, Bt) do { __builtin_amdgcn_s_setprio(1); _Pragma("unroll") for (int m = 0; m < 4; ++m) _Pragma("unroll") for (int n = 0; n < 2; ++n) { \
        acc[ai][bj][m][n] = __builtin_amdgcn_mfma_f32_16x16x32_bf16(PG8_HALF(Bt[n], 0), PG8_HALF(At[m], 0), acc[ai][bj][m][n], 0, 0, 0); \
        acc[ai][bj][m][n] = __builtin_amdgcn_mfma_f32_16x16x32_bf16(PG8_HALF(Bt[n], 1), PG8_HALF(At[m], 1), acc[ai][bj][m][n], 0, 0, 0); } __builtin_amdgcn_s_setprio(0); } while (0)
#define PG8_MMA8(ai, bj, At, Bt) do { __builtin_amdgcn_s_setprio(1); _Pragma("unroll") for (int m = 0; m < 4; ++m) _Pragma("unroll") for (int n = 0; n < 2; ++n) \
        asm volatile("v_mfma_scale_f32_16x16x128_f8f6f4 %0, %1, %2, %0, %3, %3 op_sel_hi:[0,0,0]" : "+v"(acc[ai][bj][m][n]) : "v"(Bt[n]), "v"(At[m]), "v"(mxs)); __builtin_amdgcn_s_setprio(0); } while (0)
#define PG8_MMA8_DRAIN() asm volatile("s_nop 15\n\ts_nop 15" ::: "memory")
#define PG8_WAIT_V(n) asm volatile("s_waitcnt vmcnt(" #n ")" ::: "memory")
#define PG8_WAIT_L(n) asm volatile("s_waitcnt lgkmcnt(" #n ")" ::: "memory")
#define PG8_BAR __builtin_amdgcn_s_barrier()
#define PG8_SCHED __builtin_amdgcn_sched_barrier(0)
    Unit cur, nxt; int ui = 0;
    if (!S.next(0, cur)) return;
    f32x4 acc[2][2][4][2];
#pragma unroll
    for (int a = 0; a < 2; ++a)
#pragma unroll
        for (int b = 0; b < 2; ++b)
#pragma unroll
            for (int m = 0; m < 4; ++m)
#pragma unroll
                for (int n = 0; n < 2; ++n) acc[a][b][m][n] = (f32x4){0.f, 0.f, 0.f, 0.f};
    v8i_t At[4], B0[2], B1[2]; int mxs = 0x7f7f7f7f; asm volatile("" : "+v"(mxs));
    const char* cA = (const char*)g.A + (size_t)cur.pm * tstep; const char* cB = (const char*)g.Bt + (size_t)cur.pn * tstep;
    S.a_ready(cur);
    PG8_STAGE(PG8_SB(0, 0), cB, voffB); PG8_STAGE(PG8_SA(0, 0), cA, voffA); PG8_STAGE(PG8_SB(0, 1), cB + hstep, voffB); PG8_STAGE(PG8_SA(0, 1), cA + hstep, voffA);
    if (wr == 1) PG8_BAR;
    PG8_WAIT_V(4); PG8_BAR;
    PG8_STAGE(PG8_SB(1, 0), cB + kstep, voffB); PG8_STAGE(PG8_SA(1, 0), cA + kstep, voffA); PG8_STAGE(PG8_SB(1, 1), cB + hstep + kstep, voffB);
    PG8_WAIT_V(6); PG8_BAR;
    for (;;) {
        const bool has_next = S.next(ui + 1, nxt);
        const char* nA = has_next ? (const char*)g.A + (size_t)nxt.pm * tstep : cA; const char* nB = has_next ? (const char*)g.Bt + (size_t)nxt.pn * tstep : cB;
        for (int t = 0; t < nt; t += 2) {
            const bool last = (t == nt - 2);
            const char* a1 = cA + (size_t)(t + 1) * kstep;
            const char* a2 = last ? nA : cA + (size_t)(t + 2) * kstep; const char* b2 = last ? nB : cB + (size_t)(t + 2) * kstep;
            const char* a3 = a2 + kstep; const char* b3 = b2 + kstep;
            if (last && has_next) S.a_ready(nxt);
            PG8_LDB(B0, 0, 0); PG8_SCHED; PG8_LDA(At, 0, 0); PG8_STAGE(PG8_SA(1, 1), a1 + hstep, voffA);
            PG8_WAIT_L(8); PG8_BAR; PG8_WAIT_L(0); do { if constexpr (FP8) PG8_MMA8(0, 0, At, B0); else PG8_MMA(0, 0, At, B0); } while (0); PG8_BAR; PG8_SCHED;
            PG8_LDB(B1, 0, 1); PG8_STAGE(PG8_SB(0, 0), b2, voffB);
            PG8_BAR; PG8_WAIT_L(0); do { if constexpr (FP8) PG8_MMA8(0, 1, At, B1); else PG8_MMA(0, 1, At, B1); } while (0); PG8_BAR;
            PG8_LDA(At, 0, 1); PG8_STAGE(PG8_SA(0, 0), a2, voffA);
            PG8_BAR; PG8_WAIT_L(0); do { if constexpr (FP8) PG8_MMA8(1, 0, At, B0); else PG8_MMA(1, 0, At, B0); } while (0); PG8_BAR; PG8_SCHED;
            PG8_STAGE(PG8_SB(0, 1), b2 + hstep, voffB);
            PG8_WAIT_V(6); PG8_BAR; do { if constexpr (FP8) PG8_MMA8(1, 1, At, B1); else PG8_MMA(1, 1, At, B1); } while (0); PG8_BAR;
            PG8_LDB(B0, 1, 0); PG8_SCHED; PG8_LDA(At, 1, 0); PG8_STAGE(PG8_SA(0, 1), a2 + hstep, voffA);
            PG8_WAIT_L(8); PG8_BAR; PG8_WAIT_L(0); do { if constexpr (FP8) PG8_MMA8(0, 0, At, B0); else PG8_MMA(0, 0, At, B0); } while (0); PG8_BAR; PG8_SCHED;
            PG8_LDB(B1, 1, 1); PG8_STAGE(PG8_SB(1, 0), b3, voffB);
            PG8_BAR; PG8_WAIT_L(0); do { if constexpr (FP8) PG8_MMA8(0, 1, At, B1); else PG8_MMA(0, 1, At, B1); } while (0); PG8_BAR;
            PG8_LDA(At, 1, 1); PG8_STAGE(PG8_SA(1, 0), a3, voffA);
            PG8_BAR; PG8_WAIT_L(0); do { if constexpr (FP8) PG8_MMA8(1, 0, At, B0); else PG8_MMA(1, 0, At, B0); } while (0); PG8_BAR; PG8_SCHED;
            PG8_STAGE(PG8_SB(1, 1), b3 + hstep, voffB);
            PG8_WAIT_V(6); PG8_BAR; do { if constexpr (FP8) PG8_MMA8(1, 1, At, B1); else PG8_MMA(1, 1, At, B1); } while (0); PG8_BAR;
        }
        if constexpr (FP8) PG8_MMA8_DRAIN();
        if constexpr (!Epi::AFTER_DRAIN) { E(acc, cur, wr, wc, fr, fq); S.done(cur); }
        if (!has_next) break;
#pragma unroll
        for (int a = 0; a < 2; ++a)
#pragma unroll
            for (int b = 0; b < 2; ++b)
#pragma unroll
                for (int m = 0; m < 4; ++m)
#pragma unroll
                    for (int n = 0; n < 2; ++n) acc[a][b][m][n] = (f32x4){0.f, 0.f, 0.f, 0.f};
        cur = nxt; cA = nA; cB = nB; ++ui;
    }
    PG8_WAIT_V(0);
    if (wr == 0) PG8_BAR;
    PG8_BAR;
    if constexpr (Epi::AFTER_DRAIN) { E.fused(acc, cur, wr, wc, fr, fq, lds, wid, lane); S.done(cur); }
#undef PG8_SA
#undef PG8_SB
#undef PG8_STAGE
#undef PG8_LDA
#undef PG8_LDH
#undef PG8_HALF
#undef PG8_LDB
#undef PG8_MMA
#undef PG8_MMA8
#undef PG8_MMA8_DRAIN
#undef PG8_WAIT_V
#undef PG8_WAIT_L
#undef PG8_BAR
#undef PG8_SCHED
}
}

struct Frame {
    LAS unsigned char* lds;
    int tid, lane, wave, vcu, G;
    const float* const __attribute__((address_space(4)))* in;
    float* out; unsigned char* ws;
};
enum { I_X = 0, I_C, I_CTX, I_CCTX, I_WMOD, I_BMOD, I_LNG, I_LNB, I_AWIN, I_ABG, I_ANG, I_AWOUT, I_BWIN, I_BBIN, I_BLNG, I_BLNB, I_BWS, I_BBS, I_BWOUT,
       I_CWQKV, I_CQG, I_CKG, I_CWOUT, I_PWQ, I_PK1, I_PK2, I_PU, I_PV };

template <int CTRL> __device__ __forceinline__ float dpp_mov(float v) { return __builtin_bit_cast(float, __builtin_amdgcn_update_dpp(0, __builtin_bit_cast(int, v), CTRL, 0xf, 0xf, false)); }
__device__ __forceinline__ float row16_sum(float v) {
    v += dpp_mov<0x128>(v);
    v += dpp_mov<0x124>(v);
    v += dpp_mov<0x122>(v);
    v += dpp_mov<0x121>(v);
    return v;
}
__device__ __forceinline__ float row16_max(float v) {
    v = fmaxf(v, dpp_mov<0x128>(v)); v = fmaxf(v, dpp_mov<0x124>(v)); v = fmaxf(v, dpp_mov<0x122>(v)); v = fmaxf(v, dpp_mov<0x121>(v));
    return v;
}
__device__ __forceinline__ float rl(float v, int l) { return __builtin_bit_cast(float, __builtin_amdgcn_readlane(__builtin_bit_cast(int, v), l)); }
__device__ __forceinline__ float wsum(float v) { v = row16_sum(v); return (rl(v, 0) + rl(v, 16)) + (rl(v, 32) + rl(v, 48)); }

__device__ __forceinline__ const float* mod_row(const Frame& F, int layer, int row) {
    const int b9 = row < TL ? (row >> 12) : 8;
    return (const float*)(F.ws + WS_MOD) + (size_t)(layer * 9 + b9) * NMOD;
}

__device__ __forceinline__ void p0_transpose_item(const float* W, int ldw, int K, int nblk, unsigned char* WT, LAS float* scr, int item, int lane) {
    const int kb = item / nblk, nb = item % nblk, k0 = 64 * kb, n0 = 32 * nb;
    f32x4 t[8];
#pragma unroll
    for (int i = 0; i < 8; ++i) t[i] = *(const f32x4*)(W + (size_t)(k0 + 8 * i + (lane >> 3)) * ldw + n0 + 4 * (lane & 7));
#pragma unroll
    for (int i = 0; i < 8; ++i) { LAS float* d = scr + (8 * i + (lane >> 3)) * 33 + 4 * (lane & 7); d[0] = t[i][0] * WSCALE; d[1] = t[i][1] * WSCALE; d[2] = t[i][2] * WSCALE; d[3] = t[i][3] * WSCALE; }
    LDS_WAIT(); asm volatile("" ::: "memory");
    const int c = lane & 7;
#pragma unroll
    for (int j = 0; j < 4; ++j) { const int n = (lane >> 3) + 8 * j; const LAS float* s = scr + (8 * c) * 33 + n;
        v2u o; o.x = pk4_fp8(s[0 * 33], s[1 * 33], s[2 * 33], s[3 * 33]); o.y = pk4_fp8(s[4 * 33], s[5 * 33], s[6 * 33], s[7 * 33]);
        *(v2u*)(WT + (size_t)(n0 + n) * K + k0 + 8 * c) = o; }
    LDS_WAIT(); asm volatile("" ::: "memory");
}
__device__ __forceinline__ void p0_transpose_item_bf16(const float* W, int ldw, int K, int nblk, bf16* WT, LAS float* scr, int item, int lane) {
    const int kb = item / nblk, nb = item % nblk, k0 = 64 * kb, n0 = 32 * nb;
    f32x4 t[8];
#pragma unroll
    for (int i = 0; i < 8; ++i) t[i] = *(const f32x4*)(W + (size_t)(k0 + 8 * i + (lane >> 3)) * ldw + n0 + 4 * (lane & 7));
#pragma unroll
    for (int i = 0; i < 8; ++i) { LAS float* d = scr + (8 * i + (lane >> 3)) * 33 + 4 * (lane & 7); d[0] = t[i][0]; d[1] = t[i][1]; d[2] = t[i][2]; d[3] = t[i][3]; }
    LDS_WAIT(); asm volatile("" ::: "memory");
    const int c = lane & 7;
#pragma unroll
    for (int j = 0; j < 4; ++j) { const int n = (lane >> 3) + 8 * j; const LAS float* s = scr + (8 * c) * 33 + n;
        v4u o; o.x = cvt_pk_bf16(s[0 * 33], s[1 * 33]); o.y = cvt_pk_bf16(s[2 * 33], s[3 * 33]); o.z = cvt_pk_bf16(s[4 * 33], s[5 * 33]); o.w = cvt_pk_bf16(s[6 * 33], s[7 * 33]);
        *(v4u*)(WT + (size_t)(n0 + n) * K + k0 + 8 * c) = o; }
    LDS_WAIT(); asm volatile("" ::: "memory");
}
__device__ __forceinline__ void cvt_linear(const float* src, bf16* dst, size_t n8, size_t i0, size_t stride) {
    for (size_t i = i0; i < n8; i += stride) {
        const f32x4 a = *(const f32x4*)(src + i * 8), b = *(const f32x4*)(src + i * 8 + 4);
        v4u o; o.x = cvt_pk_bf16(a[0], a[1]); o.y = cvt_pk_bf16(a[2], a[3]); o.z = cvt_pk_bf16(b[0], b[1]); o.w = cvt_pk_bf16(b[2], b[3]);
        *(v4u*)(dst + i * 8) = o;
    }
}
__device__ __forceinline__ void p0_prologue(Frame& F) {
    {
        LAS float* sc = (LAS float*)F.lds;
        LAS float* part = (LAS float*)(F.lds + 9 * 2048 * 4);
        for (int i = F.tid; i < 9 * 2048; i += NTHR) { const int r = i >> 11, k = i & 2047; const float c = r < 8 ? F.in[I_C][r * D + k] : F.in[I_CCTX][k]; sc[i] = silu(c); }
        __syncthreads();
        float* MOD = (float*)(F.ws + WS_MOD);
        for (int item = F.vcu; item < 4 * 192; item += F.G) {
            const int l = item / 192, cg = item % 192, c = cg * 64 + F.lane;
            const float* Wm = F.in[I_WMOD] + ((size_t)l * D + F.wave * 256) * NMOD + c;
            float acc[9];
#pragma unroll
            for (int r = 0; r < 9; ++r) acc[r] = 0.f;
            for (int k0 = 0; k0 < 256; k0 += 32) {
                float w[32];
#pragma unroll
                for (int u = 0; u < 32; ++u) w[u] = Wm[(size_t)(k0 + u) * NMOD];
#pragma unroll
                for (int u = 0; u < 32; ++u)
#pragma unroll
                    for (int r = 0; r < 9; ++r) acc[r] += sc[r * 2048 + F.wave * 256 + k0 + u] * w[u];
            }
#pragma unroll
            for (int r = 0; r < 9; ++r) part[(F.wave * 9 + r) * 64 + F.lane] = acc[r];
            __syncthreads();
            for (int i = F.tid; i < 9 * 64; i += NTHR) { const int r = i >> 6, ln = i & 63; float s = 0.f;
#pragma unroll
                for (int w = 0; w < 8; ++w) s += part[(w * 9 + r) * 64 + ln];
                MOD[(size_t)(l * 9 + r) * NMOD + cg * 64 + ln] = s + F.in[I_BMOD][l * NMOD + cg * 64 + ln]; }
            __syncthreads();
        }
    }
    {
        LAS float* scr = (LAS float*)(F.lds + F.wave * 16384);
        const int gw = F.vcu * NWAVES + F.wave, NGW = F.G * NWAVES;
        unsigned char* WT = F.ws + WS_WT;
        constexpr int I_A = 32 * 192, I_SQ = 32 * 64, I_BI = 32 * 256, I_BO = 64 * 64, I_CQ = 32 * 96;
        constexpr int NITEMS = 2 * I_A + 2 * I_SQ + I_BI + I_BO + I_CQ + I_SQ + 4 * I_SQ;
        for (int it = gw; it < NITEMS; it += NGW) {
            int r = it;
            if (r < 2 * I_A) { const int j = r / I_A; p0_transpose_item(F.in[I_AWIN] + (size_t)j * D * A_IN, A_IN, D, 192, WT + WT_AIN + (size_t)j * A_INP * D, scr, r % I_A, F.lane); continue; } r -= 2 * I_A;
            if (r < 2 * I_SQ) { const int j = r / I_SQ; p0_transpose_item(F.in[I_AWOUT] + (size_t)j * D * D, D, D, 64, WT + WT_AOUT + (size_t)j * D * D, scr, r % I_SQ, F.lane); continue; } r -= 2 * I_SQ;
            if (r < I_BI) { p0_transpose_item(F.in[I_BWIN], 8192, D, 256, WT + WT_BIN, scr, r, F.lane); continue; } r -= I_BI;
            if (r < I_BO) { p0_transpose_item(F.in[I_BWOUT], D, 4096, 64, WT + WT_BOUT, scr, r, F.lane); continue; } r -= I_BO;
            if (r < I_CQ) { p0_transpose_item(F.in[I_CWQKV], C_QKV, D, 96, WT + WT_CQKV, scr, r, F.lane); continue; } r -= I_CQ;
            if (r < I_SQ) { p0_transpose_item(F.in[I_CWOUT], D, D, 64, WT + WT_COUT, scr, r, F.lane); continue; } r -= I_SQ;
            { const int j = r / I_SQ;
              if ((PQ_FP8_MASK >> j) & 1) p0_transpose_item(F.in[I_PWQ] + (size_t)j * D * D, D, D, 64, WT + WT_PQ + (size_t)j * D * D * 2, scr, r % I_SQ, F.lane);
              else p0_transpose_item_bf16(F.in[I_PWQ] + (size_t)j * D * D, D, D, 64, (bf16*)(WT + WT_PQ) + (size_t)j * D * D, scr, r % I_SQ, F.lane); }
        }
        const size_t gt = (size_t)F.vcu * NTHR + F.tid, GT = (size_t)F.G * NTHR;
        for (size_t i = gt; i < (size_t)2 * 256 * D; i += GT) {
            const int j = (int)(i / (256 * D)), rem = (int)(i % (256 * D)), n = rem / D, k = rem % D;
            const float v = n < 16 ? F.in[I_AWIN][((size_t)j * D + k) * A_IN + 6144 + n] : 0.f;
            WT[WT_AIN + ((size_t)j * A_INP + 6144 + n) * D + k] = (unsigned char)(__builtin_amdgcn_cvt_pk_fp8_f32(v * WSCALE, 0.f, 0, false) & 0xff);
        }
        for (int r0 = gw; r0 < 2 * 4 * P_E; r0 += 2 * NGW) {
            f32x4 v[2][8];
#pragma unroll
            for (int h = 0; h < 2; ++h) { const int r = r0 + h * NGW, tb = r >= 4 * P_E, rr = r - tb * 4 * P_E;
                const float* src = F.in[tb ? I_PV : I_PU] + (size_t)rr * D + 4 * F.lane;
#pragma unroll
                for (int q = 0; q < 8; ++q) v[h][q] = *(const f32x4*)(src + 256 * q); }
#pragma unroll
            for (int h = 0; h < 2; ++h) { const int r = r0 + h * NGW, tb = r >= 4 * P_E, rr = r - tb * 4 * P_E;
                float mx = 0.f;
#pragma unroll
                for (int q = 0; q < 8; ++q) { const f32x4 a = __builtin_elementwise_abs(v[h][q]); mx = fmaxf(mx, fmaxf(fmaxf(a[0], a[1]), fmaxf(a[2], a[3]))); }
                mx = row16_max(mx); mx = fmaxf(fmaxf(rl(mx, 0), rl(mx, 16)), fmaxf(rl(mx, 32), rl(mx, 48)));
                const float sc = mx > 0.f ? 6.0f / mx : 1.0f;
                v4u o;
#pragma unroll
                for (int d = 0; d < 4; ++d) { unsigned w = 0u; const f32x4 x0 = v[h][2 * d] * sc, x1 = v[h][2 * d + 1] * sc;
                    w = __builtin_amdgcn_cvt_scalef32_pk_fp4_f32(w, x0[0], x0[1], 1.0f, 0); w = __builtin_amdgcn_cvt_scalef32_pk_fp4_f32(w, x0[2], x0[3], 1.0f, 1);
                    w = __builtin_amdgcn_cvt_scalef32_pk_fp4_f32(w, x1[0], x1[1], 1.0f, 2); w = __builtin_amdgcn_cvt_scalef32_pk_fp4_f32(w, x1[2], x1[3], 1.0f, 3); o[d] = w; }
                if (tb) *(v4u*)(F.ws + WS_PV8 + (size_t)rr * (D / 2) + 16 * F.lane) = o;
                else { unsigned char* ur = F.ws + WS_PU8 + (size_t)rr * (D / 2) + 2 * F.lane;
#pragma unroll
                    for (int d = 0; d < 4; ++d) { *(unsigned short*)(ur + 128 * (2 * d)) = (unsigned short)(o[d] & 0xffffu); *(unsigned short*)(ur + 128 * (2 * d + 1)) = (unsigned short)(o[d] >> 16); } }
                if (F.lane == 0) ((float*)(F.ws + WS_SC))[(size_t)tb * 4 * P_E + rr] = 1.0f / sc; }
        }
        cvt_linear(F.in[I_PK1], (bf16*)(F.ws + WS_K12), (size_t)4 * 128 * 128 / 8, gt, GT);
        cvt_linear(F.in[I_PK2], (bf16*)(F.ws + WS_K12) + 4 * 128 * 128, (size_t)4 * 128 * 128 / 8, gt, GT);
        cvt_linear(F.in[I_BWS], (bf16*)(F.ws + WS_WS), (size_t)8 * 128 * 128 / 8, gt, GT);
    }
}

template <int L> __device__ __forceinline__ const float* x_row(const Frame& F, int row) {
    if (L == 0) return row < TL ? F.in[I_X] + (size_t)row * D : F.in[I_CTX] + (size_t)(row - TL) * D;
    return (const float*)(F.ws + WS_X) + (size_t)row * D;
}
template <int L> __device__ __forceinline__ f32x4 load_x4(const Frame& F, int row, int e) {
    if (L == 0) return *(const f32x4*)(x_row<0>(F, row) + e);
    const v2u p = *(const v2u*)((const bf16*)(F.ws + WS_X) + (size_t)row * D + e);
    return (f32x4){bf_lo(p.x), bf_hi(p.x), bf_lo(p.y), bf_hi(p.y)};
}
__device__ __forceinline__ void store_x4(const Frame& F, int row, int e, f32x4 v) { v2u o; o.x = cvt_pk_bf16(v[0], v[1]); o.y = cvt_pk_bf16(v[2], v[3]); *(v2u*)((bf16*)(F.ws + WS_X) + (size_t)row * D + e) = o; }
__device__ __forceinline__ void p0b_modulate(Frame& F) {
    const int gw = F.vcu * NWAVES + F.wave, NGW = F.G * NWAVES;
    for (int row = gw; row < T; row += NGW) {
        const float* xr = x_row<0>(F, row); const float* md = mod_row(F, 0, row);
        unsigned char* hr = F.ws + WS_H + (size_t)row * D;
#pragma unroll
        for (int j = 0; j < 8; ++j) { const int e = 4 * F.lane + 256 * j;
            const f32x4 x = *(const f32x4*)(xr + e), sh = *(const f32x4*)(md + e), scl = *(const f32x4*)(md + D + e);
            const f32x4 h = x * (scl + 1.0f) + sh;
            *(unsigned*)(hr + e) = pk4_fp8(h[0], h[1], h[2], h[3]); }
    }
}

__device__ __forceinline__ void ln_rows(f32x4 (&t)[8], const float* g, const float* b, int lane) {
    float s = 0.f;
#pragma unroll
    for (int j = 0; j < 8; ++j) s += (t[j][0] + t[j][1]) + (t[j][2] + t[j][3]);
    const float mean = wsum(s) * (1.0f / D); float q = 0.f;
#pragma unroll
    for (int j = 0; j < 8; ++j) { t[j] = t[j] - mean; q += (t[j][0] * t[j][0] + t[j][1] * t[j][1]) + (t[j][2] * t[j][2] + t[j][3] * t[j][3]); }
    const float rstd = 1.0f / sqrtf(wsum(q) * (1.0f / D) + LN_EPS);
#pragma unroll
    for (int j = 0; j < 8; ++j) { const int e = 4 * lane + 256 * j; t[j] = t[j] * rstd * *(const f32x4*)(g + e) + *(const f32x4*)(b + e); }
}

template <int L> __device__ __forceinline__ void ln1_phase(Frame& F, int M) {
    const int gw = F.vcu * NWAVES + F.wave, NGW = F.G * NWAVES;
    const float* lg = F.in[I_LNG] + (size_t)(L * 2 + 0) * D; const float* lb = F.in[I_LNB] + (size_t)(L * 2 + 0) * D;
    for (int row = gw; row < M; row += NGW) {
        const float* md = mod_row(F, L, row);
        const bf16* yr = (const bf16*)(F.ws + WS_Y) + (size_t)row * D;
        bf16* hr = (bf16*)(F.ws + WS_Y) + (size_t)row * D;
        f32x4 t[8];
#pragma unroll
        for (int j = 0; j < 8; ++j) { const int e = 4 * F.lane + 256 * j;
            const f32x4 x = load_x4<L>(F, row, e), gt = *(const f32x4*)(md + 2 * D + e); const v2u y = *(const v2u*)(yr + e);
            t[j] = x * ALPHA + gt * (f32x4){bf_lo(y.x), bf_hi(y.x), bf_lo(y.y), bf_hi(y.y)}; }
        ln_rows(t, lg, lb, F.lane);
#pragma unroll
        for (int j = 0; j < 8; ++j) { const int e = 4 * F.lane + 256 * j;
            store_x4(F, row, e, t[j]);
            const f32x4 h = t[j] * (*(const f32x4*)(md + 4 * D + e) + 1.0f) + *(const f32x4*)(md + 3 * D + e);
            v2u o; o.x = cvt_pk_bf16(h[0], h[1]); o.y = cvt_pk_bf16(h[2], h[3]); *(v2u*)(hr + e) = o;
            if ((PQ_FP8_MASK >> L) & 1) *(unsigned*)(F.ws + WS_H + (size_t)row * D + e) = pk4_fp8(h[0], h[1], h[2], h[3]); }
    }
}

__device__ __forceinline__ unsigned f2mono(float f) { const unsigned b = __float_as_uint(f); return (b & 0x80000000u) ? ~b : (b | 0x80000000u); }
__device__ __forceinline__ float mono2f(unsigned m) { return __uint_as_float((m & 0x80000000u) ? (m & 0x7fffffffu) : ~m); }
__device__ __forceinline__ void ins16(unsigned (&top)[16], unsigned x) {
#pragma unroll
    for (int j = 0; j < 16; ++j) { const unsigned hi = top[j] > x ? top[j] : x; x = top[j] > x ? x : top[j]; top[j] = hi; }
}
#define TK_CE(A_, B_) { const unsigned hi_ = (A_) > (B_) ? (A_) : (B_), lo_ = (A_) > (B_) ? (B_) : (A_); (A_) = hi_; (B_) = lo_; }
__device__ __forceinline__ void sort16_desc(unsigned (&v)[16]) {
    TK_CE(v[0], v[1])
    TK_CE(v[2], v[3])
    TK_CE(v[0], v[2])
    TK_CE(v[1], v[3])
    TK_CE(v[1], v[2])
    TK_CE(v[4], v[5])
    TK_CE(v[6], v[7])
    TK_CE(v[4], v[6])
    TK_CE(v[5], v[7])
    TK_CE(v[5], v[6])
    TK_CE(v[0], v[4])
    TK_CE(v[2], v[6])
    TK_CE(v[2], v[4])
    TK_CE(v[1], v[5])
    TK_CE(v[3], v[7])
    TK_CE(v[3], v[5])
    TK_CE(v[1], v[2])
    TK_CE(v[3], v[4])
    TK_CE(v[5], v[6])
    TK_CE(v[8], v[9])
    TK_CE(v[10], v[11])
    TK_CE(v[8], v[10])
    TK_CE(v[9], v[11])
    TK_CE(v[9], v[10])
    TK_CE(v[12], v[13])
    TK_CE(v[14], v[15])
    TK_CE(v[12], v[14])
    TK_CE(v[13], v[15])
    TK_CE(v[13], v[14])
    TK_CE(v[8], v[12])
    TK_CE(v[10], v[14])
    TK_CE(v[10], v[12])
    TK_CE(v[9], v[13])
    TK_CE(v[11], v[15])
    TK_CE(v[11], v[13])
    TK_CE(v[9], v[10])
    TK_CE(v[11], v[12])
    TK_CE(v[13], v[14])
    TK_CE(v[0], v[8])
    TK_CE(v[4], v[12])
    TK_CE(v[4], v[8])
    TK_CE(v[2], v[10])
    TK_CE(v[6], v[14])
    TK_CE(v[6], v[10])
    TK_CE(v[2], v[4])
    TK_CE(v[6], v[8])
    TK_CE(v[10], v[12])
    TK_CE(v[1], v[9])
    TK_CE(v[5], v[13])
    TK_CE(v[5], v[9])
    TK_CE(v[3], v[11])
    TK_CE(v[7], v[15])
    TK_CE(v[7], v[11])
    TK_CE(v[3], v[5])
    TK_CE(v[7], v[9])
    TK_CE(v[11], v[13])
    TK_CE(v[1], v[2])
    TK_CE(v[3], v[4])
    TK_CE(v[5], v[6])
    TK_CE(v[7], v[8])
    TK_CE(v[9], v[10])
    TK_CE(v[11], v[12])
    TK_CE(v[13], v[14])
}
__device__ __forceinline__ void merge16_desc(unsigned (&top)[16], const unsigned (&s)[16]) {
#pragma unroll
    for (int i = 0; i < 16; ++i) top[i] = top[i] > s[15 - i] ? top[i] : s[15 - i];
#pragma unroll
    for (int j = 8; j > 0; j >>= 1)
#pragma unroll
        for (int i = 0; i < 16; ++i) { const int l = i ^ j; if (l > i) TK_CE(top[i], top[l]) }
}
template <int L> __device__ __forceinline__ void peer_topk_phase(Frame& F, int M) {
    const bf16* Q = (const bf16*)(F.ws + WS_Z);
    const bf16* K1 = (const bf16*)(F.ws + WS_K12) + (size_t)L * 128 * 128;
    const bf16* K2 = (const bf16*)(F.ws + WS_K12) + (size_t)(4 + L) * 128 * 128;
    int* IDX = (int*)(F.ws + WS_IDX); float* PG = (float*)(F.ws + WS_PG);
    LAS float* S1 = (LAS float*)F.lds;
    LAS float* S2 = S1 + 128 * 129;
    LAS unsigned* TK = (LAS unsigned*)(S2 + 128 * 129);
    const int fr = F.lane & 15, fq = F.lane >> 4;
    const int nunits = (M / 128) * P_HEADS;
    const int kbg = F.wave & 1, tbg = F.wave >> 1;
    bf16x8 kf1[4][4], kf2[4][4];
#pragma unroll
    for (int kk = 0; kk < 4; ++kk) { const int kb = 4 * kbg + kk;
        const bf16* k1p = K1 + (size_t)(kb * 16 + fr) * 128 + fq * 8; const bf16* k2p = K2 + (size_t)(kb * 16 + fr) * 128 + fq * 8;
#pragma unroll
        for (int ks = 0; ks < 4; ++ks) { kf1[kk][ks] = *(const bf16x8*)(k1p + ks * 32); kf2[kk][ks] = *(const bf16x8*)(k2p + ks * 32); } }
    for (int u = F.vcu; u < nunits; u += F.G) {
        const int tile = u >> 3, hd = u & 7, row0 = tile * 128;
#ifdef TK_DBL_MFMA
        for (int rr_ = 0; rr_ < 2; ++rr_)
#endif
        {
#pragma unroll
            for (int tt = 0; tt < 2; ++tt) { const int tb = 2 * tbg + tt;
                const bf16* qp = Q + (size_t)(row0 + tb * 16 + fr) * D + hd * 256 + fq * 8;
                bf16x8 a1[4], a2[4];
#pragma unroll
                for (int ks = 0; ks < 4; ++ks) { a1[ks] = *(const bf16x8*)(qp + ks * 32); a2[ks] = *(const bf16x8*)(qp + 128 + ks * 32); }
#pragma unroll
                for (int kk = 0; kk < 4; ++kk) { const int kb = 4 * kbg + kk;
                    f32x4 c1 = zero4(), c2 = zero4();
#pragma unroll
                    for (int ks = 0; ks < 4; ++ks) {
                        c1 = __builtin_amdgcn_mfma_f32_16x16x32_bf16(a1[ks], kf1[kk][ks], c1, 0, 0, 0);
                        c2 = __builtin_amdgcn_mfma_f32_16x16x32_bf16(a2[ks], kf2[kk][ks], c2, 0, 0, 0);
                    }
#pragma unroll
                    for (int j = 0; j < 4; ++j) { const int t = tb * 16 + 4 * fq + j; S1[t * 129 + kb * 16 + fr] = c1[j]; S2[t * 129 + kb * 16 + fr] = c2[j]; }
                }
            }
        }
        __syncthreads();
        {
            int tid_l = F.tid; asm volatile("" : "+v"(tid_l));
            const int t = tid_l & 127, which = (tid_l >> 7) & 1, half = tid_l >> 8;
            LAS float* sr = (which ? S2 : S1) + t * 129 + 64 * half;
            unsigned top[16];
#pragma unroll
            for (int j = 0; j < 16; ++j) top[j] = (f2mono(sr[j]) & ~0x7fu) | (unsigned)(127 - (64 * half + j));
            sort16_desc(top);
#pragma unroll 1
            for (int g = 1; g < 4; ++g) { unsigned v[16];
#pragma unroll
                for (int j = 0; j < 16; ++j) v[j] = (f2mono(sr[16 * g + j]) & ~0x7fu) | (unsigned)(127 - (64 * half + 16 * g + j));
                sort16_desc(v); merge16_desc(top, v); }
            if (half) {
#pragma unroll
                for (int j = 0; j < 16; ++j) ((LAS unsigned*)sr)[j] = top[j];
            }
            __syncthreads();
            if (!half) {
                const LAS unsigned* pr = (const LAS unsigned*)(sr + 64);
                unsigned ot[16];
#pragma unroll
                for (int j = 0; j < 16; ++j) ot[j] = pr[j];
                merge16_desc(top, ot);
#pragma unroll
                for (int j = 0; j < 16; ++j) TK[(which * 128 + t) * 17 + j] = top[j];
            }
        }
        __syncthreads();
#ifdef TK_DBL_COMB
        for (int rr_ = 0; rr_ < 2; ++rr_)
#endif
        if (F.tid < 128) {
            const int t = F.tid;
            const LAS unsigned* t1 = TK + t * 17; const LAS unsigned* t2 = TK + (128 + t) * 17;
            float v2[16];
#pragma unroll
            for (int j = 0; j < 16; ++j) v2[j] = mono2f((t2[j] & ~0x7fu) | 0x40u);
#define TK_V1(A_) mono2f((t1[A_] & ~0x7fu) | 0x40u)
#define TK_KEY(VA_, A_, B_) ((f2mono((VA_) + v2[B_]) & ~0xffu) | (unsigned)(255 - ((A_) * 16 + (B_))))
            unsigned top[16];
            { unsigned grp[16];
              const float va0 = TK_V1(0);
              grp[0] = TK_KEY(va0, 0, 0);
              grp[1] = TK_KEY(va0, 0, 1);
              grp[2] = TK_KEY(va0, 0, 2);
              grp[3] = TK_KEY(va0, 0, 3);
              grp[4] = TK_KEY(va0, 0, 4);
              grp[5] = TK_KEY(va0, 0, 5);
              grp[6] = TK_KEY(va0, 0, 6);
              grp[7] = TK_KEY(va0, 0, 7);
              grp[8] = TK_KEY(va0, 0, 8);
              grp[9] = TK_KEY(va0, 0, 9);
              grp[10] = TK_KEY(va0, 0, 10);
              grp[11] = TK_KEY(va0, 0, 11);
              grp[12] = TK_KEY(va0, 0, 12);
              grp[13] = TK_KEY(va0, 0, 13);
              grp[14] = TK_KEY(va0, 0, 14);
              grp[15] = TK_KEY(va0, 0, 15);
              sort16_desc(grp);
#pragma unroll
              for (int j = 0; j < 16; ++j) top[j] = grp[j]; }
            __builtin_amdgcn_sched_barrier(0);
            { unsigned grp[16];
              const float va1 = TK_V1(1);
              const float va2 = TK_V1(2);
              const float va3 = TK_V1(3);
              grp[0] = TK_KEY(va1, 1, 0);
              grp[1] = TK_KEY(va1, 1, 1);
              grp[2] = TK_KEY(va1, 1, 2);
              grp[3] = TK_KEY(va1, 1, 3);
              grp[4] = TK_KEY(va1, 1, 4);
              grp[5] = TK_KEY(va1, 1, 5);
              grp[6] = TK_KEY(va1, 1, 6);
              grp[7] = TK_KEY(va1, 1, 7);
              grp[8] = TK_KEY(va2, 2, 0);
              grp[9] = TK_KEY(va2, 2, 1);
              grp[10] = TK_KEY(va2, 2, 2);
              grp[11] = TK_KEY(va2, 2, 3);
              grp[12] = TK_KEY(va2, 2, 4);
              grp[13] = TK_KEY(va3, 3, 0);
              grp[14] = TK_KEY(va3, 3, 1);
              grp[15] = TK_KEY(va3, 3, 2);
              sort16_desc(grp);
              merge16_desc(top, grp); }
            __builtin_amdgcn_sched_barrier(0);
            { unsigned grp[16];
              const float va3 = TK_V1(3);
              const float va4 = TK_V1(4);
              const float va5 = TK_V1(5);
              const float va6 = TK_V1(6);
              const float va7 = TK_V1(7);
              const float va8 = TK_V1(8);
              const float va9 = TK_V1(9);
              const float va10 = TK_V1(10);
              const float va11 = TK_V1(11);
              const float va12 = TK_V1(12);
              const float va13 = TK_V1(13);
              grp[0] = TK_KEY(va3, 3, 3);
              grp[1] = TK_KEY(va4, 4, 0);
              grp[2] = TK_KEY(va4, 4, 1);
              grp[3] = TK_KEY(va4, 4, 2);
              grp[4] = TK_KEY(va5, 5, 0);
              grp[5] = TK_KEY(va5, 5, 1);
              grp[6] = TK_KEY(va6, 6, 0);
              grp[7] = TK_KEY(va6, 6, 1);
              grp[8] = TK_KEY(va7, 7, 0);
              grp[9] = TK_KEY(va7, 7, 1);
              grp[10] = TK_KEY(va8, 8, 0);
              grp[11] = TK_KEY(va9, 9, 0);
              grp[12] = TK_KEY(va10, 10, 0);
              grp[13] = TK_KEY(va11, 11, 0);
              grp[14] = TK_KEY(va12, 12, 0);
              grp[15] = TK_KEY(va13, 13, 0);
              sort16_desc(grp);
              merge16_desc(top, grp); }
            __builtin_amdgcn_sched_barrier(0);
            ins16(top, TK_KEY(TK_V1(14), 14, 0));
            ins16(top, TK_KEY(TK_V1(15), 15, 0));
#undef TK_KEY
#undef TK_V1
            float sc[16], es = 0.f;
#pragma unroll
            for (int j = 0; j < 16; ++j) sc[j] = mono2f((top[j] & ~0xffu) | 0x80u);
            const float smx = sc[0];
#pragma unroll
            for (int j = 0; j < 16; ++j) { sc[j] = __expf(sc[j] - smx); es += sc[j]; }
            const float inv = 1.0f / es;
            const size_t ob = (size_t)(row0 + t) * 128 + hd * 16;
#pragma unroll
            for (int j = 0; j < 16; ++j) { const int ci = 255 - (int)(top[j] & 0xffu), a = ci >> 4, b = ci & 15;
                const int i1 = 127 - (int)(t1[a] & 0x7fu), i2 = 127 - (int)(t2[b] & 0x7fu);
                IDX[ob + j] = i1 * 128 + i2; PG[ob + j] = sc[j] * inv; }
        }
        __syncthreads();
    }
}

constexpr int P3B = 8;
struct RowBatch { v4u r[P3B]; };
__device__ __forceinline__ void p3_load_batch(RowBatch& B, const char* tab, int ev, int lane0, int lo16) {
#pragma unroll
    for (int q = 0; q < P3B; ++q) { const int e = __builtin_amdgcn_readlane(ev, lane0 + q); B.r[q] = *(const v4u*)(tab + (size_t)e * (D / 2) + lo16); }
}
__device__ __forceinline__ float dot32_fp4(const v4u w, const f32x2* h) {
    f32x2 s = {0.f, 0.f};
#pragma unroll
    for (int d = 0; d < 4; ++d) {
#define P3_D(b) { const f32x2 p = __builtin_amdgcn_cvt_scalef32_pk_f32_fp4(w[d], 1.0f, b); s = __builtin_elementwise_fma(p, h[4 * d + b], s); }
        P3_D(0) P3_D(1) P3_D(2) P3_D(3)
#undef P3_D
    }
    return s[0] + s[1];
}
__device__ __forceinline__ void axpy32_fp4(const v4u w, float hk, f32x2* acc) {
    const f32x2 hk2 = {hk, hk};
#pragma unroll
    for (int d = 0; d < 4; ++d) {
#define P3_A(b) { const f32x2 p = __builtin_amdgcn_cvt_scalef32_pk_f32_fp4(w[d], 1.0f, b); acc[4 * d + b] = __builtin_elementwise_fma(hk2, p, acc[4 * d + b]); }
        P3_A(0) P3_A(1) P3_A(2) P3_A(3)
#undef P3_A
    }
}
__device__ __forceinline__ float reduce8(const float* d, int lane) {
    const bool b0 = lane & 1, b1 = lane & 2, b2 = lane & 4;
    float s1[4], s2[2];
#pragma unroll
    for (int j = 0; j < 4; ++j) { const float keep = b0 ? d[2 * j + 1] : d[2 * j], send = b0 ? d[2 * j] : d[2 * j + 1]; s1[j] = keep + dpp_mov<0xB1>(send); }
#pragma unroll
    for (int j = 0; j < 2; ++j) { const float keep = b1 ? s1[2 * j + 1] : s1[2 * j], send = b1 ? s1[2 * j] : s1[2 * j + 1]; s2[j] = keep + dpp_mov<0x4E>(send); }
    const float keep = b2 ? s2[1] : s2[0], send = b2 ? s2[0] : s2[1];
    float s3 = keep + dpp_mov<0x124>(send);
    s3 += dpp_mov<0x128>(s3);
    s3 += __shfl_xor(s3, 16); s3 += __shfl_xor(s3, 32);
    return s3;
}
template <int L> __device__ __forceinline__ void peer_u_phase(Frame& F, int M) {
    const int gw = F.vcu * NWAVES + F.wave, NGW = F.G * NWAVES;
    const char* PU = (const char*)(F.ws + WS_PU8) + (size_t)L * P_E * (D / 2); const char* PV = (const char*)(F.ws + WS_PV8) + (size_t)L * P_E * (D / 2);
    const float* SCU = (const float*)(F.ws + WS_SC) + (size_t)L * P_E; const float* SCV = (const float*)(F.ws + WS_SC) + (size_t)(4 + L) * P_E;
    const int* IDX = (const int*)(F.ws + WS_IDX); const float* PG = (const float*)(F.ws + WS_PG);
    const float* lg = F.in[I_LNG] + (size_t)(L * 2 + 1) * D; const float* lb = F.in[I_LNB] + (size_t)(L * 2 + 1) * D;
    for (int row = gw; row < M; row += NGW) {
        int lane_l = F.lane; asm volatile("" : "+v"(lane_l));
        const int lane = lane_l, lo16 = lane * 16;
        const int e0 = IDX[(size_t)row * 128 + lane], e1 = IDX[(size_t)row * 128 + 64 + lane];
        const float g0 = PG[(size_t)row * 128 + lane], g1 = PG[(size_t)row * 128 + 64 + lane];
        const float su0 = SCU[e0], su1 = SCU[e1], sv0 = SCV[e0], sv1 = SCV[e1];
        f32x2 hx[16];
        { const bf16* hr0 = (const bf16*)(F.ws + WS_Y) + (size_t)row * D + 4 * lane;
#pragma unroll
          for (int q = 0; q < 8; ++q) { const v2u hp = *(const v2u*)(hr0 + 256 * q); hx[2 * q] = (f32x2){bf_lo(hp.x), bf_hi(hp.x)}; hx[2 * q + 1] = (f32x2){bf_lo(hp.y), bf_hi(hp.y)}; } }
        float a0, a1;
        {
            LAS unsigned char* wl = F.lds + F.wave * 13568;
            LAS unsigned char* HI = wl + 8448;
#pragma unroll
            for (int q = 0; q < 8; ++q) {
                const f32x2 p0 = hx[2 * q], p1 = hx[2 * q + 1];
                int hi = __builtin_amdgcn_cvt_pk_fp8_f32(p0[0], p0[1], 0, false); hi = __builtin_amdgcn_cvt_pk_fp8_f32(p1[0], p1[1], hi, true);
                const f32x2 b0 = __builtin_amdgcn_cvt_pk_f32_fp8(hi, false), b1 = __builtin_amdgcn_cvt_pk_f32_fp8(hi, true);
                const f32x2 r0 = (p0 - b0) * 16.0f, r1 = (p1 - b1) * 16.0f;
                int lo = __builtin_amdgcn_cvt_pk_fp8_f32(r0[0], r0[1], 0, false); lo = __builtin_amdgcn_cvt_pk_fp8_f32(r1[0], r1[1], lo, true);
                *(LAS int*)(HI + 4 * lane + 256 * q) = hi; *(LAS int*)(HI + 2048 + 4 * lane + 256 * q) = lo;
            }
            asm volatile("" ::: "memory");
            const int n16 = lane & 15, kq = lane >> 4, hl = lane >> 5, l31 = lane & 31;
            const LAS unsigned char* bp = HI + (n16 == 1 ? 2048 : 0) + 16 * kq;
            LAS unsigned char* tw = wl + hl * 528 + 16 * l31;
            const LAS unsigned char* tr = wl + n16 * 528 + 16 * kq;
            f32x4 acc[8];
#pragma unroll
            for (int rb = 0; rb < 8; ++rb) acc[rb] = zero4();
            v4u R[2][8]; v8i_t Bk[8];
            int e0b = e0, e1b = e1;
#define UL_LOAD(S_) do { _Pragma("unroll") for (int i = 0; i < 8; ++i) { const int sa_ = 16 * ((S_) & 7) + 2 * i; \
                const int es_ = ((S_) >> 3) ? (((S_) & 7) < 4 ? e0b : e1b) : (((S_) & 7) < 4 ? e0 : e1); const int ia_ = __builtin_amdgcn_readlane(es_, sa_ & 63), ib_ = __builtin_amdgcn_readlane(es_, (sa_ + 1) & 63); \
                const int id_ = hl ? ib_ : ia_; R[(S_) & 1][i] = *(const v4u*)(PU + (size_t)id_ * (D / 2) + 512 * ((S_) >> 3) + 16 * l31); } } while (0)
#define UL_WRITE(S_) do { _Pragma("unroll") for (int i = 0; i < 8; ++i) *(LAS v4u*)(tw + 2 * i * 528) = R[(S_) & 1][i]; } while (0)
#define UL_MMA(S_) do { if (((S_) & 7) == 0) { _Pragma("unroll") for (int ml = 0; ml < 8; ++ml) { const v4u x0 = *(const LAS v4u*)(bp + 128 * (8 * ((S_) >> 3) + ml)), x1 = *(const LAS v4u*)(bp + 128 * (8 * ((S_) >> 3) + ml) + 64); \
                    Bk[ml] = (v8i_t){(int)x0.x, (int)x0.y, (int)x0.z, (int)x0.w, (int)x1.x, (int)x1.y, (int)x1.z, (int)x1.w}; } } \
                _Pragma("unroll") for (int ml = 0; ml < 8; ++ml) { const v4u w = *(const LAS v4u*)(tr + 64 * ml); \
                    acc[(S_) & 7] = __builtin_amdgcn_mfma_scale_f32_16x16x128_f8f6f4((v8i_t){(int)w.x, (int)w.y, (int)w.z, (int)w.w, 0, 0, 0, 0}, Bk[ml], acc[(S_) & 7], 4, 0, 0, 0x7f7f7f7f, 0, 0x7f7f7f7f); } } while (0)
            UL_LOAD(0); __builtin_amdgcn_sched_barrier(0);
#pragma unroll
            for (int s = 0; s < 16; ++s) {
                if (s + 1 == 8) asm volatile("" : "+v"(e0b), "+v"(e1b));
                if (s + 1 < 16) UL_LOAD(s + 1);
                __builtin_amdgcn_sched_barrier(0);
                UL_WRITE(s); __builtin_amdgcn_sched_barrier(0);
                UL_MMA(s); __builtin_amdgcn_sched_barrier(0);
            }
#undef UL_LOAD
#undef UL_WRITE
#undef UL_MMA
            asm volatile("s_nop 15\n\ts_nop 15" : "+v"(acc[0]), "+v"(acc[1]), "+v"(acc[2]), "+v"(acc[3]), "+v"(acc[4]), "+v"(acc[5]), "+v"(acc[6]), "+v"(acc[7]));
            LAS float* SS = (LAS float*)(wl + 12544);
            if (n16 < 2) {
#pragma unroll
                for (int rb = 0; rb < 8; ++rb) *(LAS f32x4*)(SS + n16 * 128 + 16 * rb + 4 * kq) = acc[rb]; }
            asm volatile("" ::: "memory");
            a0 = SS[lane] + SS[128 + lane] * 0.0625f; a1 = SS[64 + lane] + SS[192 + lane] * 0.0625f;
            asm volatile("" ::: "memory");
        }
        float* HC = (float*)(F.ws + WS_Z) + (size_t)row * 128;
        HC[lane] = gelu_tanh(a0 * su0) * g0 * sv0; HC[64 + lane] = gelu_tanh(a1 * su1) * g1 * sv1;
    }
}
template <int L> __device__ __forceinline__ void peer_v_phase(Frame& F, int M) {
    const int gw = F.vcu * NWAVES + F.wave, NGW = F.G * NWAVES;
    const char* PU = (const char*)(F.ws + WS_PU8) + (size_t)L * P_E * (D / 2); const char* PV = (const char*)(F.ws + WS_PV8) + (size_t)L * P_E * (D / 2);
    const float* SCU = (const float*)(F.ws + WS_SC) + (size_t)L * P_E; const float* SCV = (const float*)(F.ws + WS_SC) + (size_t)(4 + L) * P_E;
    const int* IDX = (const int*)(F.ws + WS_IDX); const float* PG = (const float*)(F.ws + WS_PG);
    const float* lg = F.in[I_LNG] + (size_t)(L * 2 + 1) * D; const float* lb = F.in[I_LNB] + (size_t)(L * 2 + 1) * D;
    for (int row = gw; row < M; row += NGW) {
        int lane_l = F.lane; asm volatile("" : "+v"(lane_l));
        const int lane = lane_l, lo16 = lane * 16;
        const int e0 = IDX[(size_t)row * 128 + lane], e1 = IDX[(size_t)row * 128 + 64 + lane];
        RowBatch A, Bb;
        constexpr int NB3 = 128 / P3B;
        p3_load_batch(A, PV, e0, 0, lo16);
        const float h0 = ((const float*)(F.ws + WS_Z))[(size_t)row * 128 + lane], h1 = ((const float*)(F.ws + WS_Z))[(size_t)row * 128 + 64 + lane];
        f32x2 acc[16];
#pragma unroll
        for (int j = 0; j < 16; ++j) acc[j] = (f32x2){0.f, 0.f};
#define P3_AXPY(BUF, KB) do { _Pragma("unroll") for (int q = 0; q < P3B; ++q) { const int k = (KB) + q; const float hk = rl(k < 64 ? h0 : h1, k & 63); axpy32_fp4(BUF.r[q], hk, acc); } } while (0)
        for (int bb = 0; bb < NB3; bb += 2) {
            p3_load_batch(Bb, PV, (bb + 1) * P3B < 64 ? e0 : e1, (P3B * (bb + 1)) & 63, lo16);
            P3_AXPY(A, P3B * bb);
            if (bb + 2 < NB3) p3_load_batch(A, PV, (bb + 2) * P3B < 64 ? e0 : e1, (P3B * (bb + 2)) & 63, lo16);
            P3_AXPY(Bb, P3B * bb + P3B);
        }
#undef P3_AXPY
        int lane2 = lane_l; asm volatile("" : "+v"(lane2) : "v"(acc[0]), "v"(acc[15]));
        const bf16* xr = (const bf16*)(F.ws + WS_X) + (size_t)row * D + 4 * lane2; const float* md = mod_row(F, L, row) + 4 * lane2;
        float s = 0.f;
#pragma unroll
        for (int q = 0; q < 8; ++q) { const v2u xp = *(const v2u*)(xr + 256 * q); const f32x4 xa = {bf_lo(xp.x), bf_hi(xp.x), bf_lo(xp.y), bf_hi(xp.y)}, ga = *(const f32x4*)(md + 5 * D + 256 * q);
#pragma unroll
            for (int j = 0; j < 4; ++j) { float v = acc[2 * q + (j >> 1)][j & 1]; v = ALPHA * xa[j] + ga[j] * v; acc[2 * q + (j >> 1)][j & 1] = v; s += v; } }
        const float mean = wsum(s) * (1.0f / D); float qv = 0.f;
#pragma unroll
        for (int j = 0; j < 16; ++j) { acc[j] = acc[j] - mean; qv += acc[j][0] * acc[j][0] + acc[j][1] * acc[j][1]; }
        const float rstd = 1.0f / sqrtf(wsum(qv) * (1.0f / D) + LN_EPS);
        float* xo = F.out + (size_t)row * D + 4 * lane2; bf16* xb = (bf16*)(F.ws + WS_X) + (size_t)row * D + 4 * lane2;
        unsigned char* ho = F.ws + WS_H + (size_t)row * D + 4 * lane2;
        const float* mdn = mod_row(F, (L + 1) & 3, row) + 4 * lane2;
#pragma unroll
        for (int q = 0; q < 8; ++q) { const int o = 256 * q; const f32x4 wa = *(const f32x4*)(lg + 4 * lane2 + o), ba = *(const f32x4*)(lb + 4 * lane2 + o);
            f32x4 oa;
#pragma unroll
            for (int j = 0; j < 4; ++j) oa[j] = acc[2 * q + (j >> 1)][j & 1] * rstd * wa[j] + ba[j];
            if (L == DEPTH - 1) *(f32x4*)(xo + o) = oa; else { v2u xw; xw.x = cvt_pk_bf16(oa[0], oa[1]); xw.y = cvt_pk_bf16(oa[2], oa[3]); *(v2u*)(xb + o) = xw; }
            if (L < DEPTH - 1) { const f32x4 sa = *(const f32x4*)(mdn + o), ca = *(const f32x4*)(mdn + D + o); const f32x4 ha = oa * (ca + 1.0f) + sa;
                *(unsigned*)(ho + o) = pk4_fp8(ha[0], ha[1], ha[2], ha[3]); } }
    }
}

constexpr int MP = 272;
constexpr int ML_QH = 0, ML_KH = 128 * MP, ML_VT = 2 * 128 * MP, ML_VW = 3 * 128 * MP, ML_GA = 4 * 128 * MP;
__device__ __forceinline__ s16x4 tr_read(LAS unsigned char* p) { return __builtin_amdgcn_ds_read_tr16_b64_v4i16((LAS s16x4*)p); }
__device__ __forceinline__ bf16x8 cat8(s16x4 a, s16x4 b) { return (bf16x8){a[0], a[1], a[2], a[3], b[0], b[1], b[2], b[3]}; }

template <int L> __device__ __forceinline__ void mlstm_scan_phase(Frame& F) {
    constexpr int J = L / 3;
    LAS unsigned char* lds = F.lds;
    LAS float* GA = (LAS float*)(lds + ML_GA);
    LAS float* gA = GA, *gMM = GA + 128, *gWI = GA + 256, *gEN = GA + 384, *gWS = GA + 512, *gNQ = GA + 640, *gHD = GA + 768;
    LAS float* gN = GA + 896;
    LAS float* gRS2 = GA + 896 + 512 + 16;
    const bf16* Zq = (const bf16*)(F.ws + WS_Z + ZQ); const bf16* Zk = (const bf16*)(F.ws + WS_Z + ZK); const bf16* Zv = (const bf16*)(F.ws + WS_Z + ZV);
    const float* G16 = (const float*)(F.ws + WS_GATE); const float* bg = F.in[I_ABG] + J * 16;
    const int tid0 = F.tid, w = F.wave;
    for (int unit = F.vcu; unit < 256; unit += F.G) {
        const int chain = unit >> 2, vs = unit & 3, dir = chain & 1, hd = (chain >> 1) & 3, b = chain >> 3;
        bf16* HO = (bf16*)(F.ws + (dir ? WS_Y : WS_H));
        float* GPa = (float*)(F.ws + WS_GP) + (size_t)unit * (3 * 34 * 128); float* GPb = GPa + 34 * 128; float* GPp = GPb + 34 * 128;
#define CBASE(jc_) ((jc_) < 2 ? TL + b * CL + (dir ? 1 - (jc_) : (jc_)) * 128 : b * SEQ + (dir ? 33 - (jc_) : (jc_) - 2) * 128)
        for (int jc = w; jc < 34; jc += NWAVES) {
            const int base = CBASE(jc); const int lane = tid0 & 63;
            const int s0 = 2 * lane, s1 = 2 * lane + 1;
            const float* g0 = G16 + (size_t)(base + (dir ? 127 - s0 : s0)) * 16; const float* g1 = G16 + (size_t)(base + (dir ? 127 - s1 : s1)) * 16;
            const int ci = dir * 8 + hd, cf = dir * 8 + 4 + hd;
            float li0 = g0[ci] + bg[ci], li1 = g1[ci] + bg[ci], gf0 = g0[cf] + bg[cf], gf1 = g1[cf] + bg[cf];
            li0 = 15.f * tanhf(li0 * (1.f / 15.f)); li1 = 15.f * tanhf(li1 * (1.f / 15.f)); gf0 = 15.f * tanhf(gf0 * (1.f / 15.f)); gf1 = 15.f * tanhf(gf1 * (1.f / 15.f));
            const float lf0 = fminf(gf0, 0.f) - log1pf(__expf(-fabsf(gf0))), lf1 = fminf(gf1, 0.f) - log1pf(__expf(-fabsf(gf1)));
            float p = lf0 + lf1;
#pragma unroll
            for (int o = 1; o < 64; o <<= 1) { const float t = __shfl_up(p, o); if (lane >= o) p += t; }
            const float b1 = p, b0 = p - lf1;
            const float a0 = li0 - b0, a1 = li1 - b1;
            float pm = fmaxf(a0, a1);
#pragma unroll
            for (int o = 1; o < 64; o <<= 1) { const float t = __shfl_up(pm, o); if (lane >= o) pm = fmaxf(pm, t); }
            float pe = __shfl_up(pm, 1); if (lane == 0) pe = -3.0e38f;
            *(f32x2*)(GPa + jc * 128 + s0) = (f32x2){a0, a1}; *(f32x2*)(GPb + jc * 128 + s0) = (f32x2){b0, b1}; *(f32x2*)(GPp + jc * 128 + s0) = (f32x2){fmaxf(pe, a0), pm};
        }
        f32x4 C[16];
#pragma unroll
        for (int i = 0; i < 16; ++i) C[i] = zero4();
        for (int i = tid0; i < 512; i += NTHR) gN[i] = 0.f;
        __syncthreads();
        float m = 0.f;
        v4u PQ[4], PK[4], PV[4]; float pa[4]; float pe_a, pe_b, pe_p, pl_b, pl_p;
#define LOAD_QK(jc_, hf_) do { int t_ = tid0; asm volatile("" : "+v"(t_)); const int base_ = CBASE(jc_); const size_t r0_ = (size_t)(base_ + (dir ? 127 - (t_ >> 4) : (t_ >> 4))); const long rs_ = dir ? -32 : 32; \
            const bf16* qp_ = Zq + r0_ * 1024 + hd * 256 + (hf_) * 128 + (t_ & 15) * 8; const bf16* kp_ = Zk + r0_ * 1024 + hd * 256 + (hf_) * 128 + (t_ & 15) * 8; \
            _Pragma("unroll") for (int i = 0; i < 4; ++i) { PQ[i] = *(const v4u*)(qp_ + (long)i * rs_ * 1024); PK[i] = *(const v4u*)(kp_ + (long)i * rs_ * 1024); } } while (0)
#define LOAD_V(jc_) do { int t_ = tid0; asm volatile("" : "+v"(t_)); const int base_ = CBASE(jc_); const size_t r0_ = (size_t)(base_ + (dir ? 127 - (t_ >> 4) : (t_ >> 4))); const long rs_ = dir ? -32 : 32; \
            const bf16* vp_ = Zv + r0_ * 2048 + hd * 512 + vs * 128 + (t_ & 15) * 8; \
            _Pragma("unroll") for (int i = 0; i < 4; ++i) { PV[i] = *(const v4u*)(vp_ + (long)i * rs_ * 2048); pa[i] = GPa[(jc_) * 128 + (t_ >> 4) + 32 * i]; } } while (0)
#define LOAD_G(jc_) do { int t_ = tid0; asm volatile("" : "+v"(t_)); const int o_ = (jc_) * 128 + (t_ & 127); pe_a = GPa[o_]; pe_b = GPb[o_]; pe_p = GPp[o_]; pl_b = GPb[(jc_) * 128 + 127]; pl_p = GPp[(jc_) * 128 + 127]; } while (0)
        LOAD_QK(0, 0); LOAD_V(0); LOAD_G(0);
        for (int jc = 0; jc < 34; ++jc) {
            const int base = CBASE(jc);
#define ROWMAP(r) (base + (dir ? 127 - (r) : (r)))
            LAS float* Ncur = gN + (jc & 1) * 256; LAS float* Nnxt = gN + ((jc & 1) ^ 1) * 256;
            int tid_l = tid0; asm volatile("" : "+v"(tid_l));
            const int tid = tid_l, lane = tid & 63, fr = lane & 15, fq = lane >> 4;
            int X1 = fr * MP + 16 * fq, X2 = fr * MP + 8 * fq, X3 = (8 * fq + (fr >> 2)) * MP + 8 * (fr & 3), XS = (tid >> 4) * MP + (tid & 15) * 16, X4 = 32 * fq;
            asm volatile("" : "+v"(X1), "+v"(X2), "+v"(X3), "+v"(XS), "+v"(X4));
            const int X1w = X1 + 16 * w * MP, X2w = X2 + 16 * w * MP, X3w = X3 + 32 * w;
            const float M127 = __builtin_bit_cast(float, __builtin_amdgcn_readfirstlane(__builtin_bit_cast(int, fmaxf(m, pl_p))));
            const float decay = __builtin_bit_cast(float, __builtin_amdgcn_readfirstlane(__builtin_bit_cast(int, __expf(m - M127))));
            if (tid < 128) { const float Mt = fmaxf(m, pe_p);
                gA[tid] = pe_a; gMM[tid] = Mt; gWI[tid] = __expf(m - Mt); gEN[tid] = __expf(-pe_b - Mt); gWS[tid] = __expf(pe_a - M127) * 0.0625f; }
            m = __builtin_bit_cast(float, __builtin_amdgcn_readfirstlane(__builtin_bit_cast(int, pl_b + M127)));
            f32x4 Sacc[5], CQ[8]; v2u SP[5]; float rsum = 0.f; const int lo_own = w >= 5 ? w - 4 : 0;
#pragma unroll
            for (int i = 0; i < 8; ++i) { if (i < 5) Sacc[i] = zero4(); CQ[i] = zero4(); }
#pragma unroll
            for (int hf = 0; hf < 2; ++hf) {
#pragma unroll
                for (int i = 0; i < 4; ++i) { *(LAS v4u*)(lds + ML_QH + XS + i * 32 * MP) = PQ[i]; *(LAS v4u*)(lds + ML_KH + XS + i * 32 * MP) = PK[i]; }
                if (hf == 0) {
#pragma unroll
                    for (int i = 0; i < 4; ++i) {
                        const v4u v = PV[i]; const float ws = __expf(pa[i] - M127) * 0.0625f;
                        *(LAS v4u*)(lds + ML_VT + XS + i * 32 * MP) = v;
                        v4u o; o.x = cvt_pk_bf16(bf_lo(v.x) * ws, bf_hi(v.x) * ws); o.y = cvt_pk_bf16(bf_lo(v.y) * ws, bf_hi(v.y) * ws);
                        o.z = cvt_pk_bf16(bf_lo(v.z) * ws, bf_hi(v.z) * ws); o.w = cvt_pk_bf16(bf_lo(v.w) * ws, bf_hi(v.w) * ws);
                        *(LAS v4u*)(lds + ML_VW + XS + i * 32 * MP) = o; }
                }
                __syncthreads();
                if (hf == 0) { LOAD_QK(jc, 1); }
                else if (jc < 33) { LOAD_QK(jc + 1, 0); }
#pragma unroll
                for (int i = 0; i < 5; ++i) {
                    const bool own = i <= w - lo_own; const int tbi = own ? w : 7 - w, sbi = own ? lo_own + i : i - (w + 1);
                    if (own || (w < 3 && sbi < 3 - w)) {
#pragma unroll
                        for (int ks = 0; ks < 4; ++ks) { const bf16x8 kf = *(const LAS bf16x8*)(lds + ML_KH + X1 + sbi * 16 * MP + ks * 64); const bf16x8 qf = *(const LAS bf16x8*)(lds + ML_QH + X1 + tbi * 16 * MP + ks * 64);
                            Sacc[i] = __builtin_amdgcn_mfma_f32_16x16x32_bf16(kf, qf, Sacc[i], 0, 0, 0); }
                    }
                }
                if (hf == 1) {
                    float rs_own = 0.f, rs_help = 0.f;
#pragma unroll
                    for (int i = 0; i < 5; ++i) {
                        const bool own = i <= w - lo_own; const int tbi = own ? w : 7 - w, sbi = own ? lo_own + i : i - (w + 1);
                        v2u o; o.x = 0u; o.y = 0u;
                        if (own || (w < 3 && sbi < 3 - w)) { const int t = 16 * tbi + fr; const float Mt = gMM[t]; float v[4], rs = 0.f;
#pragma unroll
                            for (int j = 0; j < 4; ++j) { const int sidx = 16 * sbi + 4 * fq + j; v[j] = (sidx <= t) ? Sacc[i][j] * 0.0625f * __expf(gA[sidx] - Mt) : 0.f; rs += v[j]; }
                            o.x = cvt_pk_bf16(v[0], v[1]); o.y = cvt_pk_bf16(v[2], v[3]);
                            if (own) rs_own += rs; else rs_help += rs; }
                        SP[i] = o;
                    }
                    rs_own += __shfl_xor(rs_own, 16); rs_own += __shfl_xor(rs_own, 32); rs_help += __shfl_xor(rs_help, 16); rs_help += __shfl_xor(rs_help, 32);
                    rsum = rs_own;
                    if (w < 3 && fq == 0) gRS2[16 * (7 - w) + fr] = rs_help;
                }
                __builtin_amdgcn_sched_barrier(0);
#pragma unroll
                for (int tb = 0; tb < 8; ++tb) {
#pragma unroll
                    for (int k2 = 0; k2 < 4; ++k2) {
                        const f32x4 c0 = C[hf * 8 + 2 * k2], c1 = C[hf * 8 + 2 * k2 + 1];
                        v4u pk; pk.x = cvt_pk_bf16(c0[0], c0[1]); pk.y = cvt_pk_bf16(c0[2], c0[3]); pk.z = cvt_pk_bf16(c1[0], c1[1]); pk.w = cvt_pk_bf16(c1[2], c1[3]);
                        const s16x4 qa = *(const LAS s16x4*)(lds + ML_QH + X2 + tb * 16 * MP + k2 * 64), qb = *(const LAS s16x4*)(lds + ML_QH + X2 + tb * 16 * MP + k2 * 64 + 32);
                        CQ[tb] = __builtin_amdgcn_mfma_f32_16x16x32_bf16(cat8(qa, qb), __builtin_bit_cast(bf16x8, pk), CQ[tb], 0, 0, 0); }
                }
                __builtin_amdgcn_sched_barrier(0);
                {
                    f32x4 nacc = zero4();
#pragma unroll
                    for (int ks = 0; ks < 4; ++ks) {
                        const LAS float* np = (const LAS float*)((LAS unsigned char*)Ncur + X4 + hf * 512 + ks * 128);
                        const f32x4 n0 = *(const LAS f32x4*)np, n1 = *(const LAS f32x4*)(np + 4);
                        v4u pk; pk.x = cvt_pk_bf16(n0[0], n0[1]); pk.y = cvt_pk_bf16(n0[2], n0[3]); pk.z = cvt_pk_bf16(n1[0], n1[1]); pk.w = cvt_pk_bf16(n1[2], n1[3]);
                        const bf16x8 qf = *(const LAS bf16x8*)(lds + ML_QH + X1w + ks * 64);
                        nacc = __builtin_amdgcn_mfma_f32_16x16x32_bf16(qf, __builtin_bit_cast(bf16x8, pk), nacc, 0, 0, 0); }
                    if (fr == 0) {
#pragma unroll
                        for (int j = 0; j < 4; ++j) { const int t = 16 * w + 4 * fq + j; gNQ[t] = (hf == 0 ? 0.f : gNQ[t]) + nacc[j]; } }
                }
                __builtin_amdgcn_sched_barrier(0);
#pragma unroll
                for (int dt = 0; dt < 8; ++dt) {
                    f32x4 acc = C[hf * 8 + dt] * decay;
#pragma unroll
                    for (int ss = 0; ss < 4; ++ss) { LAS unsigned char* p = lds + ML_KH + X3 + ss * 32 * MP + dt * 32; LAS unsigned char* pw = lds + ML_VW + X3w + ss * 32 * MP;
                        acc = __builtin_amdgcn_mfma_f32_16x16x32_bf16(cat8(tr_read(p), tr_read(p + 4 * MP)), cat8(tr_read(pw), tr_read(pw + 4 * MP)), acc, 0, 0, 0); }
                    C[hf * 8 + dt] = acc;
                }
                __builtin_amdgcn_sched_barrier(0);
                {
                    f32x4 nacc = zero4();
#pragma unroll
                    for (int ss = 0; ss < 4; ++ss) {
                        const LAS float* wp = (const LAS float*)((LAS unsigned char*)gWS + X4 + ss * 128);
                        const f32x4 w0 = *(const LAS f32x4*)wp, w1 = *(const LAS f32x4*)(wp + 4);
                        v4u pk; pk.x = cvt_pk_bf16(w0[0], w0[1]); pk.y = cvt_pk_bf16(w0[2], w0[3]); pk.z = cvt_pk_bf16(w1[0], w1[1]); pk.w = cvt_pk_bf16(w1[2], w1[3]);
                        LAS unsigned char* p = lds + ML_KH + X3w + ss * 32 * MP;
                        nacc = __builtin_amdgcn_mfma_f32_16x16x32_bf16(cat8(tr_read(p), tr_read(p + 4 * MP)), __builtin_bit_cast(bf16x8, pk), nacc, 0, 0, 0); }
                    if (fr == 0) {
#pragma unroll
                        for (int j = 0; j < 4; ++j) { const int dl = hf * 128 + 16 * w + 4 * fq + j; Nnxt[dl] = decay * Ncur[dl] + nacc[j]; } }
                }
                __syncthreads();
            }
            {
#pragma unroll
                for (int i = 0; i < 5; ++i) {
                    const bool own = i <= w - lo_own; const int tbi = own ? w : 7 - w, sbi = own ? lo_own + i : i - (w + 1);
                    if (own || (w < 3 && sbi < 3 - w)) *(LAS v2u*)(lds + ML_QH + X2 + tbi * 16 * MP + sbi * 32) = SP[i];
                }
                for (int sb = w + 1; sb < 8; ++sb) { v2u z; z.x = 0u; z.y = 0u; *(LAS v2u*)(lds + ML_QH + X2w + sb * 32) = z; }
                const int t = 16 * w + fr;
                if (fq == 0) { const float den = gWI[t] * gNQ[t] + rsum + (w >= 5 ? gRS2[t] : 0.f); gHD[t] = 1.0f / fmaxf(fabsf(den), gEN[t]); }
            }
            __syncthreads();
            {
                bf16x8 vf[4];
#pragma unroll
                for (int ss = 0; ss < 4; ++ss) { LAS unsigned char* p = lds + ML_VT + X3w + ss * 32 * MP; vf[ss] = cat8(tr_read(p), tr_read(p + 4 * MP)); }
                if (jc < 33) { LOAD_V(jc + 1); LOAD_G(jc + 1); }
                bf16* hop = HO + (size_t)ROWMAP(4 * fq) * D + hd * 512 + vs * 128 + 16 * w + fr; const long hstep = dir ? -(long)D : (long)D;
#pragma unroll
                for (int tb = 0; tb < 8; ++tb) {
                    f32x4 acc;
#pragma unroll
                    for (int j = 0; j < 4; ++j) acc[j] = CQ[tb][j] * gWI[16 * tb + 4 * fq + j];
#pragma unroll
                    for (int ss = 0; ss < 4; ++ss) { const bf16x8 sf = *(const LAS bf16x8*)(lds + ML_QH + X1 + tb * 16 * MP + ss * 64);
                        acc = __builtin_amdgcn_mfma_f32_16x16x32_bf16(sf, vf[ss], acc, 0, 0, 0); }
#pragma unroll
                    for (int j = 0; j < 4; ++j) { const float h = acc[j] * gHD[16 * tb + 4 * fq + j];
                        hop[(long)(16 * tb + j) * hstep] = (bf16)(cvt_pk_bf16(h, 0.f) & 0xffffu); }
                }
            }
            __syncthreads();
#undef ROWMAP
        }
#undef LOAD_QK
#undef LOAD_V
#undef LOAD_G
#undef CBASE
    }
}

template <int L> __device__ __forceinline__ void mlstm_post_phase(Frame& F, int M) {
    constexpr int J = L / 3;
    const int gw = F.vcu * NWAVES + F.wave, NGW = F.G * NWAVES;
    const float* ng = F.in[I_ANG] + (size_t)J * D;
    for (int row = gw; row < M; row += NGW) {
        const bf16* hf = (const bf16*)(F.ws + WS_H) + (size_t)row * D; const bf16* hb = (const bf16*)(F.ws + WS_Y) + (size_t)row * D;
        const bf16* orow = (const bf16*)(F.ws + WS_Z + ZO) + (size_t)row * D; unsigned char* g = F.ws + WS_Z + ZG + (size_t)row * D;
        f32x4 t[8]; float ss[4];
#pragma unroll
        for (int j = 0; j < 8; ++j) { const int e = 4 * F.lane + 256 * j; const v2u a = *(const v2u*)(hf + e), b = *(const v2u*)(hb + e);
            t[j] = (f32x4){bf_lo(a.x) + bf_lo(b.x), bf_hi(a.x) + bf_hi(b.x), bf_lo(a.y) + bf_lo(b.y), bf_hi(a.y) + bf_hi(b.y)}; }
#pragma unroll
        for (int h = 0; h < 4; ++h) { float q = 0.f;
#pragma unroll
            for (int jj = 0; jj < 2; ++jj) { const f32x4 v = t[2 * h + jj]; q += (v[0] * v[0] + v[1] * v[1]) + (v[2] * v[2] + v[3] * v[3]); }
            ss[h] = 1.0f / sqrtf(wsum(q) * (1.0f / A_DV) + LN_EPS); }
#pragma unroll
        for (int j = 0; j < 8; ++j) { const int e = 4 * F.lane + 256 * j; const v2u ov = *(const v2u*)(orow + e); const f32x4 gn = *(const f32x4*)(ng + e);
            const float o0 = bf_lo(ov.x), o1 = bf_hi(ov.x), o2 = bf_lo(ov.y), o3 = bf_hi(ov.y); const float r = ss[j >> 1];
            const float y0 = t[j][0] * r * gn[0] / (1.0f + __expf(-o0)), y1 = t[j][1] * r * gn[1] / (1.0f + __expf(-o1));
            const float y2 = t[j][2] * r * gn[2] / (1.0f + __expf(-o2)), y3 = t[j][3] * r * gn[3] / (1.0f + __expf(-o3));
            *(unsigned*)(g + e) = pk4_fp8(y0, y1, y2, y3); }
    }
}

__device__ __forceinline__ void gmlp_stats_phase(Frame& F, int M) {
    const int gw = F.vcu * NWAVES + F.wave, NGW = F.G * NWAVES;
    float* ST = (float*)(F.ws + WS_STAT);
    for (int row = gw; row < M; row += NGW) {
        const bf16* vr = (const bf16*)(F.ws + WS_Z + ZVV) + (size_t)row * 4096;
        v4u x[8]; float s = 0.f;
#pragma unroll
        for (int j = 0; j < 8; ++j) { x[j] = *(const v4u*)(vr + 8 * F.lane + 512 * j);
            s += (bf_lo(x[j].x) + bf_hi(x[j].x)) + (bf_lo(x[j].y) + bf_hi(x[j].y)) + (bf_lo(x[j].z) + bf_hi(x[j].z)) + (bf_lo(x[j].w) + bf_hi(x[j].w)); }
        const float mean = wsum(s) * (1.0f / 4096.f); float q = 0.f;
#pragma unroll
        for (int j = 0; j < 8; ++j) { float d;
            d = bf_lo(x[j].x) - mean; q += d * d; d = bf_hi(x[j].x) - mean; q += d * d; d = bf_lo(x[j].y) - mean; q += d * d; d = bf_hi(x[j].y) - mean; q += d * d;
            d = bf_lo(x[j].z) - mean; q += d * d; d = bf_hi(x[j].z) - mean; q += d * d; d = bf_lo(x[j].w) - mean; q += d * d; d = bf_hi(x[j].w) - mean; q += d * d; }
        const float rstd = 1.0f / sqrtf(wsum(q) * (1.0f / 4096.f) + LN_EPS);
        if (F.lane == 0) { ST[(size_t)row * 2] = mean; ST[(size_t)row * 2 + 1] = rstd; }
    }
}
__device__ __forceinline__ void gmlp_spatial_phase(Frame& F, int M) {
    LAS unsigned char* lds = F.lds;
    constexpr int GW_W = 0, GW_V = 128 * MP, GW_O = 2 * 128 * MP;
    const bf16* WS = (const bf16*)(F.ws + WS_WS); const float* ST = (const float*)(F.ws + WS_STAT);
    const bf16* U = (const bf16*)(F.ws + WS_Z + ZU); const bf16* V = (const bf16*)(F.ws + WS_Z + ZVV);
    const float* lng = F.in[I_BLNG]; const float* lnb = F.in[I_BLNB]; const float* bs = F.in[I_BBS];
    const int w = F.wave;
    const int nunits = (M / 128) * B_GROUPS;
    for (int u = F.vcu; u < nunits; u += F.G) {
        int tid_l = F.tid; asm volatile("" : "+v"(tid_l));
        const int tid = tid_l, lane = tid & 63, fr = lane & 15, fq = lane >> 4;
        const int chunk = u >> 3, g = u & 7, row0 = chunk * 128;
        const int et = tid >> 2, ec = tid & 3;
        v4u wreg[4], vreg[4][4]; float mean[4], rstd[4];
#pragma unroll
        for (int i = 0; i < 4; ++i) { const int c = tid + 512 * i, r = c >> 4, cc = c & 15;
            wreg[i] = *(const v4u*)(WS + (size_t)g * 16384 + r * 128 + cc * 8);
            mean[i] = ST[(size_t)(row0 + r) * 2]; rstd[i] = ST[(size_t)(row0 + r) * 2 + 1];
#pragma unroll
            for (int dq = 0; dq < 4; ++dq) vreg[dq][i] = *(const v4u*)(V + (size_t)(row0 + r) * 4096 + g * 512 + dq * 128 + cc * 8); }
        const float bst = bs[g * 128 + et];
#pragma unroll
        for (int i = 0; i < 4; ++i) { const int c = tid + 512 * i, r = c >> 4, cc = c & 15; *(LAS v4u*)(lds + GW_W + r * MP + cc * 16) = wreg[i]; }
#pragma unroll
        for (int dq = 0; dq < 4; ++dq) {
            const int col0 = g * 512 + dq * 128;
#pragma unroll
            for (int i = 0; i < 4; ++i) { const int c = tid + 512 * i, r = c >> 4, cc = c & 15;
                const v4u v = vreg[dq][i]; const float mn = mean[i], rs = rstd[i];
                const f32x4 ga = *(const f32x4*)(lng + col0 + cc * 8), gb = *(const f32x4*)(lng + col0 + cc * 8 + 4), ba = *(const f32x4*)(lnb + col0 + cc * 8), bb = *(const f32x4*)(lnb + col0 + cc * 8 + 4);
                v4u o;
                o.x = cvt_pk_bf16((bf_lo(v.x) - mn) * rs * ga[0] + ba[0], (bf_hi(v.x) - mn) * rs * ga[1] + ba[1]);
                o.y = cvt_pk_bf16((bf_lo(v.y) - mn) * rs * ga[2] + ba[2], (bf_hi(v.y) - mn) * rs * ga[3] + ba[3]);
                o.z = cvt_pk_bf16((bf_lo(v.z) - mn) * rs * gb[0] + bb[0], (bf_hi(v.z) - mn) * rs * gb[1] + bb[1]);
                o.w = cvt_pk_bf16((bf_lo(v.w) - mn) * rs * gb[2] + bb[2], (bf_hi(v.w) - mn) * rs * gb[3] + bb[3]);
                *(LAS v4u*)(lds + GW_V + r * MP + cc * 16) = o; }
            __syncthreads();
            v4u ureg[4];
            { const bf16* up = U + (size_t)(row0 + et) * 4096 + col0 + 32 * ec;
#pragma unroll
              for (int k = 0; k < 4; ++k) ureg[k] = *(const v4u*)(up + 8 * k); }
            bf16x8 wf[4];
#pragma unroll
            for (int ss = 0; ss < 4; ++ss) wf[ss] = *(const LAS bf16x8*)(lds + GW_W + (16 * w + fr) * MP + (32 * ss + 8 * fq) * 2);
#pragma unroll
            for (int db = 0; db < 8; ++db) {
                f32x4 acc = zero4();
#pragma unroll
                for (int ss = 0; ss < 4; ++ss) { LAS unsigned char* p = lds + GW_V + (32 * ss + 8 * fq + (fr >> 2)) * MP + (16 * db + 4 * (fr & 3)) * 2;
                    acc = __builtin_amdgcn_mfma_f32_16x16x32_bf16(cat8(tr_read(p), tr_read(p + 4 * MP)), wf[ss], acc, 0, 0, 0); }
                v2u o; o.x = cvt_pk_bf16(acc[0], acc[1]); o.y = cvt_pk_bf16(acc[2], acc[3]);
                *(LAS v2u*)(lds + GW_O + (16 * w + fr) * MP + (16 * db + 4 * fq) * 2) = o;
            }
            __syncthreads();
            { const LAS unsigned char* op = lds + GW_O + et * MP + 64 * ec;
              unsigned char* hp = F.ws + WS_H + (size_t)(row0 + et) * 4096 + col0 + 32 * ec;
              v4u out[2];
#pragma unroll
              for (int k = 0; k < 4; ++k) { const v4u sv = *(const LAS v4u*)(op + 16 * k); const v4u uv = ureg[k];
                  const unsigned lo = pk4_fp8(bf_lo(uv.x) * (bf_lo(sv.x) + bst), bf_hi(uv.x) * (bf_hi(sv.x) + bst), bf_lo(uv.y) * (bf_lo(sv.y) + bst), bf_hi(uv.y) * (bf_hi(sv.y) + bst));
                  const unsigned hi = pk4_fp8(bf_lo(uv.z) * (bf_lo(sv.z) + bst), bf_hi(uv.z) * (bf_hi(sv.z) + bst), bf_lo(uv.w) * (bf_lo(sv.w) + bst), bf_hi(uv.w) * (bf_hi(sv.w) + bst));
                  out[k >> 1][2 * (k & 1)] = lo; out[k >> 1][2 * (k & 1) + 1] = hi; }
              *(v4u*)hp = out[0]; *(v4u*)(hp + 16) = out[1]; }
        }
        __syncthreads();
    }
}

namespace att {
using bf16 = unsigned short;
constexpr int   D = 128, NW = 8, QBLK = 32, KVBLK = 64;
constexpr float SCALE = 0.088388347648318440f;
constexpr float THR = 8.f;
constexpr int SDEPTH = 2;
constexpr int LDQ = 2048, LDK = 512, LDO = 2048;
constexpr size_t SHM_V = KVBLK * D * 2, SHM_K = KVBLK * D * 2, SHM_ATTN = 2 * SHM_V + 2 * SHM_K + NW * 64 * 4;
using bf16x8 = __attribute__((ext_vector_type(8))) short;
using s16x4  = __attribute__((ext_vector_type(4))) short;
using f32x16 = __attribute__((ext_vector_type(16))) float;
using f32x8  = __attribute__((ext_vector_type(8))) float;
using u32x4  = __attribute__((ext_vector_type(4))) unsigned;
#define KSWZ(row, colB) ((row) * 256 + ((colB) ^ (((row) & 7) << 4)))
#define SBAR() __builtin_amdgcn_sched_barrier(0)
__device__ __forceinline__ int crow(int r, int hi) { return (r & 3) + 8 * (r >> 2) + 4 * hi; }
__device__ __forceinline__ unsigned cvtpk(float lo, float hi) { return ::cvt_pk_bf16(lo, hi); }
template <typename TIn> struct Stage;
template <> struct Stage<bf16>  { using T = bf16x8;
  __device__ static __forceinline__ T ld8(const bf16* p) { return *reinterpret_cast<const bf16x8*>(p); }
  __device__ static __forceinline__ bf16x8 tobf(T x) { return x; } };
__device__ __forceinline__ void partialSM(f32x16& p0, f32x16& p1, float& m_reg, float& mn, float& alpha) {
  constexpr float C = SCALE * 1.4426950408889634f;
  float pmax = p0[0]; for (int r = 1; r < 16; ++r) pmax = fmaxf(pmax, p0[r]); for (int r = 0; r < 16; ++r) pmax = fmaxf(pmax, p1[r]);
  { auto rr = __builtin_amdgcn_permlane32_swap(__float_as_uint(pmax), __float_as_uint(pmax), false, false);
    pmax = fmaxf(__uint_as_float(rr[0]), __uint_as_float(rr[1])); }
  if (__builtin_expect(__all(pmax - m_reg <= THR / SCALE), 1)) { mn = m_reg; alpha = 1.f; }
  else { mn = fmaxf(m_reg, pmax); alpha = __builtin_amdgcn_exp2f((m_reg - mn) * C); m_reg = mn; }
  float mnC = -mn * C;
  for (int r = 0; r < 16; ++r) p0[r] = fmaf(p0[r], C, mnC); for (int r = 0; r < 16; ++r) p1[r] = fmaf(p1[r], C, mnC);
  for (int r = 0; r < 16; ++r) p0[r] = __builtin_amdgcn_exp2f(p0[r]);
}
__device__ __forceinline__ void finishSM(f32x16& p0, f32x16& p1, float alpha, float& l_reg, bf16x8& pa0, bf16x8& pa1, bf16x8& pa2, bf16x8& pa3) {
  for (int r = 0; r < 16; ++r) p1[r] = __builtin_amdgcn_exp2f(p1[r]);
  float ps = 0; for (int r = 0; r < 16; ++r) ps += p0[r]; for (int r = 0; r < 16; ++r) ps += p1[r];
  { auto rr = __builtin_amdgcn_permlane32_swap(__float_as_uint(ps), __float_as_uint(ps), false, false);
    ps = __uint_as_float(rr[0]) + __uint_as_float(rr[1]); }
  l_reg = l_reg * alpha + ps;
#define PK4(P, BASE, OUT) do { unsigned a0 = cvtpk(P[BASE + 0], P[BASE + 1]), a1 = cvtpk(P[BASE + 2], P[BASE + 3]);   \
    unsigned b0 = cvtpk(P[BASE + 4], P[BASE + 5]), b1 = cvtpk(P[BASE + 6], P[BASE + 7]);                              \
    auto r0 = __builtin_amdgcn_permlane32_swap(a0, b0, false, false); auto r1 = __builtin_amdgcn_permlane32_swap(a1, b1, false, false); \
    u32x4 w = {r0[0], r1[0], r0[1], r1[1]}; OUT = *reinterpret_cast<bf16x8*>(&w); } while (0)
  PK4(p0, 0, pa0); PK4(p0, 8, pa1); PK4(p1, 0, pa2); PK4(p1, 8, pa3);
#undef PK4
}
__device__ __forceinline__ void qkt(f32x16& p0, f32x16& p1, const bf16* Ks, const bf16x8* qr, int r32, int hi) {
  p0 = f32x16{}; p1 = f32x16{};
  for (int d0 = 0; d0 < 8; ++d0) { int cb = (d0 * 16 + hi * 8) * 2;
    bf16x8 b0 = *reinterpret_cast<const bf16x8*>((const char*)Ks + KSWZ(r32, cb));
    bf16x8 b1 = *reinterpret_cast<const bf16x8*>((const char*)Ks + KSWZ(32 + r32, cb));
    p0 = __builtin_amdgcn_mfma_f32_32x32x16_bf16(b0, qr[d0], p0, 0, 0, 0);
    p1 = __builtin_amdgcn_mfma_f32_32x32x16_bf16(b1, qr[d0], p1, 0, 0, 0); }
}
__device__ __forceinline__ int v_st(int k, int c) { const int kk = (k & ~0xC) | ((k & 4) << 1) | ((k & 8) >> 1); return ((kk >> 3) * 4 + (c >> 5)) * 512 + ((kk & 7) * 32 + (c & 31)) * 2; }
__device__ __forceinline__ int v_rd_base(int lane) { return ((lane & 3) << 3) | (((lane >> 2) & 3) << 6) | (((lane >> 4) & 1) << 5) | (((lane >> 5) & 1) << 8); }
constexpr int v_rd_off(int d0, int ks, int half) { return d0 * 512 + ks * 4096 + half * 2048; }
template <int OFF> __device__ __forceinline__ s16x4 tr_read(int vb) {
  return __builtin_amdgcn_ds_read_tr16_b64_v4i16((__attribute__((address_space(3))) s16x4*)(unsigned long)(unsigned)(vb + OFF));
}
template <int D0> __device__ __forceinline__ void pv_one(f32x16& od, int vb, bf16x8 pa0, bf16x8 pa1, bf16x8 pa2, bf16x8 pa3) {
  const s16x4 l0 = tr_read<v_rd_off(D0, 0, 0)>(vb), h0 = tr_read<v_rd_off(D0, 0, 1)>(vb), l1 = tr_read<v_rd_off(D0, 1, 0)>(vb), h1 = tr_read<v_rd_off(D0, 1, 1)>(vb);
  const s16x4 l2 = tr_read<v_rd_off(D0, 2, 0)>(vb), h2 = tr_read<v_rd_off(D0, 2, 1)>(vb), l3 = tr_read<v_rd_off(D0, 3, 0)>(vb), h3 = tr_read<v_rd_off(D0, 3, 1)>(vb);
#define PK(L, H) (bf16x8){L[0], L[1], L[2], L[3], H[0], H[1], H[2], H[3]}
  od = __builtin_amdgcn_mfma_f32_32x32x16_bf16(pa0, PK(l0, h0), od, 0, 0, 0);
  od = __builtin_amdgcn_mfma_f32_32x32x16_bf16(pa1, PK(l1, h1), od, 0, 0, 0);
  od = __builtin_amdgcn_mfma_f32_32x32x16_bf16(pa2, PK(l2, h2), od, 0, 0, 0);
  od = __builtin_amdgcn_mfma_f32_32x32x16_bf16(pa3, PK(l3, h3), od, 0, 0, 0);
#undef PK
}
__device__ __forceinline__ void pv_d0(f32x16* o, int vb, bf16x8 pa0, bf16x8 pa1, bf16x8 pa2, bf16x8 pa3) {
  pv_one<0>(o[0], vb, pa0, pa1, pa2, pa3); pv_one<1>(o[1], vb, pa0, pa1, pa2, pa3); pv_one<2>(o[2], vb, pa0, pa1, pa2, pa3); pv_one<3>(o[3], vb, pa0, pa1, pa2, pa3);
}

template <typename TQ>
__device__ __forceinline__ void attn_dense_body(const TQ* __restrict__ Qb, const bf16* __restrict__ Kh, const bf16* __restrict__ Vh,
                                                unsigned char* __restrict__ Ob, int seq, char* lds, int tid_in) {
  using St = Stage<bf16>; using SQ = Stage<TQ>;
  const int tid = tid_in, wid = tid >> 6, lane = tid & 63, r32 = lane & 31, hi = lane >> 5;
  bf16* V_lds = (bf16*)lds; bf16* K_lds = (bf16*)(lds + 2 * SHM_V);
  float* ws = (float*)(lds + 2 * SHM_V + 2 * SHM_K) + wid * 64; float* li_l = ws; float* al_l = ws + 32;
  float m_reg = -1e30f, l_reg = 0; f32x16 o[4] = {}; bf16x8 qr[8];
  const TQ* Qw = Qb + (long)(wid * QBLK + r32) * LDQ + hi * 8;
#pragma unroll
  for (int d0 = 0; d0 < 8; ++d0) qr[d0] = SQ::tobf(SQ::ld8(Qw + d0 * 16));
  const int sr = tid >> 4, sc = (tid & 15) * 8, vst0 = v_st(sr, sc), vst1 = v_st(32 + sr, sc);
  const int vb0 = (int)(uintptr_t)V_lds + v_rd_base(lane);
  struct { typename St::T vs0, vs1, ks0, ks1; } sr_[SDEPTH];
#define SLOAD(i, k0) do { sr_[i].vs0 = St::ld8(&Vh[(long)((k0) + sr) * LDK + sc]); sr_[i].vs1 = St::ld8(&Vh[(long)((k0) + 32 + sr) * LDK + sc]); \
    sr_[i].ks0 = St::ld8(&Kh[(long)((k0) + sr) * LDK + sc]); sr_[i].ks1 = St::ld8(&Kh[(long)((k0) + 32 + sr) * LDK + sc]); } while (0)
#define SWRITE(b, i) do { *(bf16x8*)((char*)V_lds + (b) * SHM_V + vst0) = St::tobf(sr_[i].vs0);          \
    *(bf16x8*)((char*)V_lds + (b) * SHM_V + vst1) = St::tobf(sr_[i].vs1); int kc = sc * 2;               \
    *(bf16x8*)((char*)K_lds + (b) * SHM_K + KSWZ(sr, kc)) = St::tobf(sr_[i].ks0);                       \
    *(bf16x8*)((char*)K_lds + (b) * SHM_K + KSWZ(32 + sr, kc)) = St::tobf(sr_[i].ks1); } while (0)
#define SWAIT() do { if constexpr (SDEPTH == 2) asm volatile("s_waitcnt vmcnt(4)" ::: "memory"); else asm volatile("s_waitcnt vmcnt(0)" ::: "memory"); } while (0)
#define RESC(a) do { if (__any((a) < 1.f)) { if (hi == 0) al_l[r32] = (a); asm volatile("s_waitcnt lgkmcnt(0)" ::: "memory"); \
    for (int d = 0; d < 4; ++d) for (int r = 0; r < 16; ++r) o[d][r] *= al_l[crow(r, hi)]; } } while (0)
  f32x16 pA0, pA1, pB0, pB1; float mnA, mnB, alA, alB; bf16x8 pa0, pa1, pa2, pa3; const int NT = seq / KVBLK;
  constexpr int SE = 0, SO = SDEPTH - 1;
  SLOAD(SE, 0); asm volatile("s_waitcnt vmcnt(0)" ::: "memory"); SWRITE(0, SE); __syncthreads();
  qkt(pA0, pA1, K_lds, qr, r32, hi); partialSM(pA0, pA1, m_reg, mnA, alA);
  SLOAD(SO, KVBLK); if constexpr (SDEPTH == 2) { if (2 < NT) SLOAD(SE, 2 * KVBLK); }
  SWAIT(); SWRITE(1, SO); __syncthreads();
  for (int j = 1; j + 1 < NT; j += 2) {
    SBAR(); qkt(pB0, pB1, (bf16*)((char*)K_lds + SHM_K), qr, r32, hi);
    finishSM(pA0, pA1, alA, l_reg, pa0, pa1, pa2, pa3); SBAR();
    SLOAD(SO, (j + SDEPTH) * KVBLK); SBAR();
    pv_d0(o, vb0, pa0, pa1, pa2, pa3); partialSM(pB0, pB1, m_reg, mnB, alB);
    __syncthreads(); SWAIT(); SWRITE(0, SE);
    RESC(alB); __syncthreads();
    SBAR(); qkt(pA0, pA1, K_lds, qr, r32, hi);
    finishSM(pB0, pB1, alB, l_reg, pa0, pa1, pa2, pa3); SBAR();
    if (SDEPTH == 1 || j + 3 < NT) SLOAD(SE, (j + 1 + SDEPTH) * KVBLK); SBAR();
    pv_d0(o, vb0 + (int)SHM_V, pa0, pa1, pa2, pa3); partialSM(pA0, pA1, m_reg, mnA, alA);
    __syncthreads(); SWAIT(); SWRITE(1, SO);
    RESC(alA); __syncthreads();
  }
  SBAR(); qkt(pB0, pB1, (bf16*)((char*)K_lds + SHM_K), qr, r32, hi);
  finishSM(pA0, pA1, alA, l_reg, pa0, pa1, pa2, pa3); SBAR();
  pv_d0(o, vb0, pa0, pa1, pa2, pa3); partialSM(pB0, pB1, m_reg, mnB, alB);
  __syncthreads(); RESC(alB);
  finishSM(pB0, pB1, alB, l_reg, pa0, pa1, pa2, pa3); SBAR();
  pv_d0(o, vb0 + (int)SHM_V, pa0, pa1, pa2, pa3);
  if (hi == 0) li_l[r32] = l_reg; asm volatile("s_waitcnt lgkmcnt(0)" ::: "memory");
  float rli[16];
#pragma unroll
  for (int r = 0; r < 16; ++r) rli[r] = __builtin_amdgcn_rcpf(li_l[crow(r, hi)]);
  unsigned char* Ow = Ob + (long)(wid * QBLK) * LDO;
#pragma unroll
  for (int r = 0; r < 16; ++r) { int orow = crow(r, hi);
    for (int d0 = 0; d0 < 4; ++d0) Ow[(long)orow * LDO + d0 * 32 + r32] = (unsigned char)(__builtin_amdgcn_cvt_pk_fp8_f32(o[d0][r] * rli[r], 0.f, 0, false) & 0xff); }
#undef SLOAD
#undef SWRITE
#undef SWAIT
#undef RESC
}
}

constexpr size_t WS_ROPE = WS_STAT + 512 * 1024;
__device__ __forceinline__ void rope_table(Frame& F) {
    float* R = (float*)(F.ws + WS_ROPE);
    const int i = F.vcu * NTHR + F.tid;
    if (i < 64 * 32) { const int pos = i >> 5, fi = i & 31; const float fr = powf(10000.0f, -(float)fi / 32.0f); const float ang = (float)pos * fr; R[2 * i] = cosf(ang); R[2 * i + 1] = sinf(ang); }
}
__device__ __forceinline__ v4u normrope_seg(const bf16* src, const float* g, const float* R, bool rope, int rowpos, int colpos, int lane) {
    const v4u x = *(const v4u*)(src + 8 * lane);
    float v[8] = {bf_lo(x.x), bf_hi(x.x), bf_lo(x.y), bf_hi(x.y), bf_lo(x.z), bf_hi(x.z), bf_lo(x.w), bf_hi(x.w)};
    float q = 0.f;
#pragma unroll
    for (int i = 0; i < 8; ++i) q += v[i] * v[i];
    const float rstd = 1.0f / sqrtf(row16_sum(q) * (1.0f / 128.f) + LN_EPS);
    const int d0 = 8 * (lane & 15);
    const f32x4 ga = *(const f32x4*)(g + d0), gb = *(const f32x4*)(g + d0 + 4);
#pragma unroll
    for (int i = 0; i < 4; ++i) { v[i] *= rstd * ga[i]; v[4 + i] *= rstd * gb[i]; }
    if (rope) {
        const int pos = ((lane & 15) >> 3) ? colpos : rowpos; const bool hi = (lane & 7) >= 4; const int f0 = 8 * (lane & 3);
#pragma unroll
        for (int i = 0; i < 8; ++i) { const float p = __shfl_xor(v[i], 4); const float cs = R[(pos * 32 + f0 + i) * 2], sn = R[(pos * 32 + f0 + i) * 2 + 1];
            v[i] = hi ? (p * sn + v[i] * cs) : (v[i] * cs - p * sn); }
    }
    v4u o; o.x = cvt_pk_bf16(v[0], v[1]); o.y = cvt_pk_bf16(v[2], v[3]); o.z = cvt_pk_bf16(v[4], v[5]); o.w = cvt_pk_bf16(v[6], v[7]);
    return o;
}
__device__ __forceinline__ void attn_prep_phase(Frame& F) {
    const int gw = F.vcu * NWAVES + F.wave, NGW = F.G * NWAVES;
    const float* R = (const float*)(F.ws + WS_ROPE);
    const float* qg = F.in[I_CQG]; const float* kg = F.in[I_CKG];
    for (int row = gw; row < T; row += NGW) {
        const bool lat = row < TL; const int b = lat ? (row >> 12) : ((row - TL) >> 8); const int s = lat ? (row & 4095) : 0;
        const int rp = s >> 6, cp = s & 63; const int kvrow = lat ? (b * SKV + s) : (b * SKV + SEQ + ((row - TL) & 255));
        bf16* q = (bf16*)(F.ws + WS_Z + ZAQ) + (size_t)row * 2048;
#pragma unroll
        for (int p = 0; p < 4; ++p) { const v4u o = normrope_seg(q + 512 * p, qg, R, lat, rp, cp, F.lane); *(v4u*)(q + 512 * p + 8 * F.lane) = o; }
        const bf16* k = (const bf16*)(F.ws + WS_Z + ZAK) + (size_t)row * 512; const bf16* v = (const bf16*)(F.ws + WS_Z + ZAV) + (size_t)row * 512;
        const v4u ko = normrope_seg(k, kg, R, lat, rp, cp, F.lane);
        *(v4u*)((bf16*)(F.ws + WS_Z + ZKC) + (size_t)kvrow * 512 + 8 * F.lane) = ko;
        *(v4u*)((bf16*)(F.ws + WS_Z + ZVC) + (size_t)kvrow * 512 + 8 * F.lane) = *(const v4u*)(v + 8 * F.lane);
    }
}
__device__ __forceinline__ void attn_phase(Frame& F, char* lds, bool need_ctx) {
    const bf16* Q = (const bf16*)(F.ws + WS_Z + ZAQ); const bf16* KC = (const bf16*)(F.ws + WS_Z + ZKC); const bf16* VC = (const bf16*)(F.ws + WS_Z + ZVC);
    unsigned char* O = F.ws + WS_H;
    const int nunits = 2048 + (need_ctx ? 128 : 0);
    for (int u = F.vcu; u < nunits; u += F.G) {
        const bf16 *qp, *kp, *vp; unsigned char* op; int seq;
        if (u < 2048) { const int qb = u & 15, h = (u >> 4) & 15, b = u >> 8; const size_t qrow = (size_t)b * SEQ + qb * 256;
            qp = Q + qrow * 2048 + h * 128; kp = KC + (size_t)b * SKV * 512 + (h >> 2) * 128; vp = VC + (size_t)b * SKV * 512 + (h >> 2) * 128; op = O + qrow * 2048 + h * 128; seq = SKV;
        } else { const int uu = u - 2048, h = uu & 15, b = uu >> 4; const size_t qrow = (size_t)TL + b * CL;
            qp = Q + qrow * 2048 + h * 128; kp = KC + ((size_t)b * SKV + SEQ) * 512 + (h >> 2) * 128; vp = VC + ((size_t)b * SKV + SEQ) * 512 + (h >> 2) * 128; op = O + qrow * 2048 + h * 128; seq = CL; }
        int tid_l = threadIdx.x; asm volatile("" : "+v"(tid_l));
        att::attn_dense_body<bf16>(qp, kp, vp, op, seq, lds, tid_l);
        __syncthreads();
    }
}

#ifndef MK_N_LAUNCHES
#define MK_N_LAUNCHES 1
#endif
constexpr int NPH = 2 + 8 * DEPTH;
struct Args { const float* in[28]; float* out; unsigned char* ws; int ph_lo, ph_hi; };

typedef pg8::EpiSeg<0> EpiPlain;
__device__ __forceinline__ EpiPlain epi_plain(bf16* o, int ld) { EpiPlain E; E.base = (unsigned char*)o; E.ld = ld; E.bias = nullptr; E.gates = nullptr; E.oscale = 1.0f / WSCALE; return E; }


__global__ void __launch_bounds__(NTHR, 2) fwd_kernel(Args args) {
    extern __shared__ __attribute__((aligned(16))) unsigned char lds_raw[];
    Frame F;
    F.lds = (LAS unsigned char*)lds_raw;
    F.tid = threadIdx.x; F.lane = F.tid & 63; F.wave = __builtin_amdgcn_readfirstlane(F.tid >> 6);
    F.G = gridDim.x; { const int bx = blockIdx.x; F.vcu = (F.G % 8 == 0) ? (bx % 8) * (F.G / 8) + bx / 8 : bx; }
    typedef const Args __attribute__((address_space(4)))* KArgs;
    KArgs ka = (KArgs)__builtin_amdgcn_kernarg_segment_ptr();
    F.in = ka->in; F.out = ka->out; F.ws = ka->ws;
    volatile LAS unsigned* MISC = (volatile LAS unsigned*)(F.lds + MISC_OFF);
    for (int u = F.tid; u < (LDS_BYTES - MISC_OFF) / 4; u += NTHR) MISC[u] = 0u;
    __syncthreads();
    const int lo = ka->ph_lo, hi = ka->ph_hi;
    unsigned* barw = (unsigned*)(F.ws + WS_CTL) + CW_BAR;
    XcdBarrier bar; bar.bar = barw; bar.x = 0; bar.st = nullptr;
    if (hi - lo > 1) bar = xcd_barrier_post(barw, MISC + 8);
#ifdef ONLY_PHASE
#define IN(k) ((k) == ONLY_PHASE && lo <= (k) && (k) < hi)
#else
#define IN(k) (lo <= (k) && (k) < hi)
#endif
#define SEAM(k) do { if (IN(k) && IN((k) + 1)) xcd_barrier(bar); } while (0)
#define RELANE() do { int t_ = threadIdx.x; asm volatile("" : "+v"(t_)); F.tid = t_; F.lane = t_ & 63; KArgs k_ = ka; asm volatile("" : "+s"(k_)); F.in = k_->in; F.out = k_->out; F.ws = k_->ws; } while (0)
#define WT (F.ws + WS_WT)
#define Hb ((bf16*)(F.ws + WS_H))
#define Yb ((bf16*)(F.ws + WS_Y))
#define Zb ((bf16*)(F.ws + WS_Z))

    if (IN(0)) { RELANE(); p0_prologue(F); rope_table(F); } SEAM(0);
    if (IN(1)) { RELANE(); p0b_modulate(F); } SEAM(1);

#define GEMM_PHASE16(EPI, Aptr, Bptr, M_, N_, K_) do { pg8::Gemm g{(const bf16*)(Aptr), (const bf16*)(Bptr), (M_), (N_), (K_)}; pg8::StaticOrder S; S.init((M_), (N_), F.G, (int)blockIdx.x); \
        pg8::gemm_phase<false>(F.lds, g, S, (EPI)); } while (0)
#define GEMM_PHASE(EPI, Aptr, Bptr, M_, N_, K_) do { pg8::Gemm g{(const bf16*)(Aptr), (const bf16*)(Bptr), (M_), (N_), (K_) / 2}; pg8::StaticOrder S; S.init((M_), (N_), F.G, (int)blockIdx.x); \
        pg8::gemm_phase<true>(F.lds, g, S, (EPI)); } while (0)
#define PEER_PHASES(L, PB, M_) do { \
        if (IN((PB) + 4)) { RELANE(); ln1_phase<L>(F, (M_)); } SEAM((PB) + 4); \
        if (IN((PB) + 5)) { RELANE(); EpiPlain E = epi_plain(Zb, 2048); \
            if ((PQ_FP8_MASK >> (L)) & 1) { GEMM_PHASE(E, Hb, WT + WT_PQ + (size_t)(L) * D * D * 2, (M_), 2048, 2048); } \
            else { E.oscale = 1.0f; GEMM_PHASE16(E, Yb, WT + WT_PQ + (size_t)(L) * D * D * 2, (M_), 2048, 2048); } } SEAM((PB) + 5); \
        if (IN((PB) + 6)) { RELANE(); peer_topk_phase<L>(F, (M_)); } SEAM((PB) + 6); \
        if (IN((PB) + 7)) { RELANE(); peer_u_phase<L>(F, (M_)); if (hi - lo > 1) xcd_barrier(bar); RELANE(); peer_v_phase<L>(F, (M_)); } SEAM((PB) + 7); } while (0)
#define MLSTM_PHASES(L, PB, M_) do { \
        if (IN((PB) + 0)) { RELANE(); pg8::EpiSeg<1> E; E.base = F.ws + WS_Z; E.ld = 0; E.bias = nullptr; E.gates = (float*)(F.ws + WS_GATE); E.oscale = 1.0f / WSCALE; \
            GEMM_PHASE(E, Hb, WT + WT_AIN + (size_t)((L) / 3) * A_INP * D, T, A_INP, 2048); } SEAM((PB) + 0); \
        if (IN((PB) + 1)) { RELANE(); mlstm_scan_phase<L>(F); } SEAM((PB) + 1); \
        if (IN((PB) + 2)) { RELANE(); mlstm_post_phase<L>(F, (M_)); } SEAM((PB) + 2); \
        if (IN((PB) + 3)) { RELANE(); EpiPlain E = epi_plain(Yb, 2048); GEMM_PHASE(E, F.ws + WS_Z + ZG, WT + WT_AOUT + (size_t)((L) / 3) * D * D, (M_), 2048, 2048); } SEAM((PB) + 3); } while (0)

    MLSTM_PHASES(0, 2, T);
    PEER_PHASES(0, 2, T);
    if (IN(10)) { RELANE(); pg8::EpiSeg<2> E; E.base = F.ws + WS_Z; E.ld = 0; E.bias = F.in[I_BBIN]; E.gates = nullptr; E.oscale = 1.0f / WSCALE; GEMM_PHASE(E, Hb, WT + WT_BIN, T, 8192, 2048); } SEAM(10);
    if (IN(11)) { RELANE(); gmlp_stats_phase(F, T); } SEAM(11);
    if (IN(12)) { RELANE(); gmlp_spatial_phase(F, T); } SEAM(12);
    if (IN(13)) { RELANE(); EpiPlain E = epi_plain(Yb, 2048); GEMM_PHASE(E, Hb, WT + WT_BOUT, T, 2048, 4096); } SEAM(13);
    PEER_PHASES(1, 10, T);
    if (IN(18)) { RELANE(); pg8::EpiSeg<3> E; E.base = F.ws + WS_Z; E.ld = 0; E.bias = nullptr; E.gates = nullptr; E.oscale = 1.0f / WSCALE; GEMM_PHASE(E, Hb, WT + WT_CQKV, T, C_QKV, 2048); } SEAM(18);
    if (IN(19)) { RELANE(); attn_prep_phase(F); } SEAM(19);
    if (IN(20)) { RELANE(); attn_phase(F, (char*)lds_raw, true); } SEAM(20);
    if (IN(21)) { RELANE(); EpiPlain E = epi_plain(Yb, 2048); GEMM_PHASE(E, Hb, WT + WT_COUT, T, 2048, 2048); } SEAM(21);
    PEER_PHASES(2, 18, T);
    MLSTM_PHASES(3, 26, TL);
    PEER_PHASES(3, 26, TL);
#undef IN
#undef SEAM
#undef WT
#undef Hb
#undef Yb
#undef Zb
}


extern "C" void kernel_launch(void* const* d_in, const int* in_sizes, int n_in, void* d_out, int out_size, void* d_ws, size_t ws_size, hipStream_t stream) {
    static int grid = 0;
    if (grid == 0) {
        if (n_in != 28 || out_size != TL * D || ws_size < WS_END) { fprintf(stderr, "kernel_launch: unexpected shapes: n_in %d out %d ws %zu (need %zu)\n", n_in, out_size, ws_size, (size_t)WS_END); grid = -1; return; }
        int dev = 0, cus = 0, per_cu = 0;
        if (hipGetDevice(&dev) != hipSuccess || hipDeviceGetAttribute(&cus, hipDeviceAttributeMultiprocessorCount, dev) != hipSuccess) { grid = -1; return; }
        if (hipFuncSetAttribute((const void*)fwd_kernel, hipFuncAttributeMaxDynamicSharedMemorySize, LDS_BYTES) != hipSuccess) { fprintf(stderr, "kernel_launch: hipFuncSetAttribute failed\n"); grid = -1; return; }
        if (hipOccupancyMaxActiveBlocksPerMultiprocessor(&per_cu, (const void*)fwd_kernel, NTHR, LDS_BYTES) != hipSuccess || per_cu < 1) { fprintf(stderr, "kernel_launch: occupancy query says %d\n", per_cu); }
        (void)hipGetLastError();
        grid = cus;
    }
    if (grid < 0) return;
    if (hipMemsetAsync((char*)d_ws + WS_CTL, 0, CTL_ZERO_BYTES, stream) != hipSuccess) return;
    Args a{};
    for (int i = 0; i < 28; ++i) a.in[i] = (const float*)d_in[i];
    a.out = (float*)d_out; a.ws = (unsigned char*)d_ws;
#if MK_N_LAUNCHES == 1
    a.ph_lo = 0; a.ph_hi = NPH;
    hipLaunchKernelGGL(fwd_kernel, dim3(grid), dim3(NTHR), LDS_BYTES, stream, a);
#else
    for (int k = 0; k < NPH; ++k) { a.ph_lo = k; a.ph_hi = k + 1; hipLaunchKernelGGL(fwd_kernel, dim3(grid), dim3(NTHR), LDS_BYTES, stream, a); }
#endif
    const hipError_t le = hipPeekAtLastError();
    if (le != hipSuccess) fprintf(stderr, "kernel_launch: launch failed: %s\n", hipGetErrorName(le));
}
```

```cpp
#include <hip/hip_runtime.h>
#include <cstdio>
#include <cstdint>

#define GAS __attribute__((address_space(1)))
#define LAS __attribute__((address_space(3)))
typedef unsigned short bf16;
typedef unsigned v4u __attribute__((ext_vector_type(4)));
typedef unsigned v2u __attribute__((ext_vector_type(2)));
typedef float f32x4 __attribute__((ext_vector_type(4)));
typedef float f32x2 __attribute__((ext_vector_type(2)));
typedef short bf16x8 __attribute__((ext_vector_type(8)));
typedef short s16x4 __attribute__((ext_vector_type(4)));
typedef int v8i_t __attribute__((ext_vector_type(8)));
typedef int v4i_t __attribute__((ext_vector_type(4)));
#define LDS_WAIT() asm volatile("s_waitcnt lgkmcnt(0)" ::: "memory")
#define VM_WAIT() asm volatile("s_waitcnt vmcnt(0)" ::: "memory")

constexpr int D = 2048, NB = 8, SEQ = 4096, CL = 256, DEPTH = 4;
constexpr int TL = NB * SEQ, TC = NB * CL, T = TL + TC;
constexpr int NMOD = 6 * D;
constexpr float ALPHA = 1.681792830507429f;
constexpr float LN_EPS = 1e-6f;
constexpr int A_HEADS = 4, A_DV = 512, A_DK = 256, A_CHUNK = 128, A_IN = 6160, A_INP = 6400;
constexpr int B_INNER = 4096, B_GROUPS = 8;
constexpr int C_HEADS = 16, C_KV = 4, C_HD = 128, C_QKV = 3072, SKV = SEQ + CL;
constexpr int P_HEADS = 8, P_NK = 128, P_TOPK = 16, P_E = 16384;
constexpr int NWAVES = 8, NTHR = 512;

constexpr size_t MiB = 1u << 20;
constexpr size_t WS_CTL = 0, CTL_ZERO_BYTES = 1 * MiB;
constexpr size_t WS_MOD = 1 * MiB;
constexpr size_t WS_STAT = 3 * MiB;
constexpr size_t WS_GATE = 4 * MiB;
constexpr size_t WS_K12 = 7 * MiB;
constexpr size_t WS_WS = 8 * MiB;
constexpr size_t WS_WT = 9 * MiB;
constexpr size_t WT_AIN = 0, WT_AOUT = WT_AIN + (size_t)2 * A_INP * D, WT_BIN = WT_AOUT + (size_t)2 * D * D, WT_BOUT = WT_BIN + (size_t)8192 * D,
                 WT_CQKV = WT_BOUT + (size_t)D * 4096, WT_COUT = WT_CQKV + (size_t)C_QKV * D, WT_PQ = WT_COUT + (size_t)D * D, WT_END = WT_PQ + (size_t)4 * D * D * 2;
constexpr int PQ_FP8_MASK = 0x3;
constexpr float WSCALE = 64.0f;
constexpr size_t WS_PU8 = 192 * MiB;
constexpr size_t WS_PV8 = WS_PU8 + (size_t)4 * P_E * D;
constexpr size_t WS_SC = WS_PV8 + (size_t)4 * P_E * D;
constexpr size_t WS_X = WS_SC + 1 * MiB;
constexpr size_t WS_GP = WS_X + (size_t)T * D * 2;
constexpr size_t WS_H = WS_X + (size_t)T * D * 4;
constexpr size_t WS_Y = WS_H + (size_t)T * D * 2;
constexpr size_t WS_Z = WS_Y + (size_t)T * D * 2;
constexpr size_t WS_IDX = WS_Z + (size_t)T * 8192 * 2;
constexpr size_t WS_PG = WS_IDX + (size_t)T * 128 * 4;
constexpr size_t WS_END = WS_PG + (size_t)T * 128 * 4;
static_assert(WS_WT + WT_END <= WS_PU8, "weights fit");
constexpr size_t ZQ = 0, ZK = (size_t)T * 1024 * 2, ZV = ZK + (size_t)T * 1024 * 2, ZO = ZV + (size_t)T * 2048 * 2, ZG = 0;
constexpr size_t ZU = 0, ZVV = (size_t)T * 4096 * 2;
constexpr size_t ZAQ = 0, ZAK = (size_t)T * 2048 * 2, ZAV = ZAK + (size_t)T * 512 * 2, ZKC = ZAV + (size_t)T * 512 * 2, ZVC = ZKC + (size_t)NB * SKV * 512 * 2;
constexpr int CW_BAR = 4096;

constexpr int LDS_BYTES = 155648;
constexpr int MISC_OFF = 151552;

typedef __bf16 bf16x2_t __attribute__((ext_vector_type(2)));
__device__ __forceinline__ unsigned cvt_pk_bf16(float lo, float hi) { const f32x2 v = {lo, hi}; return __builtin_bit_cast(unsigned, __builtin_convertvector(v, bf16x2_t)); }
__device__ __forceinline__ unsigned pk4_fp8(float a, float b, float c, float d) { int w = __builtin_amdgcn_cvt_pk_fp8_f32(a, b, 0, false); return (unsigned)__builtin_amdgcn_cvt_pk_fp8_f32(c, d, w, true); }
typedef float f32x16_t __attribute__((ext_vector_type(16)));
__device__ __forceinline__ f32x4 zero4() { f32x4 z = {0.f, 0.f, 0.f, 0.f}; asm volatile("" : "+v"(z)); return z; }
__device__ __forceinline__ f32x16_t zero16() { f32x16_t z = {}; asm volatile("" : "+v"(z)); return z; }
__device__ __forceinline__ float bf_lo(unsigned u) { return __uint_as_float(u << 16); }
__device__ __forceinline__ float bf_hi(unsigned u) { return __uint_as_float(u & 0xffff0000u); }
__device__ __forceinline__ float bf2f(bf16 b) { return __uint_as_float(((unsigned)b) << 16); }
__device__ __forceinline__ float wave_sum(float v) {
#pragma unroll
    for (int o = 1; o < 64; o <<= 1) v += __shfl_xor(v, o);
    return v;
}
__device__ __forceinline__ float wave_max(float v) {
#pragma unroll
    for (int o = 1; o < 64; o <<= 1) v = fmaxf(v, __shfl_xor(v, o));
    return v;
}
__device__ __forceinline__ float fast_exp(float x) { return __builtin_amdgcn_exp2f(x * 1.4426950408889634f); }
__device__ __forceinline__ float gelu_tanh(float x) {
    const float u = 0.7978845608028654f * (x + 0.044715f * x * x * x);
    const float e = __builtin_amdgcn_exp2f(-2.0f * 1.4426950408889634f * u);
    return x * __builtin_amdgcn_rcpf(1.0f + e);
}
__device__ __forceinline__ float silu(float x) { return x / (1.0f + __expf(-x)); }

#define XB_TMO      128
#define XB_XCNT(j)  (256  + 64 * (j))
#define XB_XSUB(j)  (1280 + 64 * (j))
#define XB_XGEN(j)  (2304 + 64 * (j))
#define XB_TOP      3328
#define XB_TOPGEN   3392
#define XCD_BAR_WORDS 3456
#define XB_SPIN_CAP (1u << 22)

__device__ __forceinline__ unsigned xb_ld(unsigned* p)              { return __hip_atomic_load(p, __ATOMIC_RELAXED, __HIP_MEMORY_SCOPE_AGENT); }
__device__ __forceinline__ unsigned xb_add(unsigned* p, unsigned v) { return __hip_atomic_fetch_add(p, v, __ATOMIC_RELAXED, __HIP_MEMORY_SCOPE_AGENT); }
__device__ __forceinline__ unsigned xb_xcc_id() { return (unsigned)__builtin_amdgcn_s_getreg((3 << 11) | 20) & 0xFu; }
#define XB_SPIN(cond, bar) do { unsigned _sp = 0; while (cond) { __builtin_amdgcn_s_sleep(1); \
    if ((++_sp & 255u) == 0u) { if (xb_ld(&(bar)[XB_TMO])) break; if (_sp > XB_SPIN_CAP) { atomicAdd(&(bar)[XB_TMO], 1u); break; } } } } while (0)

struct XcdBarrier { unsigned* bar; unsigned x; volatile LAS unsigned* st; };
__device__ __forceinline__ XcdBarrier xcd_barrier_post(unsigned* bar, volatile LAS unsigned* st) {
    XcdBarrier b; b.bar = bar; b.x = xb_xcc_id(); b.st = st;
    if (threadIdx.x == 0) (void)xb_add(&bar[XB_XCNT(b.x)], 1u);
    return b;
}
__device__ __forceinline__ void xcd_barrier_complete(unsigned* bar, unsigned x, unsigned& nloc, unsigned& nx) {
    const unsigned G = gridDim.x * gridDim.y * gridDim.z;
    unsigned sum, cnt, mine, sp = 0u;
    for (;;) {
        sum = 0u; cnt = 0u; mine = 0u;
#pragma unroll
        for (unsigned j = 0; j < 16; ++j) { const unsigned c = xb_ld(&bar[XB_XCNT(j)]); sum += c; cnt += (c > 0u) ? 1u : 0u; mine = (j == x) ? c : mine; }
        if (sum == G) break;
        __builtin_amdgcn_s_sleep(1);
        if ((++sp & 255u) == 0u) { if (xb_ld(&bar[XB_TMO])) break; if (sp > XB_SPIN_CAP) { atomicAdd(&bar[XB_TMO], 1u); break; } }
    }
    nloc = mine > 0u ? mine : 1u; nx = cnt > 0u ? cnt : 1u;
}
__device__ __forceinline__ void xcd_barrier(const XcdBarrier& b) {
    asm volatile("s_waitcnt vmcnt(0)" ::: "memory");
    __syncthreads();
    if (threadIdx.x == 0) {
        unsigned* bar = b.bar;
        __builtin_amdgcn_s_waitcnt(0);
        unsigned nloc = b.st[0], nx = b.st[1];
        if (nloc == 0u) { xcd_barrier_complete(bar, b.x, nloc, nx); b.st[0] = nloc; b.st[1] = nx; }
        const unsigned old = xb_add(&bar[XB_XSUB(b.x)], 1u);
        const unsigned gen = old / nloc;
        if (old + 1u == (gen + 1u) * nloc) {
            __builtin_amdgcn_fence(__ATOMIC_RELEASE, "agent");
            asm volatile("s_waitcnt vmcnt(0)" ::: "memory");
            const unsigned og = xb_add(&bar[XB_TOP], 1u);
            const unsigned tg = og / nx;
            if (og + 1u == (tg + 1u) * nx) xb_add(&bar[XB_TOPGEN], 1u);
            else XB_SPIN(xb_ld(&bar[XB_TOPGEN]) == tg, bar);
            __builtin_amdgcn_fence(__ATOMIC_ACQUIRE, "agent");
            xb_add(&bar[XB_XGEN(b.x)], 1u);
            asm volatile("s_waitcnt vmcnt(0)" ::: "memory");
        } else {
            XB_SPIN(xb_ld(&bar[XB_XGEN(b.x)]) == gen, bar);
            __builtin_amdgcn_fence(__ATOMIC_ACQUIRE, "agent");
            asm volatile("s_waitcnt vmcnt(0)" ::: "memory");
        }
    }
    __syncthreads();
}

namespace pg8 {
#define PG8_LAS __attribute__((address_space(3)))
typedef unsigned short bf16_t;
typedef unsigned u32x4 __attribute__((ext_vector_type(4)));
using ::v4i_t; using ::v8i_t;
constexpr int BM = 256, BK = 64, HALF = 128, HTB = HALF * BK * 2, STAGE_BYTES = 8 * HTB, NXCD = 8, WGM = 8;
__host__ __device__ __forceinline__ int lds_byte(int r, int c) { const int st = (r >> 4) * 2 + (c >> 5), rr = r & 15, cc = c & 31, ob = rr * 64 + cc * 2; return st * 1024 + (ob ^ (((ob >> 9) & 1) << 5)); }
__host__ __device__ __forceinline__ void stage_rc(int b, int& R, int& C) { const int st = b / 1024, sb = b % 1024, swz = sb ^ (((sb >> 9) & 1) << 5); R = (st >> 1) * 16 + swz / 64; C = (st & 1) * 32 + (swz % 64) / 2; }
__host__ __device__ __forceinline__ int perm32(int rho) { const int n = rho >> 4, i = rho & 15; return 8 * (i >> 2) + 4 * n + (i & 3); }
struct Unit { int pm, pn; };
struct Gemm { const bf16_t* A; const bf16_t* Bt; int M, N, K; };
struct StaticOrder {
    int nM, nN, nwg, G, c;
    __host__ __device__ void init(int M, int N, int G_, int c_) { nM = M / BM; nN = N / BM; nwg = nM * nN; G = G_; c = c_; }
    __host__ __device__ bool next(int i, Unit& u) const {
        const long L = (long)i * G + c; if (L >= nwg) return false;
        int wgid = (int)L; { const int q = nwg / NXCD, r = nwg % NXCD, xcd = wgid % NXCD, off = wgid / NXCD; wgid = (xcd < r ? xcd * (q + 1) : r * (q + 1) + (xcd - r) * q) + off; }
        const int nig = WGM * nN, gid = wgid / nig, fm = gid * WGM, gsz = (nM - fm) < WGM ? (nM - fm) : WGM;
        u.pm = fm + ((wgid % nig) % gsz); u.pn = (wgid % nig) / gsz; return true;
    }
    __device__ __forceinline__ void a_ready(const Unit&) const {}
    __device__ __forceinline__ void done(const Unit&) const {}
};
template <int MODE> struct EpiSeg {
    static constexpr bool PERM = true, AFTER_DRAIN = false;
    unsigned char* base; int ld; const float* bias; float* gates; float oscale;
    __device__ __forceinline__ void operator()(const f32x4 (&acc)[2][2][4][2], const Unit& u, int wr, int wc, int fr, int fq) const {
        const int row0 = u.pm * BM + wr * 64 + fr;
        if (MODE == 1 && u.pn >= 24) {
            if (wc == 0 && fq < 2) {
#pragma unroll
                for (int ai = 0; ai < 2; ++ai)
#pragma unroll
                    for (int m = 0; m < 4; ++m) { float* rp = gates + (size_t)(row0 + ai * HALF + m * 16) * 16 + 8 * fq;
                        *(f32x4*)(rp) = acc[ai][0][m][0] * oscale; *(f32x4*)(rp + 4) = acc[ai][0][m][1] * oscale; }
            }
        } else {
        size_t off = 0; int ldc = ld, tb = 0;
        if (MODE == 1) { ldc = u.pn < 8 ? 1024 : 2048; tb = u.pn < 4 ? 0 : u.pn < 8 ? 4 : u.pn < 16 ? 8 : 16; off = u.pn < 4 ? ZQ : u.pn < 8 ? ZK : u.pn < 16 ? ZV : ZO; }
        if (MODE == 2) { ldc = 4096; tb = u.pn < 16 ? 0 : 16; off = u.pn < 16 ? ZU : ZVV; }
        if (MODE == 3) { ldc = u.pn < 8 ? 2048 : 512; tb = u.pn < 8 ? 0 : u.pn < 10 ? 8 : 10; off = u.pn < 8 ? ZAQ : u.pn < 10 ? ZAK : ZAV; }
        bf16_t* ob = (bf16_t*)(base + off);
        const int col0 = (u.pn - tb) * BM + wc * 32 + 8 * fq, bcol0 = u.pn * BM + wc * 32 + 8 * fq;
        f32x4 bv[2][2];
#pragma unroll
        for (int bj = 0; bj < 2; ++bj)
#pragma unroll
            for (int n = 0; n < 2; ++n) bv[bj][n] = (MODE == 2) ? *(const f32x4*)(bias + bcol0 + bj * HALF + 4 * n) : (f32x4){0.f, 0.f, 0.f, 0.f};
        const int lid = fr + 16 * fq, frp = 4 * (lid >> 4) + ((lid >> 2) & 3), fqp = lid & 3, srcl = frp + 16 * fqp;
        const int row0p = row0 - fr + frp, col0p = col0 - 8 * fq + 8 * fqp;
#pragma unroll
        for (int ai = 0; ai < 2; ++ai)
#pragma unroll
            for (int m = 0; m < 4; ++m) { bf16_t* rowp = ob + (size_t)(row0p + ai * HALF + m * 16) * ldc + col0p;
#pragma unroll
                for (int bj = 0; bj < 2; ++bj) { f32x4 v0 = acc[ai][bj][m][0] * oscale + bv[bj][0], v1 = acc[ai][bj][m][1] * oscale + bv[bj][1];
                    if (MODE == 2) {
#pragma unroll
                        for (int j = 0; j < 4; ++j) { v0[j] = gelu_tanh(v0[j]); v1[j] = gelu_tanh(v1[j]); } }
                    u32x4 w; w.x = (unsigned)__shfl((int)cvt_pk_bf16(v0[0], v0[1]), srcl); w.y = (unsigned)__shfl((int)cvt_pk_bf16(v0[2], v0[3]), srcl);
                    w.z = (unsigned)__shfl((int)cvt_pk_bf16(v1[0], v1[1]), srcl); w.w = (unsigned)__shfl((int)cvt_pk_bf16(v1[2], v1[3]), srcl);
                    *(u32x4*)(rowp + bj * HALF) = w; } }
        }
    }
};
template <bool FP8, class Epi, class Sched>
__device__ __forceinline__ void gemm_phase(PG8_LAS unsigned char* lds, const Gemm g, const Sched& S, const Epi& E) {
    const int tid = threadIdx.x, wid = __builtin_amdgcn_readfirstlane(tid >> 6), lane = tid & 63, wr = wid >> 2, wc = wid & 3, fr = lane & 15, fq = lane >> 4;
    const int K = g.K, nt = K / BK;
    unsigned voffA[2], voffB[2];
#pragma unroll
    for (int i = 0; i < 2; ++i) { int R, C; stage_rc(tid * 16 + i * 8192, R, C); const int Rb = Epi::PERM ? ((R & ~31) + perm32(R & 31)) : R;
        voffA[i] = (unsigned)(R * K + C) * 2u; voffB[i] = (unsigned)(Rb * K + C) * 2u; }
    const size_t kstep = (size_t)(BK * 2);
    const size_t hstep = (size_t)HALF * K * 2;
    const size_t tstep = 2 * hstep;
    const unsigned ldsw = (unsigned)wid * 1024u;
    const int aoff = lds_byte(wr * 64 + fr, fq * 8), boff = lds_byte(wc * 32 + fr, fq * 8);
#define PG8_SA(b, h) (((b) * 2 + (h)) * HTB)
#define PG8_SB(b, h) ((4 + (b) * 2 + (h)) * HTB)
#define PG8_STAGE(bufoff, gbase, voff) do { _Pragma("unroll") for (int _i = 0; _i < 2; ++_i) \
        __builtin_amdgcn_global_load_lds((const unsigned*)((const char*)(gbase) + (voff)[_i]), (PG8_LAS unsigned*)(lds + (bufoff) + ldsw + _i * 8192), 16, 0, 0); } while (0)
#define PG8_LDH(dst8, addr) do { const v4i_t lo_ = *(const PG8_LAS v4i_t*)(addr), hi_ = *(const PG8_LAS v4i_t*)((addr) + 1024); dst8 = __builtin_shufflevector(lo_, hi_, 0, 1, 2, 3, 4, 5, 6, 7); } while (0)
#define PG8_LDA(dst, b, h) do { _Pragma("unroll") for (int m = 0; m < 4; ++m) PG8_LDH(dst[m], lds + PG8_SA(b, h) + aoff + m * 2048); } while (0)
#define PG8_LDB(dst, b, h) do { _Pragma("unroll") for (int n = 0; n < 2; ++n) PG8_LDH(dst[n], lds + PG8_SB(b, h) + boff + n * 2048); } while (0)
#define PG8_HALF(v8, k) __builtin_bit_cast(bf16x8, __builtin_shufflevector(v8, v8, 4 * (k), 4 * (k) + 1, 4 * (k) + 2, 4 * (k) + 3))
#define PG8_MMA(ai, bj, At, Bt) do { __builtin_amdgcn_s_setprio(1); _Pragma("unroll") for (int m = 0; m < 4; ++m) _Pragma("unroll") for (int n = 0; n < 2; ++n) { \
        acc[ai][bj][m][n] = __builtin_amdgcn_mfma_f32_16x16x32_bf16(PG8_HALF(Bt[n], 0), PG8_HALF(At[m], 0), acc[ai][bj][m][n], 0, 0, 0); \
        acc[ai][bj][m][n] = __builtin_amdgcn_mfma_f32_16x16x32_bf16(PG8_HALF(Bt[n], 1), PG8_HALF(At[m], 1), acc[ai][bj][m][n], 0, 0, 0); } __builtin_amdgcn_s_setprio(0); } while (0)
#define PG8_MMA8(ai, bj, At, Bt) do { __builtin_amdgcn_s_setprio(1); _Pragma("unroll") for (int m = 0; m < 4; ++m) _Pragma("unroll") for (int n = 0; n < 2; ++n) \
        asm volatile("v_mfma_scale_f32_16x16x128_f8f6f4 %0, %1, %2, %0, %3, %3 op_sel_hi:[0,0,0]" : "+v"(acc[ai][bj][m][n]) : "v"(Bt[n]), "v"(At[m]), "v"(mxs)); __builtin_amdgcn_s_setprio(0); } while (0)
#define PG8_MMA8_DRAIN() asm volatile("s_nop 15\n\ts_nop 15" ::: "memory")
#define PG8_WAIT_V(n) asm volatile("s_waitcnt vmcnt(" #n ")" ::: "memory")
#define PG8_WAIT_L(n) asm volatile("s_waitcnt lgkmcnt(" #n ")" ::: "memory")
#define PG8_BAR __builtin_amdgcn_s_barrier()
#define PG8_SCHED __builtin_amdgcn_sched_barrier(0)
    Unit cur, nxt; int ui = 0;
    if (!S.next(0, cur)) return;
    f32x4 acc[2][2][4][2];
#pragma unroll
    for (int a = 0; a < 2; ++a)
#pragma unroll
        for (int b = 0; b < 2; ++b)
#pragma unroll
            for (int m = 0; m < 4; ++m)
#pragma unroll
                for (int n = 0; n < 2; ++n) acc[a][b][m][n] = (f32x4){0.f, 0.f, 0.f, 0.f};
    v8i_t At[4], B0[2], B1[2]; int mxs = 0x7f7f7f7f; asm volatile("" : "+v"(mxs));
    const char* cA = (const char*)g.A + (size_t)cur.pm * tstep; const char* cB = (const char*)g.Bt + (size_t)cur.pn * tstep;
    S.a_ready(cur);
    PG8_STAGE(PG8_SB(0, 0), cB, voffB); PG8_STAGE(PG8_SA(0, 0), cA, voffA); PG8_STAGE(PG8_SB(0, 1), cB + hstep, voffB); PG8_STAGE(PG8_SA(0, 1), cA + hstep, voffA);
    if (wr == 1) PG8_BAR;
    PG8_WAIT_V(4); PG8_BAR;
    PG8_STAGE(PG8_SB(1, 0), cB + kstep, voffB); PG8_STAGE(PG8_SA(1, 0), cA + kstep, voffA); PG8_STAGE(PG8_SB(1, 1), cB + hstep + kstep, voffB);
    PG8_WAIT_V(6); PG8_BAR;
    for (;;) {
        const bool has_next = S.next(ui + 1, nxt);
        const char* nA = has_next ? (const char*)g.A + (size_t)nxt.pm * tstep : cA; const char* nB = has_next ? (const char*)g.Bt + (size_t)nxt.pn * tstep : cB;
        for (int t = 0; t < nt; t += 2) {
            const bool last = (t == nt - 2);
            const char* a1 = cA + (size_t)(t + 1) * kstep;
            const char* a2 = last ? nA : cA + (size_t)(t + 2) * kstep; const char* b2 = last ? nB : cB + (size_t)(t + 2) * kstep;
            const char* a3 = a2 + kstep; const char* b3 = b2 + kstep;
            if (last && has_next) S.a_ready(nxt);
            PG8_LDB(B0, 0, 0); PG8_SCHED; PG8_LDA(At, 0, 0); PG8_STAGE(PG8_SA(1, 1), a1 + hstep, voffA);
            PG8_WAIT_L(8); PG8_BAR; PG8_WAIT_L(0); do { if constexpr (FP8) PG8_MMA8(0, 0, At, B0); else PG8_MMA(0, 0, At, B0); } while (0); PG8_BAR; PG8_SCHED;
            PG8_LDB(B1, 0, 1); PG8_STAGE(PG8_SB(0, 0), b2, voffB);
            PG8_BAR; PG8_WAIT_L(0); do { if constexpr (FP8) PG8_MMA8(0, 1, At, B1); else PG8_MMA(0, 1, At, B1); } while (0); PG8_BAR;
            PG8_LDA(At, 0, 1); PG8_STAGE(PG8_SA(0, 0), a2, voffA);
            PG8_BAR; PG8_WAIT_L(0); do { if constexpr (FP8) PG8_MMA8(1, 0, At, B0); else PG8_MMA(1, 0, At, B0); } while (0); PG8_BAR; PG8_SCHED;
            PG8_STAGE(PG8_SB(0, 1), b2 + hstep, voffB);
            PG8_WAIT_V(6); PG8_BAR; do { if constexpr (FP8) PG8_MMA8(1, 1, At, B1); else PG8_MMA(1, 1, At, B1); } while (0); PG8_BAR;
            PG8_LDB(B0, 1, 0); PG8_SCHED; PG8_LDA(At, 1, 0); PG8_STAGE(PG8_SA(0, 1), a2 + hstep, voffA);
            PG8_WAIT_L(8); PG8_BAR; PG8_WAIT_L(0); do { if constexpr (FP8) PG8_MMA8(0, 0, At, B0); else PG8_MMA(0, 0, At, B0); } while (0); PG8_BAR; PG8_SCHED;
            PG8_LDB(B1, 1, 1); PG8_STAGE(PG8_SB(1, 0), b3, voffB);
            PG8_BAR; PG8_WAIT_L(0); do { if constexpr (FP8) PG8_MMA8(0, 1, At, B1); else PG8_MMA(0, 1, At, B1); } while (0); PG8_BAR;
            PG8_LDA(At, 1, 1); PG8_STAGE(PG8_SA(1, 0), a3, voffA);
            PG8_BAR; PG8_WAIT_L(0); do { if constexpr (FP8) PG8_MMA8(1, 0, At, B0); else PG8_MMA(1, 0, At, B0); } while (0); PG8_BAR; PG8_SCHED;
            PG8_STAGE(PG8_SB(1, 1), b3 + hstep, voffB);
            PG8_WAIT_V(6); PG8_BAR; do { if constexpr (FP8) PG8_MMA8(1, 1, At, B1); else PG8_MMA(1, 1, At, B1); } while (0); PG8_BAR;
        }
        if constexpr (FP8) PG8_MMA8_DRAIN();
        if constexpr (!Epi::AFTER_DRAIN) { E(acc, cur, wr, wc, fr, fq); S.done(cur); }
        if (!has_next) break;
#pragma unroll
        for (int a = 0; a < 2; ++a)
#pragma unroll
            for (int b = 0; b < 2; ++b)
#pragma unroll
                for (int m = 0; m < 4; ++m)
#pragma unroll
                    for (int n = 0; n < 2; ++n) acc[a][b][m][n] = (f32x4){0.f, 0.f, 0.f, 0.f};
        cur = nxt; cA = nA; cB = nB; ++ui;
    }
    PG8_WAIT_V(0);
    if (wr == 0) PG8_BAR;
    PG8_BAR;
    if constexpr (Epi::AFTER_DRAIN) { E.fused(acc, cur, wr, wc, fr, fq, lds, wid, lane); S.done(cur); }
#undef PG8_SA
#undef PG8_SB
#undef PG8_STAGE
#undef PG8_LDA
#undef PG8_LDH
#undef PG8_HALF
#undef PG8_LDB
#undef PG8_MMA
#undef PG8_MMA8
#undef PG8_MMA8_DRAIN
#undef PG8_WAIT_V
#undef PG8_WAIT_L
#undef PG8_BAR
#undef PG8_SCHED
}
}

struct Frame {
    LAS unsigned char* lds;
    int tid, lane, wave, vcu, G;
    const float* const __attribute__((address_space(4)))* in;
    float* out; unsigned char* ws;
};
enum { I_X = 0, I_C, I_CTX, I_CCTX, I_WMOD, I_BMOD, I_LNG, I_LNB, I_AWIN, I_ABG, I_ANG, I_AWOUT, I_BWIN, I_BBIN, I_BLNG, I_BLNB, I_BWS, I_BBS, I_BWOUT,
       I_CWQKV, I_CQG, I_CKG, I_CWOUT, I_PWQ, I_PK1, I_PK2, I_PU, I_PV };

template <int CTRL> __device__ __forceinline__ float dpp_mov(float v) { return __builtin_bit_cast(float, __builtin_amdgcn_update_dpp(0, __builtin_bit_cast(int, v), CTRL, 0xf, 0xf, false)); }
__device__ __forceinline__ float row16_sum(float v) {
    v += dpp_mov<0x128>(v);
    v += dpp_mov<0x124>(v);
    v += dpp_mov<0x122>(v);
    v += dpp_mov<0x121>(v);
    return v;
}
__device__ __forceinline__ float row16_max(float v) {
    v = fmaxf(v, dpp_mov<0x128>(v)); v = fmaxf(v, dpp_mov<0x124>(v)); v = fmaxf(v, dpp_mov<0x122>(v)); v = fmaxf(v, dpp_mov<0x121>(v));
    return v;
}
__device__ __forceinline__ float rl(float v, int l) { return __builtin_bit_cast(float, __builtin_amdgcn_readlane(__builtin_bit_cast(int, v), l)); }
__device__ __forceinline__ float wsum(float v) { v = row16_sum(v); return (rl(v, 0) + rl(v, 16)) + (rl(v, 32) + rl(v, 48)); }

__device__ __forceinline__ const float* mod_row(const Frame& F, int layer, int row) {
    const int b9 = row < TL ? (row >> 12) : 8;
    return (const float*)(F.ws + WS_MOD) + (size_t)(layer * 9 + b9) * NMOD;
}

__device__ __forceinline__ void p0_transpose_item(const float* W, int ldw, int K, int nblk, unsigned char* WT, LAS float* scr, int item, int lane) {
    const int kb = item / nblk, nb = item % nblk, k0 = 64 * kb, n0 = 32 * nb;
    f32x4 t[8];
#pragma unroll
    for (int i = 0; i < 8; ++i) t[i] = *(const f32x4*)(W + (size_t)(k0 + 8 * i + (lane >> 3)) * ldw + n0 + 4 * (lane & 7));
#pragma unroll
    for (int i = 0; i < 8; ++i) { LAS float* d = scr + (8 * i + (lane >> 3)) * 33 + 4 * (lane & 7); d[0] = t[i][0] * WSCALE; d[1] = t[i][1] * WSCALE; d[2] = t[i][2] * WSCALE; d[3] = t[i][3] * WSCALE; }
    LDS_WAIT(); asm volatile("" ::: "memory");
    const int c = lane & 7;
#pragma unroll
    for (int j = 0; j < 4; ++j) { const int n = (lane >> 3) + 8 * j; const LAS float* s = scr + (8 * c) * 33 + n;
        v2u o; o.x = pk4_fp8(s[0 * 33], s[1 * 33], s[2 * 33], s[3 * 33]); o.y = pk4_fp8(s[4 * 33], s[5 * 33], s[6 * 33], s[7 * 33]);
        *(v2u*)(WT + (size_t)(n0 + n) * K + k0 + 8 * c) = o; }
    LDS_WAIT(); asm volatile("" ::: "memory");
}
__device__ __forceinline__ void p0_transpose_item_bf16(const float* W, int ldw, int K, int nblk, bf16* WT, LAS float* scr, int item, int lane) {
    const int kb = item / nblk, nb = item % nblk, k0 = 64 * kb, n0 = 32 * nb;
    f32x4 t[8];
#pragma unroll
    for (int i = 0; i < 8; ++i) t[i] = *(const f32x4*)(W + (size_t)(k0 + 8 * i + (lane >> 3)) * ldw + n0 + 4 * (lane & 7));
#pragma unroll
    for (int i = 0; i < 8; ++i) { LAS float* d = scr + (8 * i + (lane >> 3)) * 33 + 4 * (lane & 7); d[0] = t[i][0]; d[1] = t[i][1]; d[2] = t[i][2]; d[3] = t[i][3]; }
    LDS_WAIT(); asm volatile("" ::: "memory");
    const int c = lane & 7;
#pragma unroll
    for (int j = 0; j < 4; ++j) { const int n = (lane >> 3) + 8 * j; const LAS float* s = scr + (8 * c) * 33 + n;
        v4u o; o.x = cvt_pk_bf16(s[0 * 33], s[1 * 33]); o.y = cvt_pk_bf16(s[2 * 33], s[3 * 33]); o.z = cvt_pk_bf16(s[4 * 33], s[5 * 33]); o.w = cvt_pk_bf16(s[6 * 33], s[7 * 33]);
        *(v4u*)(WT + (size_t)(n0 + n) * K + k0 + 8 * c) = o; }
    LDS_WAIT(); asm volatile("" ::: "memory");
}
__device__ __forceinline__ void cvt_linear(const float* src, bf16* dst, size_t n8, size_t i0, size_t stride) {
    for (size_t i = i0; i < n8; i += stride) {
        const f32x4 a = *(const f32x4*)(src + i * 8), b = *(const f32x4*)(src + i * 8 + 4);
        v4u o; o.x = cvt_pk_bf16(a[0], a[1]); o.y = cvt_pk_bf16(a[2], a[3]); o.z = cvt_pk_bf16(b[0], b[1]); o.w = cvt_pk_bf16(b[2], b[3]);
        *(v4u*)(dst + i * 8) = o;
    }
}
__device__ __forceinline__ void p0_prologue(Frame& F) {
    {
        LAS float* sc = (LAS float*)F.lds;
        LAS float* part = (LAS float*)(F.lds + 9 * 2048 * 4);
        for (int i = F.tid; i < 9 * 2048; i += NTHR) { const int r = i >> 11, k = i & 2047; const float c = r < 8 ? F.in[I_C][r * D + k] : F.in[I_CCTX][k]; sc[i] = silu(c); }
        __syncthreads();
        float* MOD = (float*)(F.ws + WS_MOD);
        for (int item = F.vcu; item < 4 * 192; item += F.G) {
            const int l = item / 192, cg = item % 192, c = cg * 64 + F.lane;
            const float* Wm = F.in[I_WMOD] + ((size_t)l * D + F.wave * 256) * NMOD + c;
            float acc[9];
#pragma unroll
            for (int r = 0; r < 9; ++r) acc[r] = 0.f;
            for (int k0 = 0; k0 < 256; k0 += 32) {
                float w[32];
#pragma unroll
                for (int u = 0; u < 32; ++u) w[u] = Wm[(size_t)(k0 + u) * NMOD];
#pragma unroll
                for (int u = 0; u < 32; ++u)
#pragma unroll
                    for (int r = 0; r < 9; ++r) acc[r] += sc[r * 2048 + F.wave * 256 + k0 + u] * w[u];
            }
#pragma unroll
            for (int r = 0; r < 9; ++r) part[(F.wave * 9 + r) * 64 + F.lane] = acc[r];
            __syncthreads();
            for (int i = F.tid; i < 9 * 64; i += NTHR) { const int r = i >> 6, ln = i & 63; float s = 0.f;
#pragma unroll
                for (int w = 0; w < 8; ++w) s += part[(w * 9 + r) * 64 + ln];
                MOD[(size_t)(l * 9 + r) * NMOD + cg * 64 + ln] = s + F.in[I_BMOD][l * NMOD + cg * 64 + ln]; }
            __syncthreads();
        }
    }
    {
        LAS float* scr = (LAS float*)(F.lds + F.wave * 16384);
        const int gw = F.vcu * NWAVES + F.wave, NGW = F.G * NWAVES;
        unsigned char* WT = F.ws + WS_WT;
        constexpr int I_A = 32 * 192, I_SQ = 32 * 64, I_BI = 32 * 256, I_BO = 64 * 64, I_CQ = 32 * 96;
        constexpr int NITEMS = 2 * I_A + 2 * I_SQ + I_BI + I_BO + I_CQ + I_SQ + 4 * I_SQ;
        for (int it = gw; it < NITEMS; it += NGW) {
            int r = it;
            if (r < 2 * I_A) { const int j = r / I_A; p0_transpose_item(F.in[I_AWIN] + (size_t)j * D * A_IN, A_IN, D, 192, WT + WT_AIN + (size_t)j * A_INP * D, scr, r % I_A, F.lane); continue; } r -= 2 * I_A;
            if (r < 2 * I_SQ) { const int j = r / I_SQ; p0_transpose_item(F.in[I_AWOUT] + (size_t)j * D * D, D, D, 64, WT + WT_AOUT + (size_t)j * D * D, scr, r % I_SQ, F.lane); continue; } r -= 2 * I_SQ;
            if (r < I_BI) { p0_transpose_item(F.in[I_BWIN], 8192, D, 256, WT + WT_BIN, scr, r, F.lane); continue; } r -= I_BI;
            if (r < I_BO) { p0_transpose_item(F.in[I_BWOUT], D, 4096, 64, WT + WT_BOUT, scr, r, F.lane); continue; } r -= I_BO;
            if (r < I_CQ) { p0_transpose_item(F.in[I_CWQKV], C_QKV, D, 96, WT + WT_CQKV, scr, r, F.lane); continue; } r -= I_CQ;
            if (r < I_SQ) { p0_transpose_item(F.in[I_CWOUT], D, D, 64, WT + WT_COUT, scr, r, F.lane); continue; } r -= I_SQ;
            { const int j = r / I_SQ;
              if ((PQ_FP8_MASK >> j) & 1) p0_transpose_item(F.in[I_PWQ] + (size_t)j * D * D, D, D, 64, WT + WT_PQ + (size_t)j * D * D * 2, scr, r % I_SQ, F.lane);
              else p0_transpose_item_bf16(F.in[I_PWQ] + (size_t)j * D * D, D, D, 64, (bf16*)(WT + WT_PQ) + (size_t)j * D * D, scr, r % I_SQ, F.lane); }
        }
        const size_t gt = (size_t)F.vcu * NTHR + F.tid, GT = (size_t)F.G * NTHR;
        for (size_t i = gt; i < (size_t)2 * 256 * D; i += GT) {
            const int j = (int)(i / (256 * D)), rem = (int)(i % (256 * D)), n = rem / D, k = rem % D;
            const float v = n < 16 ? F.in[I_AWIN][((size_t)j * D + k) * A_IN + 6144 + n] : 0.f;
            WT[WT_AIN + ((size_t)j * A_INP + 6144 + n) * D + k] = (unsigned char)(__builtin_amdgcn_cvt_pk_fp8_f32(v * WSCALE, 0.f, 0, false) & 0xff);
        }
        for (int r0 = gw; r0 < 2 * 4 * P_E; r0 += 2 * NGW) {
            f32x4 v[2][8];
#pragma unroll
            for (int h = 0; h < 2; ++h) { const int r = r0 + h * NGW, tb = r >= 4 * P_E, rr = r - tb * 4 * P_E;
                const float* src = F.in[tb ? I_PV : I_PU] + (size_t)rr * D + 4 * F.lane;
#pragma unroll
                for (int q = 0; q < 8; ++q) v[h][q] = *(const f32x4*)(src + 256 * q); }
#pragma unroll
            for (int h = 0; h < 2; ++h) { const int r = r0 + h * NGW, tb = r >= 4 * P_E, rr = r - tb * 4 * P_E;
                float mx = 0.f;
#pragma unroll
                for (int q = 0; q < 8; ++q) { const f32x4 a = __builtin_elementwise_abs(v[h][q]); mx = fmaxf(mx, fmaxf(fmaxf(a[0], a[1]), fmaxf(a[2], a[3]))); }
                mx = row16_max(mx); mx = fmaxf(fmaxf(rl(mx, 0), rl(mx, 16)), fmaxf(rl(mx, 32), rl(mx, 48)));
                const float sc = mx > 0.f ? 6.0f / mx : 1.0f;
                v4u o;
#pragma unroll
                for (int d = 0; d < 4; ++d) { unsigned w = 0u; const f32x4 x0 = v[h][2 * d] * sc, x1 = v[h][2 * d + 1] * sc;
                    w = __builtin_amdgcn_cvt_scalef32_pk_fp4_f32(w, x0[0], x0[1], 1.0f, 0); w = __builtin_amdgcn_cvt_scalef32_pk_fp4_f32(w, x0[2], x0[3], 1.0f, 1);
                    w = __builtin_amdgcn_cvt_scalef32_pk_fp4_f32(w, x1[0], x1[1], 1.0f, 2); w = __builtin_amdgcn_cvt_scalef32_pk_fp4_f32(w, x1[2], x1[3], 1.0f, 3); o[d] = w; }
                if (tb) *(v4u*)(F.ws + WS_PV8 + (size_t)rr * (D / 2) + 16 * F.lane) = o;
                else { unsigned char* ur = F.ws + WS_PU8 + (size_t)rr * (D / 2) + 2 * F.lane;
#pragma unroll
                    for (int d = 0; d < 4; ++d) { *(unsigned short*)(ur + 128 * (2 * d)) = (unsigned short)(o[d] & 0xffffu); *(unsigned short*)(ur + 128 * (2 * d + 1)) = (unsigned short)(o[d] >> 16); } }
                if (F.lane == 0) ((float*)(F.ws + WS_SC))[(size_t)tb * 4 * P_E + rr] = 1.0f / sc; }
        }
        cvt_linear(F.in[I_PK1], (bf16*)(F.ws + WS_K12), (size_t)4 * 128 * 128 / 8, gt, GT);
        cvt_linear(F.in[I_PK2], (bf16*)(F.ws + WS_K12) + 4 * 128 * 128, (size_t)4 * 128 * 128 / 8, gt, GT);
        cvt_linear(F.in[I_BWS], (bf16*)(F.ws + WS_WS), (size_t)8 * 128 * 128 / 8, gt, GT);
    }
}

template <int L> __device__ __forceinline__ const float* x_row(const Frame& F, int row) {
    if (L == 0) return row < TL ? F.in[I_X] + (size_t)row * D : F.in[I_CTX] + (size_t)(row - TL) * D;
    return (const float*)(F.ws + WS_X) + (size_t)row * D;
}
template <int L> __device__ __forceinline__ f32x4 load_x4(const Frame& F, int row, int e) {
    if (L == 0) return *(const f32x4*)(x_row<0>(F, row) + e);
    const v2u p = *(const v2u*)((const bf16*)(F.ws + WS_X) + (size_t)row * D + e);
    return (f32x4){bf_lo(p.x), bf_hi(p.x), bf_lo(p.y), bf_hi(p.y)};
}
__device__ __forceinline__ void store_x4(const Frame& F, int row, int e, f32x4 v) { v2u o; o.x = cvt_pk_bf16(v[0], v[1]); o.y = cvt_pk_bf16(v[2], v[3]); *(v2u*)((bf16*)(F.ws + WS_X) + (size_t)row * D + e) = o; }
__device__ __forceinline__ void p0b_modulate(Frame& F) {
    const int gw = F.vcu * NWAVES + F.wave, NGW = F.G * NWAVES;
    for (int row = gw; row < T; row += NGW) {
        const float* xr = x_row<0>(F, row); const float* md = mod_row(F, 0, row);
        unsigned char* hr = F.ws + WS_H + (size_t)row * D;
#pragma unroll
        for (int j = 0; j < 8; ++j) { const int e = 4 * F.lane + 256 * j;
            const f32x4 x = *(const f32x4*)(xr + e), sh = *(const f32x4*)(md + e), scl = *(const f32x4*)(md + D + e);
            const f32x4 h = x * (scl + 1.0f) + sh;
            *(unsigned*)(hr + e) = pk4_fp8(h[0], h[1], h[2], h[3]); }
    }
}

__device__ __forceinline__ void ln_rows(f32x4 (&t)[8], const float* g, const float* b, int lane) {
    float s = 0.f;
#pragma unroll
    for (int j = 0; j < 8; ++j) s += (t[j][0] + t[j][1]) + (t[j][2] + t[j][3]);
    const float mean = wsum(s) * (1.0f / D); float q = 0.f;
#pragma unroll
    for (int j = 0; j < 8; ++j) { t[j] = t[j] - mean; q += (t[j][0] * t[j][0] + t[j][1] * t[j][1]) + (t[j][2] * t[j][2] + t[j][3] * t[j][3]); }
    const float rstd = 1.0f / sqrtf(wsum(q) * (1.0f / D) + LN_EPS);
#pragma unroll
    for (int j = 0; j < 8; ++j) { const int e = 4 * lane + 256 * j; t[j] = t[j] * rstd * *(const f32x4*)(g + e) + *(const f32x4*)(b + e); }
}

template <int L> __device__ __forceinline__ void ln1_phase(Frame& F, int M) {
    const int gw = F.vcu * NWAVES + F.wave, NGW = F.G * NWAVES;
    const float* lg = F.in[I_LNG] + (size_t)(L * 2 + 0) * D; const float* lb = F.in[I_LNB] + (size_t)(L * 2 + 0) * D;
    for (int row = gw; row < M; row += NGW) {
        const float* md = mod_row(F, L, row);
        const bf16* yr = (const bf16*)(F.ws + WS_Y) + (size_t)row * D;
        bf16* hr = (bf16*)(F.ws + WS_Y) + (size_t)row * D;
        f32x4 t[8];
#pragma unroll
        for (int j = 0; j < 8; ++j) { const int e = 4 * F.lane + 256 * j;
            const f32x4 x = load_x4<L>(F, row, e), gt = *(const f32x4*)(md + 2 * D + e); const v2u y = *(const v2u*)(yr + e);
            t[j] = x * ALPHA + gt * (f32x4){bf_lo(y.x), bf_hi(y.x), bf_lo(y.y), bf_hi(y.y)}; }
        ln_rows(t, lg, lb, F.lane);
#pragma unroll
        for (int j = 0; j < 8; ++j) { const int e = 4 * F.lane + 256 * j;
            store_x4(F, row, e, t[j]);
            const f32x4 h = t[j] * (*(const f32x4*)(md + 4 * D + e) + 1.0f) + *(const f32x4*)(md + 3 * D + e);
            v2u o; o.x = cvt_pk_bf16(h[0], h[1]); o.y = cvt_pk_bf16(h[2], h[3]); *(v2u*)(hr + e) = o;
            if ((PQ_FP8_MASK >> L) & 1) *(unsigned*)(F.ws + WS_H + (size_t)row * D + e) = pk4_fp8(h[0], h[1], h[2], h[3]); }
    }
}

__device__ __forceinline__ unsigned f2mono(float f) { const unsigned b = __float_as_uint(f); return (b & 0x80000000u) ? ~b : (b | 0x80000000u); }
__device__ __forceinline__ float mono2f(unsigned m) { return __uint_as_float((m & 0x80000000u) ? (m & 0x7fffffffu) : ~m); }
__device__ __forceinline__ void ins16(unsigned (&top)[16], unsigned x) {
#pragma unroll
    for (int j = 0; j < 16; ++j) { const unsigned hi = top[j] > x ? top[j] : x; x = top[j] > x ? x : top[j]; top[j] = hi; }
}
#define TK_CE(A_, B_) { const unsigned hi_ = (A_) > (B_) ? (A_) : (B_), lo_ = (A_) > (B_) ? (B_) : (A_); (A_) = hi_; (B_) = lo_; }
__device__ __forceinline__ void sort16_desc(unsigned (&v)[16]) {
    TK_CE(v[0], v[1])
    TK_CE(v[2], v[3])
    TK_CE(v[0], v[2])
    TK_CE(v[1], v[3])
    TK_CE(v[1], v[2])
    TK_CE(v[4], v[5])
    TK_CE(v[6], v[7])
    TK_CE(v[4], v[6])
    TK_CE(v[5], v[7])
    TK_CE(v[5], v[6])
    TK_CE(v[0], v[4])
    TK_CE(v[2], v[6])
    TK_CE(v[2], v[4])
    TK_CE(v[1], v[5])
    TK_CE(v[3], v[7])
    TK_CE(v[3], v[5])
    TK_CE(v[1], v[2])
    TK_CE(v[3], v[4])
    TK_CE(v[5], v[6])
    TK_CE(v[8], v[9])
    TK_CE(v[10], v[11])
    TK_CE(v[8], v[10])
    TK_CE(v[9], v[11])
    TK_CE(v[9], v[10])
    TK_CE(v[12], v[13])
    TK_CE(v[14], v[15])
    TK_CE(v[12], v[14])
    TK_CE(v[13], v[15])
    TK_CE(v[13], v[14])
    TK_CE(v[8], v[12])
    TK_CE(v[10], v[14])
    TK_CE(v[10], v[12])
    TK_CE(v[9], v[13])
    TK_CE(v[11], v[15])
    TK_CE(v[11], v[13])
    TK_CE(v[9], v[10])
    TK_CE(v[11], v[12])
    TK_CE(v[13], v[14])
    TK_CE(v[0], v[8])
    TK_CE(v[4], v[12])
    TK_CE(v[4], v[8])
    TK_CE(v[2], v[10])
    TK_CE(v[6], v[14])
    TK_CE(v[6], v[10])
    TK_CE(v[2], v[4])
    TK_CE(v[6], v[8])
    TK_CE(v[10], v[12])
    TK_CE(v[1], v[9])
    TK_CE(v[5], v[13])
    TK_CE(v[5], v[9])
    TK_CE(v[3], v[11])
    TK_CE(v[7], v[15])
    TK_CE(v[7], v[11])
    TK_CE(v[3], v[5])
    TK_CE(v[7], v[9])
    TK_CE(v[11], v[13])
    TK_CE(v[1], v[2])
    TK_CE(v[3], v[4])
    TK_CE(v[5], v[6])
    TK_CE(v[7], v[8])
    TK_CE(v[9], v[10])
    TK_CE(v[11], v[12])
    TK_CE(v[13], v[14])
}
__device__ __forceinline__ void merge16_desc(unsigned (&top)[16], const unsigned (&s)[16]) {
#pragma unroll
    for (int i = 0; i < 16; ++i) top[i] = top[i] > s[15 - i] ? top[i] : s[15 - i];
#pragma unroll
    for (int j = 8; j > 0; j >>= 1)
#pragma unroll
        for (int i = 0; i < 16; ++i) { const int l = i ^ j; if (l > i) TK_CE(top[i], top[l]) }
}
template <int L> __device__ __forceinline__ void peer_topk_phase(Frame& F, int M) {
    const bf16* Q = (const bf16*)(F.ws + WS_Z);
    const bf16* K1 = (const bf16*)(F.ws + WS_K12) + (size_t)L * 128 * 128;
    const bf16* K2 = (const bf16*)(F.ws + WS_K12) + (size_t)(4 + L) * 128 * 128;
    int* IDX = (int*)(F.ws + WS_IDX); float* PG = (float*)(F.ws + WS_PG);
    LAS float* S1 = (LAS float*)F.lds;
    LAS float* S2 = S1 + 128 * 129;
    LAS unsigned* TK = (LAS unsigned*)(S2 + 128 * 129);
    const int fr = F.lane & 15, fq = F.lane >> 4;
    const int nunits = (M / 128) * P_HEADS;
    const int kbg = F.wave & 1, tbg = F.wave >> 1;
    bf16x8 kf1[4][4], kf2[4][4];
#pragma unroll
    for (int kk = 0; kk < 4; ++kk) { const int kb = 4 * kbg + kk;
        const bf16* k1p = K1 + (size_t)(kb * 16 + fr) * 128 + fq * 8; const bf16* k2p = K2 + (size_t)(kb * 16 + fr) * 128 + fq * 8;
#pragma unroll
        for (int ks = 0; ks < 4; ++ks) { kf1[kk][ks] = *(const bf16x8*)(k1p + ks * 32); kf2[kk][ks] = *(const bf16x8*)(k2p + ks * 32); } }
    for (int u = F.vcu; u < nunits; u += F.G) {
        const int tile = u >> 3, hd = u & 7, row0 = tile * 128;
#ifdef TK_DBL_MFMA
        for (int rr_ = 0; rr_ < 2; ++rr_)
#endif
        {
#pragma unroll
            for (int tt = 0; tt < 2; ++tt) { const int tb = 2 * tbg + tt;
                const bf16* qp = Q + (size_t)(row0 + tb * 16 + fr) * D + hd * 256 + fq * 8;
                bf16x8 a1[4], a2[4];
#pragma unroll
                for (int ks = 0; ks < 4; ++ks) { a1[ks] = *(const bf16x8*)(qp + ks * 32); a2[ks] = *(const bf16x8*)(qp + 128 + ks * 32); }
#pragma unroll
                for (int kk = 0; kk < 4; ++kk) { const int kb = 4 * kbg + kk;
                    f32x4 c1 = zero4(), c2 = zero4();
#pragma unroll
                    for (int ks = 0; ks < 4; ++ks) {
                        c1 = __builtin_amdgcn_mfma_f32_16x16x32_bf16(a1[ks], kf1[kk][ks], c1, 0, 0, 0);
                        c2 = __builtin_amdgcn_mfma_f32_16x16x32_bf16(a2[ks], kf2[kk][ks], c2, 0, 0, 0);
                    }
#pragma unroll
                    for (int j = 0; j < 4; ++j) { const int t = tb * 16 + 4 * fq + j; const unsigned ix = (unsigned)(127 - (kb * 16 + fr));
                        ((LAS unsigned*)S1)[t * 129 + kb * 16 + fr] = (f2mono(c1[j]) & ~0x7fu) | ix; ((LAS unsigned*)S2)[t * 129 + kb * 16 + fr] = (f2mono(c2[j]) & ~0x7fu) | ix; }
                }
            }
        }
        __syncthreads();
        {
            int tid_l = F.tid; asm volatile("" : "+v"(tid_l));
            const int t = tid_l & 127, which = (tid_l >> 7) & 1, half = tid_l >> 8;
            LAS float* sr = (which ? S2 : S1) + t * 129 + 64 * half;
            unsigned top[16];
#pragma unroll
            for (int j = 0; j < 16; ++j) top[j] = ((const LAS unsigned*)sr)[j];
            sort16_desc(top);
#pragma unroll 1
            for (int g = 1; g < 4; ++g) { unsigned v[16];
#pragma unroll
                for (int j = 0; j < 16; ++j) v[j] = ((const LAS unsigned*)sr)[16 * g + j];
                sort16_desc(v); merge16_desc(top, v); }
            if (half) {
#pragma unroll
                for (int j = 0; j < 16; ++j) ((LAS unsigned*)sr)[j] = top[j];
            }
            __syncthreads();
            if (!half) {
                const LAS unsigned* pr = (const LAS unsigned*)(sr + 64);
                unsigned ot[16];
#pragma unroll
                for (int j = 0; j < 16; ++j) ot[j] = pr[j];
                merge16_desc(top, ot);
#pragma unroll
                for (int j = 0; j < 16; ++j) TK[(which * 128 + t) * 17 + j] = top[j];
            }
        }
        __syncthreads();
#ifdef TK_DBL_COMB
        for (int rr_ = 0; rr_ < 2; ++rr_)
#endif
        if (F.tid < 128) {
            const int t = F.tid;
            const LAS unsigned* t1 = TK + t * 17; const LAS unsigned* t2 = TK + (128 + t) * 17;
            float v2[16];
#pragma unroll
            for (int j = 0; j < 16; ++j) v2[j] = mono2f((t2[j] & ~0x7fu) | 0x40u);
#define TK_V1(A_) mono2f((t1[A_] & ~0x7fu) | 0x40u)
#define TK_KEY(VA_, A_, B_) ((f2mono((VA_) + v2[B_]) & ~0xffu) | (unsigned)(255 - ((A_) * 16 + (B_))))
            unsigned top[16];
            { unsigned grp[16];
              const float va0 = TK_V1(0);
              grp[0] = TK_KEY(va0, 0, 0);
              grp[1] = TK_KEY(va0, 0, 1);
              grp[2] = TK_KEY(va0, 0, 2);
              grp[3] = TK_KEY(va0, 0, 3);
              grp[4] = TK_KEY(va0, 0, 4);
              grp[5] = TK_KEY(va0, 0, 5);
              grp[6] = TK_KEY(va0, 0, 6);
              grp[7] = TK_KEY(va0, 0, 7);
              grp[8] = TK_KEY(va0, 0, 8);
              grp[9] = TK_KEY(va0, 0, 9);
              grp[10] = TK_KEY(va0, 0, 10);
              grp[11] = TK_KEY(va0, 0, 11);
              grp[12] = TK_KEY(va0, 0, 12);
              grp[13] = TK_KEY(va0, 0, 13);
              grp[14] = TK_KEY(va0, 0, 14);
              grp[15] = TK_KEY(va0, 0, 15);
              sort16_desc(grp);
#pragma unroll
              for (int j = 0; j < 16; ++j) top[j] = grp[j]; }
            __builtin_amdgcn_sched_barrier(0);
            { unsigned grp[16];
              const float va1 = TK_V1(1);
              const float va2 = TK_V1(2);
              const float va3 = TK_V1(3);
              grp[0] = TK_KEY(va1, 1, 0);
              grp[1] = TK_KEY(va1, 1, 1);
              grp[2] = TK_KEY(va1, 1, 2);
              grp[3] = TK_KEY(va1, 1, 3);
              grp[4] = TK_KEY(va1, 1, 4);
              grp[5] = TK_KEY(va1, 1, 5);
              grp[6] = TK_KEY(va1, 1, 6);
              grp[7] = TK_KEY(va1, 1, 7);
              grp[8] = TK_KEY(va2, 2, 0);
              grp[9] = TK_KEY(va2, 2, 1);
              grp[10] = TK_KEY(va2, 2, 2);
              grp[11] = TK_KEY(va2, 2, 3);
              grp[12] = TK_KEY(va2, 2, 4);
              grp[13] = TK_KEY(va3, 3, 0);
              grp[14] = TK_KEY(va3, 3, 1);
              grp[15] = TK_KEY(va3, 3, 2);
              sort16_desc(grp);
              merge16_desc(top, grp); }
            __builtin_amdgcn_sched_barrier(0);
            { unsigned grp[16];
              const float va3 = TK_V1(3);
              const float va4 = TK_V1(4);
              const float va5 = TK_V1(5);
              const float va6 = TK_V1(6);
              const float va7 = TK_V1(7);
              const float va8 = TK_V1(8);
              const float va9 = TK_V1(9);
              const float va10 = TK_V1(10);
              const float va11 = TK_V1(11);
              const float va12 = TK_V1(12);
              const float va13 = TK_V1(13);
              grp[0] = TK_KEY(va3, 3, 3);
              grp[1] = TK_KEY(va4, 4, 0);
              grp[2] = TK_KEY(va4, 4, 1);
              grp[3] = TK_KEY(va4, 4, 2);
              grp[4] = TK_KEY(va5, 5, 0);
              grp[5] = TK_KEY(va5, 5, 1);
              grp[6] = TK_KEY(va6, 6, 0);
              grp[7] = TK_KEY(va6, 6, 1);
              grp[8] = TK_KEY(va7, 7, 0);
              grp[9] = TK_KEY(va7, 7, 1);
              grp[10] = TK_KEY(va8, 8, 0);
              grp[11] = TK_KEY(va9, 9, 0);
              grp[12] = TK_KEY(va10, 10, 0);
              grp[13] = TK_KEY(va11, 11, 0);
              grp[14] = TK_KEY(va12, 12, 0);
              grp[15] = TK_KEY(va13, 13, 0);
              sort16_desc(grp);
              merge16_desc(top, grp); }
            __builtin_amdgcn_sched_barrier(0);
            ins16(top, TK_KEY(TK_V1(14), 14, 0));
            ins16(top, TK_KEY(TK_V1(15), 15, 0));
#undef TK_KEY
#undef TK_V1
            float sc[16], es = 0.f;
#pragma unroll
            for (int j = 0; j < 16; ++j) sc[j] = mono2f((top[j] & ~0xffu) | 0x80u);
            const float smx = sc[0];
#pragma unroll
            for (int j = 0; j < 16; ++j) { sc[j] = __expf(sc[j] - smx); es += sc[j]; }
            const float inv = 1.0f / es;
            const size_t ob = (size_t)(row0 + t) * 128 + hd * 16;
#pragma unroll
            for (int j = 0; j < 16; ++j) { const int ci = 255 - (int)(top[j] & 0xffu), a = ci >> 4, b = ci & 15;
                const int i1 = 127 - (int)(t1[a] & 0x7fu), i2 = 127 - (int)(t2[b] & 0x7fu);
                IDX[ob + j] = i1 * 128 + i2; PG[ob + j] = sc[j] * inv; }
        }
        __syncthreads();
    }
}

constexpr int P3B = 8;
struct RowBatch { v4u r[P3B]; };
__device__ __forceinline__ void p3_load_batch(RowBatch& B, const char* tab, int ev, int lane0, int lo16) {
#pragma unroll
    for (int q = 0; q < P3B; ++q) { const int e = __builtin_amdgcn_readlane(ev, lane0 + q); B.r[q] = *(const v4u*)(tab + (size_t)e * (D / 2) + lo16); }
}
__device__ __forceinline__ float dot32_fp4(const v4u w, const f32x2* h) {
    f32x2 s = {0.f, 0.f};
#pragma unroll
    for (int d = 0; d < 4; ++d) {
#define P3_D(b) { const f32x2 p = __builtin_amdgcn_cvt_scalef32_pk_f32_fp4(w[d], 1.0f, b); s = __builtin_elementwise_fma(p, h[4 * d + b], s); }
        P3_D(0) P3_D(1) P3_D(2) P3_D(3)
#undef P3_D
    }
    return s[0] + s[1];
}
__device__ __forceinline__ void axpy32_fp4(const v4u w, float hk, f32x2* acc) {
    const f32x2 hk2 = {hk, hk};
#pragma unroll
    for (int d = 0; d < 4; ++d) {
#define P3_A(b) { const f32x2 p = __builtin_amdgcn_cvt_scalef32_pk_f32_fp4(w[d], 1.0f, b); acc[4 * d + b] = __builtin_elementwise_fma(hk2, p, acc[4 * d + b]); }
        P3_A(0) P3_A(1) P3_A(2) P3_A(3)
#undef P3_A
    }
}
__device__ __forceinline__ float reduce8(const float* d, int lane) {
    const bool b0 = lane & 1, b1 = lane & 2, b2 = lane & 4;
    float s1[4], s2[2];
#pragma unroll
    for (int j = 0; j < 4; ++j) { const float keep = b0 ? d[2 * j + 1] : d[2 * j], send = b0 ? d[2 * j] : d[2 * j + 1]; s1[j] = keep + dpp_mov<0xB1>(send); }
#pragma unroll
    for (int j = 0; j < 2; ++j) { const float keep = b1 ? s1[2 * j + 1] : s1[2 * j], send = b1 ? s1[2 * j] : s1[2 * j + 1]; s2[j] = keep + dpp_mov<0x4E>(send); }
    const float keep = b2 ? s2[1] : s2[0], send = b2 ? s2[0] : s2[1];
    float s3 = keep + dpp_mov<0x124>(send);
    s3 += dpp_mov<0x128>(s3);
    s3 += __shfl_xor(s3, 16); s3 += __shfl_xor(s3, 32);
    return s3;
}
template <int L> __device__ __forceinline__ void peer_u_phase(Frame& F, int M) {
    const int gw = F.vcu * NWAVES + F.wave, NGW = F.G * NWAVES;
    const char* PU = (const char*)(F.ws + WS_PU8) + (size_t)L * P_E * (D / 2); const char* PV = (const char*)(F.ws + WS_PV8) + (size_t)L * P_E * (D / 2);
    const float* SCU = (const float*)(F.ws + WS_SC) + (size_t)L * P_E; const float* SCV = (const float*)(F.ws + WS_SC) + (size_t)(4 + L) * P_E;
    const int* IDX = (const int*)(F.ws + WS_IDX); const float* PG = (const float*)(F.ws + WS_PG);
    const float* lg = F.in[I_LNG] + (size_t)(L * 2 + 1) * D; const float* lb = F.in[I_LNB] + (size_t)(L * 2 + 1) * D;
    for (int row = gw; row < M; row += NGW) {
        int lane_l = F.lane; asm volatile("" : "+v"(lane_l));
        const int lane = lane_l, lo16 = lane * 16;
        const int e0 = IDX[(size_t)row * 128 + lane], e1 = IDX[(size_t)row * 128 + 64 + lane];
        const float g0 = PG[(size_t)row * 128 + lane], g1 = PG[(size_t)row * 128 + 64 + lane];
        const float su0 = SCU[e0], su1 = SCU[e1], sv0 = SCV[e0], sv1 = SCV[e1];
        f32x2 hx[16];
        { const bf16* hr0 = (const bf16*)(F.ws + WS_Y) + (size_t)row * D + 4 * lane;
#pragma unroll
          for (int q = 0; q < 8; ++q) { const v2u hp = *(const v2u*)(hr0 + 256 * q); hx[2 * q] = (f32x2){bf_lo(hp.x), bf_hi(hp.x)}; hx[2 * q + 1] = (f32x2){bf_lo(hp.y), bf_hi(hp.y)}; } }
        float a0, a1;
        {
            LAS unsigned char* wl = F.lds + F.wave * 13568;
            LAS unsigned char* HI = wl + 8448;
#pragma unroll
            for (int q = 0; q < 8; ++q) {
                const f32x2 p0 = hx[2 * q], p1 = hx[2 * q + 1];
                int hi = __builtin_amdgcn_cvt_pk_fp8_f32(p0[0], p0[1], 0, false); hi = __builtin_amdgcn_cvt_pk_fp8_f32(p1[0], p1[1], hi, true);
                const f32x2 b0 = __builtin_amdgcn_cvt_pk_f32_fp8(hi, false), b1 = __builtin_amdgcn_cvt_pk_f32_fp8(hi, true);
                const f32x2 r0 = (p0 - b0) * 16.0f, r1 = (p1 - b1) * 16.0f;
                int lo = __builtin_amdgcn_cvt_pk_fp8_f32(r0[0], r0[1], 0, false); lo = __builtin_amdgcn_cvt_pk_fp8_f32(r1[0], r1[1], lo, true);
                *(LAS int*)(HI + 4 * lane + 256 * q) = hi; *(LAS int*)(HI + 2048 + 4 * lane + 256 * q) = lo;
            }
            asm volatile("" ::: "memory");
            const int n16 = lane & 15, kq = lane >> 4, hl = lane >> 5, l31 = lane & 31;
            const LAS unsigned char* bp = HI + (n16 == 1 ? 2048 : 0) + 16 * kq;
            LAS unsigned char* tw = wl + hl * 528 + 16 * l31;
            const LAS unsigned char* tr = wl + n16 * 528 + 16 * kq;
            f32x4 acc[8];
#pragma unroll
            for (int rb = 0; rb < 8; ++rb) acc[rb] = zero4();
            v4u R[2][8]; v8i_t Bk[8];
            int e0b = e0, e1b = e1;
#define UL_LOAD(S_) do { _Pragma("unroll") for (int i = 0; i < 8; ++i) { const int sa_ = 16 * ((S_) & 7) + 2 * i; \
                const int es_ = ((S_) >> 3) ? (((S_) & 7) < 4 ? e0b : e1b) : (((S_) & 7) < 4 ? e0 : e1); const int ia_ = __builtin_amdgcn_readlane(es_, sa_ & 63), ib_ = __builtin_amdgcn_readlane(es_, (sa_ + 1) & 63); \
                const int id_ = hl ? ib_ : ia_; R[(S_) & 1][i] = *(const v4u*)(PU + (size_t)id_ * (D / 2) + 512 * ((S_) >> 3) + 16 * l31); } } while (0)
#define UL_WRITE(S_) do { _Pragma("unroll") for (int i = 0; i < 8; ++i) *(LAS v4u*)(tw + 2 * i * 528) = R[(S_) & 1][i]; } while (0)
#define UL_MMA(S_) do { if (((S_) & 7) == 0) { _Pragma("unroll") for (int ml = 0; ml < 8; ++ml) { const v4u x0 = *(const LAS v4u*)(bp + 128 * (8 * ((S_) >> 3) + ml)), x1 = *(const LAS v4u*)(bp + 128 * (8 * ((S_) >> 3) + ml) + 64); \
                    Bk[ml] = (v8i_t){(int)x0.x, (int)x0.y, (int)x0.z, (int)x0.w, (int)x1.x, (int)x1.y, (int)x1.z, (int)x1.w}; } } \
                _Pragma("unroll") for (int ml = 0; ml < 8; ++ml) { const v4u w = *(const LAS v4u*)(tr + 64 * ml); \
                    acc[(S_) & 7] = __builtin_amdgcn_mfma_scale_f32_16x16x128_f8f6f4((v8i_t){(int)w.x, (int)w.y, (int)w.z, (int)w.w, 0, 0, 0, 0}, Bk[ml], acc[(S_) & 7], 4, 0, 0, 0x7f7f7f7f, 0, 0x7f7f7f7f); } } while (0)
            UL_LOAD(0); __builtin_amdgcn_sched_barrier(0);
#pragma unroll
            for (int s = 0; s < 16; ++s) {
                if (s + 1 == 8) asm volatile("" : "+v"(e0b), "+v"(e1b));
                if (s + 1 < 16) UL_LOAD(s + 1);
                __builtin_amdgcn_sched_barrier(0);
                UL_WRITE(s); __builtin_amdgcn_sched_barrier(0);
                UL_MMA(s); __builtin_amdgcn_sched_barrier(0);
            }
#undef UL_LOAD
#undef UL_WRITE
#undef UL_MMA
            asm volatile("s_nop 15\n\ts_nop 15" : "+v"(acc[0]), "+v"(acc[1]), "+v"(acc[2]), "+v"(acc[3]), "+v"(acc[4]), "+v"(acc[5]), "+v"(acc[6]), "+v"(acc[7]));
            LAS float* SS = (LAS float*)(wl + 12544);
            if (n16 < 2) {
#pragma unroll
                for (int rb = 0; rb < 8; ++rb) *(LAS f32x4*)(SS + n16 * 128 + 16 * rb + 4 * kq) = acc[rb]; }
            asm volatile("" ::: "memory");
            a0 = SS[lane] + SS[128 + lane] * 0.0625f; a1 = SS[64 + lane] + SS[192 + lane] * 0.0625f;
            asm volatile("" ::: "memory");
        }
        float* HC = (float*)(F.ws + WS_Z) + (size_t)row * 128;
        HC[lane] = gelu_tanh(a0 * su0) * g0 * sv0; HC[64 + lane] = gelu_tanh(a1 * su1) * g1 * sv1;
    }
}
template <int L> __device__ __forceinline__ void peer_v_phase(Frame& F, int M) {
    const int gw = F.vcu * NWAVES + F.wave, NGW = F.G * NWAVES;
    const char* PU = (const char*)(F.ws + WS_PU8) + (size_t)L * P_E * (D / 2); const char* PV = (const char*)(F.ws + WS_PV8) + (size_t)L * P_E * (D / 2);
    const float* SCU = (const float*)(F.ws + WS_SC) + (size_t)L * P_E; const float* SCV = (const float*)(F.ws + WS_SC) + (size_t)(4 + L) * P_E;
    const int* IDX = (const int*)(F.ws + WS_IDX); const float* PG = (const float*)(F.ws + WS_PG);
    const float* lg = F.in[I_LNG] + (size_t)(L * 2 + 1) * D; const float* lb = F.in[I_LNB] + (size_t)(L * 2 + 1) * D;
    for (int row = gw; row < M; row += NGW) {
        int lane_l = F.lane; asm volatile("" : "+v"(lane_l));
        const int lane = lane_l, lo16 = lane * 16;
        const int e0 = IDX[(size_t)row * 128 + lane], e1 = IDX[(size_t)row * 128 + 64 + lane];
        RowBatch A, Bb;
        constexpr int NB3 = 128 / P3B;
        p3_load_batch(A, PV, e0, 0, lo16);
        const float h0 = ((const float*)(F.ws + WS_Z))[(size_t)row * 128 + lane], h1 = ((const float*)(F.ws + WS_Z))[(size_t)row * 128 + 64 + lane];
        f32x2 acc[16];
#pragma unroll
        for (int j = 0; j < 16; ++j) acc[j] = (f32x2){0.f, 0.f};
#define P3_AXPY(BUF, KB) do { _Pragma("unroll") for (int q = 0; q < P3B; ++q) { const int k = (KB) + q; const float hk = rl(k < 64 ? h0 : h1, k & 63); axpy32_fp4(BUF.r[q], hk, acc); } } while (0)
        for (int bb = 0; bb < NB3; bb += 2) {
            p3_load_batch(Bb, PV, (bb + 1) * P3B < 64 ? e0 : e1, (P3B * (bb + 1)) & 63, lo16);
            P3_AXPY(A, P3B * bb);
            if (bb + 2 < NB3) p3_load_batch(A, PV, (bb + 2) * P3B < 64 ? e0 : e1, (P3B * (bb + 2)) & 63, lo16);
            P3_AXPY(Bb, P3B * bb + P3B);
        }
#undef P3_AXPY
        int lane2 = lane_l; asm volatile("" : "+v"(lane2) : "v"(acc[0]), "v"(acc[15]));
        const bf16* xr = (const bf16*)(F.ws + WS_X) + (size_t)row * D + 4 * lane2; const float* md = mod_row(F, L, row) + 4 * lane2;
        float s = 0.f;
#pragma unroll
        for (int q = 0; q < 8; ++q) { const v2u xp = *(const v2u*)(xr + 256 * q); const f32x4 xa = {bf_lo(xp.x), bf_hi(xp.x), bf_lo(xp.y), bf_hi(xp.y)}, ga = *(const f32x4*)(md + 5 * D + 256 * q);
#pragma unroll
            for (int j = 0; j < 4; ++j) { float v = acc[2 * q + (j >> 1)][j & 1]; v = ALPHA * xa[j] + ga[j] * v; acc[2 * q + (j >> 1)][j & 1] = v; s += v; } }
        const float mean = wsum(s) * (1.0f / D); float qv = 0.f;
#pragma unroll
        for (int j = 0; j < 16; ++j) { acc[j] = acc[j] - mean; qv += acc[j][0] * acc[j][0] + acc[j][1] * acc[j][1]; }
        const float rstd = 1.0f / sqrtf(wsum(qv) * (1.0f / D) + LN_EPS);
        float* xo = F.out + (size_t)row * D + 4 * lane2; bf16* xb = (bf16*)(F.ws + WS_X) + (size_t)row * D + 4 * lane2;
        unsigned char* ho = F.ws + WS_H + (size_t)row * D + 4 * lane2;
        const float* mdn = mod_row(F, (L + 1) & 3, row) + 4 * lane2;
#pragma unroll
        for (int q = 0; q < 8; ++q) { const int o = 256 * q; const f32x4 wa = *(const f32x4*)(lg + 4 * lane2 + o), ba = *(const f32x4*)(lb + 4 * lane2 + o);
            f32x4 oa;
#pragma unroll
            for (int j = 0; j < 4; ++j) oa[j] = acc[2 * q + (j >> 1)][j & 1] * rstd * wa[j] + ba[j];
            if (L == DEPTH - 1) *(f32x4*)(xo + o) = oa; else { v2u xw; xw.x = cvt_pk_bf16(oa[0], oa[1]); xw.y = cvt_pk_bf16(oa[2], oa[3]); *(v2u*)(xb + o) = xw; }
            if (L < DEPTH - 1) { const f32x4 sa = *(const f32x4*)(mdn + o), ca = *(const f32x4*)(mdn + D + o); const f32x4 ha = oa * (ca + 1.0f) + sa;
                *(unsigned*)(ho + o) = pk4_fp8(ha[0], ha[1], ha[2], ha[3]); } }
    }
}

constexpr int MP = 272;
constexpr int ML_QH = 0, ML_KH = 128 * MP, ML_VT = 2 * 128 * MP, ML_VW = 3 * 128 * MP, ML_GA = 4 * 128 * MP;
__device__ __forceinline__ s16x4 tr_read(LAS unsigned char* p) { return __builtin_amdgcn_ds_read_tr16_b64_v4i16((LAS s16x4*)p); }
__device__ __forceinline__ bf16x8 cat8(s16x4 a, s16x4 b) { return (bf16x8){a[0], a[1], a[2], a[3], b[0], b[1], b[2], b[3]}; }

template <int L> __device__ __forceinline__ void mlstm_scan_phase(Frame& F) {
    constexpr int J = L / 3;
    LAS unsigned char* lds = F.lds;
    LAS float* GA = (LAS float*)(lds + ML_GA);
    LAS float* gA = GA, *gMM = GA + 128, *gWI = GA + 256, *gEN = GA + 384, *gWS = GA + 512, *gNQ = GA + 640, *gHD = GA + 768;
    LAS float* gN = GA + 896;
    LAS float* gRS2 = GA + 896 + 512 + 16;
    const bf16* Zq = (const bf16*)(F.ws + WS_Z + ZQ); const bf16* Zk = (const bf16*)(F.ws + WS_Z + ZK); const bf16* Zv = (const bf16*)(F.ws + WS_Z + ZV);
    const float* G16 = (const float*)(F.ws + WS_GATE); const float* bg = F.in[I_ABG] + J * 16;
    const int tid0 = F.tid, w = F.wave;
    for (int unit = F.vcu; unit < 256; unit += F.G) {
        const int chain = unit >> 2, vs = unit & 3, dir = chain & 1, hd = (chain >> 1) & 3, b = chain >> 3;
        bf16* HO = (bf16*)(F.ws + (dir ? WS_Y : WS_H));
        float* GPa = (float*)(F.ws + WS_GP) + (size_t)unit * (3 * 34 * 128); float* GPb = GPa + 34 * 128; float* GPp = GPb + 34 * 128;
#define CBASE(jc_) ((jc_) < 2 ? TL + b * CL + (dir ? 1 - (jc_) : (jc_)) * 128 : b * SEQ + (dir ? 33 - (jc_) : (jc_) - 2) * 128)
        for (int jc = w; jc < 34; jc += NWAVES) {
            const int base = CBASE(jc); const int lane = tid0 & 63;
            const int s0 = 2 * lane, s1 = 2 * lane + 1;
            const float* g0 = G16 + (size_t)(base + (dir ? 127 - s0 : s0)) * 16; const float* g1 = G16 + (size_t)(base + (dir ? 127 - s1 : s1)) * 16;
            const int ci = dir * 8 + hd, cf = dir * 8 + 4 + hd;
            float li0 = g0[ci] + bg[ci], li1 = g1[ci] + bg[ci], gf0 = g0[cf] + bg[cf], gf1 = g1[cf] + bg[cf];
            li0 = 15.f * tanhf(li0 * (1.f / 15.f)); li1 = 15.f * tanhf(li1 * (1.f / 15.f)); gf0 = 15.f * tanhf(gf0 * (1.f / 15.f)); gf1 = 15.f * tanhf(gf1 * (1.f / 15.f));
            const float lf0 = fminf(gf0, 0.f) - log1pf(__expf(-fabsf(gf0))), lf1 = fminf(gf1, 0.f) - log1pf(__expf(-fabsf(gf1)));
            float p = lf0 + lf1;
#pragma unroll
            for (int o = 1; o < 64; o <<= 1) { const float t = __shfl_up(p, o); if (lane >= o) p += t; }
            const float b1 = p, b0 = p - lf1;
            const float a0 = li0 - b0, a1 = li1 - b1;
            float pm = fmaxf(a0, a1);
#pragma unroll
            for (int o = 1; o < 64; o <<= 1) { const float t = __shfl_up(pm, o); if (lane >= o) pm = fmaxf(pm, t); }
            float pe = __shfl_up(pm, 1); if (lane == 0) pe = -3.0e38f;
            *(f32x2*)(GPa + jc * 128 + s0) = (f32x2){a0, a1}; *(f32x2*)(GPb + jc * 128 + s0) = (f32x2){b0, b1}; *(f32x2*)(GPp + jc * 128 + s0) = (f32x2){fmaxf(pe, a0), pm};
        }
        f32x4 C[16];
#pragma unroll
        for (int i = 0; i < 16; ++i) C[i] = zero4();
        for (int i = tid0; i < 512; i += NTHR) gN[i] = 0.f;
        __syncthreads();
        float m = 0.f;
        v4u PQ[4], PK[4], PV[4]; float pa[4]; float pe_a, pe_b, pe_p, pl_b, pl_p;
#define LOAD_QK(jc_, hf_) do { int t_ = tid0; asm volatile("" : "+v"(t_)); const int base_ = CBASE(jc_); const size_t r0_ = (size_t)(base_ + (dir ? 127 - (t_ >> 4) : (t_ >> 4))); const long rs_ = dir ? -32 : 32; \
            const bf16* qp_ = Zq + r0_ * 1024 + hd * 256 + (hf_) * 128 + (t_ & 15) * 8; const bf16* kp_ = Zk + r0_ * 1024 + hd * 256 + (hf_) * 128 + (t_ & 15) * 8; \
            _Pragma("unroll") for (int i = 0; i < 4; ++i) { PQ[i] = *(const v4u*)(qp_ + (long)i * rs_ * 1024); PK[i] = *(const v4u*)(kp_ + (long)i * rs_ * 1024); } } while (0)
#define LOAD_V(jc_) do { int t_ = tid0; asm volatile("" : "+v"(t_)); const int base_ = CBASE(jc_); const size_t r0_ = (size_t)(base_ + (dir ? 127 - (t_ >> 4) : (t_ >> 4))); const long rs_ = dir ? -32 : 32; \
            const bf16* vp_ = Zv + r0_ * 2048 + hd * 512 + vs * 128 + (t_ & 15) * 8; \
            _Pragma("unroll") for (int i = 0; i < 4; ++i) { PV[i] = *(const v4u*)(vp_ + (long)i * rs_ * 2048); pa[i] = GPa[(jc_) * 128 + (t_ >> 4) + 32 * i]; } } while (0)
#define LOAD_G(jc_) do { int t_ = tid0; asm volatile("" : "+v"(t_)); const int o_ = (jc_) * 128 + (t_ & 127); pe_a = GPa[o_]; pe_b = GPb[o_]; pe_p = GPp[o_]; pl_b = GPb[(jc_) * 128 + 127]; pl_p = GPp[(jc_) * 128 + 127]; } while (0)
        LOAD_QK(0, 0); LOAD_V(0); LOAD_G(0);
        for (int jc = 0; jc < 34; ++jc) {
            const int base = CBASE(jc);
#define ROWMAP(r) (base + (dir ? 127 - (r) : (r)))
            LAS float* Ncur = gN + (jc & 1) * 256; LAS float* Nnxt = gN + ((jc & 1) ^ 1) * 256;
            int tid_l = tid0; asm volatile("" : "+v"(tid_l));
            const int tid = tid_l, lane = tid & 63, fr = lane & 15, fq = lane >> 4;
            int X1 = fr * MP + 16 * fq, X2 = fr * MP + 8 * fq, X3 = (8 * fq + (fr >> 2)) * MP + 8 * (fr & 3), XS = (tid >> 4) * MP + (tid & 15) * 16, X4 = 32 * fq;
            asm volatile("" : "+v"(X1), "+v"(X2), "+v"(X3), "+v"(XS), "+v"(X4));
            const int X1w = X1 + 16 * w * MP, X2w = X2 + 16 * w * MP, X3w = X3 + 32 * w;
            const float M127 = __builtin_bit_cast(float, __builtin_amdgcn_readfirstlane(__builtin_bit_cast(int, fmaxf(m, pl_p))));
            const float decay = __builtin_bit_cast(float, __builtin_amdgcn_readfirstlane(__builtin_bit_cast(int, __expf(m - M127))));
            if (tid < 128) { const float Mt = fmaxf(m, pe_p);
                gA[tid] = pe_a; gMM[tid] = Mt; gWI[tid] = __expf(m - Mt); gEN[tid] = __expf(-pe_b - Mt); gWS[tid] = __expf(pe_a - M127) * 0.0625f; }
            m = __builtin_bit_cast(float, __builtin_amdgcn_readfirstlane(__builtin_bit_cast(int, pl_b + M127)));
            f32x4 Sacc[5], CQ[8]; v2u SP[5]; float rsum = 0.f; const int lo_own = w >= 5 ? w - 4 : 0;
#pragma unroll
            for (int i = 0; i < 8; ++i) { if (i < 5) Sacc[i] = zero4(); CQ[i] = zero4(); }
#pragma unroll
            for (int hf = 0; hf < 2; ++hf) {
#pragma unroll
                for (int i = 0; i < 4; ++i) { *(LAS v4u*)(lds + ML_QH + XS + i * 32 * MP) = PQ[i]; *(LAS v4u*)(lds + ML_KH + XS + i * 32 * MP) = PK[i]; }
                if (hf == 0) {
#pragma unroll
                    for (int i = 0; i < 4; ++i) {
                        const v4u v = PV[i]; const float ws = __expf(pa[i] - M127) * 0.0625f;
                        *(LAS v4u*)(lds + ML_VT + XS + i * 32 * MP) = v;
                        v4u o; o.x = cvt_pk_bf16(bf_lo(v.x) * ws, bf_hi(v.x) * ws); o.y = cvt_pk_bf16(bf_lo(v.y) * ws, bf_hi(v.y) * ws);
                        o.z = cvt_pk_bf16(bf_lo(v.z) * ws, bf_hi(v.z) * ws); o.w = cvt_pk_bf16(bf_lo(v.w) * ws, bf_hi(v.w) * ws);
                        *(LAS v4u*)(lds + ML_VW + XS + i * 32 * MP) = o; }
                }
                __syncthreads();
                if (hf == 0) { LOAD_QK(jc, 1); }
                else if (jc < 33) { LOAD_QK(jc + 1, 0); }
#pragma unroll
                for (int i = 0; i < 5; ++i) {
                    const bool own = i <= w - lo_own; const int tbi = own ? w : 7 - w, sbi = own ? lo_own + i : i - (w + 1);
                    if (own || (w < 3 && sbi < 3 - w)) {
#pragma unroll
                        for (int ks = 0; ks < 4; ++ks) { const bf16x8 kf = *(const LAS bf16x8*)(lds + ML_KH + X1 + sbi * 16 * MP + ks * 64); const bf16x8 qf = *(const LAS bf16x8*)(lds + ML_QH + X1 + tbi * 16 * MP + ks * 64);
                            Sacc[i] = __builtin_amdgcn_mfma_f32_16x16x32_bf16(kf, qf, Sacc[i], 0, 0, 0); }
                    }
                }
                if (hf == 1) {
                    float rs_own = 0.f, rs_help = 0.f;
#pragma unroll
                    for (int i = 0; i < 5; ++i) {
                        const bool own = i <= w - lo_own; const int tbi = own ? w : 7 - w, sbi = own ? lo_own + i : i - (w + 1);
                        v2u o; o.x = 0u; o.y = 0u;
                        if (own || (w < 3 && sbi < 3 - w)) { const int t = 16 * tbi + fr; const float Mt = gMM[t]; float v[4], rs = 0.f;
#pragma unroll
                            for (int j = 0; j < 4; ++j) { const int sidx = 16 * sbi + 4 * fq + j; v[j] = (sidx <= t) ? Sacc[i][j] * 0.0625f * __expf(gA[sidx] - Mt) : 0.f; rs += v[j]; }
                            o.x = cvt_pk_bf16(v[0], v[1]); o.y = cvt_pk_bf16(v[2], v[3]);
                            if (own) rs_own += rs; else rs_help += rs; }
                        SP[i] = o;
                    }
                    rs_own += __shfl_xor(rs_own, 16); rs_own += __shfl_xor(rs_own, 32); rs_help += __shfl_xor(rs_help, 16); rs_help += __shfl_xor(rs_help, 32);
                    rsum = rs_own;
                    if (w < 3 && fq == 0) gRS2[16 * (7 - w) + fr] = rs_help;
                }
                __builtin_amdgcn_sched_barrier(0);
#pragma unroll
                for (int tb = 0; tb < 8; ++tb) {
#pragma unroll
                    for (int k2 = 0; k2 < 4; ++k2) {
                        const f32x4 c0 = C[hf * 8 + 2 * k2], c1 = C[hf * 8 + 2 * k2 + 1];
                        v4u pk; pk.x = cvt_pk_bf16(c0[0], c0[1]); pk.y = cvt_pk_bf16(c0[2], c0[3]); pk.z = cvt_pk_bf16(c1[0], c1[1]); pk.w = cvt_pk_bf16(c1[2], c1[3]);
                        const s16x4 qa = *(const LAS s16x4*)(lds + ML_QH + X2 + tb * 16 * MP + k2 * 64), qb = *(const LAS s16x4*)(lds + ML_QH + X2 + tb * 16 * MP + k2 * 64 + 32);
                        CQ[tb] = __builtin_amdgcn_mfma_f32_16x16x32_bf16(cat8(qa, qb), __builtin_bit_cast(bf16x8, pk), CQ[tb], 0, 0, 0); }
                }
                __builtin_amdgcn_sched_barrier(0);
                {
                    f32x4 nacc = zero4();
#pragma unroll
                    for (int ks = 0; ks < 4; ++ks) {
                        const LAS float* np = (const LAS float*)((LAS unsigned char*)Ncur + X4 + hf * 512 + ks * 128);
                        const f32x4 n0 = *(const LAS f32x4*)np, n1 = *(const LAS f32x4*)(np + 4);
                        v4u pk; pk.x = cvt_pk_bf16(n0[0], n0[1]); pk.y = cvt_pk_bf16(n0[2], n0[3]); pk.z = cvt_pk_bf16(n1[0], n1[1]); pk.w = cvt_pk_bf16(n1[2], n1[3]);
                        const bf16x8 qf = *(const LAS bf16x8*)(lds + ML_QH + X1w + ks * 64);
                        nacc = __builtin_amdgcn_mfma_f32_16x16x32_bf16(qf, __builtin_bit_cast(bf16x8, pk), nacc, 0, 0, 0); }
                    if (fr == 0) {
#pragma unroll
                        for (int j = 0; j < 4; ++j) { const int t = 16 * w + 4 * fq + j; gNQ[t] = (hf == 0 ? 0.f : gNQ[t]) + nacc[j]; } }
                }
                __builtin_amdgcn_sched_barrier(0);
#pragma unroll
                for (int dt = 0; dt < 8; ++dt) {
                    f32x4 acc = C[hf * 8 + dt] * decay;
#pragma unroll
                    for (int ss = 0; ss < 4; ++ss) { LAS unsigned char* p = lds + ML_KH + X3 + ss * 32 * MP + dt * 32; LAS unsigned char* pw = lds + ML_VW + X3w + ss * 32 * MP;
                        acc = __builtin_amdgcn_mfma_f32_16x16x32_bf16(cat8(tr_read(p), tr_read(p + 4 * MP)), cat8(tr_read(pw), tr_read(pw + 4 * MP)), acc, 0, 0, 0); }
                    C[hf * 8 + dt] = acc;
                }
                __builtin_amdgcn_sched_barrier(0);
                {
                    f32x4 nacc = zero4();
#pragma unroll
                    for (int ss = 0; ss < 4; ++ss) {
                        const LAS float* wp = (const LAS float*)((LAS unsigned char*)gWS + X4 + ss * 128);
                        const f32x4 w0 = *(const LAS f32x4*)wp, w1 = *(const LAS f32x4*)(wp + 4);
                        v4u pk; pk.x = cvt_pk_bf16(w0[0], w0[1]); pk.y = cvt_pk_bf16(w0[2], w0[3]); pk.z = cvt_pk_bf16(w1[0], w1[1]); pk.w = cvt_pk_bf16(w1[2], w1[3]);
                        LAS unsigned char* p = lds + ML_KH + X3w + ss * 32 * MP;
                        nacc = __builtin_amdgcn_mfma_f32_16x16x32_bf16(cat8(tr_read(p), tr_read(p + 4 * MP)), __builtin_bit_cast(bf16x8, pk), nacc, 0, 0, 0); }
                    if (fr == 0) {
#pragma unroll
                        for (int j = 0; j < 4; ++j) { const int dl = hf * 128 + 16 * w + 4 * fq + j; Nnxt[dl] = decay * Ncur[dl] + nacc[j]; } }
                }
                __syncthreads();
            }
            {
#pragma unroll
                for (int i = 0; i < 5; ++i) {
                    const bool own = i <= w - lo_own; const int tbi = own ? w : 7 - w, sbi = own ? lo_own + i : i - (w + 1);
                    if (own || (w < 3 && sbi < 3 - w)) *(LAS v2u*)(lds + ML_QH + X2 + tbi * 16 * MP + sbi * 32) = SP[i];
                }
                for (int sb = w + 1; sb < 8; ++sb) { v2u z; z.x = 0u; z.y = 0u; *(LAS v2u*)(lds + ML_QH + X2w + sb * 32) = z; }
                const int t = 16 * w + fr;
                if (fq == 0) { const float den = gWI[t] * gNQ[t] + rsum + (w >= 5 ? gRS2[t] : 0.f); gHD[t] = 1.0f / fmaxf(fabsf(den), gEN[t]); }
            }
            __syncthreads();
            {
                bf16x8 vf[4];
#pragma unroll
                for (int ss = 0; ss < 4; ++ss) { LAS unsigned char* p = lds + ML_VT + X3w + ss * 32 * MP; vf[ss] = cat8(tr_read(p), tr_read(p + 4 * MP)); }
                if (jc < 33) { LOAD_V(jc + 1); LOAD_G(jc + 1); }
                bf16* hop = HO + (size_t)ROWMAP(4 * fq) * D + hd * 512 + vs * 128 + 16 * w + fr; const long hstep = dir ? -(long)D : (long)D;
#pragma unroll
                for (int tb = 0; tb < 8; ++tb) {
                    f32x4 acc;
#pragma unroll
                    for (int j = 0; j < 4; ++j) acc[j] = CQ[tb][j] * gWI[16 * tb + 4 * fq + j];
#pragma unroll
                    for (int ss = 0; ss < 4; ++ss) { const bf16x8 sf = *(const LAS bf16x8*)(lds + ML_QH + X1 + tb * 16 * MP + ss * 64);
                        acc = __builtin_amdgcn_mfma_f32_16x16x32_bf16(sf, vf[ss], acc, 0, 0, 0); }
#pragma unroll
                    for (int j = 0; j < 4; ++j) { const float h = acc[j] * gHD[16 * tb + 4 * fq + j];
                        hop[(long)(16 * tb + j) * hstep] = (bf16)(cvt_pk_bf16(h, 0.f) & 0xffffu); }
                }
            }
            __syncthreads();
#undef ROWMAP
        }
#undef LOAD_QK
#undef LOAD_V
#undef LOAD_G
#undef CBASE
    }
}

template <int L> __device__ __forceinline__ void mlstm_post_phase(Frame& F, int M) {
    constexpr int J = L / 3;
    const int gw = F.vcu * NWAVES + F.wave, NGW = F.G * NWAVES;
    const float* ng = F.in[I_ANG] + (size_t)J * D;
    for (int row = gw; row < M; row += NGW) {
        const bf16* hf = (const bf16*)(F.ws + WS_H) + (size_t)row * D; const bf16* hb = (const bf16*)(F.ws + WS_Y) + (size_t)row * D;
        const bf16* orow = (const bf16*)(F.ws + WS_Z + ZO) + (size_t)row * D; unsigned char* g = F.ws + WS_Z + ZG + (size_t)row * D;
        f32x4 t[8]; float ss[4];
#pragma unroll
        for (int j = 0; j < 8; ++j) { const int e = 4 * F.lane + 256 * j; const v2u a = *(const v2u*)(hf + e), b = *(const v2u*)(hb + e);
            t[j] = (f32x4){bf_lo(a.x) + bf_lo(b.x), bf_hi(a.x) + bf_hi(b.x), bf_lo(a.y) + bf_lo(b.y), bf_hi(a.y) + bf_hi(b.y)}; }
#pragma unroll
        for (int h = 0; h < 4; ++h) { float q = 0.f;
#pragma unroll
            for (int jj = 0; jj < 2; ++jj) { const f32x4 v = t[2 * h + jj]; q += (v[0] * v[0] + v[1] * v[1]) + (v[2] * v[2] + v[3] * v[3]); }
            ss[h] = 1.0f / sqrtf(wsum(q) * (1.0f / A_DV) + LN_EPS); }
#pragma unroll
        for (int j = 0; j < 8; ++j) { const int e = 4 * F.lane + 256 * j; const v2u ov = *(const v2u*)(orow + e); const f32x4 gn = *(const f32x4*)(ng + e);
            const float o0 = bf_lo(ov.x), o1 = bf_hi(ov.x), o2 = bf_lo(ov.y), o3 = bf_hi(ov.y); const float r = ss[j >> 1];
            const float y0 = t[j][0] * r * gn[0] / (1.0f + __expf(-o0)), y1 = t[j][1] * r * gn[1] / (1.0f + __expf(-o1));
            const float y2 = t[j][2] * r * gn[2] / (1.0f + __expf(-o2)), y3 = t[j][3] * r * gn[3] / (1.0f + __expf(-o3));
            *(unsigned*)(g + e) = pk4_fp8(y0, y1, y2, y3); }
    }
}

__device__ __forceinline__ void gmlp_stats_phase(Frame& F, int M) {
    const int gw = F.vcu * NWAVES + F.wave, NGW = F.G * NWAVES;
    float* ST = (float*)(F.ws + WS_STAT);
    for (int row = gw; row < M; row += NGW) {
        const bf16* vr = (const bf16*)(F.ws + WS_Z + ZVV) + (size_t)row * 4096;
        v4u x[8]; float s = 0.f;
#pragma unroll
        for (int j = 0; j < 8; ++j) { x[j] = *(const v4u*)(vr + 8 * F.lane + 512 * j);
            s += (bf_lo(x[j].x) + bf_hi(x[j].x)) + (bf_lo(x[j].y) + bf_hi(x[j].y)) + (bf_lo(x[j].z) + bf_hi(x[j].z)) + (bf_lo(x[j].w) + bf_hi(x[j].w)); }
        const float mean = wsum(s) * (1.0f / 4096.f); float q = 0.f;
#pragma unroll
        for (int j = 0; j < 8; ++j) { float d;
            d = bf_lo(x[j].x) - mean; q += d * d; d = bf_hi(x[j].x) - mean; q += d * d; d = bf_lo(x[j].y) - mean; q += d * d; d = bf_hi(x[j].y) - mean; q += d * d;
            d = bf_lo(x[j].z) - mean; q += d * d; d = bf_hi(x[j].z) - mean; q += d * d; d = bf_lo(x[j].w) - mean; q += d * d; d = bf_hi(x[j].w) - mean; q += d * d; }
        const float rstd = 1.0f / sqrtf(wsum(q) * (1.0f / 4096.f) + LN_EPS);
        if (F.lane == 0) { ST[(size_t)row * 2] = mean; ST[(size_t)row * 2 + 1] = rstd; }
    }
}
__device__ __forceinline__ void gmlp_spatial_phase(Frame& F, int M) {
    LAS unsigned char* lds = F.lds;
    constexpr int GW_W = 0, GW_V = 128 * MP, GW_O = 2 * 128 * MP;
    const bf16* WS = (const bf16*)(F.ws + WS_WS); const float* ST = (const float*)(F.ws + WS_STAT);
    const bf16* U = (const bf16*)(F.ws + WS_Z + ZU); const bf16* V = (const bf16*)(F.ws + WS_Z + ZVV);
    const float* lng = F.in[I_BLNG]; const float* lnb = F.in[I_BLNB]; const float* bs = F.in[I_BBS];
    const int w = F.wave;
    const int nunits = (M / 128) * B_GROUPS;
    for (int u = F.vcu; u < nunits; u += F.G) {
        int tid_l = F.tid; asm volatile("" : "+v"(tid_l));
        const int tid = tid_l, lane = tid & 63, fr = lane & 15, fq = lane >> 4;
        const int chunk = u >> 3, g = u & 7, row0 = chunk * 128;
        const int et = tid >> 2, ec = tid & 3;
        v4u wreg[4], vreg[4][4]; float mean[4], rstd[4];
#pragma unroll
        for (int i = 0; i < 4; ++i) { const int c = tid + 512 * i, r = c >> 4, cc = c & 15;
            wreg[i] = *(const v4u*)(WS + (size_t)g * 16384 + r * 128 + cc * 8);
            mean[i] = ST[(size_t)(row0 + r) * 2]; rstd[i] = ST[(size_t)(row0 + r) * 2 + 1];
#pragma unroll
            for (int dq = 0; dq < 4; ++dq) vreg[dq][i] = *(const v4u*)(V + (size_t)(row0 + r) * 4096 + g * 512 + dq * 128 + cc * 8); }
        const float bst = bs[g * 128 + et];
#pragma unroll
        for (int i = 0; i < 4; ++i) { const int c = tid + 512 * i, r = c >> 4, cc = c & 15; *(LAS v4u*)(lds + GW_W + r * MP + cc * 16) = wreg[i]; }
#pragma unroll
        for (int dq = 0; dq < 4; ++dq) {
            const int col0 = g * 512 + dq * 128;
#pragma unroll
            for (int i = 0; i < 4; ++i) { const int c = tid + 512 * i, r = c >> 4, cc = c & 15;
                const v4u v = vreg[dq][i]; const float mn = mean[i], rs = rstd[i];
                const f32x4 ga = *(const f32x4*)(lng + col0 + cc * 8), gb = *(const f32x4*)(lng + col0 + cc * 8 + 4), ba = *(const f32x4*)(lnb + col0 + cc * 8), bb = *(const f32x4*)(lnb + col0 + cc * 8 + 4);
                v4u o;
                o.x = cvt_pk_bf16((bf_lo(v.x) - mn) * rs * ga[0] + ba[0], (bf_hi(v.x) - mn) * rs * ga[1] + ba[1]);
                o.y = cvt_pk_bf16((bf_lo(v.y) - mn) * rs * ga[2] + ba[2], (bf_hi(v.y) - mn) * rs * ga[3] + ba[3]);
                o.z = cvt_pk_bf16((bf_lo(v.z) - mn) * rs * gb[0] + bb[0], (bf_hi(v.z) - mn) * rs * gb[1] + bb[1]);
                o.w = cvt_pk_bf16((bf_lo(v.w) - mn) * rs * gb[2] + bb[2], (bf_hi(v.w) - mn) * rs * gb[3] + bb[3]);
                *(LAS v4u*)(lds + GW_V + r * MP + cc * 16) = o; }
            __syncthreads();
            v4u ureg[4];
            { const bf16* up = U + (size_t)(row0 + et) * 4096 + col0 + 32 * ec;
#pragma unroll
              for (int k = 0; k < 4; ++k) ureg[k] = *(const v4u*)(up + 8 * k); }
            bf16x8 wf[4];
#pragma unroll
            for (int ss = 0; ss < 4; ++ss) wf[ss] = *(const LAS bf16x8*)(lds + GW_W + (16 * w + fr) * MP + (32 * ss + 8 * fq) * 2);
#pragma unroll
            for (int db = 0; db < 8; ++db) {
                f32x4 acc = zero4();
#pragma unroll
                for (int ss = 0; ss < 4; ++ss) { LAS unsigned char* p = lds + GW_V + (32 * ss + 8 * fq + (fr >> 2)) * MP + (16 * db + 4 * (fr & 3)) * 2;
                    acc = __builtin_amdgcn_mfma_f32_16x16x32_bf16(cat8(tr_read(p), tr_read(p + 4 * MP)), wf[ss], acc, 0, 0, 0); }
                v2u o; o.x = cvt_pk_bf16(acc[0], acc[1]); o.y = cvt_pk_bf16(acc[2], acc[3]);
                *(LAS v2u*)(lds + GW_O + (16 * w + fr) * MP + (16 * db + 4 * fq) * 2) = o;
            }
            __syncthreads();
            { const LAS unsigned char* op = lds + GW_O + et * MP + 64 * ec;
              unsigned char* hp = F.ws + WS_H + (size_t)(row0 + et) * 4096 + col0 + 32 * ec;
              v4u out[2];
#pragma unroll
              for (int k = 0; k < 4; ++k) { const v4u sv = *(const LAS v4u*)(op + 16 * k); const v4u uv = ureg[k];
                  const unsigned lo = pk4_fp8(bf_lo(uv.x) * (bf_lo(sv.x) + bst), bf_hi(uv.x) * (bf_hi(sv.x) + bst), bf_lo(uv.y) * (bf_lo(sv.y) + bst), bf_hi(uv.y) * (bf_hi(sv.y) + bst));
                  const unsigned hi = pk4_fp8(bf_lo(uv.z) * (bf_lo(sv.z) + bst), bf_hi(uv.z) * (bf_hi(sv.z) + bst), bf_lo(uv.w) * (bf_lo(sv.w) + bst), bf_hi(uv.w) * (bf_hi(sv.w) + bst));
                  out[k >> 1][2 * (k & 1)] = lo; out[k >> 1][2 * (k & 1) + 1] = hi; }
              *(v4u*)hp = out[0]; *(v4u*)(hp + 16) = out[1]; }
        }
        __syncthreads();
    }
}

namespace att {
using bf16 = unsigned short;
constexpr int   D = 128, NW = 8, QBLK = 32, KVBLK = 64;
constexpr float SCALE = 0.088388347648318440f;
constexpr float THR = 8.f;
constexpr int SDEPTH = 2;
constexpr int LDQ = 2048, LDK = 512, LDO = 2048;
constexpr size_t SHM_V = KVBLK * D * 2, SHM_K = KVBLK * D * 2, SHM_ATTN = 2 * SHM_V + 2 * SHM_K + NW * 64 * 4;
using bf16x8 = __attribute__((ext_vector_type(8))) short;
using s16x4  = __attribute__((ext_vector_type(4))) short;
using f32x16 = __attribute__((ext_vector_type(16))) float;
using f32x8  = __attribute__((ext_vector_type(8))) float;
using u32x4  = __attribute__((ext_vector_type(4))) unsigned;
#define KSWZ(row, colB) ((row) * 256 + ((colB) ^ (((row) & 7) << 4)))
#define SBAR() __builtin_amdgcn_sched_barrier(0)
__device__ __forceinline__ int crow(int r, int hi) { return (r & 3) + 8 * (r >> 2) + 4 * hi; }
__device__ __forceinline__ unsigned cvtpk(float lo, float hi) { return ::cvt_pk_bf16(lo, hi); }
template <typename TIn> struct Stage;
template <> struct Stage<bf16>  { using T = bf16x8;
  __device__ static __forceinline__ T ld8(const bf16* p) { return *reinterpret_cast<const bf16x8*>(p); }
  __device__ static __forceinline__ bf16x8 tobf(T x) { return x; } };
__device__ __forceinline__ void partialSM(f32x16& p0, f32x16& p1, float& m_reg, float& mn, float& alpha) {
  constexpr float C = SCALE * 1.4426950408889634f;
  float pmax = p0[0]; for (int r = 1; r < 16; ++r) pmax = fmaxf(pmax, p0[r]); for (int r = 0; r < 16; ++r) pmax = fmaxf(pmax, p1[r]);
  { auto rr = __builtin_amdgcn_permlane32_swap(__float_as_uint(pmax), __float_as_uint(pmax), false, false);
    pmax = fmaxf(__uint_as_float(rr[0]), __uint_as_float(rr[1])); }
  if (__builtin_expect(__all(pmax - m_reg <= THR / SCALE), 1)) { mn = m_reg; alpha = 1.f; }
  else { mn = fmaxf(m_reg, pmax); alpha = __builtin_amdgcn_exp2f((m_reg - mn) * C); m_reg = mn; }
  float mnC = -mn * C;
  for (int r = 0; r < 16; ++r) p0[r] = fmaf(p0[r], C, mnC); for (int r = 0; r < 16; ++r) p1[r] = fmaf(p1[r], C, mnC);
  for (int r = 0; r < 16; ++r) p0[r] = __builtin_amdgcn_exp2f(p0[r]);
}
__device__ __forceinline__ void finishSM(f32x16& p0, f32x16& p1, float alpha, float& l_reg, bf16x8& pa0, bf16x8& pa1, bf16x8& pa2, bf16x8& pa3) {
  for (int r = 0; r < 16; ++r) p1[r] = __builtin_amdgcn_exp2f(p1[r]);
  float ps = 0; for (int r = 0; r < 16; ++r) ps += p0[r]; for (int r = 0; r < 16; ++r) ps += p1[r];
  { auto rr = __builtin_amdgcn_permlane32_swap(__float_as_uint(ps), __float_as_uint(ps), false, false);
    ps = __uint_as_float(rr[0]) + __uint_as_float(rr[1]); }
  l_reg = l_reg * alpha + ps;
#define PK4(P, BASE, OUT) do { unsigned a0 = cvtpk(P[BASE + 0], P[BASE + 1]), a1 = cvtpk(P[BASE + 2], P[BASE + 3]);   \
    unsigned b0 = cvtpk(P[BASE + 4], P[BASE + 5]), b1 = cvtpk(P[BASE + 6], P[BASE + 7]);                              \
    auto r0 = __builtin_amdgcn_permlane32_swap(a0, b0, false, false); auto r1 = __builtin_amdgcn_permlane32_swap(a1, b1, false, false); \
    u32x4 w = {r0[0], r1[0], r0[1], r1[1]}; OUT = *reinterpret_cast<bf16x8*>(&w); } while (0)
  PK4(p0, 0, pa0); PK4(p0, 8, pa1); PK4(p1, 0, pa2); PK4(p1, 8, pa3);
#undef PK4
}
__device__ __forceinline__ void qkt(f32x16& p0, f32x16& p1, const bf16* Ks, const bf16x8* qr, int r32, int hi) {
  p0 = f32x16{}; p1 = f32x16{};
  for (int d0 = 0; d0 < 8; ++d0) { int cb = (d0 * 16 + hi * 8) * 2;
    bf16x8 b0 = *reinterpret_cast<const bf16x8*>((const char*)Ks + KSWZ(r32, cb));
    bf16x8 b1 = *reinterpret_cast<const bf16x8*>((const char*)Ks + KSWZ(32 + r32, cb));
    p0 = __builtin_amdgcn_mfma_f32_32x32x16_bf16(b0, qr[d0], p0, 0, 0, 0);
    p1 = __builtin_amdgcn_mfma_f32_32x32x16_bf16(b1, qr[d0], p1, 0, 0, 0); }
}
__device__ __forceinline__ int v_st(int k, int c) { const int kk = (k & ~0xC) | ((k & 4) << 1) | ((k & 8) >> 1); return ((kk >> 3) * 4 + (c >> 5)) * 512 + ((kk & 7) * 32 + (c & 31)) * 2; }
__device__ __forceinline__ int v_rd_base(int lane) { return ((lane & 3) << 3) | (((lane >> 2) & 3) << 6) | (((lane >> 4) & 1) << 5) | (((lane >> 5) & 1) << 8); }
constexpr int v_rd_off(int d0, int ks, int half) { return d0 * 512 + ks * 4096 + half * 2048; }
template <int OFF> __device__ __forceinline__ s16x4 tr_read(int vb) {
  return __builtin_amdgcn_ds_read_tr16_b64_v4i16((__attribute__((address_space(3))) s16x4*)(unsigned long)(unsigned)(vb + OFF));
}
template <int D0> __device__ __forceinline__ void pv_one(f32x16& od, int vb, bf16x8 pa0, bf16x8 pa1, bf16x8 pa2, bf16x8 pa3) {
  const s16x4 l0 = tr_read<v_rd_off(D0, 0, 0)>(vb), h0 = tr_read<v_rd_off(D0, 0, 1)>(vb), l1 = tr_read<v_rd_off(D0, 1, 0)>(vb), h1 = tr_read<v_rd_off(D0, 1, 1)>(vb);
  const s16x4 l2 = tr_read<v_rd_off(D0, 2, 0)>(vb), h2 = tr_read<v_rd_off(D0, 2, 1)>(vb), l3 = tr_read<v_rd_off(D0, 3, 0)>(vb), h3 = tr_read<v_rd_off(D0, 3, 1)>(vb);
#define PK(L, H) (bf16x8){L[0], L[1], L[2], L[3], H[0], H[1], H[2], H[3]}
  od = __builtin_amdgcn_mfma_f32_32x32x16_bf16(pa0, PK(l0, h0), od, 0, 0, 0);
  od = __builtin_amdgcn_mfma_f32_32x32x16_bf16(pa1, PK(l1, h1), od, 0, 0, 0);
  od = __builtin_amdgcn_mfma_f32_32x32x16_bf16(pa2, PK(l2, h2), od, 0, 0, 0);
  od = __builtin_amdgcn_mfma_f32_32x32x16_bf16(pa3, PK(l3, h3), od, 0, 0, 0);
#undef PK
}
__device__ __forceinline__ void pv_d0(f32x16* o, int vb, bf16x8 pa0, bf16x8 pa1, bf16x8 pa2, bf16x8 pa3) {
  pv_one<0>(o[0], vb, pa0, pa1, pa2, pa3); pv_one<1>(o[1], vb, pa0, pa1, pa2, pa3); pv_one<2>(o[2], vb, pa0, pa1, pa2, pa3); pv_one<3>(o[3], vb, pa0, pa1, pa2, pa3);
}

template <typename TQ>
__device__ __forceinline__ void attn_dense_body(const TQ* __restrict__ Qb, const bf16* __restrict__ Kh, const bf16* __restrict__ Vh,
                                                unsigned char* __restrict__ Ob, int seq, char* lds, int tid_in) {
  using St = Stage<bf16>; using SQ = Stage<TQ>;
  const int tid = tid_in, wid = tid >> 6, lane = tid & 63, r32 = lane & 31, hi = lane >> 5;
  bf16* V_lds = (bf16*)lds; bf16* K_lds = (bf16*)(lds + 2 * SHM_V);
  float* ws = (float*)(lds + 2 * SHM_V + 2 * SHM_K) + wid * 64; float* li_l = ws; float* al_l = ws + 32;
  float m_reg = -1e30f, l_reg = 0; f32x16 o[4] = {}; bf16x8 qr[8];
  const TQ* Qw = Qb + (long)(wid * QBLK + r32) * LDQ + hi * 8;
#pragma unroll
  for (int d0 = 0; d0 < 8; ++d0) qr[d0] = SQ::tobf(SQ::ld8(Qw + d0 * 16));
  const int sr = tid >> 4, sc = (tid & 15) * 8, vst0 = v_st(sr, sc), vst1 = v_st(32 + sr, sc);
  const int vb0 = (int)(uintptr_t)V_lds + v_rd_base(lane);
  struct { typename St::T vs0, vs1, ks0, ks1; } sr_[SDEPTH];
#define SLOAD(i, k0) do { sr_[i].vs0 = St::ld8(&Vh[(long)((k0) + sr) * LDK + sc]); sr_[i].vs1 = St::ld8(&Vh[(long)((k0) + 32 + sr) * LDK + sc]); \
    sr_[i].ks0 = St::ld8(&Kh[(long)((k0) + sr) * LDK + sc]); sr_[i].ks1 = St::ld8(&Kh[(long)((k0) + 32 + sr) * LDK + sc]); } while (0)
#define SWRITE(b, i) do { *(bf16x8*)((char*)V_lds + (b) * SHM_V + vst0) = St::tobf(sr_[i].vs0);          \
    *(bf16x8*)((char*)V_lds + (b) * SHM_V + vst1) = St::tobf(sr_[i].vs1); int kc = sc * 2;               \
    *(bf16x8*)((char*)K_lds + (b) * SHM_K + KSWZ(sr, kc)) = St::tobf(sr_[i].ks0);                       \
    *(bf16x8*)((char*)K_lds + (b) * SHM_K + KSWZ(32 + sr, kc)) = St::tobf(sr_[i].ks1); } while (0)
#define SWAIT() do { if constexpr (SDEPTH == 2) asm volatile("s_waitcnt vmcnt(4)" ::: "memory"); else asm volatile("s_waitcnt vmcnt(0)" ::: "memory"); } while (0)
#define RESC(a) do { if (__any((a) < 1.f)) { if (hi == 0) al_l[r32] = (a); asm volatile("s_waitcnt lgkmcnt(0)" ::: "memory"); \
    for (int d = 0; d < 4; ++d) for (int r = 0; r < 16; ++r) o[d][r] *= al_l[crow(r, hi)]; } } while (0)
  f32x16 pA0, pA1, pB0, pB1; float mnA, mnB, alA, alB; bf16x8 pa0, pa1, pa2, pa3; const int NT = seq / KVBLK;
  constexpr int SE = 0, SO = SDEPTH - 1;
  SLOAD(SE, 0); asm volatile("s_waitcnt vmcnt(0)" ::: "memory"); SWRITE(0, SE); __syncthreads();
  qkt(pA0, pA1, K_lds, qr, r32, hi); partialSM(pA0, pA1, m_reg, mnA, alA);
  SLOAD(SO, KVBLK); if constexpr (SDEPTH == 2) { if (2 < NT) SLOAD(SE, 2 * KVBLK); }
  SWAIT(); SWRITE(1, SO); __syncthreads();
  for (int j = 1; j + 1 < NT; j += 2) {
    SBAR(); qkt(pB0, pB1, (bf16*)((char*)K_lds + SHM_K), qr, r32, hi);
    finishSM(pA0, pA1, alA, l_reg, pa0, pa1, pa2, pa3); SBAR();
    SLOAD(SO, (j + SDEPTH) * KVBLK); SBAR();
    pv_d0(o, vb0, pa0, pa1, pa2, pa3); partialSM(pB0, pB1, m_reg, mnB, alB);
    __syncthreads(); SWAIT(); SWRITE(0, SE);
    RESC(alB); __syncthreads();
    SBAR(); qkt(pA0, pA1, K_lds, qr, r32, hi);
    finishSM(pB0, pB1, alB, l_reg, pa0, pa1, pa2, pa3); SBAR();
    if (SDEPTH == 1 || j + 3 < NT) SLOAD(SE, (j + 1 + SDEPTH) * KVBLK); SBAR();
    pv_d0(o, vb0 + (int)SHM_V, pa0, pa1, pa2, pa3); partialSM(pA0, pA1, m_reg, mnA, alA);
    __syncthreads(); SWAIT(); SWRITE(1, SO);
    RESC(alA); __syncthreads();
  }
  SBAR(); qkt(pB0, pB1, (bf16*)((char*)K_lds + SHM_K), qr, r32, hi);
  finishSM(pA0, pA1, alA, l_reg, pa0, pa1, pa2, pa3); SBAR();
  pv_d0(o, vb0, pa0, pa1, pa2, pa3); partialSM(pB0, pB1, m_reg, mnB, alB);
  __syncthreads(); RESC(alB);
  finishSM(pB0, pB1, alB, l_reg, pa0, pa1, pa2, pa3); SBAR();
  pv_d0(o, vb0 + (int)SHM_V, pa0, pa1, pa2, pa3);
  if (hi == 0) li_l[r32] = l_reg; asm volatile("s_waitcnt lgkmcnt(0)" ::: "memory");
  float rli[16];
#pragma unroll
  for (int r = 0; r < 16; ++r) rli[r] = __builtin_amdgcn_rcpf(li_l[crow(r, hi)]);
  unsigned char* Ow = Ob + (long)(wid * QBLK) * LDO;
#pragma unroll
  for (int r = 0; r < 16; ++r) { int orow = crow(r, hi);
    for (int d0 = 0; d0 < 4; ++d0) Ow[(long)orow * LDO + d0 * 32 + r32] = (unsigned char)(__builtin_amdgcn_cvt_pk_fp8_f32(o[d0][r] * rli[r], 0.f, 0, false) & 0xff); }
#undef SLOAD
#undef SWRITE
#undef SWAIT
#undef RESC
}
}

constexpr size_t WS_ROPE = WS_STAT + 512 * 1024;
__device__ __forceinline__ void rope_table(Frame& F) {
    float* R = (float*)(F.ws + WS_ROPE);
    const int i = F.vcu * NTHR + F.tid;
    if (i < 64 * 32) { const int pos = i >> 5, fi = i & 31; const float fr = powf(10000.0f, -(float)fi / 32.0f); const float ang = (float)pos * fr; R[2 * i] = cosf(ang); R[2 * i + 1] = sinf(ang); }
}
__device__ __forceinline__ v4u normrope_seg(const bf16* src, const float* g, const float* R, bool rope, int rowpos, int colpos, int lane) {
    const v4u x = *(const v4u*)(src + 8 * lane);
    float v[8] = {bf_lo(x.x), bf_hi(x.x), bf_lo(x.y), bf_hi(x.y), bf_lo(x.z), bf_hi(x.z), bf_lo(x.w), bf_hi(x.w)};
    float q = 0.f;
#pragma unroll
    for (int i = 0; i < 8; ++i) q += v[i] * v[i];
    const float rstd = 1.0f / sqrtf(row16_sum(q) * (1.0f / 128.f) + LN_EPS);
    const int d0 = 8 * (lane & 15);
    const f32x4 ga = *(const f32x4*)(g + d0), gb = *(const f32x4*)(g + d0 + 4);
#pragma unroll
    for (int i = 0; i < 4; ++i) { v[i] *= rstd * ga[i]; v[4 + i] *= rstd * gb[i]; }
    if (rope) {
        const int pos = ((lane & 15) >> 3) ? colpos : rowpos; const bool hi = (lane & 7) >= 4; const int f0 = 8 * (lane & 3);
#pragma unroll
        for (int i = 0; i < 8; ++i) { const float p = __shfl_xor(v[i], 4); const float cs = R[(pos * 32 + f0 + i) * 2], sn = R[(pos * 32 + f0 + i) * 2 + 1];
            v[i] = hi ? (p * sn + v[i] * cs) : (v[i] * cs - p * sn); }
    }
    v4u o; o.x = cvt_pk_bf16(v[0], v[1]); o.y = cvt_pk_bf16(v[2], v[3]); o.z = cvt_pk_bf16(v[4], v[5]); o.w = cvt_pk_bf16(v[6], v[7]);
    return o;
}
__device__ __forceinline__ void attn_prep_phase(Frame& F) {
    const int gw = F.vcu * NWAVES + F.wave, NGW = F.G * NWAVES;
    const float* R = (const float*)(F.ws + WS_ROPE);
    const float* qg = F.in[I_CQG]; const float* kg = F.in[I_CKG];
    for (int row = gw; row < T; row += NGW) {
        const bool lat = row < TL; const int b = lat ? (row >> 12) : ((row - TL) >> 8); const int s = lat ? (row & 4095) : 0;
        const int rp = s >> 6, cp = s & 63; const int kvrow = lat ? (b * SKV + s) : (b * SKV + SEQ + ((row - TL) & 255));
        bf16* q = (bf16*)(F.ws + WS_Z + ZAQ) + (size_t)row * 2048;
#pragma unroll
        for (int p = 0; p < 4; ++p) { const v4u o = normrope_seg(q + 512 * p, qg, R, lat, rp, cp, F.lane); *(v4u*)(q + 512 * p + 8 * F.lane) = o; }
        const bf16* k = (const bf16*)(F.ws + WS_Z + ZAK) + (size_t)row * 512; const bf16* v = (const bf16*)(F.ws + WS_Z + ZAV) + (size_t)row * 512;
        const v4u ko = normrope_seg(k, kg, R, lat, rp, cp, F.lane);
        *(v4u*)((bf16*)(F.ws + WS_Z + ZKC) + (size_t)kvrow * 512 + 8 * F.lane) = ko;
        *(v4u*)((bf16*)(F.ws + WS_Z + ZVC) + (size_t)kvrow * 512 + 8 * F.lane) = *(const v4u*)(v + 8 * F.lane);
    }
}
__device__ __forceinline__ void attn_phase(Frame& F, char* lds, bool need_ctx) {
    const bf16* Q = (const bf16*)(F.ws + WS_Z + ZAQ); const bf16* KC = (const bf16*)(F.ws + WS_Z + ZKC); const bf16* VC = (const bf16*)(F.ws + WS_Z + ZVC);
    unsigned char* O = F.ws + WS_H;
    const int nunits = 2048 + (need_ctx ? 128 : 0);
    for (int u = F.vcu; u < nunits; u += F.G) {
        const bf16 *qp, *kp, *vp; unsigned char* op; int seq;
        if (u < 2048) { const int qb = u & 15, h = (u >> 4) & 15, b = u >> 8; const size_t qrow = (size_t)b * SEQ + qb * 256;
            qp = Q + qrow * 2048 + h * 128; kp = KC + (size_t)b * SKV * 512 + (h >> 2) * 128; vp = VC + (size_t)b * SKV * 512 + (h >> 2) * 128; op = O + qrow * 2048 + h * 128; seq = SKV;
        } else { const int uu = u - 2048, h = uu & 15, b = uu >> 4; const size_t qrow = (size_t)TL + b * CL;
            qp = Q + qrow * 2048 + h * 128; kp = KC + ((size_t)b * SKV + SEQ) * 512 + (h >> 2) * 128; vp = VC + ((size_t)b * SKV + SEQ) * 512 + (h >> 2) * 128; op = O + qrow * 2048 + h * 128; seq = CL; }
        int tid_l = threadIdx.x; asm volatile("" : "+v"(tid_l));
        att::attn_dense_body<bf16>(qp, kp, vp, op, seq, lds, tid_l);
        __syncthreads();
    }
}

#ifndef MK_N_LAUNCHES
#define MK_N_LAUNCHES 1
#endif
constexpr int NPH = 2 + 8 * DEPTH;
struct Args { const float* in[28]; float* out; unsigned char* ws; int ph_lo, ph_hi; };

typedef pg8::EpiSeg<0> EpiPlain;
__device__ __forceinline__ EpiPlain epi_plain(bf16* o, int ld) { EpiPlain E; E.base = (unsigned char*)o; E.ld = ld; E.bias = nullptr; E.gates = nullptr; E.oscale = 1.0f / WSCALE; return E; }


__global__ void __launch_bounds__(NTHR, 2) fwd_kernel(Args args) {
    extern __shared__ __attribute__((aligned(16))) unsigned char lds_raw[];
    Frame F;
    F.lds = (LAS unsigned char*)lds_raw;
    F.tid = threadIdx.x; F.lane = F.tid & 63; F.wave = __builtin_amdgcn_readfirstlane(F.tid >> 6);
    F.G = gridDim.x; { const int bx = blockIdx.x; F.vcu = (F.G % 8 == 0) ? (bx % 8) * (F.G / 8) + bx / 8 : bx; }
    typedef const Args __attribute__((address_space(4)))* KArgs;
    KArgs ka = (KArgs)__builtin_amdgcn_kernarg_segment_ptr();
    F.in = ka->in; F.out = ka->out; F.ws = ka->ws;
    volatile LAS unsigned* MISC = (volatile LAS unsigned*)(F.lds + MISC_OFF);
    for (int u = F.tid; u < (LDS_BYTES - MISC_OFF) / 4; u += NTHR) MISC[u] = 0u;
    __syncthreads();
    const int lo = ka->ph_lo, hi = ka->ph_hi;
    unsigned* barw = (unsigned*)(F.ws + WS_CTL) + CW_BAR;
    XcdBarrier bar; bar.bar = barw; bar.x = 0; bar.st = nullptr;
    if (hi - lo > 1) bar = xcd_barrier_post(barw, MISC + 8);
#ifdef ONLY_PHASE
#define IN(k) ((k) == ONLY_PHASE && lo <= (k) && (k) < hi)
#else
#define IN(k) (lo <= (k) && (k) < hi)
#endif
#define SEAM(k) do { if (IN(k) && IN((k) + 1)) xcd_barrier(bar); } while (0)
#define RELANE() do { int t_ = threadIdx.x; asm volatile("" : "+v"(t_)); F.tid = t_; F.lane = t_ & 63; KArgs k_ = ka; asm volatile("" : "+s"(k_)); F.in = k_->in; F.out = k_->out; F.ws = k_->ws; } while (0)
#define WT (F.ws + WS_WT)
#define Hb ((bf16*)(F.ws + WS_H))
#define Yb ((bf16*)(F.ws + WS_Y))
#define Zb ((bf16*)(F.ws + WS_Z))

    if (IN(0)) { RELANE(); p0_prologue(F); rope_table(F); } SEAM(0);
    if (IN(1)) { RELANE(); p0b_modulate(F); } SEAM(1);

#define GEMM_PHASE16(EPI, Aptr, Bptr, M_, N_, K_) do { pg8::Gemm g{(const bf16*)(Aptr), (const bf16*)(Bptr), (M_), (N_), (K_)}; pg8::StaticOrder S; S.init((M_), (N_), F.G, (int)blockIdx.x); \
        pg8::gemm_phase<false>(F.lds, g, S, (EPI)); } while (0)
#define GEMM_PHASE(EPI, Aptr, Bptr, M_, N_, K_) do { pg8::Gemm g{(const bf16*)(Aptr), (const bf16*)(Bptr), (M_), (N_), (K_) / 2}; pg8::StaticOrder S; S.init((M_), (N_), F.G, (int)blockIdx.x); \
        pg8::gemm_phase<true>(F.lds, g, S, (EPI)); } while (0)
#define PEER_PHASES(L, PB, M_) do { \
        if (IN((PB) + 4)) { RELANE(); ln1_phase<L>(F, (M_)); } SEAM((PB) + 4); \
        if (IN((PB) + 5)) { RELANE(); EpiPlain E = epi_plain(Zb, 2048); \
            if ((PQ_FP8_MASK >> (L)) & 1) { GEMM_PHASE(E, Hb, WT + WT_PQ + (size_t)(L) * D * D * 2, (M_), 2048, 2048); } \
            else { E.oscale = 1.0f; GEMM_PHASE16(E, Yb, WT + WT_PQ + (size_t)(L) * D * D * 2, (M_), 2048, 2048); } } SEAM((PB) + 5); \
        if (IN((PB) + 6)) { RELANE(); peer_topk_phase<L>(F, (M_)); } SEAM((PB) + 6); \
        if (IN((PB) + 7)) { RELANE(); peer_u_phase<L>(F, (M_)); if (hi - lo > 1) xcd_barrier(bar); RELANE(); peer_v_phase<L>(F, (M_)); } SEAM((PB) + 7); } while (0)
#define MLSTM_PHASES(L, PB, M_) do { \
        if (IN((PB) + 0)) { RELANE(); pg8::EpiSeg<1> E; E.base = F.ws + WS_Z; E.ld = 0; E.bias = nullptr; E.gates = (float*)(F.ws + WS_GATE); E.oscale = 1.0f / WSCALE; \
            GEMM_PHASE(E, Hb, WT + WT_AIN + (size_t)((L) / 3) * A_INP * D, T, A_INP, 2048); } SEAM((PB) + 0); \
        if (IN((PB) + 1)) { RELANE(); mlstm_scan_phase<L>(F); } SEAM((PB) + 1); \
        if (IN((PB) + 2)) { RELANE(); mlstm_post_phase<L>(F, (M_)); } SEAM((PB) + 2); \
        if (IN((PB) + 3)) { RELANE(); EpiPlain E = epi_plain(Yb, 2048); GEMM_PHASE(E, F.ws + WS_Z + ZG, WT + WT_AOUT + (size_t)((L) / 3) * D * D, (M_), 2048, 2048); } SEAM((PB) + 3); } while (0)

    MLSTM_PHASES(0, 2, T);
    PEER_PHASES(0, 2, T);
    if (IN(10)) { RELANE(); pg8::EpiSeg<2> E; E.base = F.ws + WS_Z; E.ld = 0; E.bias = F.in[I_BBIN]; E.gates = nullptr; E.oscale = 1.0f / WSCALE; GEMM_PHASE(E, Hb, WT + WT_BIN, T, 8192, 2048); } SEAM(10);
    if (IN(11)) { RELANE(); gmlp_stats_phase(F, T); } SEAM(11);
    if (IN(12)) { RELANE(); gmlp_spatial_phase(F, T); } SEAM(12);
    if (IN(13)) { RELANE(); EpiPlain E = epi_plain(Yb, 2048); GEMM_PHASE(E, Hb, WT + WT_BOUT, T, 2048, 4096); } SEAM(13);
    PEER_PHASES(1, 10, T);
    if (IN(18)) { RELANE(); pg8::EpiSeg<3> E; E.base = F.ws + WS_Z; E.ld = 0; E.bias = nullptr; E.gates = nullptr; E.oscale = 1.0f / WSCALE; GEMM_PHASE(E, Hb, WT + WT_CQKV, T, C_QKV, 2048); } SEAM(18);
    if (IN(19)) { RELANE(); attn_prep_phase(F); } SEAM(19);
    if (IN(20)) { RELANE(); attn_phase(F, (char*)lds_raw, true); } SEAM(20);
    if (IN(21)) { RELANE(); EpiPlain E = epi_plain(Yb, 2048); GEMM_PHASE(E, Hb, WT + WT_COUT, T, 2048, 2048); } SEAM(21);
    PEER_PHASES(2, 18, T);
    MLSTM_PHASES(3, 26, TL);
    PEER_PHASES(3, 26, TL);
#undef IN
#undef SEAM
#undef WT
#undef Hb
#undef Yb
#undef Zb
}


extern "C" void kernel_launch(void* const* d_in, const int* in_sizes, int n_in, void* d_out, int out_size, void* d_ws, size_t ws_size, hipStream_t stream) {
    static int grid = 0;
    if (grid == 0) {
        if (n_in != 28 || out_size != TL * D || ws_size < WS_END) { fprintf(stderr, "kernel_launch: unexpected shapes: n_in %d out %d ws %zu (need %zu)\n", n_in, out_size, ws_size, (size_t)WS_END); grid = -1; return; }
        int dev = 0, cus = 0, per_cu = 0;
        if (hipGetDevice(&dev) != hipSuccess || hipDeviceGetAttribute(&cus, hipDeviceAttributeMultiprocessorCount, dev) != hipSuccess) { grid = -1; return; }
        if (hipFuncSetAttribute((const void*)fwd_kernel, hipFuncAttributeMaxDynamicSharedMemorySize, LDS_BYTES) != hipSuccess) { fprintf(stderr, "kernel_launch: hipFuncSetAttribute failed\n"); grid = -1; return; }
        if (hipOccupancyMaxActiveBlocksPerMultiprocessor(&per_cu, (const void*)fwd_kernel, NTHR, LDS_BYTES) != hipSuccess || per_cu < 1) { fprintf(stderr, "kernel_launch: occupancy query says %d\n", per_cu); }
        (void)hipGetLastError();
        grid = cus;
    }
    if (grid < 0) return;
    if (hipMemsetAsync((char*)d_ws + WS_CTL, 0, CTL_ZERO_BYTES, stream) != hipSuccess) return;
    Args a{};
    for (int i = 0; i < 28; ++i) a.in[i] = (const float*)d_in[i];
    a.out = (float*)d_out; a.ws = (unsigned char*)d_ws;
#if MK_N_LAUNCHES == 1
    a.ph_lo = 0; a.ph_hi = NPH;
    hipLaunchKernelGGL(fwd_kernel, dim3(grid), dim3(NTHR), LDS_BYTES, stream, a);
#else
    for (int k = 0; k < NPH; ++k) { a.ph_lo = k; a.ph_hi = k + 1; hipLaunchKernelGGL(fwd_kernel, dim3(grid), dim3(NTHR), LDS_BYTES, stream, a); }
#endif
    const hipError_t le = hipPeekAtLastError();
    if (le != hipSuccess) fprintf(stderr, "kernel_launch: launch failed: %s\n", hipGetErrorName(le));
}
```

```cpp
#include <hip/hip_runtime.h>
#include <cstdio>
#include <cstdint>

#define GAS __attribute__((address_space(1)))
#define LAS __attribute__((address_space(3)))
typedef unsigned short bf16;
typedef unsigned v4u __attribute__((ext_vector_type(4)));
typedef unsigned v2u __attribute__((ext_vector_type(2)));
typedef float f32x4 __attribute__((ext_vector_type(4)));
typedef float f32x2 __attribute__((ext_vector_type(2)));
typedef short bf16x8 __attribute__((ext_vector_type(8)));
typedef short s16x4 __attribute__((ext_vector_type(4)));
typedef int v8i_t __attribute__((ext_vector_type(8)));
typedef int v4i_t __attribute__((ext_vector_type(4)));
#define LDS_WAIT() asm volatile("s_waitcnt lgkmcnt(0)" ::: "memory")
#define VM_WAIT() asm volatile("s_waitcnt vmcnt(0)" ::: "memory")

constexpr int D = 2048, NB = 8, SEQ = 4096, CL = 256, DEPTH = 4;
constexpr int TL = NB * SEQ, TC = NB * CL, T = TL + TC;
constexpr int NMOD = 6 * D;
constexpr float ALPHA = 1.681792830507429f;
constexpr float LN_EPS = 1e-6f;
constexpr int A_HEADS = 4, A_DV = 512, A_DK = 256, A_CHUNK = 128, A_IN = 6160, A_INP = 6400;
constexpr int B_INNER = 4096, B_GROUPS = 8;
constexpr int C_HEADS = 16, C_KV = 4, C_HD = 128, C_QKV = 3072, SKV = SEQ + CL;
constexpr int P_HEADS = 8, P_NK = 128, P_TOPK = 16, P_E = 16384;
constexpr int NWAVES = 8, NTHR = 512;

constexpr size_t MiB = 1u << 20;
constexpr size_t WS_CTL = 0, CTL_ZERO_BYTES = 1 * MiB;
constexpr size_t WS_MOD = 1 * MiB;
constexpr size_t WS_STAT = 3 * MiB;
constexpr size_t WS_GATE = 4 * MiB;
constexpr size_t WS_K12 = 7 * MiB;
constexpr size_t WS_WS = 8 * MiB;
constexpr size_t WS_WT = 9 * MiB;
constexpr size_t WT_AIN = 0, WT_AOUT = WT_AIN + (size_t)2 * A_INP * D, WT_BIN = WT_AOUT + (size_t)2 * D * D, WT_BOUT = WT_BIN + (size_t)8192 * D,
                 WT_CQKV = WT_BOUT + (size_t)D * 4096, WT_COUT = WT_CQKV + (size_t)C_QKV * D, WT_PQ = WT_COUT + (size_t)D * D, WT_END = WT_PQ + (size_t)4 * D * D * 2;
constexpr int PQ_FP8_MASK = 0x3;
constexpr float WSCALE = 64.0f;
constexpr size_t WS_PU8 = 192 * MiB;
constexpr size_t WS_PV8 = WS_PU8 + (size_t)4 * P_E * D;
constexpr size_t WS_SC = WS_PV8 + (size_t)4 * P_E * D;
constexpr size_t WS_X = WS_SC + 1 * MiB;
constexpr size_t WS_GP = WS_X + (size_t)T * D * 2;
constexpr size_t WS_H = WS_X + (size_t)T * D * 4;
constexpr size_t WS_Y = WS_H + (size_t)T * D * 2;
constexpr size_t WS_Z = WS_Y + (size_t)T * D * 2;
constexpr size_t WS_IDX = WS_Z + (size_t)T * 8192 * 2;
constexpr size_t WS_PG = WS_IDX + (size_t)T * 128 * 4;
constexpr size_t WS_END = WS_PG + (size_t)T * 128 * 4;
static_assert(WS_WT + WT_END <= WS_PU8, "weights fit");
constexpr size_t ZQ = 0, ZK = (size_t)T * 1024 * 2, ZV = ZK + (size_t)T * 1024 * 2, ZO = ZV + (size_t)T * 2048 * 2, ZG = 0;
constexpr size_t ZU = 0, ZVV = (size_t)T * 4096 * 2;
constexpr size_t ZAQ = 0, ZAK = (size_t)T * 2048 * 2, ZAV = ZAK + (size_t)T * 512 * 2, ZKC = ZAV + (size_t)T * 512 * 2, ZVC = ZKC + (size_t)NB * SKV * 512 * 2;
constexpr int CW_BAR = 4096;

constexpr int LDS_BYTES = 155648;
constexpr int MISC_OFF = 151552;

typedef __bf16 bf16x2_t __attribute__((ext_vector_type(2)));
__device__ __forceinline__ unsigned cvt_pk_bf16(float lo, float hi) { const f32x2 v = {lo, hi}; return __builtin_bit_cast(unsigned, __builtin_convertvector(v, bf16x2_t)); }
__device__ __forceinline__ unsigned pk4_fp8(float a, float b, float c, float d) { int w = __builtin_amdgcn_cvt_pk_fp8_f32(a, b, 0, false); return (unsigned)__builtin_amdgcn_cvt_pk_fp8_f32(c, d, w, true); }
typedef float f32x16_t __attribute__((ext_vector_type(16)));
__device__ __forceinline__ f32x4 zero4() { f32x4 z = {0.f, 0.f, 0.f, 0.f}; asm volatile("" : "+v"(z)); return z; }
__device__ __forceinline__ f32x16_t zero16() { f32x16_t z = {}; asm volatile("" : "+v"(z)); return z; }
__device__ __forceinline__ float bf_lo(unsigned u) { return __uint_as_float(u << 16); }
__device__ __forceinline__ float bf_hi(unsigned u) { return __uint_as_float(u & 0xffff0000u); }
__device__ __forceinline__ float bf2f(bf16 b) { return __uint_as_float(((unsigned)b) << 16); }
__device__ __forceinline__ float wave_sum(float v) {
#pragma unroll
    for (int o = 1; o < 64; o <<= 1) v += __shfl_xor(v, o);
    return v;
}
__device__ __forceinline__ float wave_max(float v) {
#pragma unroll
    for (int o = 1; o < 64; o <<= 1) v = fmaxf(v, __shfl_xor(v, o));
    return v;
}
__device__ __forceinline__ float fast_exp(float x) { return __builtin_amdgcn_exp2f(x * 1.4426950408889634f); }
__device__ __forceinline__ float gelu_tanh(float x) {
    const float u = 0.7978845608028654f * (x + 0.044715f * x * x * x);
    const float e = __builtin_amdgcn_exp2f(-2.0f * 1.4426950408889634f * u);
    return x * __builtin_amdgcn_rcpf(1.0f + e);
}
__device__ __forceinline__ float silu(float x) { return x / (1.0f + __expf(-x)); }

#define XB_TMO      128
#define XB_XCNT(j)  (256  + 64 * (j))
#define XB_XSUB(j)  (1280 + 64 * (j))
#define XB_XGEN(j)  (2304 + 64 * (j))
#define XB_TOP      3328
#define XB_TOPGEN   3392
#define XCD_BAR_WORDS 3456
#define XB_SPIN_CAP (1u << 22)

__device__ __forceinline__ unsigned xb_ld(unsigned* p)              { return __hip_atomic_load(p, __ATOMIC_RELAXED, __HIP_MEMORY_SCOPE_AGENT); }
__device__ __forceinline__ unsigned xb_add(unsigned* p, unsigned v) { return __hip_atomic_fetch_add(p, v, __ATOMIC_RELAXED, __HIP_MEMORY_SCOPE_AGENT); }
__device__ __forceinline__ unsigned xb_xcc_id() { return (unsigned)__builtin_amdgcn_s_getreg((3 << 11) | 20) & 0xFu; }
#define XB_SPIN(cond, bar) do { unsigned _sp = 0; while (cond) { __builtin_amdgcn_s_sleep(1); \
    if ((++_sp & 255u) == 0u) { if (xb_ld(&(bar)[XB_TMO])) break; if (_sp > XB_SPIN_CAP) { atomicAdd(&(bar)[XB_TMO], 1u); break; } } } } while (0)

struct XcdBarrier { unsigned* bar; unsigned x; volatile LAS unsigned* st; };
__device__ __forceinline__ XcdBarrier xcd_barrier_post(unsigned* bar, volatile LAS unsigned* st) {
    XcdBarrier b; b.bar = bar; b.x = xb_xcc_id(); b.st = st;
    if (threadIdx.x == 0) (void)xb_add(&bar[XB_XCNT(b.x)], 1u);
    return b;
}
__device__ __forceinline__ void xcd_barrier_complete(unsigned* bar, unsigned x, unsigned& nloc, unsigned& nx) {
    const unsigned G = gridDim.x * gridDim.y * gridDim.z;
    unsigned sum, cnt, mine, sp = 0u;
    for (;;) {
        sum = 0u; cnt = 0u; mine = 0u;
#pragma unroll
        for (unsigned j = 0; j < 16; ++j) { const unsigned c = xb_ld(&bar[XB_XCNT(j)]); sum += c; cnt += (c > 0u) ? 1u : 0u; mine = (j == x) ? c : mine; }
        if (sum == G) break;
        __builtin_amdgcn_s_sleep(1);
        if ((++sp & 255u) == 0u) { if (xb_ld(&bar[XB_TMO])) break; if (sp > XB_SPIN_CAP) { atomicAdd(&bar[XB_TMO], 1u); break; } }
    }
    nloc = mine > 0u ? mine : 1u; nx = cnt > 0u ? cnt : 1u;
}
__device__ __forceinline__ void xcd_barrier(const XcdBarrier& b) {
    asm volatile("s_waitcnt vmcnt(0)" ::: "memory");
    __syncthreads();
    if (threadIdx.x == 0) {
        unsigned* bar = b.bar;
        __builtin_amdgcn_s_waitcnt(0);
        unsigned nloc = b.st[0], nx = b.st[1];
        if (nloc == 0u) { xcd_barrier_complete(bar, b.x, nloc, nx); b.st[0] = nloc; b.st[1] = nx; }
        const unsigned old = xb_add(&bar[XB_XSUB(b.x)], 1u);
        const unsigned gen = old / nloc;
        if (old + 1u == (gen + 1u) * nloc) {
            __builtin_amdgcn_fence(__ATOMIC_RELEASE, "agent");
            asm volatile("s_waitcnt vmcnt(0)" ::: "memory");
            const unsigned og = xb_add(&bar[XB_TOP], 1u);
            const unsigned tg = og / nx;
            if (og + 1u == (tg + 1u) * nx) xb_add(&bar[XB_TOPGEN], 1u);
            else XB_SPIN(xb_ld(&bar[XB_TOPGEN]) == tg, bar);
            __builtin_amdgcn_fence(__ATOMIC_ACQUIRE, "agent");
            xb_add(&bar[XB_XGEN(b.x)], 1u);
            asm volatile("s_waitcnt vmcnt(0)" ::: "memory");
        } else {
            XB_SPIN(xb_ld(&bar[XB_XGEN(b.x)]) == gen, bar);
            __builtin_amdgcn_fence(__ATOMIC_ACQUIRE, "agent");
            asm volatile("s_waitcnt vmcnt(0)" ::: "memory");
        }
    }
    __syncthreads();
}

namespace pg8 {
#define PG8_LAS __attribute__((address_space(3)))
typedef unsigned short bf16_t;
typedef unsigned u32x4 __attribute__((ext_vector_type(4)));
using ::v4i_t; using ::v8i_t;
constexpr int BM = 256, BK = 64, HALF = 128, HTB = HALF * BK * 2, STAGE_BYTES = 8 * HTB, NXCD = 8, WGM = 8;
__host__ __device__ __forceinline__ int lds_byte(int r, int c) { const int st = (r >> 4) * 2 + (c >> 5), rr = r & 15, cc = c & 31, ob = rr * 64 + cc * 2; return st * 1024 + (ob ^ (((ob >> 9) & 1) << 5)); }
__host__ __device__ __forceinline__ void stage_rc(int b, int& R, int& C) { const int st = b / 1024, sb = b % 1024, swz = sb ^ (((sb >> 9) & 1) << 5); R = (st >> 1) * 16 + swz / 64; C = (st & 1) * 32 + (swz % 64) / 2; }
__host__ __device__ __forceinline__ int perm32(int rho) { const int n = rho >> 4, i = rho & 15; return 8 * (i >> 2) + 4 * n + (i & 3); }
struct Unit { int pm, pn; };
struct Gemm { const bf16_t* A; const bf16_t* Bt; int M, N, K; };
struct StaticOrder {
    int nM, nN, nwg, G, c;
    __host__ __device__ void init(int M, int N, int G_, int c_) { nM = M / BM; nN = N / BM; nwg = nM * nN; G = G_; c = c_; }
    __host__ __device__ bool next(int i, Unit& u) const {
        const long L = (long)i * G + c; if (L >= nwg) return false;
        int wgid = (int)L; { const int q = nwg / NXCD, r = nwg % NXCD, xcd = wgid % NXCD, off = wgid / NXCD; wgid = (xcd < r ? xcd * (q + 1) : r * (q + 1) + (xcd - r) * q) + off; }
        const int nig = WGM * nN, gid = wgid / nig, fm = gid * WGM, gsz = (nM - fm) < WGM ? (nM - fm) : WGM;
        u.pm = fm + ((wgid % nig) % gsz); u.pn = (wgid % nig) / gsz; return true;
    }
    __device__ __forceinline__ void a_ready(const Unit&) const {}
    __device__ __forceinline__ void done(const Unit&) const {}
};
template <int MODE> struct EpiSeg {
    static constexpr bool PERM = true, AFTER_DRAIN = false;
    unsigned char* base; int ld; const float* bias; float* gates; float oscale;
    __device__ __forceinline__ void operator()(const f32x4 (&acc)[2][2][4][2], const Unit& u, int wr, int wc, int fr, int fq) const {
        const int row0 = u.pm * BM + wr * 64 + fr;
        if (MODE == 1 && u.pn >= 24) {
            if (wc == 0 && fq < 2) {
#pragma unroll
                for (int ai = 0; ai < 2; ++ai)
#pragma unroll
                    for (int m = 0; m < 4; ++m) { float* rp = gates + (size_t)(row0 + ai * HALF + m * 16) * 16 + 8 * fq;
                        *(f32x4*)(rp) = acc[ai][0][m][0] * oscale; *(f32x4*)(rp + 4) = acc[ai][0][m][1] * oscale; }
            }
        } else {
        size_t off = 0; int ldc = ld, tb = 0;
        if (MODE == 1) { ldc = u.pn < 8 ? 1024 : 2048; tb = u.pn < 4 ? 0 : u.pn < 8 ? 4 : u.pn < 16 ? 8 : 16; off = u.pn < 4 ? ZQ : u.pn < 8 ? ZK : u.pn < 16 ? ZV : ZO; }
        if (MODE == 2) { ldc = 4096; tb = u.pn < 16 ? 0 : 16; off = u.pn < 16 ? ZU : ZVV; }
        if (MODE == 3) { ldc = u.pn < 8 ? 2048 : 512; tb = u.pn < 8 ? 0 : u.pn < 10 ? 8 : 10; off = u.pn < 8 ? ZAQ : u.pn < 10 ? ZAK : ZAV; }
        bf16_t* ob = (bf16_t*)(base + off);
        const int col0 = (u.pn - tb) * BM + wc * 32 + 8 * fq, bcol0 = u.pn * BM + wc * 32 + 8 * fq;
        f32x4 bv[2][2];
#pragma unroll
        for (int bj = 0; bj < 2; ++bj)
#pragma unroll
            for (int n = 0; n < 2; ++n) bv[bj][n] = (MODE == 2) ? *(const f32x4*)(bias + bcol0 + bj * HALF + 4 * n) : (f32x4){0.f, 0.f, 0.f, 0.f};
        const int lid = fr + 16 * fq, frp = 4 * (lid >> 4) + ((lid >> 2) & 3), fqp = lid & 3, srcl = frp + 16 * fqp;
        const int row0p = row0 - fr + frp, col0p = col0 - 8 * fq + 8 * fqp;
#pragma unroll
        for (int ai = 0; ai < 2; ++ai)
#pragma unroll
            for (int m = 0; m < 4; ++m) { bf16_t* rowp = ob + (size_t)(row0p + ai * HALF + m * 16) * ldc + col0p;
#pragma unroll
                for (int bj = 0; bj < 2; ++bj) { f32x4 v0 = acc[ai][bj][m][0] * oscale + bv[bj][0], v1 = acc[ai][bj][m][1] * oscale + bv[bj][1];
                    if (MODE == 2) {
#pragma unroll
                        for (int j = 0; j < 4; ++j) { v0[j] = gelu_tanh(v0[j]); v1[j] = gelu_tanh(v1[j]); } }
                    u32x4 w; w.x = (unsigned)__shfl((int)cvt_pk_bf16(v0[0], v0[1]), srcl); w.y = (unsigned)__shfl((int)cvt_pk_bf16(v0[2], v0[3]), srcl);
                    w.z = (unsigned)__shfl((int)cvt_pk_bf16(v1[0], v1[1]), srcl); w.w = (unsigned)__shfl((int)cvt_pk_bf16(v1[2], v1[3]), srcl);
                    *(u32x4*)(rowp + bj * HALF) = w; } }
        }
    }
};
template <bool FP8, class Epi, class Sched>
__device__ __forceinline__ void gemm_phase(PG8_LAS unsigned char* lds, const Gemm g, const Sched& S, const Epi& E) {
    const int tid = threadIdx.x, wid = __builtin_amdgcn_readfirstlane(tid >> 6), lane = tid & 63, wr = wid >> 2, wc = wid & 3, fr = lane & 15, fq = lane >> 4;
    const int K = g.K, nt = K / BK;
    unsigned voffA[2], voffB[2];
#pragma unroll
    for (int i = 0; i < 2; ++i) { int R, C; stage_rc(tid * 16 + i * 8192, R, C); const int Rb = Epi::PERM ? ((R & ~31) + perm32(R & 31)) : R;
        voffA[i] = (unsigned)(R * K + C) * 2u; voffB[i] = (unsigned)(Rb * K + C) * 2u; }
    const size_t kstep = (size_t)(BK * 2);
    const size_t hstep = (size_t)HALF * K * 2;
    const size_t tstep = 2 * hstep;
    const unsigned ldsw = (unsigned)wid * 1024u;
    const int aoff = lds_byte(wr * 64 + fr, fq * 8), boff = lds_byte(wc * 32 + fr, fq * 8);
#define PG8_SA(b, h) (((b) * 2 + (h)) * HTB)
#define PG8_SB(b, h) ((4 + (b) * 2 + (h)) * HTB)
#define PG8_STAGE(bufoff, gbase, voff) do { _Pragma("unroll") for (int _i = 0; _i < 2; ++_i) \
        __builtin_amdgcn_global_load_lds((const unsigned*)((const char*)(gbase) + (voff)[_i]), (PG8_LAS unsigned*)(lds + (bufoff) + ldsw + _i * 8192), 16, 0, 0); } while (0)
#define PG8_LDH(dst8, addr) do { const v4i_t lo_ = *(const PG8_LAS v4i_t*)(addr), hi_ = *(const PG8_LAS v4i_t*)((addr) + 1024); dst8 = __builtin_shufflevector(lo_, hi_, 0, 1, 2, 3, 4, 5, 6, 7); } while (0)
#define PG8_LDA(dst, b, h) do { _Pragma("unroll") for (int m = 0; m < 4; ++m) PG8_LDH(dst[m], lds + PG8_SA(b, h) + aoff + m * 2048); } while (0)
#define PG8_LDB(dst, b, h) do { _Pragma("unroll") for (int n = 0; n < 2; ++n) PG8_LDH(dst[n], lds + PG8_SB(b, h) + boff + n * 2048); } while (0)
#define PG8_HALF(v8, k) __builtin_bit_cast(bf16x8, __builtin_shufflevector(v8, v8, 4 * (k), 4 * (k) + 1, 4 * (k) + 2, 4 * (k) + 3))
#define PG8_MMA(ai, bj, At, Bt) do { __builtin_amdgcn_s_setprio(1); _Pragma("unroll") for (int m = 0; m < 4; ++m) _Pragma("unroll") for (int n = 0; n < 2; ++n) { \
        acc[ai][bj][m][n] = __builtin_amdgcn_mfma_f32_16x16x32_bf16(PG8_HALF(Bt[n], 0), PG8_HALF(At[m], 0), acc[ai][bj][m][n], 0, 0, 0); \
        acc[ai][bj][m][n] = __builtin_amdgcn_mfma_f32_16x16x32_bf16(PG8_HALF(Bt[n], 1), PG8_HALF(At[m], 1), acc[ai][bj][m][n], 0, 0, 0); } __builtin_amdgcn_s_setprio(0); } while (0)
#define PG8_MMA8(ai, bj, At, Bt) do { __builtin_amdgcn_s_setprio(1); _Pragma("unroll") for (int m = 0; m < 4; ++m) _Pragma("unroll") for (int n = 0; n < 2; ++n) \
        asm volatile("v_mfma_scale_f32_16x16x128_f8f6f4 %0, %1, %2, %0, %3, %3 op_sel_hi:[0,0,0]" : "+v"(acc[ai][bj][m][n]) : "v"(Bt[n]), "v"(At[m]), "v"(mxs)); __builtin_amdgcn_s_setprio(0); } while (0)
#define PG8_MMA8_DRAIN() asm volatile("s_nop 15\n\ts_nop 15" ::: "memory")
#define PG8_WAIT_V(n) asm volatile("s_waitcnt vmcnt(" #n ")" ::: "memory")
#define PG8_WAIT_L(n) asm volatile("s_waitcnt lgkmcnt(" #n ")" ::: "memory")
#define PG8_BAR __builtin_amdgcn_s_barrier()
#define PG8_SCHED __builtin_amdgcn_sched_barrier(0)
    Unit cur, nxt; int ui = 0;
    if (!S.next(0, cur)) return;
    f32x4 acc[2][2][4][2];
#pragma unroll
    for (int a = 0; a < 2; ++a)
#pragma unroll
        for (int b = 0; b < 2; ++b)
#pragma unroll
            for (int m = 0; m < 4; ++m)
#pragma unroll
                for (int n = 0; n < 2; ++n) acc[a][b][m][n] = (f32x4){0.f, 0.f, 0.f, 0.f};
    v8i_t At[4], B0[2], B1[2]; int mxs = 0x7f7f7f7f; asm volatile("" : "+v"(mxs));
    const char* cA = (const char*)g.A + (size_t)cur.pm * tstep; const char* cB = (const char*)g.Bt + (size_t)cur.pn * tstep;
    S.a_ready(cur);
    PG8_STAGE(PG8_SB(0, 0), cB, voffB); PG8_STAGE(PG8_SA(0, 0), cA, voffA); PG8_STAGE(PG8_SB(0, 1), cB + hstep, voffB); PG8_STAGE(PG8_SA(0, 1), cA + hstep, voffA);
    if (wr == 1) PG8_BAR;
    PG8_WAIT_V(4); PG8_BAR;
    PG8_STAGE(PG8_SB(1, 0), cB + kstep, voffB); PG8_STAGE(PG8_SA(1, 0), cA + kstep, voffA); PG8_STAGE(PG8_SB(1, 1), cB + hstep + kstep, voffB);
    PG8_WAIT_V(6); PG8_BAR;
    for (;;) {
        const bool has_next = S.next(ui + 1, nxt);
        const char* nA = has_next ? (const char*)g.A + (size_t)nxt.pm * tstep : cA; const char* nB = has_next ? (const char*)g.Bt + (size_t)nxt.pn * tstep : cB;
        for (int t = 0; t < nt; t += 2) {
            const bool last = (t == nt - 2);
            const char* a1 = cA + (size_t)(t + 1) * kstep;
            const char* a2 = last ? nA : cA + (size_t)(t + 2) * kstep; const char* b2 = last ? nB : cB + (size_t)(t + 2) * kstep;
            const char* a3 = a2 + kstep; const char* b3 = b2 + kstep;
            if (last && has_next) S.a_ready(nxt);
            PG8_LDB(B0, 0, 0); PG8_SCHED; PG8_LDA(At, 0, 0); PG8_STAGE(PG8_SA(1, 1), a1 + hstep, voffA);
            PG8_WAIT_L(8); PG8_BAR; PG8_WAIT_L(0); do { if constexpr (FP8) PG8_MMA8(0, 0, At, B0); else PG8_MMA(0, 0, At, B0); } while (0); PG8_BAR; PG8_SCHED;
            PG8_LDB(B1, 0, 1); PG8_STAGE(PG8_SB(0, 0), b2, voffB);
            PG8_BAR; PG8_WAIT_L(0); do { if constexpr (FP8) PG8_MMA8(0, 1, At, B1); else PG8_MMA(0, 1, At, B1); } while (0); PG8_BAR;
            PG8_LDA(At, 0, 1); PG8_STAGE(PG8_SA(0, 0), a2, voffA);
            PG8_BAR; PG8_WAIT_L(0); do { if constexpr (FP8) PG8_MMA8(1, 0, At, B0); else PG8_MMA(1, 0, At, B0); } while (0); PG8_BAR; PG8_SCHED;
            PG8_STAGE(PG8_SB(0, 1), b2 + hstep, voffB);
            PG8_WAIT_V(6); PG8_BAR; do { if constexpr (FP8) PG8_MMA8(1, 1, At, B1); else PG8_MMA(1, 1, At, B1); } while (0); PG8_BAR;
            PG8_LDB(B0, 1, 0); PG8_SCHED; PG8_LDA(At, 1, 0); PG8_STAGE(PG8_SA(0, 1), a2 + hstep, voffA);
            PG8_WAIT_L(8); PG8_BAR; PG8_WAIT_L(0); do { if constexpr (FP8) PG8_MMA8(0, 0, At, B0); else PG8_MMA(0, 0, At, B0); } while (0); PG8_BAR; PG8_SCHED;
            PG8_LDB(B1, 1, 1); PG8_STAGE(PG8_SB(1, 0), b3, voffB);
            PG8_BAR; PG8_WAIT_L(0); do { if constexpr (FP8) PG8_MMA8(0, 1, At, B1); else PG8_MMA(0, 1, At, B1); } while (0); PG8_BAR;
            PG8_LDA(At, 1, 1); PG8_STAGE(PG8_SA(1, 0), a3, voffA);
            PG8_BAR; PG8_WAIT_L(0); do { if constexpr (FP8) PG8_MMA8(1, 0, At, B0); else PG8_MMA(1, 0, At, B0); } while (0); PG8_BAR; PG8_SCHED;
            PG8_STAGE(PG8_SB(1, 1), b3 + hstep, voffB);
            PG8_WAIT_V(6); PG8_BAR; do { if constexpr (FP8) PG8_MMA8(1, 1, At, B1); else PG8_MMA(1, 1, At, B1); } while (0); PG8_BAR;
        }
        if constexpr (FP8) PG8_MMA8_DRAIN();
        if constexpr (!Epi::AFTER_DRAIN) { E(acc, cur, wr, wc, fr, fq); S.done(cur); }
        if (!has_next) break;
#pragma unroll
        for (int a = 0; a < 2; ++a)
#pragma unroll
            for (int b = 0; b < 2; ++b)
#pragma unroll
                for (int m = 0; m < 4; ++m)
#pragma unroll
                    for (int n = 0; n < 2; ++n) acc[a][b][m][n] = (f32x4){0.f, 0.f, 0.f, 0.f};
        cur = nxt; cA = nA; cB = nB; ++ui;
    }
    PG8_WAIT_V(0);
    if (wr == 0) PG8_BAR;
    PG8_BAR;
    if constexpr (Epi::AFTER_DRAIN) { E.fused(acc, cur, wr, wc, fr, fq, lds, wid, lane); S.done(cur); }
#undef PG8_SA
#undef PG8_SB
#undef PG8_STAGE
#undef PG8_LDA
#undef PG8_LDH
#undef PG8_HALF
#undef PG8_LDB
#undef PG8_MMA
#undef PG8_MMA8
#undef PG8_MMA8_DRAIN
#undef PG8_WAIT_V
#undef PG8_WAIT_L
#undef PG8_BAR
#undef PG8_SCHED
}
}

struct Frame {
    LAS unsigned char* lds;
    int tid, lane, wave, vcu, G;
    const float* const __attribute__((address_space(4)))* in;
    float* out; unsigned char* ws;
};
enum { I_X = 0, I_C, I_CTX, I_CCTX, I_WMOD, I_BMOD, I_LNG, I_LNB, I_AWIN, I_ABG, I_ANG, I_AWOUT, I_BWIN, I_BBIN, I_BLNG, I_BLNB, I_BWS, I_BBS, I_BWOUT,
       I_CWQKV, I_CQG, I_CKG, I_CWOUT, I_PWQ, I_PK1, I_PK2, I_PU, I_PV };

template <int CTRL> __device__ __forceinline__ float dpp_mov(float v) { return __builtin_bit_cast(float, __builtin_amdgcn_update_dpp(0, __builtin_bit_cast(int, v), CTRL, 0xf, 0xf, false)); }
__device__ __forceinline__ float row16_sum(float v) {
    v += dpp_mov<0x128>(v);
    v += dpp_mov<0x124>(v);
    v += dpp_mov<0x122>(v);
    v += dpp_mov<0x121>(v);
    return v;
}
__device__ __forceinline__ float row16_max(float v) {
    v = fmaxf(v, dpp_mov<0x128>(v)); v = fmaxf(v, dpp_mov<0x124>(v)); v = fmaxf(v, dpp_mov<0x122>(v)); v = fmaxf(v, dpp_mov<0x121>(v));
    return v;
}
__device__ __forceinline__ float rl(float v, int l) { return __builtin_bit_cast(float, __builtin_amdgcn_readlane(__builtin_bit_cast(int, v), l)); }
__device__ __forceinline__ float wsum(float v) { v = row16_sum(v); return (rl(v, 0) + rl(v, 16)) + (rl(v, 32) + rl(v, 48)); }

__device__ __forceinline__ const float* mod_row(const Frame& F, int layer, int row) {
    const int b9 = row < TL ? (row >> 12) : 8;
    return (const float*)(F.ws + WS_MOD) + (size_t)(layer * 9 + b9) * NMOD;
}

__device__ __forceinline__ void p0_transpose_item(const float* W, int ldw, int K, int nblk, unsigned char* WT, LAS float* scr, int item, int lane) {
    const int kb = item / nblk, nb = item % nblk, k0 = 64 * kb, n0 = 32 * nb;
    f32x4 t[8];
#pragma unroll
    for (int i = 0; i < 8; ++i) t[i] = *(const f32x4*)(W + (size_t)(k0 + 8 * i + (lane >> 3)) * ldw + n0 + 4 * (lane & 7));
#pragma unroll
    for (int i = 0; i < 8; ++i) { LAS float* d = scr + (8 * i + (lane >> 3)) * 33 + 4 * (lane & 7); d[0] = t[i][0] * WSCALE; d[1] = t[i][1] * WSCALE; d[2] = t[i][2] * WSCALE; d[3] = t[i][3] * WSCALE; }
    LDS_WAIT(); asm volatile("" ::: "memory");
    const int c = lane & 7;
#pragma unroll
    for (int j = 0; j < 4; ++j) { const int n = (lane >> 3) + 8 * j; const LAS float* s = scr + (8 * c) * 33 + n;
        v2u o; o.x = pk4_fp8(s[0 * 33], s[1 * 33], s[2 * 33], s[3 * 33]); o.y = pk4_fp8(s[4 * 33], s[5 * 33], s[6 * 33], s[7 * 33]);
        *(v2u*)(WT + (size_t)(n0 + n) * K + k0 + 8 * c) = o; }
    LDS_WAIT(); asm volatile("" ::: "memory");
}
__device__ __forceinline__ void p0_transpose_item_bf16(const float* W, int ldw, int K, int nblk, bf16* WT, LAS float* scr, int item, int lane) {
    const int kb = item / nblk, nb = item % nblk, k0 = 64 * kb, n0 = 32 * nb;
    f32x4 t[8];
#pragma unroll
    for (int i = 0; i < 8; ++i) t[i] = *(const f32x4*)(W + (size_t)(k0 + 8 * i + (lane >> 3)) * ldw + n0 + 4 * (lane & 7));
#pragma unroll
    for (int i = 0; i < 8; ++i) { LAS float* d = scr + (8 * i + (lane >> 3)) * 33 + 4 * (lane & 7); d[0] = t[i][0]; d[1] = t[i][1]; d[2] = t[i][2]; d[3] = t[i][3]; }
    LDS_WAIT(); asm volatile("" ::: "memory");
    const int c = lane & 7;
#pragma unroll
    for (int j = 0; j < 4; ++j) { const int n = (lane >> 3) + 8 * j; const LAS float* s = scr + (8 * c) * 33 + n;
        v4u o; o.x = cvt_pk_bf16(s[0 * 33], s[1 * 33]); o.y = cvt_pk_bf16(s[2 * 33], s[3 * 33]); o.z = cvt_pk_bf16(s[4 * 33], s[5 * 33]); o.w = cvt_pk_bf16(s[6 * 33], s[7 * 33]);
        *(v4u*)(WT + (size_t)(n0 + n) * K + k0 + 8 * c) = o; }
    LDS_WAIT(); asm volatile("" ::: "memory");
}
__device__ __forceinline__ void cvt_linear(const float* src, bf16* dst, size_t n8, size_t i0, size_t stride) {
    for (size_t i = i0; i < n8; i += stride) {
        const f32x4 a = *(const f32x4*)(src + i * 8), b = *(const f32x4*)(src + i * 8 + 4);
        v4u o; o.x = cvt_pk_bf16(a[0], a[1]); o.y = cvt_pk_bf16(a[2], a[3]); o.z = cvt_pk_bf16(b[0], b[1]); o.w = cvt_pk_bf16(b[2], b[3]);
        *(v4u*)(dst + i * 8) = o;
    }
}
__device__ __forceinline__ void p0_prologue(Frame& F) {
    {
        LAS float* sc = (LAS float*)F.lds;
        LAS float* part = (LAS float*)(F.lds + 9 * 2048 * 4);
        for (int i = F.tid; i < 9 * 2048; i += NTHR) { const int r = i >> 11, k = i & 2047; const float c = r < 8 ? F.in[I_C][r * D + k] : F.in[I_CCTX][k]; sc[i] = silu(c); }
        __syncthreads();
        float* MOD = (float*)(F.ws + WS_MOD);
        for (int item = F.vcu; item < 4 * 192; item += F.G) {
            const int l = item / 192, cg = item % 192, c = cg * 64 + F.lane;
            const float* Wm = F.in[I_WMOD] + ((size_t)l * D + F.wave * 256) * NMOD + c;
            float acc[9];
#pragma unroll
            for (int r = 0; r < 9; ++r) acc[r] = 0.f;
            for (int k0 = 0; k0 < 256; k0 += 32) {
                float w[32];
#pragma unroll
                for (int u = 0; u < 32; ++u) w[u] = Wm[(size_t)(k0 + u) * NMOD];
#pragma unroll
                for (int u = 0; u < 32; ++u)
#pragma unroll
                    for (int r = 0; r < 9; ++r) acc[r] += sc[r * 2048 + F.wave * 256 + k0 + u] * w[u];
            }
#pragma unroll
            for (int r = 0; r < 9; ++r) part[(F.wave * 9 + r) * 64 + F.lane] = acc[r];
            __syncthreads();
            for (int i = F.tid; i < 9 * 64; i += NTHR) { const int r = i >> 6, ln = i & 63; float s = 0.f;
#pragma unroll
                for (int w = 0; w < 8; ++w) s += part[(w * 9 + r) * 64 + ln];
                MOD[(size_t)(l * 9 + r) * NMOD + cg * 64 + ln] = s + F.in[I_BMOD][l * NMOD + cg * 64 + ln]; }
            __syncthreads();
        }
    }
    {
        LAS float* scr = (LAS float*)(F.lds + F.wave * 16384);
        const int gw = F.vcu * NWAVES + F.wave, NGW = F.G * NWAVES;
        unsigned char* WT = F.ws + WS_WT;
        constexpr int I_A = 32 * 192, I_SQ = 32 * 64, I_BI = 32 * 256, I_BO = 64 * 64, I_CQ = 32 * 96;
        constexpr int NITEMS = 2 * I_A + 2 * I_SQ + I_BI + I_BO + I_CQ + I_SQ + 4 * I_SQ;
        for (int it = gw; it < NITEMS; it += NGW) {
            int r = it;
            if (r < 2 * I_A) { const int j = r / I_A; p0_transpose_item(F.in[I_AWIN] + (size_t)j * D * A_IN, A_IN, D, 192, WT + WT_AIN + (size_t)j * A_INP * D, scr, r % I_A, F.lane); continue; } r -= 2 * I_A;
            if (r < 2 * I_SQ) { const int j = r / I_SQ; p0_transpose_item(F.in[I_AWOUT] + (size_t)j * D * D, D, D, 64, WT + WT_AOUT + (size_t)j * D * D, scr, r % I_SQ, F.lane); continue; } r -= 2 * I_SQ;
            if (r < I_BI) { p0_transpose_item(F.in[I_BWIN], 8192, D, 256, WT + WT_BIN, scr, r, F.lane); continue; } r -= I_BI;
            if (r < I_BO) { p0_transpose_item(F.in[I_BWOUT], D, 4096, 64, WT + WT_BOUT, scr, r, F.lane); continue; } r -= I_BO;
            if (r < I_CQ) { p0_transpose_item(F.in[I_CWQKV], C_QKV, D, 96, WT + WT_CQKV, scr, r, F.lane); continue; } r -= I_CQ;
            if (r < I_SQ) { p0_transpose_item(F.in[I_CWOUT], D, D, 64, WT + WT_COUT, scr, r, F.lane); continue; } r -= I_SQ;
            { const int j = r / I_SQ;
              if ((PQ_FP8_MASK >> j) & 1) p0_transpose_item(F.in[I_PWQ] + (size_t)j * D * D, D, D, 64, WT + WT_PQ + (size_t)j * D * D * 2, scr, r % I_SQ, F.lane);
              else p0_transpose_item_bf16(F.in[I_PWQ] + (size_t)j * D * D, D, D, 64, (bf16*)(WT + WT_PQ) + (size_t)j * D * D, scr, r % I_SQ, F.lane); }
        }
        const size_t gt = (size_t)F.vcu * NTHR + F.tid, GT = (size_t)F.G * NTHR;
        for (size_t i = gt; i < (size_t)2 * 256 * D; i += GT) {
            const int j = (int)(i / (256 * D)), rem = (int)(i % (256 * D)), n = rem / D, k = rem % D;
            const float v = n < 16 ? F.in[I_AWIN][((size_t)j * D + k) * A_IN + 6144 + n] : 0.f;
            WT[WT_AIN + ((size_t)j * A_INP + 6144 + n) * D + k] = (unsigned char)(__builtin_amdgcn_cvt_pk_fp8_f32(v * WSCALE, 0.f, 0, false) & 0xff);
        }
        for (int r0 = gw; r0 < 2 * 4 * P_E; r0 += 2 * NGW) {
            f32x4 v[2][8];
#pragma unroll
            for (int h = 0; h < 2; ++h) { const int r = r0 + h * NGW, tb = r >= 4 * P_E, rr = r - tb * 4 * P_E;
                const float* src = F.in[tb ? I_PV : I_PU] + (size_t)rr * D + 4 * F.lane;
#pragma unroll
                for (int q = 0; q < 8; ++q) v[h][q] = *(const f32x4*)(src + 256 * q); }
#pragma unroll
            for (int h = 0; h < 2; ++h) { const int r = r0 + h * NGW, tb = r >= 4 * P_E, rr = r - tb * 4 * P_E;
                float mx = 0.f;
#pragma unroll
                for (int q = 0; q < 8; ++q) { const f32x4 a = __builtin_elementwise_abs(v[h][q]); mx = fmaxf(mx, fmaxf(fmaxf(a[0], a[1]), fmaxf(a[2], a[3]))); }
                mx = row16_max(mx); mx = fmaxf(fmaxf(rl(mx, 0), rl(mx, 16)), fmaxf(rl(mx, 32), rl(mx, 48)));
                const float sc = mx > 0.f ? 6.0f / mx : 1.0f;
                v4u o;
#pragma unroll
                for (int d = 0; d < 4; ++d) { unsigned w = 0u; const f32x4 x0 = v[h][2 * d] * sc, x1 = v[h][2 * d + 1] * sc;
                    w = __builtin_amdgcn_cvt_scalef32_pk_fp4_f32(w, x0[0], x0[1], 1.0f, 0); w = __builtin_amdgcn_cvt_scalef32_pk_fp4_f32(w, x0[2], x0[3], 1.0f, 1);
                    w = __builtin_amdgcn_cvt_scalef32_pk_fp4_f32(w, x1[0], x1[1], 1.0f, 2); w = __builtin_amdgcn_cvt_scalef32_pk_fp4_f32(w, x1[2], x1[3], 1.0f, 3); o[d] = w; }
                if (tb) *(v4u*)(F.ws + WS_PV8 + (size_t)rr * (D / 2) + 16 * F.lane) = o;
                else { unsigned char* ur = F.ws + WS_PU8 + (size_t)rr * (D / 2) + 2 * F.lane;
#pragma unroll
                    for (int d = 0; d < 4; ++d) { *(unsigned short*)(ur + 128 * (2 * d)) = (unsigned short)(o[d] & 0xffffu); *(unsigned short*)(ur + 128 * (2 * d + 1)) = (unsigned short)(o[d] >> 16); } }
                if (F.lane == 0) ((float*)(F.ws + WS_SC))[(size_t)tb * 4 * P_E + rr] = 1.0f / sc; }
        }
        cvt_linear(F.in[I_PK1], (bf16*)(F.ws + WS_K12), (size_t)4 * 128 * 128 / 8, gt, GT);
        cvt_linear(F.in[I_PK2], (bf16*)(F.ws + WS_K12) + 4 * 128 * 128, (size_t)4 * 128 * 128 / 8, gt, GT);
        cvt_linear(F.in[I_BWS], (bf16*)(F.ws + WS_WS), (size_t)8 * 128 * 128 / 8, gt, GT);
    }
}

template <int L> __device__ __forceinline__ const float* x_row(const Frame& F, int row) {
    if (L == 0) return row < TL ? F.in[I_X] + (size_t)row * D : F.in[I_CTX] + (size_t)(row - TL) * D;
    return (const float*)(F.ws + WS_X) + (size_t)row * D;
}
template <int L> __device__ __forceinline__ f32x4 load_x4(const Frame& F, int row, int e) {
    if (L == 0) return *(const f32x4*)(x_row<0>(F, row) + e);
    const v2u p = *(const v2u*)((const bf16*)(F.ws + WS_X) + (size_t)row * D + e);
    return (f32x4){bf_lo(p.x), bf_hi(p.x), bf_lo(p.y), bf_hi(p.y)};
}
__device__ __forceinline__ void store_x4(const Frame& F, int row, int e, f32x4 v) { v2u o; o.x = cvt_pk_bf16(v[0], v[1]); o.y = cvt_pk_bf16(v[2], v[3]); *(v2u*)((bf16*)(F.ws + WS_X) + (size_t)row * D + e) = o; }
__device__ __forceinline__ void p0b_modulate(Frame& F) {
    const int gw = F.vcu * NWAVES + F.wave, NGW = F.G * NWAVES;
    for (int row = gw; row < T; row += NGW) {
        const float* xr = x_row<0>(F, row); const float* md = mod_row(F, 0, row);
        unsigned char* hr = F.ws + WS_H + (size_t)row * D;
#pragma unroll
        for (int j = 0; j < 8; ++j) { const int e = 4 * F.lane + 256 * j;
            const f32x4 x = *(const f32x4*)(xr + e), sh = *(const f32x4*)(md + e), scl = *(const f32x4*)(md + D + e);
            const f32x4 h = x * (scl + 1.0f) + sh;
            *(unsigned*)(hr + e) = pk4_fp8(h[0], h[1], h[2], h[3]); }
    }
}

__device__ __forceinline__ void ln_rows(f32x4 (&t)[8], const float* g, const float* b, int lane) {
    float s = 0.f;
#pragma unroll
    for (int j = 0; j < 8; ++j) s += (t[j][0] + t[j][1]) + (t[j][2] + t[j][3]);
    const float mean = wsum(s) * (1.0f / D); float q = 0.f;
#pragma unroll
    for (int j = 0; j < 8; ++j) { t[j] = t[j] - mean; q += (t[j][0] * t[j][0] + t[j][1] * t[j][1]) + (t[j][2] * t[j][2] + t[j][3] * t[j][3]); }
    const float rstd = 1.0f / sqrtf(wsum(q) * (1.0f / D) + LN_EPS);
#pragma unroll
    for (int j = 0; j < 8; ++j) { const int e = 4 * lane + 256 * j; t[j] = t[j] * rstd * *(const f32x4*)(g + e) + *(const f32x4*)(b + e); }
}

template <int L> __device__ __forceinline__ void ln1_phase(Frame& F, int M) {
    const int gw = F.vcu * NWAVES + F.wave, NGW = F.G * NWAVES;
    const float* lg = F.in[I_LNG] + (size_t)(L * 2 + 0) * D; const float* lb = F.in[I_LNB] + (size_t)(L * 2 + 0) * D;
    for (int row = gw; row < M; row += NGW) {
        const float* md = mod_row(F, L, row);
        const bf16* yr = (const bf16*)(F.ws + WS_Y) + (size_t)row * D;
        bf16* hr = (bf16*)(F.ws + WS_Y) + (size_t)row * D;
        f32x4 t[8];
#pragma unroll
        for (int j = 0; j < 8; ++j) { const int e = 4 * F.lane + 256 * j;
            const f32x4 x = load_x4<L>(F, row, e), gt = *(const f32x4*)(md + 2 * D + e); const v2u y = *(const v2u*)(yr + e);
            t[j] = x * ALPHA + gt * (f32x4){bf_lo(y.x), bf_hi(y.x), bf_lo(y.y), bf_hi(y.y)}; }
        ln_rows(t, lg, lb, F.lane);
#pragma unroll
        for (int j = 0; j < 8; ++j) { const int e = 4 * F.lane + 256 * j;
            store_x4(F, row, e, t[j]);
            const f32x4 h = t[j] * (*(const f32x4*)(md + 4 * D + e) + 1.0f) + *(const f32x4*)(md + 3 * D + e);
            v2u o; o.x = cvt_pk_bf16(h[0], h[1]); o.y = cvt_pk_bf16(h[2], h[3]); *(v2u*)(hr + e) = o;
            if ((PQ_FP8_MASK >> L) & 1) *(unsigned*)(F.ws + WS_H + (size_t)row * D + e) = pk4_fp8(h[0], h[1], h[2], h[3]); }
    }
}

__device__ __forceinline__ unsigned f2mono(float f) { const unsigned b = __float_as_uint(f); return (b & 0x80000000u) ? ~b : (b | 0x80000000u); }
__device__ __forceinline__ float mono2f(unsigned m) { return __uint_as_float((m & 0x80000000u) ? (m & 0x7fffffffu) : ~m); }
__device__ __forceinline__ void ins16(unsigned (&top)[16], unsigned x) {
#pragma unroll
    for (int j = 0; j < 16; ++j) { const unsigned hi = top[j] > x ? top[j] : x; x = top[j] > x ? x : top[j]; top[j] = hi; }
}
#define TK_CE(A_, B_) { const unsigned hi_ = (A_) > (B_) ? (A_) : (B_), lo_ = (A_) > (B_) ? (B_) : (A_); (A_) = hi_; (B_) = lo_; }
__device__ __forceinline__ void sort16_desc(unsigned (&v)[16]) {
    TK_CE(v[0], v[1])
    TK_CE(v[2], v[3])
    TK_CE(v[0], v[2])
    TK_CE(v[1], v[3])
    TK_CE(v[1], v[2])
    TK_CE(v[4], v[5])
    TK_CE(v[6], v[7])
    TK_CE(v[4], v[6])
    TK_CE(v[5], v[7])
    TK_CE(v[5], v[6])
    TK_CE(v[0], v[4])
    TK_CE(v[2], v[6])
    TK_CE(v[2], v[4])
    TK_CE(v[1], v[5])
    TK_CE(v[3], v[7])
    TK_CE(v[3], v[5])
    TK_CE(v[1], v[2])
    TK_CE(v[3], v[4])
    TK_CE(v[5], v[6])
    TK_CE(v[8], v[9])
    TK_CE(v[10], v[11])
    TK_CE(v[8], v[10])
    TK_CE(v[9], v[11])
    TK_CE(v[9], v[10])
    TK_CE(v[12], v[13])
    TK_CE(v[14], v[15])
    TK_CE(v[12], v[14])
    TK_CE(v[13], v[15])
    TK_CE(v[13], v[14])
    TK_CE(v[8], v[12])
    TK_CE(v[10], v[14])
    TK_CE(v[10], v[12])
    TK_CE(v[9], v[13])
    TK_CE(v[11], v[15])
    TK_CE(v[11], v[13])
    TK_CE(v[9], v[10])
    TK_CE(v[11], v[12])
    TK_CE(v[13], v[14])
    TK_CE(v[0], v[8])
    TK_CE(v[4], v[12])
    TK_CE(v[4], v[8])
    TK_CE(v[2], v[10])
    TK_CE(v[6], v[14])
    TK_CE(v[6], v[10])
    TK_CE(v[2], v[4])
    TK_CE(v[6], v[8])
    TK_CE(v[10], v[12])
    TK_CE(v[1], v[9])
    TK_CE(v[5], v[13])
    TK_CE(v[5], v[9])
    TK_CE(v[3], v[11])
    TK_CE(v[7], v[15])
    TK_CE(v[7], v[11])
    TK_CE(v[3], v[5])
    TK_CE(v[7], v[9])
    TK_CE(v[11], v[13])
    TK_CE(v[1], v[2])
    TK_CE(v[3], v[4])
    TK_CE(v[5], v[6])
    TK_CE(v[7], v[8])
    TK_CE(v[9], v[10])
    TK_CE(v[11], v[12])
    TK_CE(v[13], v[14])
}
__device__ __forceinline__ void merge16_desc(unsigned (&top)[16], const unsigned (&s)[16]) {
#pragma unroll
    for (int i = 0; i < 16; ++i) top[i] = top[i] > s[15 - i] ? top[i] : s[15 - i];
#pragma unroll
    for (int j = 8; j > 0; j >>= 1)
#pragma unroll
        for (int i = 0; i < 16; ++i) { const int l = i ^ j; if (l > i) TK_CE(top[i], top[l]) }
}
template <int L> __device__ __forceinline__ void peer_topk_phase(Frame& F, int M) {
    const bf16* Q = (const bf16*)(F.ws + WS_Z);
    const bf16* K1 = (const bf16*)(F.ws + WS_K12) + (size_t)L * 128 * 128;
    const bf16* K2 = (const bf16*)(F.ws + WS_K12) + (size_t)(4 + L) * 128 * 128;
    int* IDX = (int*)(F.ws + WS_IDX); float* PG = (float*)(F.ws + WS_PG);
    LAS float* S1 = (LAS float*)F.lds;
    LAS float* S2 = S1 + 128 * 129;
    LAS unsigned* TK = (LAS unsigned*)(S2 + 128 * 129);
    const int fr = F.lane & 15, fq = F.lane >> 4;
    const int nunits = (M / 128) * P_HEADS;
    const int kbg = F.wave & 1, tbg = F.wave >> 1;
    const int tb_lo = tbg == 0 ? 0 : tbg == 1 ? 1 : tbg == 2 ? 3 : 5, ntb = tbg == 0 ? 1 : tbg == 3 ? 3 : 2;
    bf16x8 kf1[4][4], kf2[4][4];
#pragma unroll
    for (int kk = 0; kk < 4; ++kk) { const int kb = 4 * kbg + kk;
        const bf16* k1p = K1 + (size_t)(kb * 16 + fr) * 128 + fq * 8; const bf16* k2p = K2 + (size_t)(kb * 16 + fr) * 128 + fq * 8;
#pragma unroll
        for (int ks = 0; ks < 4; ++ks) { kf1[kk][ks] = *(const bf16x8*)(k1p + ks * 32); kf2[kk][ks] = *(const bf16x8*)(k2p + ks * 32); } }
    for (int u = F.vcu; u < nunits; u += F.G) {
        const int tile = u >> 3, hd = u & 7, row0 = tile * 128;
#ifdef TK_DBL_MFMA
        for (int rr_ = 0; rr_ < 2; ++rr_)
#endif
        {
#pragma unroll 1
            for (int tt = 0; tt < ntb; ++tt) { const int tb = tb_lo + tt;
                const bf16* qp = Q + (size_t)(row0 + tb * 16 + fr) * D + hd * 256 + fq * 8;
                bf16x8 a1[4], a2[4];
#pragma unroll
                for (int ks = 0; ks < 4; ++ks) { a1[ks] = *(const bf16x8*)(qp + ks * 32); a2[ks] = *(const bf16x8*)(qp + 128 + ks * 32); }
#pragma unroll
                for (int kk = 0; kk < 4; ++kk) { const int kb = 4 * kbg + kk;
                    f32x4 c1 = zero4(), c2 = zero4();
#pragma unroll
                    for (int ks = 0; ks < 4; ++ks) {
                        c1 = __builtin_amdgcn_mfma_f32_16x16x32_bf16(a1[ks], kf1[kk][ks], c1, 0, 0, 0);
                        c2 = __builtin_amdgcn_mfma_f32_16x16x32_bf16(a2[ks], kf2[kk][ks], c2, 0, 0, 0);
                    }
#pragma unroll
                    for (int j = 0; j < 4; ++j) { const int t = tb * 16 + 4 * fq + j; const unsigned ix = (unsigned)(127 - (kb * 16 + fr));
                        ((LAS unsigned*)S1)[t * 129 + kb * 16 + fr] = (f2mono(c1[j]) & ~0x7fu) | ix; ((LAS unsigned*)S2)[t * 129 + kb * 16 + fr] = (f2mono(c2[j]) & ~0x7fu) | ix; }
                }
            }
        }
        __syncthreads();
        {
            int tid_l = F.tid; asm volatile("" : "+v"(tid_l));
            const int t = tid_l & 127, which = (tid_l >> 7) & 1, half = tid_l >> 8;
            LAS float* sr = (which ? S2 : S1) + t * 129 + 64 * half;
            unsigned top[16];
#pragma unroll
            for (int j = 0; j < 16; ++j) top[j] = ((const LAS unsigned*)sr)[j];
            sort16_desc(top);
#pragma unroll 1
            for (int g = 1; g < 4; ++g) { unsigned v[16];
#pragma unroll
                for (int j = 0; j < 16; ++j) v[j] = ((const LAS unsigned*)sr)[16 * g + j];
                sort16_desc(v); merge16_desc(top, v); }
            if (half) {
#pragma unroll
                for (int j = 0; j < 16; ++j) ((LAS unsigned*)sr)[j] = top[j];
            }
            __syncthreads();
            if (!half) {
                const LAS unsigned* pr = (const LAS unsigned*)(sr + 64);
                unsigned ot[16];
#pragma unroll
                for (int j = 0; j < 16; ++j) ot[j] = pr[j];
                merge16_desc(top, ot);
#pragma unroll
                for (int j = 0; j < 16; ++j) TK[(which * 128 + t) * 17 + j] = top[j];
            }
        }
        __syncthreads();
#ifdef TK_DBL_COMB
        for (int rr_ = 0; rr_ < 2; ++rr_)
#endif
        if (F.tid < 128) {
            const int t = F.tid;
            const LAS unsigned* t1 = TK + t * 17; const LAS unsigned* t2 = TK + (128 + t) * 17;
            float v2[16];
#pragma unroll
            for (int j = 0; j < 16; ++j) v2[j] = mono2f((t2[j] & ~0x7fu) | 0x40u);
#define TK_V1(A_) mono2f((t1[A_] & ~0x7fu) | 0x40u)
#define TK_KEY(VA_, A_, B_) ((f2mono((VA_) + v2[B_]) & ~0xffu) | (unsigned)(255 - ((A_) * 16 + (B_))))
            unsigned top[16];
            { unsigned grp[16];
              const float va0 = TK_V1(0);
              grp[0] = TK_KEY(va0, 0, 0);
              grp[1] = TK_KEY(va0, 0, 1);
              grp[2] = TK_KEY(va0, 0, 2);
              grp[3] = TK_KEY(va0, 0, 3);
              grp[4] = TK_KEY(va0, 0, 4);
              grp[5] = TK_KEY(va0, 0, 5);
              grp[6] = TK_KEY(va0, 0, 6);
              grp[7] = TK_KEY(va0, 0, 7);
              grp[8] = TK_KEY(va0, 0, 8);
              grp[9] = TK_KEY(va0, 0, 9);
              grp[10] = TK_KEY(va0, 0, 10);
              grp[11] = TK_KEY(va0, 0, 11);
              grp[12] = TK_KEY(va0, 0, 12);
              grp[13] = TK_KEY(va0, 0, 13);
              grp[14] = TK_KEY(va0, 0, 14);
              grp[15] = TK_KEY(va0, 0, 15);
              sort16_desc(grp);
#pragma unroll
              for (int j = 0; j < 16; ++j) top[j] = grp[j]; }
            __builtin_amdgcn_sched_barrier(0);
            { unsigned grp[16];
              const float va1 = TK_V1(1);
              const float va2 = TK_V1(2);
              const float va3 = TK_V1(3);
              grp[0] = TK_KEY(va1, 1, 0);
              grp[1] = TK_KEY(va1, 1, 1);
              grp[2] = TK_KEY(va1, 1, 2);
              grp[3] = TK_KEY(va1, 1, 3);
              grp[4] = TK_KEY(va1, 1, 4);
              grp[5] = TK_KEY(va1, 1, 5);
              grp[6] = TK_KEY(va1, 1, 6);
              grp[7] = TK_KEY(va1, 1, 7);
              grp[8] = TK_KEY(va2, 2, 0);
              grp[9] = TK_KEY(va2, 2, 1);
              grp[10] = TK_KEY(va2, 2, 2);
              grp[11] = TK_KEY(va2, 2, 3);
              grp[12] = TK_KEY(va2, 2, 4);
              grp[13] = TK_KEY(va3, 3, 0);
              grp[14] = TK_KEY(va3, 3, 1);
              grp[15] = TK_KEY(va3, 3, 2);
              sort16_desc(grp);
              merge16_desc(top, grp); }
            __builtin_amdgcn_sched_barrier(0);
            { unsigned grp[16];
              const float va3 = TK_V1(3);
              const float va4 = TK_V1(4);
              const float va5 = TK_V1(5);
              const float va6 = TK_V1(6);
              const float va7 = TK_V1(7);
              const float va8 = TK_V1(8);
              const float va9 = TK_V1(9);
              const float va10 = TK_V1(10);
              const float va11 = TK_V1(11);
              const float va12 = TK_V1(12);
              const float va13 = TK_V1(13);
              grp[0] = TK_KEY(va3, 3, 3);
              grp[1] = TK_KEY(va4, 4, 0);
              grp[2] = TK_KEY(va4, 4, 1);
              grp[3] = TK_KEY(va4, 4, 2);
              grp[4] = TK_KEY(va5, 5, 0);
              grp[5] = TK_KEY(va5, 5, 1);
              grp[6] = TK_KEY(va6, 6, 0);
              grp[7] = TK_KEY(va6, 6, 1);
              grp[8] = TK_KEY(va7, 7, 0);
              grp[9] = TK_KEY(va7, 7, 1);
              grp[10] = TK_KEY(va8, 8, 0);
              grp[11] = TK_KEY(va9, 9, 0);
              grp[12] = TK_KEY(va10, 10, 0);
              grp[13] = TK_KEY(va11, 11, 0);
              grp[14] = TK_KEY(va12, 12, 0);
              grp[15] = TK_KEY(va13, 13, 0);
              sort16_desc(grp);
              merge16_desc(top, grp); }
            __builtin_amdgcn_sched_barrier(0);
            ins16(top, TK_KEY(TK_V1(14), 14, 0));
            ins16(top, TK_KEY(TK_V1(15), 15, 0));
#undef TK_KEY
#undef TK_V1
            float sc[16], es = 0.f;
#pragma unroll
            for (int j = 0; j < 16; ++j) sc[j] = mono2f((top[j] & ~0xffu) | 0x80u);
            const float smx = sc[0];
#pragma unroll
            for (int j = 0; j < 16; ++j) { sc[j] = __expf(sc[j] - smx); es += sc[j]; }
            const float inv = 1.0f / es;
            const size_t ob = (size_t)(row0 + t) * 128 + hd * 16;
#pragma unroll
            for (int j = 0; j < 16; ++j) { const int ci = 255 - (int)(top[j] & 0xffu), a = ci >> 4, b = ci & 15;
                const int i1 = 127 - (int)(t1[a] & 0x7fu), i2 = 127 - (int)(t2[b] & 0x7fu);
                IDX[ob + j] = i1 * 128 + i2; PG[ob + j] = sc[j] * inv; }
        }
    }
}

constexpr int P3B = 8;
struct RowBatch { v4u r[P3B]; };
__device__ __forceinline__ void p3_load_batch(RowBatch& B, const char* tab, int ev, int lane0, int lo16) {
#pragma unroll
    for (int q = 0; q < P3B; ++q) { const int e = __builtin_amdgcn_readlane(ev, lane0 + q); B.r[q] = *(const v4u*)(tab + (size_t)e * (D / 2) + lo16); }
}
__device__ __forceinline__ float dot32_fp4(const v4u w, const f32x2* h) {
    f32x2 s = {0.f, 0.f};
#pragma unroll
    for (int d = 0; d < 4; ++d) {
#define P3_D(b) { const f32x2 p = __builtin_amdgcn_cvt_scalef32_pk_f32_fp4(w[d], 1.0f, b); s = __builtin_elementwise_fma(p, h[4 * d + b], s); }
        P3_D(0) P3_D(1) P3_D(2) P3_D(3)
#undef P3_D
    }
    return s[0] + s[1];
}
__device__ __forceinline__ void axpy32_fp4(const v4u w, float hk, f32x2* acc) {
    const f32x2 hk2 = {hk, hk};
#pragma unroll
    for (int d = 0; d < 4; ++d) {
#define P3_A(b) { const f32x2 p = __builtin_amdgcn_cvt_scalef32_pk_f32_fp4(w[d], 1.0f, b); acc[4 * d + b] = __builtin_elementwise_fma(hk2, p, acc[4 * d + b]); }
        P3_A(0) P3_A(1) P3_A(2) P3_A(3)
#undef P3_A
    }
}
__device__ __forceinline__ float reduce8(const float* d, int lane) {
    const bool b0 = lane & 1, b1 = lane & 2, b2 = lane & 4;
    float s1[4], s2[2];
#pragma unroll
    for (int j = 0; j < 4; ++j) { const float keep = b0 ? d[2 * j + 1] : d[2 * j], send = b0 ? d[2 * j] : d[2 * j + 1]; s1[j] = keep + dpp_mov<0xB1>(send); }
#pragma unroll
    for (int j = 0; j < 2; ++j) { const float keep = b1 ? s1[2 * j + 1] : s1[2 * j], send = b1 ? s1[2 * j] : s1[2 * j + 1]; s2[j] = keep + dpp_mov<0x4E>(send); }
    const float keep = b2 ? s2[1] : s2[0], send = b2 ? s2[0] : s2[1];
    float s3 = keep + dpp_mov<0x124>(send);
    s3 += dpp_mov<0x128>(s3);
    s3 += __shfl_xor(s3, 16); s3 += __shfl_xor(s3, 32);
    return s3;
}
template <int L> __device__ __forceinline__ void peer_u_phase(Frame& F, int M) {
    const int gw = F.vcu * NWAVES + F.wave, NGW = F.G * NWAVES;
    const char* PU = (const char*)(F.ws + WS_PU8) + (size_t)L * P_E * (D / 2); const char* PV = (const char*)(F.ws + WS_PV8) + (size_t)L * P_E * (D / 2);
    const float* SCU = (const float*)(F.ws + WS_SC) + (size_t)L * P_E; const float* SCV = (const float*)(F.ws + WS_SC) + (size_t)(4 + L) * P_E;
    const int* IDX = (const int*)(F.ws + WS_IDX); const float* PG = (const float*)(F.ws + WS_PG);
    const float* lg = F.in[I_LNG] + (size_t)(L * 2 + 1) * D; const float* lb = F.in[I_LNB] + (size_t)(L * 2 + 1) * D;
    for (int row = gw; row < M; row += NGW) {
        int lane_l = F.lane; asm volatile("" : "+v"(lane_l));
        const int lane = lane_l, lo16 = lane * 16;
        const int e0 = IDX[(size_t)row * 128 + lane], e1 = IDX[(size_t)row * 128 + 64 + lane];
        const float g0 = PG[(size_t)row * 128 + lane], g1 = PG[(size_t)row * 128 + 64 + lane];
        const float su0 = SCU[e0], su1 = SCU[e1], sv0 = SCV[e0], sv1 = SCV[e1];
        f32x2 hx[16];
        { const bf16* hr0 = (const bf16*)(F.ws + WS_Y) + (size_t)row * D + 4 * lane;
#pragma unroll
          for (int q = 0; q < 8; ++q) { const v2u hp = *(const v2u*)(hr0 + 256 * q); hx[2 * q] = (f32x2){bf_lo(hp.x), bf_hi(hp.x)}; hx[2 * q + 1] = (f32x2){bf_lo(hp.y), bf_hi(hp.y)}; } }
        float a0, a1;
        {
            LAS unsigned char* wl = F.lds + F.wave * 13568;
            LAS unsigned char* HI = wl + 8448;
#pragma unroll
            for (int q = 0; q < 8; ++q) {
                const f32x2 p0 = hx[2 * q], p1 = hx[2 * q + 1];
                int hi = __builtin_amdgcn_cvt_pk_fp8_f32(p0[0], p0[1], 0, false); hi = __builtin_amdgcn_cvt_pk_fp8_f32(p1[0], p1[1], hi, true);
                const f32x2 b0 = __builtin_amdgcn_cvt_pk_f32_fp8(hi, false), b1 = __builtin_amdgcn_cvt_pk_f32_fp8(hi, true);
                const f32x2 r0 = (p0 - b0) * 16.0f, r1 = (p1 - b1) * 16.0f;
                int lo = __builtin_amdgcn_cvt_pk_fp8_f32(r0[0], r0[1], 0, false); lo = __builtin_amdgcn_cvt_pk_fp8_f32(r1[0], r1[1], lo, true);
                *(LAS int*)(HI + 4 * lane + 256 * q) = hi; *(LAS int*)(HI + 2048 + 4 * lane + 256 * q) = lo;
            }
            asm volatile("" ::: "memory");
            const int n16 = lane & 15, kq = lane >> 4, hl = lane >> 5, l31 = lane & 31;
            const LAS unsigned char* bp = HI + (n16 == 1 ? 2048 : 0) + 16 * kq;
            LAS unsigned char* tw = wl + hl * 528 + 16 * l31;
            const LAS unsigned char* tr = wl + n16 * 528 + 16 * kq;
            f32x4 acc[8];
#pragma unroll
            for (int rb = 0; rb < 8; ++rb) acc[rb] = zero4();
            v4u R[2][8]; v8i_t Bk[8];
            int e0b = e0, e1b = e1;
#define UL_LOAD(S_) do { _Pragma("unroll") for (int i = 0; i < 8; ++i) { const int sa_ = 16 * ((S_) & 7) + 2 * i; \
                const int es_ = ((S_) >> 3) ? (((S_) & 7) < 4 ? e0b : e1b) : (((S_) & 7) < 4 ? e0 : e1); const int ia_ = __builtin_amdgcn_readlane(es_, sa_ & 63), ib_ = __builtin_amdgcn_readlane(es_, (sa_ + 1) & 63); \
                const int id_ = hl ? ib_ : ia_; R[(S_) & 1][i] = *(const v4u*)(PU + (size_t)id_ * (D / 2) + 512 * ((S_) >> 3) + 16 * l31); } } while (0)
#define UL_WRITE(S_) do { _Pragma("unroll") for (int i = 0; i < 8; ++i) *(LAS v4u*)(tw + 2 * i * 528) = R[(S_) & 1][i]; } while (0)
#define UL_MMA(S_) do { if (((S_) & 7) == 0) { _Pragma("unroll") for (int ml = 0; ml < 8; ++ml) { const v4u x0 = *(const LAS v4u*)(bp + 128 * (8 * ((S_) >> 3) + ml)), x1 = *(const LAS v4u*)(bp + 128 * (8 * ((S_) >> 3) + ml) + 64); \
                    Bk[ml] = (v8i_t){(int)x0.x, (int)x0.y, (int)x0.z, (int)x0.w, (int)x1.x, (int)x1.y, (int)x1.z, (int)x1.w}; } } \
                _Pragma("unroll") for (int ml = 0; ml < 8; ++ml) { const v4u w = *(const LAS v4u*)(tr + 64 * ml); \
                    acc[(S_) & 7] = __builtin_amdgcn_mfma_scale_f32_16x16x128_f8f6f4((v8i_t){(int)w.x, (int)w.y, (int)w.z, (int)w.w, 0, 0, 0, 0}, Bk[ml], acc[(S_) & 7], 4, 0, 0, 0x7f7f7f7f, 0, 0x7f7f7f7f); } } while (0)
            UL_LOAD(0); __builtin_amdgcn_sched_barrier(0);
#pragma unroll
            for (int s = 0; s < 16; ++s) {
                if (s + 1 == 8) asm volatile("" : "+v"(e0b), "+v"(e1b));
                if (s + 1 < 16) UL_LOAD(s + 1);
                __builtin_amdgcn_sched_barrier(0);
                UL_WRITE(s); __builtin_amdgcn_sched_barrier(0);
                UL_MMA(s); __builtin_amdgcn_sched_barrier(0);
            }
#undef UL_LOAD
#undef UL_WRITE
#undef UL_MMA
            asm volatile("s_nop 15\n\ts_nop 15" : "+v"(acc[0]), "+v"(acc[1]), "+v"(acc[2]), "+v"(acc[3]), "+v"(acc[4]), "+v"(acc[5]), "+v"(acc[6]), "+v"(acc[7]));
            LAS float* SS = (LAS float*)(wl + 12544);
            if (n16 < 2) {
#pragma unroll
                for (int rb = 0; rb < 8; ++rb) *(LAS f32x4*)(SS + n16 * 128 + 16 * rb + 4 * kq) = acc[rb]; }
            asm volatile("" ::: "memory");
            a0 = SS[lane] + SS[128 + lane] * 0.0625f; a1 = SS[64 + lane] + SS[192 + lane] * 0.0625f;
            asm volatile("" ::: "memory");
        }
        float* HC = (float*)(F.ws + WS_Z) + (size_t)row * 128;
        HC[lane] = gelu_tanh(a0 * su0) * g0 * sv0; HC[64 + lane] = gelu_tanh(a1 * su1) * g1 * sv1;
    }
}
template <int L> __device__ __forceinline__ void peer_v_phase(Frame& F, int M) {
    const int gw = F.vcu * NWAVES + F.wave, NGW = F.G * NWAVES;
    const char* PU = (const char*)(F.ws + WS_PU8) + (size_t)L * P_E * (D / 2); const char* PV = (const char*)(F.ws + WS_PV8) + (size_t)L * P_E * (D / 2);
    const float* SCU = (const float*)(F.ws + WS_SC) + (size_t)L * P_E; const float* SCV = (const float*)(F.ws + WS_SC) + (size_t)(4 + L) * P_E;
    const int* IDX = (const int*)(F.ws + WS_IDX); const float* PG = (const float*)(F.ws + WS_PG);
    const float* lg = F.in[I_LNG] + (size_t)(L * 2 + 1) * D; const float* lb = F.in[I_LNB] + (size_t)(L * 2 + 1) * D;
    for (int row = gw; row < M; row += NGW) {
        int lane_l = F.lane; asm volatile("" : "+v"(lane_l));
        const int lane = lane_l, lo16 = lane * 16;
        const int e0 = IDX[(size_t)row * 128 + lane], e1 = IDX[(size_t)row * 128 + 64 + lane];
        RowBatch A, Bb;
        constexpr int NB3 = 128 / P3B;
        p3_load_batch(A, PV, e0, 0, lo16);
        const float h0 = ((const float*)(F.ws + WS_Z))[(size_t)row * 128 + lane], h1 = ((const float*)(F.ws + WS_Z))[(size_t)row * 128 + 64 + lane];
        f32x2 acc[16];
#pragma unroll
        for (int j = 0; j < 16; ++j) acc[j] = (f32x2){0.f, 0.f};
#define P3_AXPY(BUF, KB) do { _Pragma("unroll") for (int q = 0; q < P3B; ++q) { const int k = (KB) + q; const float hk = rl(k < 64 ? h0 : h1, k & 63); axpy32_fp4(BUF.r[q], hk, acc); } } while (0)
        for (int bb = 0; bb < NB3; bb += 2) {
            p3_load_batch(Bb, PV, (bb + 1) * P3B < 64 ? e0 : e1, (P3B * (bb + 1)) & 63, lo16);
            P3_AXPY(A, P3B * bb);
            if (bb + 2 < NB3) p3_load_batch(A, PV, (bb + 2) * P3B < 64 ? e0 : e1, (P3B * (bb + 2)) & 63, lo16);
            P3_AXPY(Bb, P3B * bb + P3B);
        }
#undef P3_AXPY
        int lane2 = lane_l; asm volatile("" : "+v"(lane2) : "v"(acc[0]), "v"(acc[15]));
        const bf16* xr = (const bf16*)(F.ws + WS_X) + (size_t)row * D + 4 * lane2; const float* md = mod_row(F, L, row) + 4 * lane2;
        float s = 0.f;
#pragma unroll
        for (int q = 0; q < 8; ++q) { const v2u xp = *(const v2u*)(xr + 256 * q); const f32x4 xa = {bf_lo(xp.x), bf_hi(xp.x), bf_lo(xp.y), bf_hi(xp.y)}, ga = *(const f32x4*)(md + 5 * D + 256 * q);
#pragma unroll
            for (int j = 0; j < 4; ++j) { float v = acc[2 * q + (j >> 1)][j & 1]; v = ALPHA * xa[j] + ga[j] * v; acc[2 * q + (j >> 1)][j & 1] = v; s += v; } }
        const float mean = wsum(s) * (1.0f / D); float qv = 0.f;
#pragma unroll
        for (int j = 0; j < 16; ++j) { acc[j] = acc[j] - mean; qv += acc[j][0] * acc[j][0] + acc[j][1] * acc[j][1]; }
        const float rstd = 1.0f / sqrtf(wsum(qv) * (1.0f / D) + LN_EPS);
        float* xo = F.out + (size_t)row * D + 4 * lane2; bf16* xb = (bf16*)(F.ws + WS_X) + (size_t)row * D + 4 * lane2;
        unsigned char* ho = F.ws + WS_H + (size_t)row * D + 4 * lane2;
        const float* mdn = mod_row(F, (L + 1) & 3, row) + 4 * lane2;
#pragma unroll
        for (int q = 0; q < 8; ++q) { const int o = 256 * q; const f32x4 wa = *(const f32x4*)(lg + 4 * lane2 + o), ba = *(const f32x4*)(lb + 4 * lane2 + o);
            f32x4 oa;
#pragma unroll
            for (int j = 0; j < 4; ++j) oa[j] = acc[2 * q + (j >> 1)][j & 1] * rstd * wa[j] + ba[j];
            if (L == DEPTH - 1) *(f32x4*)(xo + o) = oa; else { v2u xw; xw.x = cvt_pk_bf16(oa[0], oa[1]); xw.y = cvt_pk_bf16(oa[2], oa[3]); *(v2u*)(xb + o) = xw; }
            if (L < DEPTH - 1) { const f32x4 sa = *(const f32x4*)(mdn + o), ca = *(const f32x4*)(mdn + D + o); const f32x4 ha = oa * (ca + 1.0f) + sa;
                *(unsigned*)(ho + o) = pk4_fp8(ha[0], ha[1], ha[2], ha[3]); } }
    }
}

constexpr int MP = 272;
constexpr int ML_QH = 0, ML_KH = 128 * MP, ML_VT = 2 * 128 * MP, ML_VW = 3 * 128 * MP, ML_GA = 4 * 128 * MP;
__device__ __forceinline__ s16x4 tr_read(LAS unsigned char* p) { return __builtin_amdgcn_ds_read_tr16_b64_v4i16((LAS s16x4*)p); }
__device__ __forceinline__ bf16x8 cat8(s16x4 a, s16x4 b) { return (bf16x8){a[0], a[1], a[2], a[3], b[0], b[1], b[2], b[3]}; }

template <int L> __device__ __forceinline__ void mlstm_scan_phase(Frame& F) {
    constexpr int J = L / 3;
    LAS unsigned char* lds = F.lds;
    LAS float* GA = (LAS float*)(lds + ML_GA);
    LAS float* gA = GA, *gMM = GA + 128, *gWI = GA + 256, *gEN = GA + 384, *gWS = GA + 512, *gNQ = GA + 640, *gHD = GA + 768;
    LAS float* gN = GA + 896;
    LAS float* gRS2 = GA + 896 + 512 + 16;
    const bf16* Zq = (const bf16*)(F.ws + WS_Z + ZQ); const bf16* Zk = (const bf16*)(F.ws + WS_Z + ZK); const bf16* Zv = (const bf16*)(F.ws + WS_Z + ZV);
    const float* G16 = (const float*)(F.ws + WS_GATE); const float* bg = F.in[I_ABG] + J * 16;
    const int tid0 = F.tid, w = F.wave;
    for (int unit = F.vcu; unit < 256; unit += F.G) {
        const int chain = unit >> 2, vs = unit & 3, dir = chain & 1, hd = (chain >> 1) & 3, b = chain >> 3;
        bf16* HO = (bf16*)(F.ws + (dir ? WS_Y : WS_H));
        float* GPa = (float*)(F.ws + WS_GP) + (size_t)unit * (3 * 34 * 128); float* GPb = GPa + 34 * 128; float* GPp = GPb + 34 * 128;
#define CBASE(jc_) ((jc_) < 2 ? TL + b * CL + (dir ? 1 - (jc_) : (jc_)) * 128 : b * SEQ + (dir ? 33 - (jc_) : (jc_) - 2) * 128)
        for (int jc = w; jc < 34; jc += NWAVES) {
            const int base = CBASE(jc); const int lane = tid0 & 63;
            const int s0 = 2 * lane, s1 = 2 * lane + 1;
            const float* g0 = G16 + (size_t)(base + (dir ? 127 - s0 : s0)) * 16; const float* g1 = G16 + (size_t)(base + (dir ? 127 - s1 : s1)) * 16;
            const int ci = dir * 8 + hd, cf = dir * 8 + 4 + hd;
            float li0 = g0[ci] + bg[ci], li1 = g1[ci] + bg[ci], gf0 = g0[cf] + bg[cf], gf1 = g1[cf] + bg[cf];
            li0 = 15.f * tanhf(li0 * (1.f / 15.f)); li1 = 15.f * tanhf(li1 * (1.f / 15.f)); gf0 = 15.f * tanhf(gf0 * (1.f / 15.f)); gf1 = 15.f * tanhf(gf1 * (1.f / 15.f));
            const float lf0 = fminf(gf0, 0.f) - log1pf(__expf(-fabsf(gf0))), lf1 = fminf(gf1, 0.f) - log1pf(__expf(-fabsf(gf1)));
            float p = lf0 + lf1;
#pragma unroll
            for (int o = 1; o < 64; o <<= 1) { const float t = __shfl_up(p, o); if (lane >= o) p += t; }
            const float b1 = p, b0 = p - lf1;
            const float a0 = li0 - b0, a1 = li1 - b1;
            float pm = fmaxf(a0, a1);
#pragma unroll
            for (int o = 1; o < 64; o <<= 1) { const float t = __shfl_up(pm, o); if (lane >= o) pm = fmaxf(pm, t); }
            float pe = __shfl_up(pm, 1); if (lane == 0) pe = -3.0e38f;
            *(f32x2*)(GPa + jc * 128 + s0) = (f32x2){a0, a1}; *(f32x2*)(GPb + jc * 128 + s0) = (f32x2){b0, b1}; *(f32x2*)(GPp + jc * 128 + s0) = (f32x2){fmaxf(pe, a0), pm};
        }
        f32x4 C[16];
#pragma unroll
        for (int i = 0; i < 16; ++i) C[i] = zero4();
        for (int i = tid0; i < 512; i += NTHR) gN[i] = 0.f;
        __syncthreads();
        float m = 0.f;
        v4u PQ[4], PK[4], PV[4]; float pa[4]; float pe_a, pe_b, pe_p, pl_b, pl_p;
#define LOAD_QK(jc_, hf_) do { int t_ = tid0; asm volatile("" : "+v"(t_)); const int base_ = CBASE(jc_); const size_t r0_ = (size_t)(base_ + (dir ? 127 - (t_ >> 4) : (t_ >> 4))); const long rs_ = dir ? -32 : 32; \
            const bf16* qp_ = Zq + r0_ * 1024 + hd * 256 + (hf_) * 128 + (t_ & 15) * 8; const bf16* kp_ = Zk + r0_ * 1024 + hd * 256 + (hf_) * 128 + (t_ & 15) * 8; \
            _Pragma("unroll") for (int i = 0; i < 4; ++i) { PQ[i] = *(const v4u*)(qp_ + (long)i * rs_ * 1024); PK[i] = *(const v4u*)(kp_ + (long)i * rs_ * 1024); } } while (0)
#define LOAD_V(jc_) do { int t_ = tid0; asm volatile("" : "+v"(t_)); const int base_ = CBASE(jc_); const size_t r0_ = (size_t)(base_ + (dir ? 127 - (t_ >> 4) : (t_ >> 4))); const long rs_ = dir ? -32 : 32; \
            const bf16* vp_ = Zv + r0_ * 2048 + hd * 512 + vs * 128 + (t_ & 15) * 8; \
            _Pragma("unroll") for (int i = 0; i < 4; ++i) { PV[i] = *(const v4u*)(vp_ + (long)i * rs_ * 2048); pa[i] = GPa[(jc_) * 128 + (t_ >> 4) + 32 * i]; } } while (0)
#define LOAD_G(jc_) do { int t_ = tid0; asm volatile("" : "+v"(t_)); const int o_ = (jc_) * 128 + (t_ & 127); pe_a = GPa[o_]; pe_b = GPb[o_]; pe_p = GPp[o_]; pl_b = GPb[(jc_) * 128 + 127]; pl_p = GPp[(jc_) * 128 + 127]; } while (0)
        LOAD_QK(0, 0); LOAD_V(0); LOAD_G(0);
        for (int jc = 0; jc < 34; ++jc) {
            const int base = CBASE(jc);
#define ROWMAP(r) (base + (dir ? 127 - (r) : (r)))
            LAS float* Ncur = gN + (jc & 1) * 256; LAS float* Nnxt = gN + ((jc & 1) ^ 1) * 256;
            int tid_l = tid0; asm volatile("" : "+v"(tid_l));
            const int tid = tid_l, lane = tid & 63, fr = lane & 15, fq = lane >> 4;
            int X1 = fr * MP + 16 * fq, X2 = fr * MP + 8 * fq, X3 = (8 * fq + (fr >> 2)) * MP + 8 * (fr & 3), XS = (tid >> 4) * MP + (tid & 15) * 16, X4 = 32 * fq;
            asm volatile("" : "+v"(X1), "+v"(X2), "+v"(X3), "+v"(XS), "+v"(X4));
            const int X1w = X1 + 16 * w * MP, X2w = X2 + 16 * w * MP, X3w = X3 + 32 * w;
            const float M127 = __builtin_bit_cast(float, __builtin_amdgcn_readfirstlane(__builtin_bit_cast(int, fmaxf(m, pl_p))));
            const float decay = __builtin_bit_cast(float, __builtin_amdgcn_readfirstlane(__builtin_bit_cast(int, __expf(m - M127))));
            if (tid < 128) { const float Mt = fmaxf(m, pe_p);
                gA[tid] = pe_a; gMM[tid] = Mt; gWI[tid] = __expf(m - Mt); gEN[tid] = __expf(-pe_b - Mt); gWS[tid] = __expf(pe_a - M127) * 0.0625f; }
            m = __builtin_bit_cast(float, __builtin_amdgcn_readfirstlane(__builtin_bit_cast(int, pl_b + M127)));
            f32x4 Sacc[5], CQ[8]; v2u SP[5]; float rsum = 0.f; const int lo_own = w >= 5 ? w - 4 : 0;
#pragma unroll
            for (int i = 0; i < 8; ++i) { if (i < 5) Sacc[i] = zero4(); CQ[i] = zero4(); }
#pragma unroll
            for (int hf = 0; hf < 2; ++hf) {
#pragma unroll
                for (int i = 0; i < 4; ++i) { *(LAS v4u*)(lds + ML_QH + XS + i * 32 * MP) = PQ[i]; *(LAS v4u*)(lds + ML_KH + XS + i * 32 * MP) = PK[i]; }
                if (hf == 0) {
#pragma unroll
                    for (int i = 0; i < 4; ++i) {
                        const v4u v = PV[i]; const float ws = __expf(pa[i] - M127) * 0.0625f;
                        *(LAS v4u*)(lds + ML_VT + XS + i * 32 * MP) = v;
                        v4u o; o.x = cvt_pk_bf16(bf_lo(v.x) * ws, bf_hi(v.x) * ws); o.y = cvt_pk_bf16(bf_lo(v.y) * ws, bf_hi(v.y) * ws);
                        o.z = cvt_pk_bf16(bf_lo(v.z) * ws, bf_hi(v.z) * ws); o.w = cvt_pk_bf16(bf_lo(v.w) * ws, bf_hi(v.w) * ws);
                        *(LAS v4u*)(lds + ML_VW + XS + i * 32 * MP) = o; }
                }
                __syncthreads();
                if (hf == 0) { LOAD_QK(jc, 1); }
                else if (jc < 33) { LOAD_QK(jc + 1, 0); }
#pragma unroll
                for (int i = 0; i < 5; ++i) {
                    const bool own = i <= w - lo_own; const int tbi = own ? w : 7 - w, sbi = own ? lo_own + i : i - (w + 1);
                    if (own || (w < 3 && sbi < 3 - w)) {
#pragma unroll
                        for (int ks = 0; ks < 4; ++ks) { const bf16x8 kf = *(const LAS bf16x8*)(lds + ML_KH + X1 + sbi * 16 * MP + ks * 64); const bf16x8 qf = *(const LAS bf16x8*)(lds + ML_QH + X1 + tbi * 16 * MP + ks * 64);
                            Sacc[i] = __builtin_amdgcn_mfma_f32_16x16x32_bf16(kf, qf, Sacc[i], 0, 0, 0); }
                    }
                }
                if (hf == 1) {
                    float rs_own = 0.f, rs_help = 0.f;
#pragma unroll
                    for (int i = 0; i < 5; ++i) {
                        const bool own = i <= w - lo_own; const int tbi = own ? w : 7 - w, sbi = own ? lo_own + i : i - (w + 1);
                        v2u o; o.x = 0u; o.y = 0u;
                        if (own || (w < 3 && sbi < 3 - w)) { const int t = 16 * tbi + fr; const float Mt = gMM[t]; float v[4], rs = 0.f;
#pragma unroll
                            for (int j = 0; j < 4; ++j) { const int sidx = 16 * sbi + 4 * fq + j; v[j] = (sidx <= t) ? Sacc[i][j] * 0.0625f * __expf(gA[sidx] - Mt) : 0.f; rs += v[j]; }
                            o.x = cvt_pk_bf16(v[0], v[1]); o.y = cvt_pk_bf16(v[2], v[3]);
                            if (own) rs_own += rs; else rs_help += rs; }
                        SP[i] = o;
                    }
                    rs_own += __shfl_xor(rs_own, 16); rs_own += __shfl_xor(rs_own, 32); rs_help += __shfl_xor(rs_help, 16); rs_help += __shfl_xor(rs_help, 32);
                    rsum = rs_own;
                    if (w < 3 && fq == 0) gRS2[16 * (7 - w) + fr] = rs_help;
                }
                __builtin_amdgcn_sched_barrier(0);
#pragma unroll
                for (int tb = 0; tb < 8; ++tb) {
#pragma unroll
                    for (int k2 = 0; k2 < 4; ++k2) {
                        const f32x4 c0 = C[hf * 8 + 2 * k2], c1 = C[hf * 8 + 2 * k2 + 1];
                        v4u pk; pk.x = cvt_pk_bf16(c0[0], c0[1]); pk.y = cvt_pk_bf16(c0[2], c0[3]); pk.z = cvt_pk_bf16(c1[0], c1[1]); pk.w = cvt_pk_bf16(c1[2], c1[3]);
                        const s16x4 qa = *(const LAS s16x4*)(lds + ML_QH + X2 + tb * 16 * MP + k2 * 64), qb = *(const LAS s16x4*)(lds + ML_QH + X2 + tb * 16 * MP + k2 * 64 + 32);
                        CQ[tb] = __builtin_amdgcn_mfma_f32_16x16x32_bf16(cat8(qa, qb), __builtin_bit_cast(bf16x8, pk), CQ[tb], 0, 0, 0); }
                }
                __builtin_amdgcn_sched_barrier(0);
                {
                    f32x4 nacc = zero4();
#pragma unroll
                    for (int ks = 0; ks < 4; ++ks) {
                        const LAS float* np = (const LAS float*)((LAS unsigned char*)Ncur + X4 + hf * 512 + ks * 128);
                        const f32x4 n0 = *(const LAS f32x4*)np, n1 = *(const LAS f32x4*)(np + 4);
                        v4u pk; pk.x = cvt_pk_bf16(n0[0], n0[1]); pk.y = cvt_pk_bf16(n0[2], n0[3]); pk.z = cvt_pk_bf16(n1[0], n1[1]); pk.w = cvt_pk_bf16(n1[2], n1[3]);
                        const bf16x8 qf = *(const LAS bf16x8*)(lds + ML_QH + X1w + ks * 64);
                        nacc = __builtin_amdgcn_mfma_f32_16x16x32_bf16(qf, __builtin_bit_cast(bf16x8, pk), nacc, 0, 0, 0); }
                    if (fr == 0) {
#pragma unroll
                        for (int j = 0; j < 4; ++j) { const int t = 16 * w + 4 * fq + j; gNQ[t] = (hf == 0 ? 0.f : gNQ[t]) + nacc[j]; } }
                }
                __builtin_amdgcn_sched_barrier(0);
#pragma unroll
                for (int dt = 0; dt < 8; ++dt) {
                    f32x4 acc = C[hf * 8 + dt] * decay;
#pragma unroll
                    for (int ss = 0; ss < 4; ++ss) { LAS unsigned char* p = lds + ML_KH + X3 + ss * 32 * MP + dt * 32; LAS unsigned char* pw = lds + ML_VW + X3w + ss * 32 * MP;
                        acc = __builtin_amdgcn_mfma_f32_16x16x32_bf16(cat8(tr_read(p), tr_read(p + 4 * MP)), cat8(tr_read(pw), tr_read(pw + 4 * MP)), acc, 0, 0, 0); }
                    C[hf * 8 + dt] = acc;
                }
                __builtin_amdgcn_sched_barrier(0);
                {
                    f32x4 nacc = zero4();
#pragma unroll
                    for (int ss = 0; ss < 4; ++ss) {
                        const LAS float* wp = (const LAS float*)((LAS unsigned char*)gWS + X4 + ss * 128);
                        const f32x4 w0 = *(const LAS f32x4*)wp, w1 = *(const LAS f32x4*)(wp + 4);
                        v4u pk; pk.x = cvt_pk_bf16(w0[0], w0[1]); pk.y = cvt_pk_bf16(w0[2], w0[3]); pk.z = cvt_pk_bf16(w1[0], w1[1]); pk.w = cvt_pk_bf16(w1[2], w1[3]);
                        LAS unsigned char* p = lds + ML_KH + X3w + ss * 32 * MP;
                        nacc = __builtin_amdgcn_mfma_f32_16x16x32_bf16(cat8(tr_read(p), tr_read(p + 4 * MP)), __builtin_bit_cast(bf16x8, pk), nacc, 0, 0, 0); }
                    if (fr == 0) {
#pragma unroll
                        for (int j = 0; j < 4; ++j) { const int dl = hf * 128 + 16 * w + 4 * fq + j; Nnxt[dl] = decay * Ncur[dl] + nacc[j]; } }
                }
                __syncthreads();
            }
            {
#pragma unroll
                for (int i = 0; i < 5; ++i) {
                    const bool own = i <= w - lo_own; const int tbi = own ? w : 7 - w, sbi = own ? lo_own + i : i - (w + 1);
                    if (own || (w < 3 && sbi < 3 - w)) *(LAS v2u*)(lds + ML_QH + X2 + tbi * 16 * MP + sbi * 32) = SP[i];
                }
                for (int sb = w + 1; sb < 8; ++sb) { v2u z; z.x = 0u; z.y = 0u; *(LAS v2u*)(lds + ML_QH + X2w + sb * 32) = z; }
                const int t = 16 * w + fr;
                if (fq == 0) { const float den = gWI[t] * gNQ[t] + rsum + (w >= 5 ? gRS2[t] : 0.f); gHD[t] = 1.0f / fmaxf(fabsf(den), gEN[t]); }
            }
            __syncthreads();
            {
                bf16x8 vf[4];
#pragma unroll
                for (int ss = 0; ss < 4; ++ss) { LAS unsigned char* p = lds + ML_VT + X3w + ss * 32 * MP; vf[ss] = cat8(tr_read(p), tr_read(p + 4 * MP)); }
                if (jc < 33) { LOAD_V(jc + 1); LOAD_G(jc + 1); }
                bf16* hop = HO + (size_t)ROWMAP(4 * fq) * D + hd * 512 + vs * 128 + 16 * w + fr; const long hstep = dir ? -(long)D : (long)D;
#pragma unroll
                for (int tb = 0; tb < 8; ++tb) {
                    f32x4 acc;
#pragma unroll
                    for (int j = 0; j < 4; ++j) acc[j] = CQ[tb][j] * gWI[16 * tb + 4 * fq + j];
#pragma unroll
                    for (int ss = 0; ss < 4; ++ss) { const bf16x8 sf = *(const LAS bf16x8*)(lds + ML_QH + X1 + tb * 16 * MP + ss * 64);
                        acc = __builtin_amdgcn_mfma_f32_16x16x32_bf16(sf, vf[ss], acc, 0, 0, 0); }
#pragma unroll
                    for (int j = 0; j < 4; ++j) { const float h = acc[j] * gHD[16 * tb + 4 * fq + j];
                        hop[(long)(16 * tb + j) * hstep] = (bf16)(cvt_pk_bf16(h, 0.f) & 0xffffu); }
                }
            }
            __syncthreads();
#undef ROWMAP
        }
#undef LOAD_QK
#undef LOAD_V
#undef LOAD_G
#undef CBASE
    }
}

template <int L> __device__ __forceinline__ void mlstm_post_phase(Frame& F, int M) {
    constexpr int J = L / 3;
    const int gw = F.vcu * NWAVES + F.wave, NGW = F.G * NWAVES;
    const float* ng = F.in[I_ANG] + (size_t)J * D;
    for (int row = gw; row < M; row += NGW) {
        const bf16* hf = (const bf16*)(F.ws + WS_H) + (size_t)row * D; const bf16* hb = (const bf16*)(F.ws + WS_Y) + (size_t)row * D;
        const bf16* orow = (const bf16*)(F.ws + WS_Z + ZO) + (size_t)row * D; unsigned char* g = F.ws + WS_Z + ZG + (size_t)row * D;
        f32x4 t[8]; float ss[4];
#pragma unroll
        for (int j = 0; j < 8; ++j) { const int e = 4 * F.lane + 256 * j; const v2u a = *(const v2u*)(hf + e), b = *(const v2u*)(hb + e);
            t[j] = (f32x4){bf_lo(a.x) + bf_lo(b.x), bf_hi(a.x) + bf_hi(b.x), bf_lo(a.y) + bf_lo(b.y), bf_hi(a.y) + bf_hi(b.y)}; }
#pragma unroll
        for (int h = 0; h < 4; ++h) { float q = 0.f;
#pragma unroll
            for (int jj = 0; jj < 2; ++jj) { const f32x4 v = t[2 * h + jj]; q += (v[0] * v[0] + v[1] * v[1]) + (v[2] * v[2] + v[3] * v[3]); }
            ss[h] = 1.0f / sqrtf(wsum(q) * (1.0f / A_DV) + LN_EPS); }
#pragma unroll
        for (int j = 0; j < 8; ++j) { const int e = 4 * F.lane + 256 * j; const v2u ov = *(const v2u*)(orow + e); const f32x4 gn = *(const f32x4*)(ng + e);
            const float o0 = bf_lo(ov.x), o1 = bf_hi(ov.x), o2 = bf_lo(ov.y), o3 = bf_hi(ov.y); const float r = ss[j >> 1];
            const float y0 = t[j][0] * r * gn[0] / (1.0f + __expf(-o0)), y1 = t[j][1] * r * gn[1] / (1.0f + __expf(-o1));
            const float y2 = t[j][2] * r * gn[2] / (1.0f + __expf(-o2)), y3 = t[j][3] * r * gn[3] / (1.0f + __expf(-o3));
            *(unsigned*)(g + e) = pk4_fp8(y0, y1, y2, y3); }
    }
}

__device__ __forceinline__ void gmlp_stats_phase(Frame& F, int M) {
    const int gw = F.vcu * NWAVES + F.wave, NGW = F.G * NWAVES;
    float* ST = (float*)(F.ws + WS_STAT);
    for (int row = gw; row < M; row += NGW) {
        const bf16* vr = (const bf16*)(F.ws + WS_Z + ZVV) + (size_t)row * 4096;
        v4u x[8]; float s = 0.f;
#pragma unroll
        for (int j = 0; j < 8; ++j) { x[j] = *(const v4u*)(vr + 8 * F.lane + 512 * j);
            s += (bf_lo(x[j].x) + bf_hi(x[j].x)) + (bf_lo(x[j].y) + bf_hi(x[j].y)) + (bf_lo(x[j].z) + bf_hi(x[j].z)) + (bf_lo(x[j].w) + bf_hi(x[j].w)); }
        const float mean = wsum(s) * (1.0f / 4096.f); float q = 0.f;
#pragma unroll
        for (int j = 0; j < 8; ++j) { float d;
            d = bf_lo(x[j].x) - mean; q += d * d; d = bf_hi(x[j].x) - mean; q += d * d; d = bf_lo(x[j].y) - mean; q += d * d; d = bf_hi(x[j].y) - mean; q += d * d;
            d = bf_lo(x[j].z) - mean; q += d * d; d = bf_hi(x[j].z) - mean; q += d * d; d = bf_lo(x[j].w) - mean; q += d * d; d = bf_hi(x[j].w) - mean; q += d * d; }
        const float rstd = 1.0f / sqrtf(wsum(q) * (1.0f / 4096.f) + LN_EPS);
        if (F.lane == 0) { ST[(size_t)row * 2] = mean; ST[(size_t)row * 2 + 1] = rstd; }
    }
}
__device__ __forceinline__ void gmlp_spatial_phase(Frame& F, int M) {
    LAS unsigned char* lds = F.lds;
    constexpr int GW_W = 0, GW_V = 128 * MP, GW_O = 2 * 128 * MP;
    const bf16* WS = (const bf16*)(F.ws + WS_WS); const float* ST = (const float*)(F.ws + WS_STAT);
    const bf16* U = (const bf16*)(F.ws + WS_Z + ZU); const bf16* V = (const bf16*)(F.ws + WS_Z + ZVV);
    const float* lng = F.in[I_BLNG]; const float* lnb = F.in[I_BLNB]; const float* bs = F.in[I_BBS];
    const int w = F.wave;
    const int nunits = (M / 128) * B_GROUPS;
    for (int u = F.vcu; u < nunits; u += F.G) {
        int tid_l = F.tid; asm volatile("" : "+v"(tid_l));
        const int tid = tid_l, lane = tid & 63, fr = lane & 15, fq = lane >> 4;
        const int chunk = u >> 3, g = u & 7, row0 = chunk * 128;
        const int et = tid >> 2, ec = tid & 3;
        v4u wreg[4], vreg[4][4]; float mean[4], rstd[4];
#pragma unroll
        for (int i = 0; i < 4; ++i) { const int c = tid + 512 * i, r = c >> 4, cc = c & 15;
            wreg[i] = *(const v4u*)(WS + (size_t)g * 16384 + r * 128 + cc * 8);
            mean[i] = ST[(size_t)(row0 + r) * 2]; rstd[i] = ST[(size_t)(row0 + r) * 2 + 1];
#pragma unroll
            for (int dq = 0; dq < 4; ++dq) vreg[dq][i] = *(const v4u*)(V + (size_t)(row0 + r) * 4096 + g * 512 + dq * 128 + cc * 8); }
        const float bst = bs[g * 128 + et];
#pragma unroll
        for (int i = 0; i < 4; ++i) { const int c = tid + 512 * i, r = c >> 4, cc = c & 15; *(LAS v4u*)(lds + GW_W + r * MP + cc * 16) = wreg[i]; }
#pragma unroll
        for (int dq = 0; dq < 4; ++dq) {
            const int col0 = g * 512 + dq * 128;
#pragma unroll
            for (int i = 0; i < 4; ++i) { const int c = tid + 512 * i, r = c >> 4, cc = c & 15;
                const v4u v = vreg[dq][i]; const float mn = mean[i], rs = rstd[i];
                const f32x4 ga = *(const f32x4*)(lng + col0 + cc * 8), gb = *(const f32x4*)(lng + col0 + cc * 8 + 4), ba = *(const f32x4*)(lnb + col0 + cc * 8), bb = *(const f32x4*)(lnb + col0 + cc * 8 + 4);
                v4u o;
                o.x = cvt_pk_bf16((bf_lo(v.x) - mn) * rs * ga[0] + ba[0], (bf_hi(v.x) - mn) * rs * ga[1] + ba[1]);
                o.y = cvt_pk_bf16((bf_lo(v.y) - mn) * rs * ga[2] + ba[2], (bf_hi(v.y) - mn) * rs * ga[3] + ba[3]);
                o.z = cvt_pk_bf16((bf_lo(v.z) - mn) * rs * gb[0] + bb[0], (bf_hi(v.z) - mn) * rs * gb[1] + bb[1]);
                o.w = cvt_pk_bf16((bf_lo(v.w) - mn) * rs * gb[2] + bb[2], (bf_hi(v.w) - mn) * rs * gb[3] + bb[3]);
                *(LAS v4u*)(lds + GW_V + r * MP + cc * 16) = o; }
            __syncthreads();
            v4u ureg[4];
            { const bf16* up = U + (size_t)(row0 + et) * 4096 + col0 + 32 * ec;
#pragma unroll
              for (int k = 0; k < 4; ++k) ureg[k] = *(const v4u*)(up + 8 * k); }
            bf16x8 wf[4];
#pragma unroll
            for (int ss = 0; ss < 4; ++ss) wf[ss] = *(const LAS bf16x8*)(lds + GW_W + (16 * w + fr) * MP + (32 * ss + 8 * fq) * 2);
#pragma unroll
            for (int db = 0; db < 8; ++db) {
                f32x4 acc = zero4();
#pragma unroll
                for (int ss = 0; ss < 4; ++ss) { LAS unsigned char* p = lds + GW_V + (32 * ss + 8 * fq + (fr >> 2)) * MP + (16 * db + 4 * (fr & 3)) * 2;
                    acc = __builtin_amdgcn_mfma_f32_16x16x32_bf16(cat8(tr_read(p), tr_read(p + 4 * MP)), wf[ss], acc, 0, 0, 0); }
                v2u o; o.x = cvt_pk_bf16(acc[0], acc[1]); o.y = cvt_pk_bf16(acc[2], acc[3]);
                *(LAS v2u*)(lds + GW_O + (16 * w + fr) * MP + (16 * db + 4 * fq) * 2) = o;
            }
            __syncthreads();
            { const LAS unsigned char* op = lds + GW_O + et * MP + 64 * ec;
              unsigned char* hp = F.ws + WS_H + (size_t)(row0 + et) * 4096 + col0 + 32 * ec;
              v4u out[2];
#pragma unroll
              for (int k = 0; k < 4; ++k) { const v4u sv = *(const LAS v4u*)(op + 16 * k); const v4u uv = ureg[k];
                  const unsigned lo = pk4_fp8(bf_lo(uv.x) * (bf_lo(sv.x) + bst), bf_hi(uv.x) * (bf_hi(sv.x) + bst), bf_lo(uv.y) * (bf_lo(sv.y) + bst), bf_hi(uv.y) * (bf_hi(sv.y) + bst));
                  const unsigned hi = pk4_fp8(bf_lo(uv.z) * (bf_lo(sv.z) + bst), bf_hi(uv.z) * (bf_hi(sv.z) + bst), bf_lo(uv.w) * (bf_lo(sv.w) + bst), bf_hi(uv.w) * (bf_hi(sv.w) + bst));
                  out[k >> 1][2 * (k & 1)] = lo; out[k >> 1][2 * (k & 1) + 1] = hi; }
              *(v4u*)hp = out[0]; *(v4u*)(hp + 16) = out[1]; }
        }
        __syncthreads();
    }
}

namespace att {
using bf16 = unsigned short;
constexpr int   D = 128, NW = 8, QBLK = 32, KVBLK = 64;
constexpr float SCALE = 0.088388347648318440f;
constexpr float THR = 8.f;
constexpr int SDEPTH = 2;
constexpr int LDQ = 2048, LDK = 512, LDO = 2048;
constexpr size_t SHM_V = KVBLK * D * 2, SHM_K = KVBLK * D * 2, SHM_ATTN = 2 * SHM_V + 2 * SHM_K + NW * 64 * 4;
using bf16x8 = __attribute__((ext_vector_type(8))) short;
using s16x4  = __attribute__((ext_vector_type(4))) short;
using f32x16 = __attribute__((ext_vector_type(16))) float;
using f32x8  = __attribute__((ext_vector_type(8))) float;
using u32x4  = __attribute__((ext_vector_type(4))) unsigned;
#define KSWZ(row, colB) ((row) * 256 + ((colB) ^ (((row) & 7) << 4)))
#define SBAR() __builtin_amdgcn_sched_barrier(0)
__device__ __forceinline__ int crow(int r, int hi) { return (r & 3) + 8 * (r >> 2) + 4 * hi; }
__device__ __forceinline__ unsigned cvtpk(float lo, float hi) { return ::cvt_pk_bf16(lo, hi); }
template <typename TIn> struct Stage;
template <> struct Stage<bf16>  { using T = bf16x8;
  __device__ static __forceinline__ T ld8(const bf16* p) { return *reinterpret_cast<const bf16x8*>(p); }
  __device__ static __forceinline__ bf16x8 tobf(T x) { return x; } };
__device__ __forceinline__ void partialSM(f32x16& p0, f32x16& p1, float& m_reg, float& mn, float& alpha) {
  constexpr float C = SCALE * 1.4426950408889634f;
  float pmax = p0[0]; for (int r = 1; r < 16; ++r) pmax = fmaxf(pmax, p0[r]); for (int r = 0; r < 16; ++r) pmax = fmaxf(pmax, p1[r]);
  { auto rr = __builtin_amdgcn_permlane32_swap(__float_as_uint(pmax), __float_as_uint(pmax), false, false);
    pmax = fmaxf(__uint_as_float(rr[0]), __uint_as_float(rr[1])); }
  if (__builtin_expect(__all(pmax - m_reg <= THR / SCALE), 1)) { mn = m_reg; alpha = 1.f; }
  else { mn = fmaxf(m_reg, pmax); alpha = __builtin_amdgcn_exp2f((m_reg - mn) * C); m_reg = mn; }
  float mnC = -mn * C;
  for (int r = 0; r < 16; ++r) p0[r] = fmaf(p0[r], C, mnC); for (int r = 0; r < 16; ++r) p1[r] = fmaf(p1[r], C, mnC);
  for (int r = 0; r < 16; ++r) p0[r] = __builtin_amdgcn_exp2f(p0[r]);
}
__device__ __forceinline__ void finishSM(f32x16& p0, f32x16& p1, float alpha, float& l_reg, bf16x8& pa0, bf16x8& pa1, bf16x8& pa2, bf16x8& pa3) {
  for (int r = 0; r < 16; ++r) p1[r] = __builtin_amdgcn_exp2f(p1[r]);
  float ps = 0; for (int r = 0; r < 16; ++r) ps += p0[r]; for (int r = 0; r < 16; ++r) ps += p1[r];
  { auto rr = __builtin_amdgcn_permlane32_swap(__float_as_uint(ps), __float_as_uint(ps), false, false);
    ps = __uint_as_float(rr[0]) + __uint_as_float(rr[1]); }
  l_reg = l_reg * alpha + ps;
#define PK4(P, BASE, OUT) do { unsigned a0 = cvtpk(P[BASE + 0], P[BASE + 1]), a1 = cvtpk(P[BASE + 2], P[BASE + 3]);   \
    unsigned b0 = cvtpk(P[BASE + 4], P[BASE + 5]), b1 = cvtpk(P[BASE + 6], P[BASE + 7]);                              \
    auto r0 = __builtin_amdgcn_permlane32_swap(a0, b0, false, false); auto r1 = __builtin_amdgcn_permlane32_swap(a1, b1, false, false); \
    u32x4 w = {r0[0], r1[0], r0[1], r1[1]}; OUT = *reinterpret_cast<bf16x8*>(&w); } while (0)
  PK4(p0, 0, pa0); PK4(p0, 8, pa1); PK4(p1, 0, pa2); PK4(p1, 8, pa3);
#undef PK4
}
__device__ __forceinline__ void qkt(f32x16& p0, f32x16& p1, const bf16* Ks, const bf16x8* qr, int r32, int hi) {
  p0 = f32x16{}; p1 = f32x16{};
  for (int d0 = 0; d0 < 8; ++d0) { int cb = (d0 * 16 + hi * 8) * 2;
    bf16x8 b0 = *reinterpret_cast<const bf16x8*>((const char*)Ks + KSWZ(r32, cb));
    bf16x8 b1 = *reinterpret_cast<const bf16x8*>((const char*)Ks + KSWZ(32 + r32, cb));
    p0 = __builtin_amdgcn_mfma_f32_32x32x16_bf16(b0, qr[d0], p0, 0, 0, 0);
    p1 = __builtin_amdgcn_mfma_f32_32x32x16_bf16(b1, qr[d0], p1, 0, 0, 0); }
}
__device__ __forceinline__ int v_st(int k, int c) { const int kk = (k & ~0xC) | ((k & 4) << 1) | ((k & 8) >> 1); return ((kk >> 3) * 4 + (c >> 5)) * 512 + ((kk & 7) * 32 + (c & 31)) * 2; }
__device__ __forceinline__ int v_rd_base(int lane) { return ((lane & 3) << 3) | (((lane >> 2) & 3) << 6) | (((lane >> 4) & 1) << 5) | (((lane >> 5) & 1) << 8); }
constexpr int v_rd_off(int d0, int ks, int half) { return d0 * 512 + ks * 4096 + half * 2048; }
template <int OFF> __device__ __forceinline__ s16x4 tr_read(int vb) {
  return __builtin_amdgcn_ds_read_tr16_b64_v4i16((__attribute__((address_space(3))) s16x4*)(unsigned long)(unsigned)(vb + OFF));
}
template <int D0> __device__ __forceinline__ void pv_one(f32x16& od, int vb, bf16x8 pa0, bf16x8 pa1, bf16x8 pa2, bf16x8 pa3) {
  const s16x4 l0 = tr_read<v_rd_off(D0, 0, 0)>(vb), h0 = tr_read<v_rd_off(D0, 0, 1)>(vb), l1 = tr_read<v_rd_off(D0, 1, 0)>(vb), h1 = tr_read<v_rd_off(D0, 1, 1)>(vb);
  const s16x4 l2 = tr_read<v_rd_off(D0, 2, 0)>(vb), h2 = tr_read<v_rd_off(D0, 2, 1)>(vb), l3 = tr_read<v_rd_off(D0, 3, 0)>(vb), h3 = tr_read<v_rd_off(D0, 3, 1)>(vb);
#define PK(L, H) (bf16x8){L[0], L[1], L[2], L[3], H[0], H[1], H[2], H[3]}
  od = __builtin_amdgcn_mfma_f32_32x32x16_bf16(pa0, PK(l0, h0), od, 0, 0, 0);
  od = __builtin_amdgcn_mfma_f32_32x32x16_bf16(pa1, PK(l1, h1), od, 0, 0, 0);
  od = __builtin_amdgcn_mfma_f32_32x32x16_bf16(pa2, PK(l2, h2), od, 0, 0, 0);
  od = __builtin_amdgcn_mfma_f32_32x32x16_bf16(pa3, PK(l3, h3), od, 0, 0, 0);
#undef PK
}
__device__ __forceinline__ void pv_d0(f32x16* o, int vb, bf16x8 pa0, bf16x8 pa1, bf16x8 pa2, bf16x8 pa3) {
  pv_one<0>(o[0], vb, pa0, pa1, pa2, pa3); pv_one<1>(o[1], vb, pa0, pa1, pa2, pa3); pv_one<2>(o[2], vb, pa0, pa1, pa2, pa3); pv_one<3>(o[3], vb, pa0, pa1, pa2, pa3);
}

template <typename TQ>
__device__ __forceinline__ void attn_dense_body(const TQ* __restrict__ Qb, const bf16* __restrict__ Kh, const bf16* __restrict__ Vh,
                                                unsigned char* __restrict__ Ob, int seq, char* lds, int tid_in) {
  using St = Stage<bf16>; using SQ = Stage<TQ>;
  const int tid = tid_in, wid = tid >> 6, lane = tid & 63, r32 = lane & 31, hi = lane >> 5;
  bf16* V_lds = (bf16*)lds; bf16* K_lds = (bf16*)(lds + 2 * SHM_V);
  float* ws = (float*)(lds + 2 * SHM_V + 2 * SHM_K) + wid * 64; float* li_l = ws; float* al_l = ws + 32;
  float m_reg = -1e30f, l_reg = 0; f32x16 o[4] = {}; bf16x8 qr[8];
  const TQ* Qw = Qb + (long)(wid * QBLK + r32) * LDQ + hi * 8;
#pragma unroll
  for (int d0 = 0; d0 < 8; ++d0) qr[d0] = SQ::tobf(SQ::ld8(Qw + d0 * 16));
  const int sr = tid >> 4, sc = (tid & 15) * 8, vst0 = v_st(sr, sc), vst1 = v_st(32 + sr, sc);
  const int vb0 = (int)(uintptr_t)V_lds + v_rd_base(lane);
  struct { typename St::T vs0, vs1, ks0, ks1; } sr_[SDEPTH];
#define SLOAD(i, k0) do { sr_[i].vs0 = St::ld8(&Vh[(long)((k0) + sr) * LDK + sc]); sr_[i].vs1 = St::ld8(&Vh[(long)((k0) + 32 + sr) * LDK + sc]); \
    sr_[i].ks0 = St::ld8(&Kh[(long)((k0) + sr) * LDK + sc]); sr_[i].ks1 = St::ld8(&Kh[(long)((k0) + 32 + sr) * LDK + sc]); } while (0)
#define SWRITE(b, i) do { *(bf16x8*)((char*)V_lds + (b) * SHM_V + vst0) = St::tobf(sr_[i].vs0);          \
    *(bf16x8*)((char*)V_lds + (b) * SHM_V + vst1) = St::tobf(sr_[i].vs1); int kc = sc * 2;               \
    *(bf16x8*)((char*)K_lds + (b) * SHM_K + KSWZ(sr, kc)) = St::tobf(sr_[i].ks0);                       \
    *(bf16x8*)((char*)K_lds + (b) * SHM_K + KSWZ(32 + sr, kc)) = St::tobf(sr_[i].ks1); } while (0)
#define SWAIT() do { if constexpr (SDEPTH == 2) asm volatile("s_waitcnt vmcnt(4)" ::: "memory"); else asm volatile("s_waitcnt vmcnt(0)" ::: "memory"); } while (0)
#define RESC(a) do { if (__any((a) < 1.f)) { if (hi == 0) al_l[r32] = (a); asm volatile("s_waitcnt lgkmcnt(0)" ::: "memory"); \
    for (int d = 0; d < 4; ++d) for (int r = 0; r < 16; ++r) o[d][r] *= al_l[crow(r, hi)]; } } while (0)
  f32x16 pA0, pA1, pB0, pB1; float mnA, mnB, alA, alB; bf16x8 pa0, pa1, pa2, pa3; const int NT = seq / KVBLK;
  constexpr int SE = 0, SO = SDEPTH - 1;
  SLOAD(SE, 0); asm volatile("s_waitcnt vmcnt(0)" ::: "memory"); SWRITE(0, SE); __syncthreads();
  qkt(pA0, pA1, K_lds, qr, r32, hi); partialSM(pA0, pA1, m_reg, mnA, alA);
  SLOAD(SO, KVBLK); if constexpr (SDEPTH == 2) { if (2 < NT) SLOAD(SE, 2 * KVBLK); }
  SWAIT(); SWRITE(1, SO); __syncthreads();
  for (int j = 1; j + 1 < NT; j += 2) {
    SBAR(); qkt(pB0, pB1, (bf16*)((char*)K_lds + SHM_K), qr, r32, hi);
    finishSM(pA0, pA1, alA, l_reg, pa0, pa1, pa2, pa3); SBAR();
    SLOAD(SO, (j + SDEPTH) * KVBLK); SBAR();
    pv_d0(o, vb0, pa0, pa1, pa2, pa3); partialSM(pB0, pB1, m_reg, mnB, alB);
    __syncthreads(); SWAIT(); SWRITE(0, SE);
    RESC(alB); __syncthreads();
    SBAR(); qkt(pA0, pA1, K_lds, qr, r32, hi);
    finishSM(pB0, pB1, alB, l_reg, pa0, pa1, pa2, pa3); SBAR();
    if (SDEPTH == 1 || j + 3 < NT) SLOAD(SE, (j + 1 + SDEPTH) * KVBLK); SBAR();
    pv_d0(o, vb0 + (int)SHM_V, pa0, pa1, pa2, pa3); partialSM(pA0, pA1, m_reg, mnA, alA);
    __syncthreads(); SWAIT(); SWRITE(1, SO);
    RESC(alA); __syncthreads();
  }
  SBAR(); qkt(pB0, pB1, (bf16*)((char*)K_lds + SHM_K), qr, r32, hi);
  finishSM(pA0, pA1, alA, l_reg, pa0, pa1, pa2, pa3); SBAR();
  pv_d0(o, vb0, pa0, pa1, pa2, pa3); partialSM(pB0, pB1, m_reg, mnB, alB);
  __syncthreads(); RESC(alB);
  finishSM(pB0, pB1, alB, l_reg, pa0, pa1, pa2, pa3); SBAR();
  pv_d0(o, vb0 + (int)SHM_V, pa0, pa1, pa2, pa3);
  if (hi == 0) li_l[r32] = l_reg; asm volatile("s_waitcnt lgkmcnt(0)" ::: "memory");
  float rli[16];
#pragma unroll
  for (int r = 0; r < 16; ++r) rli[r] = __builtin_amdgcn_rcpf(li_l[crow(r, hi)]);
  unsigned char* Ow = Ob + (long)(wid * QBLK) * LDO;
#pragma unroll
  for (int r = 0; r < 16; ++r) { int orow = crow(r, hi);
    for (int d0 = 0; d0 < 4; ++d0) Ow[(long)orow * LDO + d0 * 32 + r32] = (unsigned char)(__builtin_amdgcn_cvt_pk_fp8_f32(o[d0][r] * rli[r], 0.f, 0, false) & 0xff); }
#undef SLOAD
#undef SWRITE
#undef SWAIT
#undef RESC
}
}

constexpr size_t WS_ROPE = WS_STAT + 512 * 1024;
__device__ __forceinline__ void rope_table(Frame& F) {
    float* R = (float*)(F.ws + WS_ROPE);
    const int i = F.vcu * NTHR + F.tid;
    if (i < 64 * 32) { const int pos = i >> 5, fi = i & 31; const float fr = powf(10000.0f, -(float)fi / 32.0f); const float ang = (float)pos * fr; R[2 * i] = cosf(ang); R[2 * i + 1] = sinf(ang); }
}
__device__ __forceinline__ v4u normrope_seg(const bf16* src, const float* g, const float* R, bool rope, int rowpos, int colpos, int lane) {
    const v4u x = *(const v4u*)(src + 8 * lane);
    float v[8] = {bf_lo(x.x), bf_hi(x.x), bf_lo(x.y), bf_hi(x.y), bf_lo(x.z), bf_hi(x.z), bf_lo(x.w), bf_hi(x.w)};
    float q = 0.f;
#pragma unroll
    for (int i = 0; i < 8; ++i) q += v[i] * v[i];
    const float rstd = 1.0f / sqrtf(row16_sum(q) * (1.0f / 128.f) + LN_EPS);
    const int d0 = 8 * (lane & 15);
    const f32x4 ga = *(const f32x4*)(g + d0), gb = *(const f32x4*)(g + d0 + 4);
#pragma unroll
    for (int i = 0; i < 4; ++i) { v[i] *= rstd * ga[i]; v[4 + i] *= rstd * gb[i]; }
    if (rope) {
        const int pos = ((lane & 15) >> 3) ? colpos : rowpos; const bool hi = (lane & 7) >= 4; const int f0 = 8 * (lane & 3);
#pragma unroll
        for (int i = 0; i < 8; ++i) { const float p = __shfl_xor(v[i], 4); const float cs = R[(pos * 32 + f0 + i) * 2], sn = R[(pos * 32 + f0 + i) * 2 + 1];
            v[i] = hi ? (p * sn + v[i] * cs) : (v[i] * cs - p * sn); }
    }
    v4u o; o.x = cvt_pk_bf16(v[0], v[1]); o.y = cvt_pk_bf16(v[2], v[3]); o.z = cvt_pk_bf16(v[4], v[5]); o.w = cvt_pk_bf16(v[6], v[7]);
    return o;
}
__device__ __forceinline__ void attn_prep_phase(Frame& F) {
    const int gw = F.vcu * NWAVES + F.wave, NGW = F.G * NWAVES;
    const float* R = (const float*)(F.ws + WS_ROPE);
    const float* qg = F.in[I_CQG]; const float* kg = F.in[I_CKG];
    for (int row = gw; row < T; row += NGW) {
        const bool lat = row < TL; const int b = lat ? (row >> 12) : ((row - TL) >> 8); const int s = lat ? (row & 4095) : 0;
        const int rp = s >> 6, cp = s & 63; const int kvrow = lat ? (b * SKV + s) : (b * SKV + SEQ + ((row - TL) & 255));
        bf16* q = (bf16*)(F.ws + WS_Z + ZAQ) + (size_t)row * 2048;
#pragma unroll
        for (int p = 0; p < 4; ++p) { const v4u o = normrope_seg(q + 512 * p, qg, R, lat, rp, cp, F.lane); *(v4u*)(q + 512 * p + 8 * F.lane) = o; }
        const bf16* k = (const bf16*)(F.ws + WS_Z + ZAK) + (size_t)row * 512; const bf16* v = (const bf16*)(F.ws + WS_Z + ZAV) + (size_t)row * 512;
        const v4u ko = normrope_seg(k, kg, R, lat, rp, cp, F.lane);
        *(v4u*)((bf16*)(F.ws + WS_Z + ZKC) + (size_t)kvrow * 512 + 8 * F.lane) = ko;
        *(v4u*)((bf16*)(F.ws + WS_Z + ZVC) + (size_t)kvrow * 512 + 8 * F.lane) = *(const v4u*)(v + 8 * F.lane);
    }
}
__device__ __forceinline__ void attn_phase(Frame& F, char* lds, bool need_ctx) {
    const bf16* Q = (const bf16*)(F.ws + WS_Z + ZAQ); const bf16* KC = (const bf16*)(F.ws + WS_Z + ZKC); const bf16* VC = (const bf16*)(F.ws + WS_Z + ZVC);
    unsigned char* O = F.ws + WS_H;
    const int nunits = 2048 + (need_ctx ? 128 : 0);
    for (int u = F.vcu; u < nunits; u += F.G) {
        const bf16 *qp, *kp, *vp; unsigned char* op; int seq;
        if (u < 2048) { const int qb = u & 15, h = (u >> 4) & 15, b = u >> 8; const size_t qrow = (size_t)b * SEQ + qb * 256;
            qp = Q + qrow * 2048 + h * 128; kp = KC + (size_t)b * SKV * 512 + (h >> 2) * 128; vp = VC + (size_t)b * SKV * 512 + (h >> 2) * 128; op = O + qrow * 2048 + h * 128; seq = SKV;
        } else { const int uu = u - 2048, h = uu & 15, b = uu >> 4; const size_t qrow = (size_t)TL + b * CL;
            qp = Q + qrow * 2048 + h * 128; kp = KC + ((size_t)b * SKV + SEQ) * 512 + (h >> 2) * 128; vp = VC + ((size_t)b * SKV + SEQ) * 512 + (h >> 2) * 128; op = O + qrow * 2048 + h * 128; seq = CL; }
        int tid_l = threadIdx.x; asm volatile("" : "+v"(tid_l));
        att::attn_dense_body<bf16>(qp, kp, vp, op, seq, lds, tid_l);
        __syncthreads();
    }
}

#ifndef MK_N_LAUNCHES
#define MK_N_LAUNCHES 1
#endif
constexpr int NPH = 2 + 8 * DEPTH;
struct Args { const float* in[28]; float* out; unsigned char* ws; int ph_lo, ph_hi; };

typedef pg8::EpiSeg<0> EpiPlain;
__device__ __forceinline__ EpiPlain epi_plain(bf16* o, int ld) { EpiPlain E; E.base = (unsigned char*)o; E.ld = ld; E.bias = nullptr; E.gates = nullptr; E.oscale = 1.0f / WSCALE; return E; }


__global__ void __launch_bounds__(NTHR, 2) fwd_kernel(Args args) {
    extern __shared__ __attribute__((aligned(16))) unsigned char lds_raw[];
    Frame F;
    F.lds = (LAS unsigned char*)lds_raw;
    F.tid = threadIdx.x; F.lane = F.tid & 63; F.wave = __builtin_amdgcn_readfirstlane(F.tid >> 6);
    F.G = gridDim.x; { const int bx = blockIdx.x; F.vcu = (F.G % 8 == 0) ? (bx % 8) * (F.G / 8) + bx / 8 : bx; }
    typedef const Args __attribute__((address_space(4)))* KArgs;
    KArgs ka = (KArgs)__builtin_amdgcn_kernarg_segment_ptr();
    F.in = ka->in; F.out = ka->out; F.ws = ka->ws;
    volatile LAS unsigned* MISC = (volatile LAS unsigned*)(F.lds + MISC_OFF);
    for (int u = F.tid; u < (LDS_BYTES - MISC_OFF) / 4; u += NTHR) MISC[u] = 0u;
    __syncthreads();
    const int lo = ka->ph_lo, hi = ka->ph_hi;
    unsigned* barw = (unsigned*)(F.ws + WS_CTL) + CW_BAR;
    XcdBarrier bar; bar.bar = barw; bar.x = 0; bar.st = nullptr;
    if (hi - lo > 1) bar = xcd_barrier_post(barw, MISC + 8);
#ifdef ONLY_PHASE
#define IN(k) ((k) == ONLY_PHASE && lo <= (k) && (k) < hi)
#else
#define IN(k) (lo <= (k) && (k) < hi)
#endif
#define SEAM(k) do { if (IN(k) && IN((k) + 1)) xcd_barrier(bar); } while (0)
#define RELANE() do { int t_ = threadIdx.x; asm volatile("" : "+v"(t_)); F.tid = t_; F.lane = t_ & 63; KArgs k_ = ka; asm volatile("" : "+s"(k_)); F.in = k_->in; F.out = k_->out; F.ws = k_->ws; } while (0)
#define WT (F.ws + WS_WT)
#define Hb ((bf16*)(F.ws + WS_H))
#define Yb ((bf16*)(F.ws + WS_Y))
#define Zb ((bf16*)(F.ws + WS_Z))

    if (IN(0)) { RELANE(); p0_prologue(F); rope_table(F); } SEAM(0);
    if (IN(1)) { RELANE(); p0b_modulate(F); } SEAM(1);

#define GEMM_PHASE16(EPI, Aptr, Bptr, M_, N_, K_) do { pg8::Gemm g{(const bf16*)(Aptr), (const bf16*)(Bptr), (M_), (N_), (K_)}; pg8::StaticOrder S; S.init((M_), (N_), F.G, (int)blockIdx.x); \
        pg8::gemm_phase<false>(F.lds, g, S, (EPI)); } while (0)
#define GEMM_PHASE(EPI, Aptr, Bptr, M_, N_, K_) do { pg8::Gemm g{(const bf16*)(Aptr), (const bf16*)(Bptr), (M_), (N_), (K_) / 2}; pg8::StaticOrder S; S.init((M_), (N_), F.G, (int)blockIdx.x); \
        pg8::gemm_phase<true>(F.lds, g, S, (EPI)); } while (0)
#define PEER_PHASES(L, PB, M_) do { \
        if (IN((PB) + 4)) { RELANE(); ln1_phase<L>(F, (M_)); } SEAM((PB) + 4); \
        if (IN((PB) + 5)) { RELANE(); EpiPlain E = epi_plain(Zb, 2048); \
            if ((PQ_FP8_MASK >> (L)) & 1) { GEMM_PHASE(E, Hb, WT + WT_PQ + (size_t)(L) * D * D * 2, (M_), 2048, 2048); } \
            else { E.oscale = 1.0f; GEMM_PHASE16(E, Yb, WT + WT_PQ + (size_t)(L) * D * D * 2, (M_), 2048, 2048); } } SEAM((PB) + 5); \
        if (IN((PB) + 6)) { RELANE(); peer_topk_phase<L>(F, (M_)); } SEAM((PB) + 6); \
        if (IN((PB) + 7)) { RELANE(); peer_u_phase<L>(F, (M_)); if (hi - lo > 1) xcd_barrier(bar); RELANE(); peer_v_phase<L>(F, (M_)); } SEAM((PB) + 7); } while (0)
#define MLSTM_PHASES(L, PB, M_) do { \
        if (IN((PB) + 0)) { RELANE(); pg8::EpiSeg<1> E; E.base = F.ws + WS_Z; E.ld = 0; E.bias = nullptr; E.gates = (float*)(F.ws + WS_GATE); E.oscale = 1.0f / WSCALE; \
            GEMM_PHASE(E, Hb, WT + WT_AIN + (size_t)((L) / 3) * A_INP * D, T, A_INP, 2048); } SEAM((PB) + 0); \
        if (IN((PB) + 1)) { RELANE(); mlstm_scan_phase<L>(F); } SEAM((PB) + 1); \
        if (IN((PB) + 2)) { RELANE(); mlstm_post_phase<L>(F, (M_)); } SEAM((PB) + 2); \
        if (IN((PB) + 3)) { RELANE(); EpiPlain E = epi_plain(Yb, 2048); GEMM_PHASE(E, F.ws + WS_Z + ZG, WT + WT_AOUT + (size_t)((L) / 3) * D * D, (M_), 2048, 2048); } SEAM((PB) + 3); } while (0)

    MLSTM_PHASES(0, 2, T);
    PEER_PHASES(0, 2, T);
    if (IN(10)) { RELANE(); pg8::EpiSeg<2> E; E.base = F.ws + WS_Z; E.ld = 0; E.bias = F.in[I_BBIN]; E.gates = nullptr; E.oscale = 1.0f / WSCALE; GEMM_PHASE(E, Hb, WT + WT_BIN, T, 8192, 2048); } SEAM(10);
    if (IN(11)) { RELANE(); gmlp_stats_phase(F, T); } SEAM(11);
    if (IN(12)) { RELANE(); gmlp_spatial_phase(F, T); } SEAM(12);
    if (IN(13)) { RELANE(); EpiPlain E = epi_plain(Yb, 2048); GEMM_PHASE(E, Hb, WT + WT_BOUT, T, 2048, 4096); } SEAM(13);
    PEER_PHASES(1, 10, T);
    if (IN(18)) { RELANE(); pg8::EpiSeg<3> E; E.base = F.ws + WS_Z; E.ld = 0; E.bias = nullptr; E.gates = nullptr; E.oscale = 1.0f / WSCALE; GEMM_PHASE(E, Hb, WT + WT_CQKV, T, C_QKV, 2048); } SEAM(18);
    if (IN(19)) { RELANE(); attn_prep_phase(F); } SEAM(19);
    if (IN(20)) { RELANE(); attn_phase(F, (char*)lds_raw, true); } SEAM(20);
    if (IN(21)) { RELANE(); EpiPlain E = epi_plain(Yb, 2048); GEMM_PHASE(E, Hb, WT + WT_COUT, T, 2048, 2048); } SEAM(21);
    PEER_PHASES(2, 18, T);
    MLSTM_PHASES(3, 26, TL);
    PEER_PHASES(3, 26, TL);
#undef IN
#undef SEAM
#undef WT
#undef Hb
#undef Yb
#undef Zb
}


extern "C" void kernel_launch(void* const* d_in, const int* in_sizes, int n_in, void* d_out, int out_size, void* d_ws, size_t ws_size, hipStream_t stream) {
    static int grid = 0;
    if (grid == 0) {
        if (n_in != 28 || out_size != TL * D || ws_size < WS_END) { fprintf(stderr, "kernel_launch: unexpected shapes: n_in %d out %d ws %zu (need %zu)\n", n_in, out_size, ws_size, (size_t)WS_END); grid = -1; return; }
        int dev = 0, cus = 0, per_cu = 0;
        if (hipGetDevice(&dev) != hipSuccess || hipDeviceGetAttribute(&cus, hipDeviceAttributeMultiprocessorCount, dev) != hipSuccess) { grid = -1; return; }
        if (hipFuncSetAttribute((const void*)fwd_kernel, hipFuncAttributeMaxDynamicSharedMemorySize, LDS_BYTES) != hipSuccess) { fprintf(stderr, "kernel_launch: hipFuncSetAttribute failed\n"); grid = -1; return; }
        if (hipOccupancyMaxActiveBlocksPerMultiprocessor(&per_cu, (const void*)fwd_kernel, NTHR, LDS_BYTES) != hipSuccess || per_cu < 1) { fprintf(stderr, "kernel_launch: occupancy query says %d\n", per_cu); }
        (void)hipGetLastError();
        grid = cus;
    }
    if (grid < 0) return;
    if (hipMemsetAsync((char*)d_ws + WS_CTL, 0, CTL_ZERO_BYTES, stream) != hipSuccess) return;
    Args a{};
    for (int i = 0; i < 28; ++i) a.in[i] = (const float*)d_in[i];
    a.out = (float*)d_out; a.ws = (unsigned char*)d_ws;
#if MK_N_LAUNCHES == 1
    a.ph_lo = 0; a.ph_hi = NPH;
    hipLaunchKernelGGL(fwd_kernel, dim3(grid), dim3(NTHR), LDS_BYTES, stream, a);
#else
    for (int k = 0; k < NPH; ++k) { a.ph_lo = k; a.ph_hi = k + 1; hipLaunchKernelGGL(fwd_kernel, dim3(grid), dim3(NTHR), LDS_BYTES, stream, a); }
#endif
    const hipError_t le = hipPeekAtLastError();
    if (le != hipSuccess) fprintf(stderr, "kernel_launch: launch failed: %s\n", hipGetErrorName(le));
}
```

```cpp
#include <hip/hip_runtime.h>
#include <cstdio>
#include <cstdint>

#define GAS __attribute__((address_space(1)))
#define LAS __attribute__((address_space(3)))
typedef unsigned short bf16;
typedef unsigned v4u __attribute__((ext_vector_type(4)));
typedef unsigned v2u __attribute__((ext_vector_type(2)));
typedef float f32x4 __attribute__((ext_vector_type(4)));
typedef float f32x2 __attribute__((ext_vector_type(2)));
typedef short bf16x8 __attribute__((ext_vector_type(8)));
typedef short s16x4 __attribute__((ext_vector_type(4)));
typedef int v8i_t __attribute__((ext_vector_type(8)));
typedef int v4i_t __attribute__((ext_vector_type(4)));
#define LDS_WAIT() asm volatile("s_waitcnt lgkmcnt(0)" ::: "memory")
#define VM_WAIT() asm volatile("s_waitcnt vmcnt(0)" ::: "memory")

constexpr int D = 2048, NB = 8, SEQ = 4096, CL = 256, DEPTH = 4;
constexpr int TL = NB * SEQ, TC = NB * CL, T = TL + TC;
constexpr int NMOD = 6 * D;
constexpr float ALPHA = 1.681792830507429f;
constexpr float LN_EPS = 1e-6f;
constexpr int A_HEADS = 4, A_DV = 512, A_DK = 256, A_CHUNK = 128, A_IN = 6160, A_INP = 6400;
constexpr int B_INNER = 4096, B_GROUPS = 8;
constexpr int C_HEADS = 16, C_KV = 4, C_HD = 128, C_QKV = 3072, SKV = SEQ + CL;
constexpr int P_HEADS = 8, P_NK = 128, P_TOPK = 16, P_E = 16384;
constexpr int NWAVES = 8, NTHR = 512;

constexpr size_t MiB = 1u << 20;
constexpr size_t WS_CTL = 0, CTL_ZERO_BYTES = 1 * MiB;
constexpr size_t WS_MOD = 1 * MiB;
constexpr size_t WS_STAT = 3 * MiB;
constexpr size_t WS_GATE = 4 * MiB;
constexpr size_t WS_K12 = 7 * MiB;
constexpr size_t WS_WS = 8 * MiB;
constexpr size_t WS_WT = 9 * MiB;
constexpr size_t WT_AIN = 0, WT_AOUT = WT_AIN + (size_t)2 * A_INP * D, WT_BIN = WT_AOUT + (size_t)2 * D * D, WT_BOUT = WT_BIN + (size_t)8192 * D,
                 WT_CQKV = WT_BOUT + (size_t)D * 4096, WT_COUT = WT_CQKV + (size_t)C_QKV * D, WT_PQ = WT_COUT + (size_t)D * D, WT_END = WT_PQ + (size_t)4 * D * D * 2;
constexpr int PQ_FP8_MASK = 0x3;
constexpr float WSCALE = 64.0f;
constexpr size_t WS_PU8 = 192 * MiB;
constexpr size_t WS_PV8 = WS_PU8 + (size_t)4 * P_E * D;
constexpr size_t WS_SC = WS_PV8 + (size_t)4 * P_E * D;
constexpr size_t WS_X = WS_SC + 1 * MiB;
constexpr size_t WS_GP = WS_X + (size_t)T * D * 2;
constexpr size_t WS_H = WS_X + (size_t)T * D * 4;
constexpr size_t WS_Y = WS_H + (size_t)T * D * 2;
constexpr size_t WS_Z = WS_Y + (size_t)T * D * 2;
constexpr size_t WS_IDX = WS_Z + (size_t)T * 8192 * 2;
constexpr size_t WS_PG = WS_IDX + (size_t)T * 128 * 4;
constexpr size_t WS_END = WS_PG + (size_t)T * 128 * 4;
static_assert(WS_WT + WT_END <= WS_PU8, "weights fit");
constexpr size_t ZQ = 0, ZK = (size_t)T * 1024 * 2, ZV = ZK + (size_t)T * 1024 * 2, ZO = ZV + (size_t)T * 2048 * 2, ZG = 0;
constexpr size_t ZU = 0, ZVV = (size_t)T * 4096 * 2;
constexpr size_t ZAQ = 0, ZAK = (size_t)T * 2048 * 2, ZAV = ZAK + (size_t)T * 512 * 2, ZKC = ZAV + (size_t)T * 512 * 2, ZVC = ZKC + (size_t)NB * SKV * 512 * 2;
constexpr int CW_BAR = 4096;

constexpr int LDS_BYTES = 155648;
constexpr int MISC_OFF = 151552;

typedef __bf16 bf16x2_t __attribute__((ext_vector_type(2)));
__device__ __forceinline__ unsigned cvt_pk_bf16(float lo, float hi) { const f32x2 v = {lo, hi}; return __builtin_bit_cast(unsigned, __builtin_convertvector(v, bf16x2_t)); }
__device__ __forceinline__ unsigned pk4_fp8(float a, float b, float c, float d) { int w = __builtin_amdgcn_cvt_pk_fp8_f32(a, b, 0, false); return (unsigned)__builtin_amdgcn_cvt_pk_fp8_f32(c, d, w, true); }
typedef float f32x16_t __attribute__((ext_vector_type(16)));
__device__ __forceinline__ f32x4 zero4() { f32x4 z = {0.f, 0.f, 0.f, 0.f}; asm volatile("" : "+v"(z)); return z; }
__device__ __forceinline__ f32x16_t zero16() { f32x16_t z = {}; asm volatile("" : "+v"(z)); return z; }
__device__ __forceinline__ float bf_lo(unsigned u) { return __uint_as_float(u << 16); }
__device__ __forceinline__ float bf_hi(unsigned u) { return __uint_as_float(u & 0xffff0000u); }
__device__ __forceinline__ float bf2f(bf16 b) { return __uint_as_float(((unsigned)b) << 16); }
__device__ __forceinline__ float wave_sum(float v) {
#pragma unroll
    for (int o = 1; o < 64; o <<= 1) v += __shfl_xor(v, o);
    return v;
}
__device__ __forceinline__ float wave_max(float v) {
#pragma unroll
    for (int o = 1; o < 64; o <<= 1) v = fmaxf(v, __shfl_xor(v, o));
    return v;
}
__device__ __forceinline__ float fast_exp(float x) { return __builtin_amdgcn_exp2f(x * 1.4426950408889634f); }
__device__ __forceinline__ float gelu_tanh(float x) {
    const float u = 0.7978845608028654f * (x + 0.044715f * x * x * x);
    const float e = __builtin_amdgcn_exp2f(-2.0f * 1.4426950408889634f * u);
    return x * __builtin_amdgcn_rcpf(1.0f + e);
}
__device__ __forceinline__ float silu(float x) { return x / (1.0f + __expf(-x)); }

#define XB_TMO      128
#define XB_XCNT(j)  (256  + 64 * (j))
#define XB_XSUB(j)  (1280 + 64 * (j))
#define XB_XGEN(j)  (2304 + 64 * (j))
#define XB_TOP      3328
#define XB_TOPGEN   3392
#define XCD_BAR_WORDS 3456
#define XB_SPIN_CAP (1u << 22)

__device__ __forceinline__ unsigned xb_ld(unsigned* p)              { return __hip_atomic_load(p, __ATOMIC_RELAXED, __HIP_MEMORY_SCOPE_AGENT); }
__device__ __forceinline__ unsigned xb_add(unsigned* p, unsigned v) { return __hip_atomic_fetch_add(p, v, __ATOMIC_RELAXED, __HIP_MEMORY_SCOPE_AGENT); }
__device__ __forceinline__ unsigned xb_xcc_id() { return (unsigned)__builtin_amdgcn_s_getreg((3 << 11) | 20) & 0xFu; }
#define XB_SPIN(cond, bar) do { unsigned _sp = 0; while (cond) { __builtin_amdgcn_s_sleep(1); \
    if ((++_sp & 255u) == 0u) { if (xb_ld(&(bar)[XB_TMO])) break; if (_sp > XB_SPIN_CAP) { atomicAdd(&(bar)[XB_TMO], 1u); break; } } } } while (0)

struct XcdBarrier { unsigned* bar; unsigned x; volatile LAS unsigned* st; };
__device__ __forceinline__ XcdBarrier xcd_barrier_post(unsigned* bar, volatile LAS unsigned* st) {
    XcdBarrier b; b.bar = bar; b.x = xb_xcc_id(); b.st = st;
    if (threadIdx.x == 0) (void)xb_add(&bar[XB_XCNT(b.x)], 1u);
    return b;
}
__device__ __forceinline__ void xcd_barrier_complete(unsigned* bar, unsigned x, unsigned& nloc, unsigned& nx) {
    const unsigned G = gridDim.x * gridDim.y * gridDim.z;
    unsigned sum, cnt, mine, sp = 0u;
    for (;;) {
        sum = 0u; cnt = 0u; mine = 0u;
#pragma unroll
        for (unsigned j = 0; j < 16; ++j) { const unsigned c = xb_ld(&bar[XB_XCNT(j)]); sum += c; cnt += (c > 0u) ? 1u : 0u; mine = (j == x) ? c : mine; }
        if (sum == G) break;
        __builtin_amdgcn_s_sleep(1);
        if ((++sp & 255u) == 0u) { if (xb_ld(&bar[XB_TMO])) break; if (sp > XB_SPIN_CAP) { atomicAdd(&bar[XB_TMO], 1u); break; } }
    }
    nloc = mine > 0u ? mine : 1u; nx = cnt > 0u ? cnt : 1u;
}
__device__ __forceinline__ void xcd_barrier(const XcdBarrier& b) {
    asm volatile("s_waitcnt vmcnt(0)" ::: "memory");
    __syncthreads();
    if (threadIdx.x == 0) {
        unsigned* bar = b.bar;
        __builtin_amdgcn_s_waitcnt(0);
        unsigned nloc = b.st[0], nx = b.st[1];
        if (nloc == 0u) { xcd_barrier_complete(bar, b.x, nloc, nx); b.st[0] = nloc; b.st[1] = nx; }
        const unsigned old = xb_add(&bar[XB_XSUB(b.x)], 1u);
        const unsigned gen = old / nloc;
        if (old + 1u == (gen + 1u) * nloc) {
            __builtin_amdgcn_fence(__ATOMIC_RELEASE, "agent");
            asm volatile("s_waitcnt vmcnt(0)" ::: "memory");
            const unsigned og = xb_add(&bar[XB_TOP], 1u);
            const unsigned tg = og / nx;
            if (og + 1u == (tg + 1u) * nx) xb_add(&bar[XB_TOPGEN], 1u);
            else XB_SPIN(xb_ld(&bar[XB_TOPGEN]) == tg, bar);
            __builtin_amdgcn_fence(__ATOMIC_ACQUIRE, "agent");
            xb_add(&bar[XB_XGEN(b.x)], 1u);
            asm volatile("s_waitcnt vmcnt(0)" ::: "memory");
        } else {
            XB_SPIN(xb_ld(&bar[XB_XGEN(b.x)]) == gen, bar);
            __builtin_amdgcn_fence(__ATOMIC_ACQUIRE, "agent");
            asm volatile("s_waitcnt vmcnt(0)" ::: "memory");
        }
    }
    __syncthreads();
}

namespace pg8 {
#define PG8_LAS __attribute__((address_space(3)))
typedef unsigned short bf16_t;
typedef unsigned u32x4 __attribute__((ext_vector_type(4)));
using ::v4i_t; using ::v8i_t;
constexpr int BM = 256, BK = 64, HALF = 128, HTB = HALF * BK * 2, STAGE_BYTES = 8 * HTB, NXCD = 8, WGM = 8;
__host__ __device__ __forceinline__ int lds_byte(int r, int c) { const int st = (r >> 4) * 2 + (c >> 5), rr = r & 15, cc = c & 31, ob = rr * 64 + cc * 2; return st * 1024 + (ob ^ (((ob >> 9) & 1) << 5)); }
__host__ __device__ __forceinline__ void stage_rc(int b, int& R, int& C) { const int st = b / 1024, sb = b % 1024, swz = sb ^ (((sb >> 9) & 1) << 5); R = (st >> 1) * 16 + swz / 64; C = (st & 1) * 32 + (swz % 64) / 2; }
__host__ __device__ __forceinline__ int perm32(int rho) { const int n = rho >> 4, i = rho & 15; return 8 * (i >> 2) + 4 * n + (i & 3); }
struct Unit { int pm, pn; };
struct Gemm { const bf16_t* A; const bf16_t* Bt; int M, N, K; };
struct StaticOrder {
    int nM, nN, nwg, G, c;
    __host__ __device__ void init(int M, int N, int G_, int c_) { nM = M / BM; nN = N / BM; nwg = nM * nN; G = G_; c = c_; }
    __host__ __device__ bool next(int i, Unit& u) const {
        const long L = (long)i * G + c; if (L >= nwg) return false;
        int wgid = (int)L; { const int q = nwg / NXCD, r = nwg % NXCD, xcd = wgid % NXCD, off = wgid / NXCD; wgid = (xcd < r ? xcd * (q + 1) : r * (q + 1) + (xcd - r) * q) + off; }
        const int nig = WGM * nN, gid = wgid / nig, fm = gid * WGM, gsz = (nM - fm) < WGM ? (nM - fm) : WGM;
        u.pm = fm + ((wgid % nig) % gsz); u.pn = (wgid % nig) / gsz; return true;
    }
    __device__ __forceinline__ void a_ready(const Unit&) const {}
    __device__ __forceinline__ void done(const Unit&) const {}
};
template <int MODE> struct EpiSeg {
    static constexpr bool PERM = true, AFTER_DRAIN = false;
    unsigned char* base; int ld; const float* bias; float* gates; float oscale;
    __device__ __forceinline__ void operator()(const f32x4 (&acc)[2][2][4][2], const Unit& u, int wr, int wc, int fr, int fq) const {
        const int row0 = u.pm * BM + wr * 64 + fr;
        if (MODE == 1 && u.pn >= 24) {
            if (wc == 0 && fq < 2) {
#pragma unroll
                for (int ai = 0; ai < 2; ++ai)
#pragma unroll
                    for (int m = 0; m < 4; ++m) { float* rp = gates + (size_t)(row0 + ai * HALF + m * 16) * 16 + 8 * fq;
                        *(f32x4*)(rp) = acc[ai][0][m][0] * oscale; *(f32x4*)(rp + 4) = acc[ai][0][m][1] * oscale; }
            }
        } else {
        size_t off = 0; int ldc = ld, tb = 0;
        if (MODE == 1) { ldc = u.pn < 8 ? 1024 : 2048; tb = u.pn < 4 ? 0 : u.pn < 8 ? 4 : u.pn < 16 ? 8 : 16; off = u.pn < 4 ? ZQ : u.pn < 8 ? ZK : u.pn < 16 ? ZV : ZO; }
        if (MODE == 2) { ldc = 4096; tb = u.pn < 16 ? 0 : 16; off = u.pn < 16 ? ZU : ZVV; }
        if (MODE == 3) { ldc = u.pn < 8 ? 2048 : 512; tb = u.pn < 8 ? 0 : u.pn < 10 ? 8 : 10; off = u.pn < 8 ? ZAQ : u.pn < 10 ? ZAK : ZAV; }
        bf16_t* ob = (bf16_t*)(base + off);
        const int col0 = (u.pn - tb) * BM + wc * 32 + 8 * fq, bcol0 = u.pn * BM + wc * 32 + 8 * fq;
        f32x4 bv[2][2];
#pragma unroll
        for (int bj = 0; bj < 2; ++bj)
#pragma unroll
            for (int n = 0; n < 2; ++n) bv[bj][n] = (MODE == 2) ? *(const f32x4*)(bias + bcol0 + bj * HALF + 4 * n) : (f32x4){0.f, 0.f, 0.f, 0.f};
        const int lid = fr + 16 * fq, frp = 4 * (lid >> 4) + ((lid >> 2) & 3), fqp = lid & 3, srcl = frp + 16 * fqp;
        const int row0p = row0 - fr + frp, col0p = col0 - 8 * fq + 8 * fqp;
#pragma unroll
        for (int ai = 0; ai < 2; ++ai)
#pragma unroll
            for (int m = 0; m < 4; ++m) { bf16_t* rowp = ob + (size_t)(row0p + ai * HALF + m * 16) * ldc + col0p;
#pragma unroll
                for (int bj = 0; bj < 2; ++bj) { f32x4 v0 = acc[ai][bj][m][0] * oscale + bv[bj][0], v1 = acc[ai][bj][m][1] * oscale + bv[bj][1];
                    if (MODE == 2) {
#pragma unroll
                        for (int j = 0; j < 4; ++j) { v0[j] = gelu_tanh(v0[j]); v1[j] = gelu_tanh(v1[j]); } }
                    u32x4 w; w.x = (unsigned)__shfl((int)cvt_pk_bf16(v0[0], v0[1]), srcl); w.y = (unsigned)__shfl((int)cvt_pk_bf16(v0[2], v0[3]), srcl);
                    w.z = (unsigned)__shfl((int)cvt_pk_bf16(v1[0], v1[1]), srcl); w.w = (unsigned)__shfl((int)cvt_pk_bf16(v1[2], v1[3]), srcl);
                    *(u32x4*)(rowp + bj * HALF) = w; } }
        }
    }
};
template <bool FP8, class Epi, class Sched>
__device__ __forceinline__ void gemm_phase(PG8_LAS unsigned char* lds, const Gemm g, const Sched& S, const Epi& E) {
    const int tid = threadIdx.x, wid = __builtin_amdgcn_readfirstlane(tid >> 6), lane = tid & 63, wr = wid >> 2, wc = wid & 3, fr = lane & 15, fq = lane >> 4;
    const int K = g.K, nt = K / BK;
    unsigned voffA[2], voffB[2];
#pragma unroll
    for (int i = 0; i < 2; ++i) { int R, C; stage_rc(tid * 16 + i * 8192, R, C); const int Rb = Epi::PERM ? ((R & ~31) + perm32(R & 31)) : R;
        voffA[i] = (unsigned)(R * K + C) * 2u; voffB[i] = (unsigned)(Rb * K + C) * 2u; }
    const size_t kstep = (size_t)(BK * 2);
    const size_t hstep = (size_t)HALF * K * 2;
    const size_t tstep = 2 * hstep;
    const unsigned ldsw = (unsigned)wid * 1024u;
    const int aoff = lds_byte(wr * 64 + fr, fq * 8), boff = lds_byte(wc * 32 + fr, fq * 8);
#define PG8_SA(b, h) (((b) * 2 + (h)) * HTB)
#define PG8_SB(b, h) ((4 + (b) * 2 + (h)) * HTB)
#define PG8_STAGE(bufoff, gbase, voff) do { _Pragma("unroll") for (int _i = 0; _i < 2; ++_i) \
        __builtin_amdgcn_global_load_lds((const unsigned*)((const char*)(gbase) + (voff)[_i]), (PG8_LAS unsigned*)(lds + (bufoff) + ldsw + _i * 8192), 16, 0, 0); } while (0)
#define PG8_LDH(dst8, addr) do { const v4i_t lo_ = *(const PG8_LAS v4i_t*)(addr), hi_ = *(const PG8_LAS v4i_t*)((addr) + 1024); dst8 = __builtin_shufflevector(lo_, hi_, 0, 1, 2, 3, 4, 5, 6, 7); } while (0)
#define PG8_LDA(dst, b, h) do { _Pragma("unroll") for (int m = 0; m < 4; ++m) PG8_LDH(dst[m], lds + PG8_SA(b, h) + aoff + m * 2048); } while (0)
#define PG8_LDB(dst, b, h) do { _Pragma("unroll") for (int n = 0; n < 2; ++n) PG8_LDH(dst[n], lds + PG8_SB(b, h) + boff + n * 2048); } while (0)
#define PG8_HALF(v8, k) __builtin_bit_cast(bf16x8, __builtin_shufflevector(v8, v8, 4 * (k), 4 * (k) + 1, 4 * (k) + 2, 4 * (k) + 3))
#define PG8_MMA(ai, bj, At, Bt) do { __builtin_amdgcn_s_setprio(1); _Pragma("unroll") for (int m = 0; m < 4; ++m) _Pragma("unroll") for (int n = 0; n < 2; ++n) { \
        acc[ai][bj][m][n] = __builtin_amdgcn_mfma_f32_16x16x32_bf16(PG8_HALF(Bt[n], 0), PG8_HALF(At[m], 0), acc[ai][bj][m][n], 0, 0, 0); \
        acc[ai][bj][m][n] = __builtin_amdgcn_mfma_f32_16x16x32_bf16(PG8_HALF(Bt[n], 1), PG8_HALF(At[m], 1), acc[ai][bj][m][n], 0, 0, 0); } __builtin_amdgcn_s_setprio(0); } while (0)
#define PG8_MMA8(ai, bj, At, Bt) do { __builtin_amdgcn_s_setprio(1); _Pragma("unroll") for (int m = 0; m < 4; ++m) _Pragma("unroll") for (int n = 0; n < 2; ++n) \
        asm volatile("v_mfma_scale_f32_16x16x128_f8f6f4 %0, %1, %2, %0, %3, %3 op_sel_hi:[0,0,0]" : "+v"(acc[ai][bj][m][n]) : "v"(Bt[n]), "v"(At[m]), "v"(mxs)); __builtin_amdgcn_s_setprio(0); } while (0)
#define PG8_MMA8_DRAIN() asm volatile("s_nop 15\n\ts_nop 15" ::: "memory")
#define PG8_WAIT_V(n) asm volatile("s_waitcnt vmcnt(" #n ")" ::: "memory")
#define PG8_WAIT_L(n) asm volatile("s_waitcnt lgkmcnt(" #n ")" ::: "memory")
#define PG8_BAR __builtin_amdgcn_s_barrier()
#define PG8_SCHED __builtin_amdgcn_sched_barrier(0)
    Unit cur, nxt; int ui = 0;
    if (!S.next(0, cur)) return;
    f32x4 acc[2][2][4][2];
#pragma unroll
    for (int a = 0; a < 2; ++a)
#pragma unroll
        for (int b = 0; b < 2; ++b)
#pragma unroll
            for (int m = 0; m < 4; ++m)
#pragma unroll
                for (int n = 0; n < 2; ++n) acc[a][b][m][n] = (f32x4){0.f, 0.f, 0.f, 0.f};
    v8i_t At[4], B0[2], B1[2]; int mxs = 0x7f7f7f7f; asm volatile("" : "+v"(mxs));
    const char* cA = (const char*)g.A + (size_t)cur.pm * tstep; const char* cB = (const char*)g.Bt + (size_t)cur.pn * tstep;
    S.a_ready(cur);
    PG8_STAGE(PG8_SB(0, 0), cB, voffB); PG8_STAGE(PG8_SA(0, 0), cA, voffA); PG8_STAGE(PG8_SB(0, 1), cB + hstep, voffB); PG8_STAGE(PG8_SA(0, 1), cA + hstep, voffA);
    if (wr == 1) PG8_BAR;
    PG8_WAIT_V(4); PG8_BAR;
    PG8_STAGE(PG8_SB(1, 0), cB + kstep, voffB); PG8_STAGE(PG8_SA(1, 0), cA + kstep, voffA); PG8_STAGE(PG8_SB(1, 1), cB + hstep + kstep, voffB);
    PG8_WAIT_V(6); PG8_BAR;
    for (;;) {
        const bool has_next = S.next(ui + 1, nxt);
        const char* nA = has_next ? (const char*)g.A + (size_t)nxt.pm * tstep : cA; const char* nB = has_next ? (const char*)g.Bt + (size_t)nxt.pn * tstep : cB;
        for (int t = 0; t < nt; t += 2) {
            const bool last = (t == nt - 2);
            const char* a1 = cA + (size_t)(t + 1) * kstep;
            const char* a2 = last ? nA : cA + (size_t)(t + 2) * kstep; const char* b2 = last ? nB : cB + (size_t)(t + 2) * kstep;
            const char* a3 = a2 + kstep; const char* b3 = b2 + kstep;
            if (last && has_next) S.a_ready(nxt);
            PG8_LDB(B0, 0, 0); PG8_SCHED; PG8_LDA(At, 0, 0); PG8_STAGE(PG8_SA(1, 1), a1 + hstep, voffA);
            PG8_WAIT_L(8); PG8_BAR; PG8_WAIT_L(0); do { if constexpr (FP8) PG8_MMA8(0, 0, At, B0); else PG8_MMA(0, 0, At, B0); } while (0); PG8_BAR; PG8_SCHED;
            PG8_LDB(B1, 0, 1); PG8_STAGE(PG8_SB(0, 0), b2, voffB);
            PG8_BAR; PG8_WAIT_L(0); do { if constexpr (FP8) PG8_MMA8(0, 1, At, B1); else PG8_MMA(0, 1, At, B1); } while (0); PG8_BAR;
            PG8_LDA(At, 0, 1); PG8_STAGE(PG8_SA(0, 0), a2, voffA);
            PG8_BAR; PG8_WAIT_L(0); do { if constexpr (FP8) PG8_MMA8(1, 0, At, B0); else PG8_MMA(1, 0, At, B0); } while (0); PG8_BAR; PG8_SCHED;
            PG8_STAGE(PG8_SB(0, 1), b2 + hstep, voffB);
            PG8_WAIT_V(6); PG8_BAR; do { if constexpr (FP8) PG8_MMA8(1, 1, At, B1); else PG8_MMA(1, 1, At, B1); } while (0); PG8_BAR;
            PG8_LDB(B0, 1, 0); PG8_SCHED; PG8_LDA(At, 1, 0); PG8_STAGE(PG8_SA(0, 1), a2 + hstep, voffA);
            PG8_WAIT_L(8); PG8_BAR; PG8_WAIT_L(0); do { if constexpr (FP8) PG8_MMA8(0, 0, At, B0); else PG8_MMA(0, 0, At, B0); } while (0); PG8_BAR; PG8_SCHED;
            PG8_LDB(B1, 1, 1); PG8_STAGE(PG8_SB(1, 0), b3, voffB);
            PG8_BAR; PG8_WAIT_L(0); do { if constexpr (FP8) PG8_MMA8(0, 1, At, B1); else PG8_MMA(0, 1, At, B1); } while (0); PG8_BAR;
            PG8_LDA(At, 1, 1); PG8_STAGE(PG8_SA(1, 0), a3, voffA);
            PG8_BAR; PG8_WAIT_L(0); do { if constexpr (FP8) PG8_MMA8(1, 0, At, B0); else PG8_MMA(1, 0, At, B0); } while (0); PG8_BAR; PG8_SCHED;
            PG8_STAGE(PG8_SB(1, 1), b3 + hstep, voffB);
            PG8_WAIT_V(6); PG8_BAR; do { if constexpr (FP8) PG8_MMA8(1, 1, At, B1); else PG8_MMA(1, 1, At, B1); } while (0); PG8_BAR;
        }
        if constexpr (FP8) PG8_MMA8_DRAIN();
        if constexpr (!Epi::AFTER_DRAIN) { E(acc, cur, wr, wc, fr, fq); S.done(cur); }
        if (!has_next) break;
#pragma unroll
        for (int a = 0; a < 2; ++a)
#pragma unroll
            for (int b = 0; b < 2; ++b)
#pragma unroll
                for (int m = 0; m < 4; ++m)
#pragma unroll
                    for (int n = 0; n < 2; ++n) acc[a][b][m][n] = (f32x4){0.f, 0.f, 0.f, 0.f};
        cur = nxt; cA = nA; cB = nB; ++ui;
    }
    PG8_WAIT_V(0);
    if (wr == 0) PG8_BAR;
    PG8_BAR;
    if constexpr (Epi::AFTER_DRAIN) { E.fused(acc, cur, wr, wc, fr, fq, lds, wid, lane); S.done(cur); }
#undef PG8_SA
#undef PG8_SB
#undef PG8_STAGE
#undef PG8_LDA
#undef PG8_LDH
#undef PG8_HALF
#undef PG8_LDB
#undef PG8_MMA
#undef PG8_MMA8
#undef PG8_MMA8_DRAIN
#undef PG8_WAIT_V
#undef PG8_WAIT_L
#undef PG8_BAR
#undef PG8_SCHED
}
}

struct Frame {
    LAS unsigned char* lds;
    int tid, lane, wave, vcu, G;
    const float* const __attribute__((address_space(4)))* in;
    float* out; unsigned char* ws;
};
enum { I_X = 0, I_C, I_CTX, I_CCTX, I_WMOD, I_BMOD, I_LNG, I_LNB, I_AWIN, I_ABG, I_ANG, I_AWOUT, I_BWIN, I_BBIN, I_BLNG, I_BLNB, I_BWS, I_BBS, I_BWOUT,
       I_CWQKV, I_CQG, I_CKG, I_CWOUT, I_PWQ, I_PK1, I_PK2, I_PU, I_PV };

template <int CTRL> __device__ __forceinline__ float dpp_mov(float v) { return __builtin_bit_cast(float, __builtin_amdgcn_update_dpp(0, __builtin_bit_cast(int, v), CTRL, 0xf, 0xf, false)); }
__device__ __forceinline__ float row16_sum(float v) {
    v += dpp_mov<0x128>(v);
    v += dpp_mov<0x124>(v);
    v += dpp_mov<0x122>(v);
    v += dpp_mov<0x121>(v);
    return v;
}
__device__ __forceinline__ float row16_max(float v) {
    v = fmaxf(v, dpp_mov<0x128>(v)); v = fmaxf(v, dpp_mov<0x124>(v)); v = fmaxf(v, dpp_mov<0x122>(v)); v = fmaxf(v, dpp_mov<0x121>(v));
    return v;
}
__device__ __forceinline__ float rl(float v, int l) { return __builtin_bit_cast(float, __builtin_amdgcn_readlane(__builtin_bit_cast(int, v), l)); }
__device__ __forceinline__ float wsum(float v) { v = row16_sum(v); return (rl(v, 0) + rl(v, 16)) + (rl(v, 32) + rl(v, 48)); }

__device__ __forceinline__ const float* mod_row(const Frame& F, int layer, int row) {
    const int b9 = row < TL ? (row >> 12) : 8;
    return (const float*)(F.ws + WS_MOD) + (size_t)(layer * 9 + b9) * NMOD;
}

__device__ __forceinline__ void p0_transpose_item(const float* W, int ldw, int K, int nblk, unsigned char* WT, LAS float* scr, int item, int lane) {
    const int kb = item / nblk, nb = item % nblk, k0 = 64 * kb, n0 = 32 * nb;
    f32x4 t[8];
#pragma unroll
    for (int i = 0; i < 8; ++i) t[i] = *(const f32x4*)(W + (size_t)(k0 + 8 * i + (lane >> 3)) * ldw + n0 + 4 * (lane & 7));
#pragma unroll
    for (int i = 0; i < 8; ++i) { LAS float* d = scr + (8 * i + (lane >> 3)) * 33 + 4 * (lane & 7); d[0] = t[i][0] * WSCALE; d[1] = t[i][1] * WSCALE; d[2] = t[i][2] * WSCALE; d[3] = t[i][3] * WSCALE; }
    LDS_WAIT(); asm volatile("" ::: "memory");
    const int c = lane & 7;
#pragma unroll
    for (int j = 0; j < 4; ++j) { const int n = (lane >> 3) + 8 * j; const LAS float* s = scr + (8 * c) * 33 + n;
        v2u o; o.x = pk4_fp8(s[0 * 33], s[1 * 33], s[2 * 33], s[3 * 33]); o.y = pk4_fp8(s[4 * 33], s[5 * 33], s[6 * 33], s[7 * 33]);
        *(v2u*)(WT + (size_t)(n0 + n) * K + k0 + 8 * c) = o; }
    LDS_WAIT(); asm volatile("" ::: "memory");
}
__device__ __forceinline__ void p0_transpose_item_bf16(const float* W, int ldw, int K, int nblk, bf16* WT, LAS float* scr, int item, int lane) {
    const int kb = item / nblk, nb = item % nblk, k0 = 64 * kb, n0 = 32 * nb;
    f32x4 t[8];
#pragma unroll
    for (int i = 0; i < 8; ++i) t[i] = *(const f32x4*)(W + (size_t)(k0 + 8 * i + (lane >> 3)) * ldw + n0 + 4 * (lane & 7));
#pragma unroll
    for (int i = 0; i < 8; ++i) { LAS float* d = scr + (8 * i + (lane >> 3)) * 33 + 4 * (lane & 7); d[0] = t[i][0]; d[1] = t[i][1]; d[2] = t[i][2]; d[3] = t[i][3]; }
    LDS_WAIT(); asm volatile("" ::: "memory");
    const int c = lane & 7;
#pragma unroll
    for (int j = 0; j < 4; ++j) { const int n = (lane >> 3) + 8 * j; const LAS float* s = scr + (8 * c) * 33 + n;
        v4u o; o.x = cvt_pk_bf16(s[0 * 33], s[1 * 33]); o.y = cvt_pk_bf16(s[2 * 33], s[3 * 33]); o.z = cvt_pk_bf16(s[4 * 33], s[5 * 33]); o.w = cvt_pk_bf16(s[6 * 33], s[7 * 33]);
        *(v4u*)(WT + (size_t)(n0 + n) * K + k0 + 8 * c) = o; }
    LDS_WAIT(); asm volatile("" ::: "memory");
}
__device__ __forceinline__ void cvt_linear(const float* src, bf16* dst, size_t n8, size_t i0, size_t stride) {
    for (size_t i = i0; i < n8; i += stride) {
        const f32x4 a = *(const f32x4*)(src + i * 8), b = *(const f32x4*)(src + i * 8 + 4);
        v4u o; o.x = cvt_pk_bf16(a[0], a[1]); o.y = cvt_pk_bf16(a[2], a[3]); o.z = cvt_pk_bf16(b[0], b[1]); o.w = cvt_pk_bf16(b[2], b[3]);
        *(v4u*)(dst + i * 8) = o;
    }
}
__device__ __forceinline__ void p0_prologue(Frame& F) {
    {
        LAS float* sc = (LAS float*)F.lds;
        LAS float* part = (LAS float*)(F.lds + 9 * 2048 * 4);
        for (int i = F.tid; i < 9 * 2048; i += NTHR) { const int r = i >> 11, k = i & 2047; const float c = r < 8 ? F.in[I_C][r * D + k] : F.in[I_CCTX][k]; sc[i] = silu(c); }
        __syncthreads();
        float* MOD = (float*)(F.ws + WS_MOD);
        for (int item = F.vcu; item < 4 * 192; item += F.G) {
            const int l = item / 192, cg = item % 192, c = cg * 64 + F.lane;
            const float* Wm = F.in[I_WMOD] + ((size_t)l * D + F.wave * 256) * NMOD + c;
            float acc[9];
#pragma unroll
            for (int r = 0; r < 9; ++r) acc[r] = 0.f;
            for (int k0 = 0; k0 < 256; k0 += 32) {
                float w[32];
#pragma unroll
                for (int u = 0; u < 32; ++u) w[u] = Wm[(size_t)(k0 + u) * NMOD];
#pragma unroll
                for (int u = 0; u < 32; ++u)
#pragma unroll
                    for (int r = 0; r < 9; ++r) acc[r] += sc[r * 2048 + F.wave * 256 + k0 + u] * w[u];
            }
#pragma unroll
            for (int r = 0; r < 9; ++r) part[(F.wave * 9 + r) * 64 + F.lane] = acc[r];
            __syncthreads();
            for (int i = F.tid; i < 9 * 64; i += NTHR) { const int r = i >> 6, ln = i & 63; float s = 0.f;
#pragma unroll
                for (int w = 0; w < 8; ++w) s += part[(w * 9 + r) * 64 + ln];
                MOD[(size_t)(l * 9 + r) * NMOD + cg * 64 + ln] = s + F.in[I_BMOD][l * NMOD + cg * 64 + ln]; }
            __syncthreads();
        }
    }
    {
        LAS float* scr = (LAS float*)(F.lds + F.wave * 16384);
        const int gw = F.vcu * NWAVES + F.wave, NGW = F.G * NWAVES;
        unsigned char* WT = F.ws + WS_WT;
        constexpr int I_A = 32 * 192, I_SQ = 32 * 64, I_BI = 32 * 256, I_BO = 64 * 64, I_CQ = 32 * 96;
        constexpr int NITEMS = 2 * I_A + 2 * I_SQ + I_BI + I_BO + I_CQ + I_SQ + 4 * I_SQ;
        for (int it = gw; it < NITEMS; it += NGW) {
            int r = it;
            if (r < 2 * I_A) { const int j = r / I_A; p0_transpose_item(F.in[I_AWIN] + (size_t)j * D * A_IN, A_IN, D, 192, WT + WT_AIN + (size_t)j * A_INP * D, scr, r % I_A, F.lane); continue; } r -= 2 * I_A;
            if (r < 2 * I_SQ) { const int j = r / I_SQ; p0_transpose_item(F.in[I_AWOUT] + (size_t)j * D * D, D, D, 64, WT + WT_AOUT + (size_t)j * D * D, scr, r % I_SQ, F.lane); continue; } r -= 2 * I_SQ;
            if (r < I_BI) { p0_transpose_item(F.in[I_BWIN], 8192, D, 256, WT + WT_BIN, scr, r, F.lane); continue; } r -= I_BI;
            if (r < I_BO) { p0_transpose_item(F.in[I_BWOUT], D, 4096, 64, WT + WT_BOUT, scr, r, F.lane); continue; } r -= I_BO;
            if (r < I_CQ) { p0_transpose_item(F.in[I_CWQKV], C_QKV, D, 96, WT + WT_CQKV, scr, r, F.lane); continue; } r -= I_CQ;
            if (r < I_SQ) { p0_transpose_item(F.in[I_CWOUT], D, D, 64, WT + WT_COUT, scr, r, F.lane); continue; } r -= I_SQ;
            { const int j = r / I_SQ;
              if ((PQ_FP8_MASK >> j) & 1) p0_transpose_item(F.in[I_PWQ] + (size_t)j * D * D, D, D, 64, WT + WT_PQ + (size_t)j * D * D * 2, scr, r % I_SQ, F.lane);
              else p0_transpose_item_bf16(F.in[I_PWQ] + (size_t)j * D * D, D, D, 64, (bf16*)(WT + WT_PQ) + (size_t)j * D * D, scr, r % I_SQ, F.lane); }
        }
        const size_t gt = (size_t)F.vcu * NTHR + F.tid, GT = (size_t)F.G * NTHR;
        for (size_t i = gt; i < (size_t)2 * 256 * D; i += GT) {
            const int j = (int)(i / (256 * D)), rem = (int)(i % (256 * D)), n = rem / D, k = rem % D;
            const float v = n < 16 ? F.in[I_AWIN][((size_t)j * D + k) * A_IN + 6144 + n] : 0.f;
            WT[WT_AIN + ((size_t)j * A_INP + 6144 + n) * D + k] = (unsigned char)(__builtin_amdgcn_cvt_pk_fp8_f32(v * WSCALE, 0.f, 0, false) & 0xff);
        }
        for (int r0 = gw; r0 < 2 * 4 * P_E; r0 += 2 * NGW) {
            f32x4 v[2][8];
#pragma unroll
            for (int h = 0; h < 2; ++h) { const int r = r0 + h * NGW, tb = r >= 4 * P_E, rr = r - tb * 4 * P_E;
                const float* src = F.in[tb ? I_PV : I_PU] + (size_t)rr * D + 4 * F.lane;
#pragma unroll
                for (int q = 0; q < 8; ++q) v[h][q] = *(const f32x4*)(src + 256 * q); }
#pragma unroll
            for (int h = 0; h < 2; ++h) { const int r = r0 + h * NGW, tb = r >= 4 * P_E, rr = r - tb * 4 * P_E;
                float mx = 0.f;
#pragma unroll
                for (int q = 0; q < 8; ++q) { const f32x4 a = __builtin_elementwise_abs(v[h][q]); mx = fmaxf(mx, fmaxf(fmaxf(a[0], a[1]), fmaxf(a[2], a[3]))); }
                mx = row16_max(mx); mx = fmaxf(fmaxf(rl(mx, 0), rl(mx, 16)), fmaxf(rl(mx, 32), rl(mx, 48)));
                const float sc = mx > 0.f ? 6.0f / mx : 1.0f;
                v4u o;
#pragma unroll
                for (int d = 0; d < 4; ++d) { unsigned w = 0u; const f32x4 x0 = v[h][2 * d] * sc, x1 = v[h][2 * d + 1] * sc;
                    w = __builtin_amdgcn_cvt_scalef32_pk_fp4_f32(w, x0[0], x0[1], 1.0f, 0); w = __builtin_amdgcn_cvt_scalef32_pk_fp4_f32(w, x0[2], x0[3], 1.0f, 1);
                    w = __builtin_amdgcn_cvt_scalef32_pk_fp4_f32(w, x1[0], x1[1], 1.0f, 2); w = __builtin_amdgcn_cvt_scalef32_pk_fp4_f32(w, x1[2], x1[3], 1.0f, 3); o[d] = w; }
                if (tb) *(v4u*)(F.ws + WS_PV8 + (size_t)rr * (D / 2) + 16 * F.lane) = o;
                else { unsigned char* ur = F.ws + WS_PU8 + (size_t)rr * (D / 2) + 2 * F.lane;
#pragma unroll
                    for (int d = 0; d < 4; ++d) { *(unsigned short*)(ur + 128 * (2 * d)) = (unsigned short)(o[d] & 0xffffu); *(unsigned short*)(ur + 128 * (2 * d + 1)) = (unsigned short)(o[d] >> 16); } }
                if (F.lane == 0) ((float*)(F.ws + WS_SC))[(size_t)tb * 4 * P_E + rr] = 1.0f / sc; }
        }
        cvt_linear(F.in[I_PK1], (bf16*)(F.ws + WS_K12), (size_t)4 * 128 * 128 / 8, gt, GT);
        cvt_linear(F.in[I_PK2], (bf16*)(F.ws + WS_K12) + 4 * 128 * 128, (size_t)4 * 128 * 128 / 8, gt, GT);
        cvt_linear(F.in[I_BWS], (bf16*)(F.ws + WS_WS), (size_t)8 * 128 * 128 / 8, gt, GT);
    }
}

template <int L> __device__ __forceinline__ const float* x_row(const Frame& F, int row) {
    if (L == 0) return row < TL ? F.in[I_X] + (size_t)row * D : F.in[I_CTX] + (size_t)(row - TL) * D;
    return (const float*)(F.ws + WS_X) + (size_t)row * D;
}
template <int L> __device__ __forceinline__ f32x4 load_x4(const Frame& F, int row, int e) {
    if (L == 0) return *(const f32x4*)(x_row<0>(F, row) + e);
    const v2u p = *(const v2u*)((const bf16*)(F.ws + WS_X) + (size_t)row * D + e);
    return (f32x4){bf_lo(p.x), bf_hi(p.x), bf_lo(p.y), bf_hi(p.y)};
}
__device__ __forceinline__ void store_x4(const Frame& F, int row, int e, f32x4 v) { v2u o; o.x = cvt_pk_bf16(v[0], v[1]); o.y = cvt_pk_bf16(v[2], v[3]); *(v2u*)((bf16*)(F.ws + WS_X) + (size_t)row * D + e) = o; }
__device__ __forceinline__ void p0b_modulate(Frame& F) {
    const int gw = F.vcu * NWAVES + F.wave, NGW = F.G * NWAVES;
    for (int row = gw; row < T; row += NGW) {
        const float* xr = x_row<0>(F, row); const float* md = mod_row(F, 0, row);
        unsigned char* hr = F.ws + WS_H + (size_t)row * D;
#pragma unroll
        for (int j = 0; j < 8; ++j) { const int e = 4 * F.lane + 256 * j;
            const f32x4 x = *(const f32x4*)(xr + e), sh = *(const f32x4*)(md + e), scl = *(const f32x4*)(md + D + e);
            const f32x4 h = x * (scl + 1.0f) + sh;
            *(unsigned*)(hr + e) = pk4_fp8(h[0], h[1], h[2], h[3]); }
    }
}

__device__ __forceinline__ void ln_rows(f32x4 (&t)[8], const float* g, const float* b, int lane) {
    float s = 0.f;
#pragma unroll
    for (int j = 0; j < 8; ++j) s += (t[j][0] + t[j][1]) + (t[j][2] + t[j][3]);
    const float mean = wsum(s) * (1.0f / D); float q = 0.f;
#pragma unroll
    for (int j = 0; j < 8; ++j) { t[j] = t[j] - mean; q += (t[j][0] * t[j][0] + t[j][1] * t[j][1]) + (t[j][2] * t[j][2] + t[j][3] * t[j][3]); }
    const float rstd = 1.0f / sqrtf(wsum(q) * (1.0f / D) + LN_EPS);
#pragma unroll
    for (int j = 0; j < 8; ++j) { const int e = 4 * lane + 256 * j; t[j] = t[j] * rstd * *(const f32x4*)(g + e) + *(const f32x4*)(b + e); }
}

template <int L> __device__ __forceinline__ void ln1_phase(Frame& F, int M) {
    const int gw = F.vcu * NWAVES + F.wave, NGW = F.G * NWAVES;
    const float* lg = F.in[I_LNG] + (size_t)(L * 2 + 0) * D; const float* lb = F.in[I_LNB] + (size_t)(L * 2 + 0) * D;
    for (int row = gw; row < M; row += NGW) {
        const float* md = mod_row(F, L, row);
        const bf16* yr = (const bf16*)(F.ws + WS_Y) + (size_t)row * D;
        bf16* hr = (bf16*)(F.ws + WS_Y) + (size_t)row * D;
        f32x4 t[8];
#pragma unroll
        for (int j = 0; j < 8; ++j) { const int e = 4 * F.lane + 256 * j;
            const f32x4 x = load_x4<L>(F, row, e), gt = *(const f32x4*)(md + 2 * D + e); const v2u y = *(const v2u*)(yr + e);
            t[j] = x * ALPHA + gt * (f32x4){bf_lo(y.x), bf_hi(y.x), bf_lo(y.y), bf_hi(y.y)}; }
        ln_rows(t, lg, lb, F.lane);
#pragma unroll
        for (int j = 0; j < 8; ++j) { const int e = 4 * F.lane + 256 * j;
            store_x4(F, row, e, t[j]);
            const f32x4 h = t[j] * (*(const f32x4*)(md + 4 * D + e) + 1.0f) + *(const f32x4*)(md + 3 * D + e);
            v2u o; o.x = cvt_pk_bf16(h[0], h[1]); o.y = cvt_pk_bf16(h[2], h[3]); *(v2u*)(hr + e) = o;
            if ((PQ_FP8_MASK >> L) & 1) *(unsigned*)(F.ws + WS_H + (size_t)row * D + e) = pk4_fp8(h[0], h[1], h[2], h[3]); }
    }
}

__device__ __forceinline__ unsigned f2mono(float f) { const unsigned b = __float_as_uint(f); return (b & 0x80000000u) ? ~b : (b | 0x80000000u); }
__device__ __forceinline__ float mono2f(unsigned m) { return __uint_as_float((m & 0x80000000u) ? (m & 0x7fffffffu) : ~m); }
__device__ __forceinline__ void ins16(unsigned (&top)[16], unsigned x) {
#pragma unroll
    for (int j = 0; j < 16; ++j) { const unsigned hi = top[j] > x ? top[j] : x; x = top[j] > x ? x : top[j]; top[j] = hi; }
}
#define TK_CE(A_, B_) { const unsigned hi_ = (A_) > (B_) ? (A_) : (B_), lo_ = (A_) > (B_) ? (B_) : (A_); (A_) = hi_; (B_) = lo_; }
__device__ __forceinline__ void sort16_desc(unsigned (&v)[16]) {
    TK_CE(v[0], v[1])
    TK_CE(v[2], v[3])
    TK_CE(v[0], v[2])
    TK_CE(v[1], v[3])
    TK_CE(v[1], v[2])
    TK_CE(v[4], v[5])
    TK_CE(v[6], v[7])
    TK_CE(v[4], v[6])
    TK_CE(v[5], v[7])
    TK_CE(v[5], v[6])
    TK_CE(v[0], v[4])
    TK_CE(v[2], v[6])
    TK_CE(v[2], v[4])
    TK_CE(v[1], v[5])
    TK_CE(v[3], v[7])
    TK_CE(v[3], v[5])
    TK_CE(v[1], v[2])
    TK_CE(v[3], v[4])
    TK_CE(v[5], v[6])
    TK_CE(v[8], v[9])
    TK_CE(v[10], v[11])
    TK_CE(v[8], v[10])
    TK_CE(v[9], v[11])
    TK_CE(v[9], v[10])
    TK_CE(v[12], v[13])
    TK_CE(v[14], v[15])
    TK_CE(v[12], v[14])
    TK_CE(v[13], v[15])
    TK_CE(v[13], v[14])
    TK_CE(v[8], v[12])
    TK_CE(v[10], v[14])
    TK_CE(v[10], v[12])
    TK_CE(v[9], v[13])
    TK_CE(v[11], v[15])
    TK_CE(v[11], v[13])
    TK_CE(v[9], v[10])
    TK_CE(v[11], v[12])
    TK_CE(v[13], v[14])
    TK_CE(v[0], v[8])
    TK_CE(v[4], v[12])
    TK_CE(v[4], v[8])
    TK_CE(v[2], v[10])
    TK_CE(v[6], v[14])
    TK_CE(v[6], v[10])
    TK_CE(v[2], v[4])
    TK_CE(v[6], v[8])
    TK_CE(v[10], v[12])
    TK_CE(v[1], v[9])
    TK_CE(v[5], v[13])
    TK_CE(v[5], v[9])
    TK_CE(v[3], v[11])
    TK_CE(v[7], v[15])
    TK_CE(v[7], v[11])
    TK_CE(v[3], v[5])
    TK_CE(v[7], v[9])
    TK_CE(v[11], v[13])
    TK_CE(v[1], v[2])
    TK_CE(v[3], v[4])
    TK_CE(v[5], v[6])
    TK_CE(v[7], v[8])
    TK_CE(v[9], v[10])
    TK_CE(v[11], v[12])
    TK_CE(v[13], v[14])
}
__device__ __forceinline__ void merge16_desc(unsigned (&top)[16], const unsigned (&s)[16]) {
#pragma unroll
    for (int i = 0; i < 16; ++i) top[i] = top[i] > s[15 - i] ? top[i] : s[15 - i];
#pragma unroll
    for (int j = 8; j > 0; j >>= 1)
#pragma unroll
        for (int i = 0; i < 16; ++i) { const int l = i ^ j; if (l > i) TK_CE(top[i], top[l]) }
}
template <int L> __device__ __forceinline__ void peer_topk_phase(Frame& F, int M) {
    const bf16* Q = (const bf16*)(F.ws + WS_Z);
    const bf16* K1 = (const bf16*)(F.ws + WS_K12) + (size_t)L * 128 * 128;
    const bf16* K2 = (const bf16*)(F.ws + WS_K12) + (size_t)(4 + L) * 128 * 128;
    int* IDX = (int*)(F.ws + WS_IDX); float* PG = (float*)(F.ws + WS_PG);
    LAS float* S1 = (LAS float*)F.lds;
    LAS float* S2 = S1 + 128 * 129;
    LAS unsigned* TK = (LAS unsigned*)(S2 + 128 * 129);
    const int fr = F.lane & 15, fq = F.lane >> 4;
    const int nunits = (M / 128) * P_HEADS;
    const int kbg = F.wave & 1, tbg = F.wave >> 1;
    const int tb_lo = tbg == 0 ? 0 : tbg == 1 ? 1 : tbg == 2 ? 3 : 5, ntb = tbg == 0 ? 1 : tbg == 3 ? 3 : 2;
    bf16x8 kf1[4][4], kf2[4][4];
#pragma unroll
    for (int kk = 0; kk < 4; ++kk) { const int kb = 4 * kbg + kk;
        const bf16* k1p = K1 + (size_t)(kb * 16 + fr) * 128 + fq * 8; const bf16* k2p = K2 + (size_t)(kb * 16 + fr) * 128 + fq * 8;
#pragma unroll
        for (int ks = 0; ks < 4; ++ks) { kf1[kk][ks] = *(const bf16x8*)(k1p + ks * 32); kf2[kk][ks] = *(const bf16x8*)(k2p + ks * 32); } }
    for (int u = F.vcu; u < nunits; u += F.G) {
        const int tile = u >> 3, hd = u & 7, row0 = tile * 128;
#ifdef TK_DBL_MFMA
        for (int rr_ = 0; rr_ < 2; ++rr_)
#endif
        {
#pragma unroll 1
            for (int tt = 0; tt < ntb; ++tt) { const int tb = tb_lo + tt;
                const bf16* qp = Q + (size_t)(row0 + tb * 16 + fr) * D + hd * 256 + fq * 8;
                bf16x8 a1[4], a2[4];
#pragma unroll
                for (int ks = 0; ks < 4; ++ks) { a1[ks] = *(const bf16x8*)(qp + ks * 32); a2[ks] = *(const bf16x8*)(qp + 128 + ks * 32); }
#pragma unroll
                for (int kk = 0; kk < 4; ++kk) { const int kb = 4 * kbg + kk;
                    f32x4 c1 = zero4(), c2 = zero4();
#pragma unroll
                    for (int ks = 0; ks < 4; ++ks) {
                        c1 = __builtin_amdgcn_mfma_f32_16x16x32_bf16(a1[ks], kf1[kk][ks], c1, 0, 0, 0);
                        c2 = __builtin_amdgcn_mfma_f32_16x16x32_bf16(a2[ks], kf2[kk][ks], c2, 0, 0, 0);
                    }
#pragma unroll
                    for (int j = 0; j < 4; ++j) { const int t = tb * 16 + 4 * fq + j; const unsigned ix = (unsigned)(127 - (kb * 16 + fr));
                        ((LAS unsigned*)S1)[t * 129 + kb * 16 + fr] = (f2mono(c1[j]) & ~0x7fu) | ix; ((LAS unsigned*)S2)[t * 129 + kb * 16 + fr] = (f2mono(c2[j]) & ~0x7fu) | ix; }
                }
            }
        }
        __syncthreads();
        {
            int tid_l = F.tid; asm volatile("" : "+v"(tid_l));
            const int t = tid_l & 127, which = (tid_l >> 7) & 1, half = tid_l >> 8;
            LAS float* sr = (which ? S2 : S1) + t * 129 + 64 * half;
            unsigned top[16];
#pragma unroll
            for (int j = 0; j < 16; ++j) top[j] = ((const LAS unsigned*)sr)[j];
            sort16_desc(top);
#pragma unroll 1
            for (int g = 1; g < 4; ++g) { unsigned v[16];
#pragma unroll
                for (int j = 0; j < 16; ++j) v[j] = ((const LAS unsigned*)sr)[16 * g + j];
                sort16_desc(v); merge16_desc(top, v); }
            if (half) {
#pragma unroll
                for (int j = 0; j < 16; ++j) ((LAS unsigned*)sr)[j] = top[j];
            }
            __syncthreads();
            if (!half) {
                const LAS unsigned* pr = (const LAS unsigned*)(sr + 64);
                unsigned ot[16];
#pragma unroll
                for (int j = 0; j < 16; ++j) ot[j] = pr[j];
                merge16_desc(top, ot);
#pragma unroll
                for (int j = 0; j < 16; ++j) TK[(which * 128 + t) * 17 + j] = top[j];
            }
        }
        __syncthreads();
#ifdef TK_DBL_COMB
        for (int rr_ = 0; rr_ < 2; ++rr_)
#endif
        if (F.tid < 128) {
            const int t = F.tid;
            const LAS unsigned* t1 = TK + t * 17; const LAS unsigned* t2 = TK + (128 + t) * 17;
            float v2[16];
#pragma unroll
            for (int j = 0; j < 16; ++j) v2[j] = mono2f((t2[j] & ~0x7fu) | 0x40u);
#define TK_V1(A_) mono2f((t1[A_] & ~0x7fu) | 0x40u)
#define TK_KEY(VA_, A_, B_) ((f2mono((VA_) + v2[B_]) & ~0xffu) | (unsigned)(255 - ((A_) * 16 + (B_))))
            unsigned top[16];
            { unsigned grp[16];
              const float va0 = TK_V1(0);
              grp[0] = TK_KEY(va0, 0, 0);
              grp[1] = TK_KEY(va0, 0, 1);
              grp[2] = TK_KEY(va0, 0, 2);
              grp[3] = TK_KEY(va0, 0, 3);
              grp[4] = TK_KEY(va0, 0, 4);
              grp[5] = TK_KEY(va0, 0, 5);
              grp[6] = TK_KEY(va0, 0, 6);
              grp[7] = TK_KEY(va0, 0, 7);
              grp[8] = TK_KEY(va0, 0, 8);
              grp[9] = TK_KEY(va0, 0, 9);
              grp[10] = TK_KEY(va0, 0, 10);
              grp[11] = TK_KEY(va0, 0, 11);
              grp[12] = TK_KEY(va0, 0, 12);
              grp[13] = TK_KEY(va0, 0, 13);
              grp[14] = TK_KEY(va0, 0, 14);
              grp[15] = TK_KEY(va0, 0, 15);
              sort16_desc(grp);
#pragma unroll
              for (int j = 0; j < 16; ++j) top[j] = grp[j]; }
            __builtin_amdgcn_sched_barrier(0);
            { unsigned grp[16];
              const float va1 = TK_V1(1);
              const float va2 = TK_V1(2);
              const float va3 = TK_V1(3);
              grp[0] = TK_KEY(va1, 1, 0);
              grp[1] = TK_KEY(va1, 1, 1);
              grp[2] = TK_KEY(va1, 1, 2);
              grp[3] = TK_KEY(va1, 1, 3);
              grp[4] = TK_KEY(va1, 1, 4);
              grp[5] = TK_KEY(va1, 1, 5);
              grp[6] = TK_KEY(va1, 1, 6);
              grp[7] = TK_KEY(va1, 1, 7);
              grp[8] = TK_KEY(va2, 2, 0);
              grp[9] = TK_KEY(va2, 2, 1);
              grp[10] = TK_KEY(va2, 2, 2);
              grp[11] = TK_KEY(va2, 2, 3);
              grp[12] = TK_KEY(va2, 2, 4);
              grp[13] = TK_KEY(va3, 3, 0);
              grp[14] = TK_KEY(va3, 3, 1);
              grp[15] = TK_KEY(va3, 3, 2);
              sort16_desc(grp);
              merge16_desc(top, grp); }
            __builtin_amdgcn_sched_barrier(0);
            { unsigned grp[16];
              const float va3 = TK_V1(3);
              const float va4 = TK_V1(4);
              const float va5 = TK_V1(5);
              const float va6 = TK_V1(6);
              const float va7 = TK_V1(7);
              const float va8 = TK_V1(8);
              const float va9 = TK_V1(9);
              const float va10 = TK_V1(10);
              const float va11 = TK_V1(11);
              const float va12 = TK_V1(12);
              const float va13 = TK_V1(13);
              grp[0] = TK_KEY(va3, 3, 3);
              grp[1] = TK_KEY(va4, 4, 0);
              grp[2] = TK_KEY(va4, 4, 1);
              grp[3] = TK_KEY(va4, 4, 2);
              grp[4] = TK_KEY(va5, 5, 0);
              grp[5] = TK_KEY(va5, 5, 1);
              grp[6] = TK_KEY(va6, 6, 0);
              grp[7] = TK_KEY(va6, 6, 1);
              grp[8] = TK_KEY(va7, 7, 0);
              grp[9] = TK_KEY(va7, 7, 1);
              grp[10] = TK_KEY(va8, 8, 0);
              grp[11] = TK_KEY(va9, 9, 0);
              grp[12] = TK_KEY(va10, 10, 0);
              grp[13] = TK_KEY(va11, 11, 0);
              grp[14] = TK_KEY(va12, 12, 0);
              grp[15] = TK_KEY(va13, 13, 0);
              sort16_desc(grp);
              merge16_desc(top, grp); }
            __builtin_amdgcn_sched_barrier(0);
            ins16(top, TK_KEY(TK_V1(14), 14, 0));
            ins16(top, TK_KEY(TK_V1(15), 15, 0));
#undef TK_KEY
#undef TK_V1
            float sc[16], es = 0.f;
#pragma unroll
            for (int j = 0; j < 16; ++j) sc[j] = mono2f((top[j] & ~0xffu) | 0x80u);
            const float smx = sc[0];
#pragma unroll
            for (int j = 0; j < 16; ++j) { sc[j] = __expf(sc[j] - smx); es += sc[j]; }
            const float inv = 1.0f / es;
            const size_t ob = (size_t)(row0 + t) * 128 + hd * 16;
#pragma unroll
            for (int j = 0; j < 16; ++j) { const int ci = 255 - (int)(top[j] & 0xffu), a = ci >> 4, b = ci & 15;
                const int i1 = 127 - (int)(t1[a] & 0x7fu), i2 = 127 - (int)(t2[b] & 0x7fu);
                IDX[ob + j] = i1 * 128 + i2; PG[ob + j] = sc[j] * inv; }
        }
    }
}

constexpr int P3B = 8;
struct RowBatch { v4u r[P3B]; };
__device__ __forceinline__ void p3_load_batch(RowBatch& B, const char* tab, int ev, int lane0, int lo16) {
#pragma unroll
    for (int q = 0; q < P3B; ++q) { const int e = __builtin_amdgcn_readlane(ev, lane0 + q); B.r[q] = *(const v4u*)(tab + (size_t)e * (D / 2) + lo16); }
}
__device__ __forceinline__ float dot32_fp4(const v4u w, const f32x2* h) {
    f32x2 s = {0.f, 0.f};
#pragma unroll
    for (int d = 0; d < 4; ++d) {
#define P3_D(b) { const f32x2 p = __builtin_amdgcn_cvt_scalef32_pk_f32_fp4(w[d], 1.0f, b); s = __builtin_elementwise_fma(p, h[4 * d + b], s); }
        P3_D(0) P3_D(1) P3_D(2) P3_D(3)
#undef P3_D
    }
    return s[0] + s[1];
}
__device__ __forceinline__ void axpy32_fp4(const v4u w, float hk, f32x2* acc) {
    const f32x2 hk2 = {hk, hk};
#pragma unroll
    for (int d = 0; d < 4; ++d) {
#define P3_A(b) { const f32x2 p = __builtin_amdgcn_cvt_scalef32_pk_f32_fp4(w[d], 1.0f, b); acc[4 * d + b] = __builtin_elementwise_fma(hk2, p, acc[4 * d + b]); }
        P3_A(0) P3_A(1) P3_A(2) P3_A(3)
#undef P3_A
    }
}
__device__ __forceinline__ float reduce8(const float* d, int lane) {
    const bool b0 = lane & 1, b1 = lane & 2, b2 = lane & 4;
    float s1[4], s2[2];
#pragma unroll
    for (int j = 0; j < 4; ++j) { const float keep = b0 ? d[2 * j + 1] : d[2 * j], send = b0 ? d[2 * j] : d[2 * j + 1]; s1[j] = keep + dpp_mov<0xB1>(send); }
#pragma unroll
    for (int j = 0; j < 2; ++j) { const float keep = b1 ? s1[2 * j + 1] : s1[2 * j], send = b1 ? s1[2 * j] : s1[2 * j + 1]; s2[j] = keep + dpp_mov<0x4E>(send); }
    const float keep = b2 ? s2[1] : s2[0], send = b2 ? s2[0] : s2[1];
    float s3 = keep + dpp_mov<0x124>(send);
    s3 += dpp_mov<0x128>(s3);
    s3 += __shfl_xor(s3, 16); s3 += __shfl_xor(s3, 32);
    return s3;
}
template <int L> __device__ __forceinline__ void peer_u_phase(Frame& F, int M) {
    const int gw = F.vcu * NWAVES + F.wave, NGW = F.G * NWAVES;
    const char* PU = (const char*)(F.ws + WS_PU8) + (size_t)L * P_E * (D / 2); const char* PV = (const char*)(F.ws + WS_PV8) + (size_t)L * P_E * (D / 2);
    const float* SCU = (const float*)(F.ws + WS_SC) + (size_t)L * P_E; const float* SCV = (const float*)(F.ws + WS_SC) + (size_t)(4 + L) * P_E;
    const int* IDX = (const int*)(F.ws + WS_IDX); const float* PG = (const float*)(F.ws + WS_PG);
    const float* lg = F.in[I_LNG] + (size_t)(L * 2 + 1) * D; const float* lb = F.in[I_LNB] + (size_t)(L * 2 + 1) * D;
    for (int row = gw; row < M; row += NGW) {
        int lane_l = F.lane; asm volatile("" : "+v"(lane_l));
        const int lane = lane_l, lo16 = lane * 16;
        const int e0 = IDX[(size_t)row * 128 + lane], e1 = IDX[(size_t)row * 128 + 64 + lane];
        const float g0 = PG[(size_t)row * 128 + lane], g1 = PG[(size_t)row * 128 + 64 + lane];
        const float su0 = SCU[e0], su1 = SCU[e1], sv0 = SCV[e0], sv1 = SCV[e1];
        f32x2 hx[16];
        { const bf16* hr0 = (const bf16*)(F.ws + WS_Y) + (size_t)row * D + 4 * lane;
#pragma unroll
          for (int q = 0; q < 8; ++q) { const v2u hp = *(const v2u*)(hr0 + 256 * q); hx[2 * q] = (f32x2){bf_lo(hp.x), bf_hi(hp.x)}; hx[2 * q + 1] = (f32x2){bf_lo(hp.y), bf_hi(hp.y)}; } }
        float a0, a1;
        {
            LAS unsigned char* wl = F.lds + F.wave * 13568;
            LAS unsigned char* HI = wl + 8448;
#pragma unroll
            for (int q = 0; q < 8; ++q) {
                const f32x2 p0 = hx[2 * q], p1 = hx[2 * q + 1];
                int hi = __builtin_amdgcn_cvt_pk_fp8_f32(p0[0], p0[1], 0, false); hi = __builtin_amdgcn_cvt_pk_fp8_f32(p1[0], p1[1], hi, true);
                const f32x2 b0 = __builtin_amdgcn_cvt_pk_f32_fp8(hi, false), b1 = __builtin_amdgcn_cvt_pk_f32_fp8(hi, true);
                const f32x2 r0 = (p0 - b0) * 16.0f, r1 = (p1 - b1) * 16.0f;
                int lo = __builtin_amdgcn_cvt_pk_fp8_f32(r0[0], r0[1], 0, false); lo = __builtin_amdgcn_cvt_pk_fp8_f32(r1[0], r1[1], lo, true);
                *(LAS int*)(HI + 4 * lane + 256 * q) = hi; *(LAS int*)(HI + 2048 + 4 * lane + 256 * q) = lo;
            }
            asm volatile("" ::: "memory");
            const int n16 = lane & 15, kq = lane >> 4, hl = lane >> 5, l31 = lane & 31;
            const LAS unsigned char* bp = HI + (n16 == 1 ? 2048 : 0) + 16 * kq;
            LAS unsigned char* tw = wl + hl * 528 + 16 * l31;
            const LAS unsigned char* tr = wl + n16 * 528 + 16 * kq;
            f32x4 acc[8];
#pragma unroll
            for (int rb = 0; rb < 8; ++rb) acc[rb] = zero4();
            v4u R[2][8]; v8i_t Bk[8];
            int e0b = e0, e1b = e1;
#define UL_LOAD(S_) do { _Pragma("unroll") for (int i = 0; i < 8; ++i) { const int sa_ = 16 * ((S_) & 7) + 2 * i; \
                const int es_ = ((S_) >> 3) ? (((S_) & 7) < 4 ? e0b : e1b) : (((S_) & 7) < 4 ? e0 : e1); const int ia_ = __builtin_amdgcn_readlane(es_, sa_ & 63), ib_ = __builtin_amdgcn_readlane(es_, (sa_ + 1) & 63); \
                const int id_ = hl ? ib_ : ia_; R[(S_) & 1][i] = *(const v4u*)(PU + (size_t)id_ * (D / 2) + 512 * ((S_) >> 3) + 16 * l31); } } while (0)
#define UL_WRITE(S_) do { _Pragma("unroll") for (int i = 0; i < 8; ++i) *(LAS v4u*)(tw + 2 * i * 528) = R[(S_) & 1][i]; } while (0)
#define UL_MMA(S_) do { if (((S_) & 7) == 0) { _Pragma("unroll") for (int ml = 0; ml < 8; ++ml) { const v4u x0 = *(const LAS v4u*)(bp + 128 * (8 * ((S_) >> 3) + ml)), x1 = *(const LAS v4u*)(bp + 128 * (8 * ((S_) >> 3) + ml) + 64); \
                    Bk[ml] = (v8i_t){(int)x0.x, (int)x0.y, (int)x0.z, (int)x0.w, (int)x1.x, (int)x1.y, (int)x1.z, (int)x1.w}; } } \
                _Pragma("unroll") for (int ml = 0; ml < 8; ++ml) { const v4u w = *(const LAS v4u*)(tr + 64 * ml); \
                    acc[(S_) & 7] = __builtin_amdgcn_mfma_scale_f32_16x16x128_f8f6f4((v8i_t){(int)w.x, (int)w.y, (int)w.z, (int)w.w, 0, 0, 0, 0}, Bk[ml], acc[(S_) & 7], 4, 0, 0, 0x7f7f7f7f, 0, 0x7f7f7f7f); } } while (0)
            UL_LOAD(0); __builtin_amdgcn_sched_barrier(0);
#pragma unroll
            for (int s = 0; s < 16; ++s) {
                if (s + 1 == 8) asm volatile("" : "+v"(e0b), "+v"(e1b));
                if (s + 1 < 16) UL_LOAD(s + 1);
                __builtin_amdgcn_sched_barrier(0);
                UL_WRITE(s); __builtin_amdgcn_sched_barrier(0);
                UL_MMA(s); __builtin_amdgcn_sched_barrier(0);
            }
#undef UL_LOAD
#undef UL_WRITE
#undef UL_MMA
            asm volatile("s_nop 15\n\ts_nop 15" : "+v"(acc[0]), "+v"(acc[1]), "+v"(acc[2]), "+v"(acc[3]), "+v"(acc[4]), "+v"(acc[5]), "+v"(acc[6]), "+v"(acc[7]));
            LAS float* SS = (LAS float*)(wl + 12544);
            if (n16 < 2) {
#pragma unroll
                for (int rb = 0; rb < 8; ++rb) *(LAS f32x4*)(SS + n16 * 128 + 16 * rb + 4 * kq) = acc[rb]; }
            asm volatile("" ::: "memory");
            a0 = SS[lane] + SS[128 + lane] * 0.0625f; a1 = SS[64 + lane] + SS[192 + lane] * 0.0625f;
            asm volatile("" ::: "memory");
        }
        float* HC = (float*)(F.ws + WS_Z) + (size_t)row * 128;
        HC[lane] = gelu_tanh(a0 * su0) * g0 * sv0; HC[64 + lane] = gelu_tanh(a1 * su1) * g1 * sv1;
    }
}
template <int L> __device__ __forceinline__ void peer_v_phase(Frame& F, int M) {
    const int gw = F.vcu * NWAVES + F.wave, NGW = F.G * NWAVES;
    const char* PU = (const char*)(F.ws + WS_PU8) + (size_t)L * P_E * (D / 2); const char* PV = (const char*)(F.ws + WS_PV8) + (size_t)L * P_E * (D / 2);
    const float* SCU = (const float*)(F.ws + WS_SC) + (size_t)L * P_E; const float* SCV = (const float*)(F.ws + WS_SC) + (size_t)(4 + L) * P_E;
    const int* IDX = (const int*)(F.ws + WS_IDX); const float* PG = (const float*)(F.ws + WS_PG);
    const float* lg = F.in[I_LNG] + (size_t)(L * 2 + 1) * D; const float* lb = F.in[I_LNB] + (size_t)(L * 2 + 1) * D;
    for (int row = gw; row < M; row += NGW) {
        int lane_l = F.lane; asm volatile("" : "+v"(lane_l));
        const int lane = lane_l, lo16 = lane * 16;
        const int e0 = IDX[(size_t)row * 128 + lane], e1 = IDX[(size_t)row * 128 + 64 + lane];
        RowBatch A, Bb;
        constexpr int NB3 = 128 / P3B;
        p3_load_batch(A, PV, e0, 0, lo16);
        const float h0 = ((const float*)(F.ws + WS_Z))[(size_t)row * 128 + lane], h1 = ((const float*)(F.ws + WS_Z))[(size_t)row * 128 + 64 + lane];
        f32x2 acc[16];
#pragma unroll
        for (int j = 0; j < 16; ++j) acc[j] = (f32x2){0.f, 0.f};
#define P3_AXPY(BUF, KB) do { _Pragma("unroll") for (int q = 0; q < P3B; ++q) { const int k = (KB) + q; const float hk = rl(k < 64 ? h0 : h1, k & 63); axpy32_fp4(BUF.r[q], hk, acc); } } while (0)
        for (int bb = 0; bb < NB3; bb += 2) {
            p3_load_batch(Bb, PV, (bb + 1) * P3B < 64 ? e0 : e1, (P3B * (bb + 1)) & 63, lo16);
            P3_AXPY(A, P3B * bb);
            if (bb + 2 < NB3) p3_load_batch(A, PV, (bb + 2) * P3B < 64 ? e0 : e1, (P3B * (bb + 2)) & 63, lo16);
            P3_AXPY(Bb, P3B * bb + P3B);
        }
#undef P3_AXPY
        int lane2 = lane_l; asm volatile("" : "+v"(lane2) : "v"(acc[0]), "v"(acc[15]));
        const bf16* xr = (const bf16*)(F.ws + WS_X) + (size_t)row * D + 4 * lane2; const float* md = mod_row(F, L, row) + 4 * lane2;
        float s = 0.f;
#pragma unroll
        for (int q = 0; q < 8; ++q) { const v2u xp = *(const v2u*)(xr + 256 * q); const f32x4 xa = {bf_lo(xp.x), bf_hi(xp.x), bf_lo(xp.y), bf_hi(xp.y)}, ga = *(const f32x4*)(md + 5 * D + 256 * q);
#pragma unroll
            for (int j = 0; j < 4; ++j) { float v = acc[2 * q + (j >> 1)][j & 1]; v = ALPHA * xa[j] + ga[j] * v; acc[2 * q + (j >> 1)][j & 1] = v; s += v; } }
        const float mean = wsum(s) * (1.0f / D); float qv = 0.f;
#pragma unroll
        for (int j = 0; j < 16; ++j) { acc[j] = acc[j] - mean; qv += acc[j][0] * acc[j][0] + acc[j][1] * acc[j][1]; }
        const float rstd = 1.0f / sqrtf(wsum(qv) * (1.0f / D) + LN_EPS);
        float* xo = F.out + (size_t)row * D + 4 * lane2; bf16* xb = (bf16*)(F.ws + WS_X) + (size_t)row * D + 4 * lane2;
        unsigned char* ho = F.ws + WS_H + (size_t)row * D + 4 * lane2;
        const float* mdn = mod_row(F, (L + 1) & 3, row) + 4 * lane2;
#pragma unroll
        for (int q = 0; q < 8; ++q) { const int o = 256 * q; const f32x4 wa = *(const f32x4*)(lg + 4 * lane2 + o), ba = *(const f32x4*)(lb + 4 * lane2 + o);
            f32x4 oa;
#pragma unroll
            for (int j = 0; j < 4; ++j) oa[j] = acc[2 * q + (j >> 1)][j & 1] * rstd * wa[j] + ba[j];
            if (L == DEPTH - 1) *(f32x4*)(xo + o) = oa; else { v2u xw; xw.x = cvt_pk_bf16(oa[0], oa[1]); xw.y = cvt_pk_bf16(oa[2], oa[3]); *(v2u*)(xb + o) = xw; }
            if (L < DEPTH - 1) { const f32x4 sa = *(const f32x4*)(mdn + o), ca = *(const f32x4*)(mdn + D + o); const f32x4 ha = oa * (ca + 1.0f) + sa;
                *(unsigned*)(ho + o) = pk4_fp8(ha[0], ha[1], ha[2], ha[3]); } }
    }
}

constexpr int MP = 272;
constexpr int ML_QH = 0, ML_KH = 128 * MP, ML_VT = 2 * 128 * MP, ML_VW = 3 * 128 * MP, ML_GA = 4 * 128 * MP;
__device__ __forceinline__ s16x4 tr_read(LAS unsigned char* p) { return __builtin_amdgcn_ds_read_tr16_b64_v4i16((LAS s16x4*)p); }
__device__ __forceinline__ bf16x8 cat8(s16x4 a, s16x4 b) { return (bf16x8){a[0], a[1], a[2], a[3], b[0], b[1], b[2], b[3]}; }

template <int L> __device__ __forceinline__ void mlstm_scan_phase(Frame& F) {
    constexpr int J = L / 3;
    LAS unsigned char* lds = F.lds;
    LAS float* GA = (LAS float*)(lds + ML_GA);
    LAS float* gA = GA, *gMM = GA + 128, *gWI = GA + 256, *gEN = GA + 384, *gWS = GA + 512, *gNQ = GA + 640, *gHD = GA + 768;
    LAS float* gN = GA + 896;
    LAS float* gRS2 = GA + 896 + 512 + 16;
    const bf16* Zq = (const bf16*)(F.ws + WS_Z + ZQ); const bf16* Zk = (const bf16*)(F.ws + WS_Z + ZK); const bf16* Zv = (const bf16*)(F.ws + WS_Z + ZV);
    const float* G16 = (const float*)(F.ws + WS_GATE); const float* bg = F.in[I_ABG] + J * 16;
    const int tid0 = F.tid, w = F.wave;
    for (int unit = F.vcu; unit < 256; unit += F.G) {
        const int chain = unit >> 2, vs = unit & 3, dir = chain & 1, hd = (chain >> 1) & 3, b = chain >> 3;
        bf16* HO = (bf16*)(F.ws + (dir ? WS_Y : WS_H));
        float* GPa = (float*)(F.ws + WS_GP) + (size_t)unit * (3 * 34 * 128); float* GPb = GPa + 34 * 128; float* GPp = GPb + 34 * 128;
#define CBASE(jc_) ((jc_) < 2 ? TL + b * CL + (dir ? 1 - (jc_) : (jc_)) * 128 : b * SEQ + (dir ? 33 - (jc_) : (jc_) - 2) * 128)
        for (int jc = w; jc < 34; jc += NWAVES) {
            const int base = CBASE(jc); const int lane = tid0 & 63;
            const int s0 = 2 * lane, s1 = 2 * lane + 1;
            const float* g0 = G16 + (size_t)(base + (dir ? 127 - s0 : s0)) * 16; const float* g1 = G16 + (size_t)(base + (dir ? 127 - s1 : s1)) * 16;
            const int ci = dir * 8 + hd, cf = dir * 8 + 4 + hd;
            float li0 = g0[ci] + bg[ci], li1 = g1[ci] + bg[ci], gf0 = g0[cf] + bg[cf], gf1 = g1[cf] + bg[cf];
            li0 = 15.f * tanhf(li0 * (1.f / 15.f)); li1 = 15.f * tanhf(li1 * (1.f / 15.f)); gf0 = 15.f * tanhf(gf0 * (1.f / 15.f)); gf1 = 15.f * tanhf(gf1 * (1.f / 15.f));
            const float lf0 = fminf(gf0, 0.f) - log1pf(__expf(-fabsf(gf0))), lf1 = fminf(gf1, 0.f) - log1pf(__expf(-fabsf(gf1)));
            float p = lf0 + lf1;
#pragma unroll
            for (int o = 1; o < 64; o <<= 1) { const float t = __shfl_up(p, o); if (lane >= o) p += t; }
            const float b1 = p, b0 = p - lf1;
            const float a0 = li0 - b0, a1 = li1 - b1;
            float pm = fmaxf(a0, a1);
#pragma unroll
            for (int o = 1; o < 64; o <<= 1) { const float t = __shfl_up(pm, o); if (lane >= o) pm = fmaxf(pm, t); }
            float pe = __shfl_up(pm, 1); if (lane == 0) pe = -3.0e38f;
            *(f32x2*)(GPa + jc * 128 + s0) = (f32x2){a0, a1}; *(f32x2*)(GPb + jc * 128 + s0) = (f32x2){b0, b1}; *(f32x2*)(GPp + jc * 128 + s0) = (f32x2){fmaxf(pe, a0), pm};
        }
        f32x4 C[16];
#pragma unroll
        for (int i = 0; i < 16; ++i) C[i] = zero4();
        for (int i = tid0; i < 512; i += NTHR) gN[i] = 0.f;
        __syncthreads();
        float m = 0.f;
        v4u PQ[4], PK[4], PV[4]; float pa[4]; float pe_a, pe_b, pe_p, pl_b, pl_p;
#define LOAD_QK(jc_, hf_) do { int t_ = tid0; asm volatile("" : "+v"(t_)); const int base_ = CBASE(jc_); const size_t r0_ = (size_t)(base_ + (dir ? 127 - (t_ >> 4) : (t_ >> 4))); const long rs_ = dir ? -32 : 32; \
            const bf16* qp_ = Zq + r0_ * 1024 + hd * 256 + (hf_) * 128 + (t_ & 15) * 8; const bf16* kp_ = Zk + r0_ * 1024 + hd * 256 + (hf_) * 128 + (t_ & 15) * 8; \
            _Pragma("unroll") for (int i = 0; i < 4; ++i) { PQ[i] = *(const v4u*)(qp_ + (long)i * rs_ * 1024); PK[i] = *(const v4u*)(kp_ + (long)i * rs_ * 1024); } } while (0)
#define LOAD_V(jc_) do { int t_ = tid0; asm volatile("" : "+v"(t_)); const int base_ = CBASE(jc_); const size_t r0_ = (size_t)(base_ + (dir ? 127 - (t_ >> 4) : (t_ >> 4))); const long rs_ = dir ? -32 : 32; \
            const bf16* vp_ = Zv + r0_ * 2048 + hd * 512 + vs * 128 + (t_ & 15) * 8; \
            _Pragma("unroll") for (int i = 0; i < 4; ++i) { PV[i] = *(const v4u*)(vp_ + (long)i * rs_ * 2048); pa[i] = GPa[(jc_) * 128 + (t_ >> 4) + 32 * i]; } } while (0)
#define LOAD_G(jc_) do { int t_ = tid0; asm volatile("" : "+v"(t_)); const int o_ = (jc_) * 128 + (t_ & 127); pe_a = GPa[o_]; pe_b = GPb[o_]; pe_p = GPp[o_]; pl_b = GPb[(jc_) * 128 + 127]; pl_p = GPp[(jc_) * 128 + 127]; } while (0)
        LOAD_QK(0, 0); LOAD_V(0); LOAD_G(0);
        for (int jc = 0; jc < 34; ++jc) {
            const int base = CBASE(jc);
#define ROWMAP(r) (base + (dir ? 127 - (r) : (r)))
            LAS float* Ncur = gN + (jc & 1) * 256; LAS float* Nnxt = gN + ((jc & 1) ^ 1) * 256;
            int tid_l = tid0; asm volatile("" : "+v"(tid_l));
            const int tid = tid_l, lane = tid & 63, fr = lane & 15, fq = lane >> 4;
            int X1 = fr * MP + 16 * fq, X2 = fr * MP + 8 * fq, X3 = (8 * fq + (fr >> 2)) * MP + 8 * (fr & 3), XS = (tid >> 4) * MP + (tid & 15) * 16, X4 = 32 * fq;
            asm volatile("" : "+v"(X1), "+v"(X2), "+v"(X3), "+v"(XS), "+v"(X4));
            const int X1w = X1 + 16 * w * MP, X2w = X2 + 16 * w * MP, X3w = X3 + 32 * w;
            const float M127 = __builtin_bit_cast(float, __builtin_amdgcn_readfirstlane(__builtin_bit_cast(int, fmaxf(m, pl_p))));
            const float decay = __builtin_bit_cast(float, __builtin_amdgcn_readfirstlane(__builtin_bit_cast(int, __expf(m - M127))));
            if (tid < 128) { const float Mt = fmaxf(m, pe_p);
                gA[tid] = pe_a; gMM[tid] = Mt; gWI[tid] = __expf(m - Mt); gEN[tid] = __expf(-pe_b - Mt); gWS[tid] = __expf(pe_a - M127) * 0.0625f; }
            m = __builtin_bit_cast(float, __builtin_amdgcn_readfirstlane(__builtin_bit_cast(int, pl_b + M127)));
            f32x4 Sacc[5], CQ[8]; v2u SP[5]; float rsum = 0.f; const int lo_own = w >= 5 ? w - 4 : 0;
#pragma unroll
            for (int i = 0; i < 8; ++i) { if (i < 5) Sacc[i] = zero4(); CQ[i] = zero4(); }
#pragma unroll
            for (int hf = 0; hf < 2; ++hf) {
#pragma unroll
                for (int i = 0; i < 4; ++i) { *(LAS v4u*)(lds + ML_QH + XS + i * 32 * MP) = PQ[i]; *(LAS v4u*)(lds + ML_KH + XS + i * 32 * MP) = PK[i]; }
                if (hf == 0) {
#pragma unroll
                    for (int i = 0; i < 4; ++i) {
                        const v4u v = PV[i]; const float ws = __expf(pa[i] - M127) * 0.0625f;
                        *(LAS v4u*)(lds + ML_VT + XS + i * 32 * MP) = v;
                        v4u o; o.x = cvt_pk_bf16(bf_lo(v.x) * ws, bf_hi(v.x) * ws); o.y = cvt_pk_bf16(bf_lo(v.y) * ws, bf_hi(v.y) * ws);
                        o.z = cvt_pk_bf16(bf_lo(v.z) * ws, bf_hi(v.z) * ws); o.w = cvt_pk_bf16(bf_lo(v.w) * ws, bf_hi(v.w) * ws);
                        *(LAS v4u*)(lds + ML_VW + XS + i * 32 * MP) = o; }
                }
                __syncthreads();
                if (hf == 0) { LOAD_QK(jc, 1); }
                else if (jc < 33) { LOAD_QK(jc + 1, 0); }
#pragma unroll
                for (int i = 0; i < 5; ++i) {
                    const bool own = i <= w - lo_own; const int tbi = own ? w : 7 - w, sbi = own ? lo_own + i : i - (w + 1);
                    if (own || (w < 3 && sbi < 3 - w)) {
#pragma unroll
                        for (int ks = 0; ks < 4; ++ks) { const bf16x8 kf = *(const LAS bf16x8*)(lds + ML_KH + X1 + sbi * 16 * MP + ks * 64); const bf16x8 qf = *(const LAS bf16x8*)(lds + ML_QH + X1 + tbi * 16 * MP + ks * 64);
                            Sacc[i] = __builtin_amdgcn_mfma_f32_16x16x32_bf16(kf, qf, Sacc[i], 0, 0, 0); }
                    }
                }
                if (hf == 1) {
                    float rs_own = 0.f, rs_help = 0.f;
#pragma unroll
                    for (int i = 0; i < 5; ++i) {
                        const bool own = i <= w - lo_own; const int tbi = own ? w : 7 - w, sbi = own ? lo_own + i : i - (w + 1);
                        v2u o; o.x = 0u; o.y = 0u;
                        if (own || (w < 3 && sbi < 3 - w)) { const int t = 16 * tbi + fr; const float Mt = gMM[t]; float v[4], rs = 0.f;
#pragma unroll
                            for (int j = 0; j < 4; ++j) { const int sidx = 16 * sbi + 4 * fq + j; v[j] = (sidx <= t) ? Sacc[i][j] * 0.0625f * __expf(gA[sidx] - Mt) : 0.f; rs += v[j]; }
                            o.x = cvt_pk_bf16(v[0], v[1]); o.y = cvt_pk_bf16(v[2], v[3]);
                            if (own) rs_own += rs; else rs_help += rs; }
                        SP[i] = o;
                    }
                    rs_own += __shfl_xor(rs_own, 16); rs_own += __shfl_xor(rs_own, 32); rs_help += __shfl_xor(rs_help, 16); rs_help += __shfl_xor(rs_help, 32);
                    rsum = rs_own;
                    if (w < 3 && fq == 0) gRS2[16 * (7 - w) + fr] = rs_help;
                }
                __builtin_amdgcn_sched_barrier(0);
#pragma unroll
                for (int tb = 0; tb < 8; ++tb) {
#pragma unroll
                    for (int k2 = 0; k2 < 4; ++k2) {
                        const f32x4 c0 = C[hf * 8 + 2 * k2], c1 = C[hf * 8 + 2 * k2 + 1];
                        v4u pk; pk.x = cvt_pk_bf16(c0[0], c0[1]); pk.y = cvt_pk_bf16(c0[2], c0[3]); pk.z = cvt_pk_bf16(c1[0], c1[1]); pk.w = cvt_pk_bf16(c1[2], c1[3]);
                        const s16x4 qa = *(const LAS s16x4*)(lds + ML_QH + X2 + tb * 16 * MP + k2 * 64), qb = *(const LAS s16x4*)(lds + ML_QH + X2 + tb * 16 * MP + k2 * 64 + 32);
                        CQ[tb] = __builtin_amdgcn_mfma_f32_16x16x32_bf16(cat8(qa, qb), __builtin_bit_cast(bf16x8, pk), CQ[tb], 0, 0, 0); }
                }
                __builtin_amdgcn_sched_barrier(0);
                {
                    f32x4 nacc = zero4();
#pragma unroll
                    for (int ks = 0; ks < 4; ++ks) {
                        const LAS float* np = (const LAS float*)((LAS unsigned char*)Ncur + X4 + hf * 512 + ks * 128);
                        const f32x4 n0 = *(const LAS f32x4*)np, n1 = *(const LAS f32x4*)(np + 4);
                        v4u pk; pk.x = cvt_pk_bf16(n0[0], n0[1]); pk.y = cvt_pk_bf16(n0[2], n0[3]); pk.z = cvt_pk_bf16(n1[0], n1[1]); pk.w = cvt_pk_bf16(n1[2], n1[3]);
                        const bf16x8 qf = *(const LAS bf16x8*)(lds + ML_QH + X1w + ks * 64);
                        nacc = __builtin_amdgcn_mfma_f32_16x16x32_bf16(qf, __builtin_bit_cast(bf16x8, pk), nacc, 0, 0, 0); }
                    if (fr == 0) {
#pragma unroll
                        for (int j = 0; j < 4; ++j) { const int t = 16 * w + 4 * fq + j; gNQ[t] = (hf == 0 ? 0.f : gNQ[t]) + nacc[j]; } }
                }
                __builtin_amdgcn_sched_barrier(0);
#pragma unroll
                for (int dt = 0; dt < 8; ++dt) {
                    f32x4 acc = C[hf * 8 + dt] * decay;
#pragma unroll
                    for (int ss = 0; ss < 4; ++ss) { LAS unsigned char* p = lds + ML_KH + X3 + ss * 32 * MP + dt * 32; LAS unsigned char* pw = lds + ML_VW + X3w + ss * 32 * MP;
                        acc = __builtin_amdgcn_mfma_f32_16x16x32_bf16(cat8(tr_read(p), tr_read(p + 4 * MP)), cat8(tr_read(pw), tr_read(pw + 4 * MP)), acc, 0, 0, 0); }
                    C[hf * 8 + dt] = acc;
                }
                __builtin_amdgcn_sched_barrier(0);
                {
                    f32x4 nacc = zero4();
#pragma unroll
                    for (int ss = 0; ss < 4; ++ss) {
                        const LAS float* wp = (const LAS float*)((LAS unsigned char*)gWS + X4 + ss * 128);
                        const f32x4 w0 = *(const LAS f32x4*)wp, w1 = *(const LAS f32x4*)(wp + 4);
                        v4u pk; pk.x = cvt_pk_bf16(w0[0], w0[1]); pk.y = cvt_pk_bf16(w0[2], w0[3]); pk.z = cvt_pk_bf16(w1[0], w1[1]); pk.w = cvt_pk_bf16(w1[2], w1[3]);
                        LAS unsigned char* p = lds + ML_KH + X3w + ss * 32 * MP;
                        nacc = __builtin_amdgcn_mfma_f32_16x16x32_bf16(cat8(tr_read(p), tr_read(p + 4 * MP)), __builtin_bit_cast(bf16x8, pk), nacc, 0, 0, 0); }
                    if (fr == 0) {
#pragma unroll
                        for (int j = 0; j < 4; ++j) { const int dl = hf * 128 + 16 * w + 4 * fq + j; Nnxt[dl] = decay * Ncur[dl] + nacc[j]; } }
                }
                __syncthreads();
            }
            {
#pragma unroll
                for (int i = 0; i < 5; ++i) {
                    const bool own = i <= w - lo_own; const int tbi = own ? w : 7 - w, sbi = own ? lo_own + i : i - (w + 1);
                    if (own || (w < 3 && sbi < 3 - w)) *(LAS v2u*)(lds + ML_QH + X2 + tbi * 16 * MP + sbi * 32) = SP[i];
                }
                for (int sb = w + 1; sb < 8; ++sb) { v2u z; z.x = 0u; z.y = 0u; *(LAS v2u*)(lds + ML_QH + X2w + sb * 32) = z; }
                const int t = 16 * w + fr;
                if (fq == 0) { const float den = gWI[t] * gNQ[t] + rsum + (w >= 5 ? gRS2[t] : 0.f); gHD[t] = 1.0f / fmaxf(fabsf(den), gEN[t]); }
            }
            __syncthreads();
            {
                bf16x8 vf[4];
#pragma unroll
                for (int ss = 0; ss < 4; ++ss) { LAS unsigned char* p = lds + ML_VT + X3w + ss * 32 * MP; vf[ss] = cat8(tr_read(p), tr_read(p + 4 * MP)); }
                if (jc < 33) { LOAD_V(jc + 1); LOAD_G(jc + 1); }
                bf16* hop = HO + (size_t)ROWMAP(4 * fq) * D + hd * 512 + vs * 128 + 16 * w + fr; const long hstep = dir ? -(long)D : (long)D;
#pragma unroll
                for (int tb = 0; tb < 8; ++tb) {
                    f32x4 acc;
#pragma unroll
                    for (int j = 0; j < 4; ++j) acc[j] = CQ[tb][j] * gWI[16 * tb + 4 * fq + j];
#pragma unroll
                    for (int ss = 0; ss < 4; ++ss) { const bf16x8 sf = *(const LAS bf16x8*)(lds + ML_QH + X1 + tb * 16 * MP + ss * 64);
                        acc = __builtin_amdgcn_mfma_f32_16x16x32_bf16(sf, vf[ss], acc, 0, 0, 0); }
#pragma unroll
                    for (int j = 0; j < 4; ++j) { const float h = acc[j] * gHD[16 * tb + 4 * fq + j];
                        hop[(long)(16 * tb + j) * hstep] = (bf16)(cvt_pk_bf16(h, 0.f) & 0xffffu); }
                }
            }
            __syncthreads();
#undef ROWMAP
        }
#undef LOAD_QK
#undef LOAD_V
#undef LOAD_G
#undef CBASE
    }
}

template <int L> __device__ __forceinline__ void mlstm_post_phase(Frame& F, int M) {
    constexpr int J = L / 3;
    const int gw = F.vcu * NWAVES + F.wave, NGW = F.G * NWAVES;
    const float* ng = F.in[I_ANG] + (size_t)J * D;
    for (int row = gw; row < M; row += NGW) {
        const bf16* hf = (const bf16*)(F.ws + WS_H) + (size_t)row * D; const bf16* hb = (const bf16*)(F.ws + WS_Y) + (size_t)row * D;
        const bf16* orow = (const bf16*)(F.ws + WS_Z + ZO) + (size_t)row * D; unsigned char* g = F.ws + WS_Z + ZG + (size_t)row * D;
        f32x4 t[8]; float ss[4];
#pragma unroll
        for (int j = 0; j < 8; ++j) { const int e = 4 * F.lane + 256 * j; const v2u a = *(const v2u*)(hf + e), b = *(const v2u*)(hb + e);
            t[j] = (f32x4){bf_lo(a.x) + bf_lo(b.x), bf_hi(a.x) + bf_hi(b.x), bf_lo(a.y) + bf_lo(b.y), bf_hi(a.y) + bf_hi(b.y)}; }
#pragma unroll
        for (int h = 0; h < 4; ++h) { float q = 0.f;
#pragma unroll
            for (int jj = 0; jj < 2; ++jj) { const f32x4 v = t[2 * h + jj]; q += (v[0] * v[0] + v[1] * v[1]) + (v[2] * v[2] + v[3] * v[3]); }
            ss[h] = 1.0f / sqrtf(wsum(q) * (1.0f / A_DV) + LN_EPS); }
#pragma unroll
        for (int j = 0; j < 8; ++j) { const int e = 4 * F.lane + 256 * j; const v2u ov = *(const v2u*)(orow + e); const f32x4 gn = *(const f32x4*)(ng + e);
            const float o0 = bf_lo(ov.x), o1 = bf_hi(ov.x), o2 = bf_lo(ov.y), o3 = bf_hi(ov.y); const float r = ss[j >> 1];
            const float y0 = t[j][0] * r * gn[0] / (1.0f + __expf(-o0)), y1 = t[j][1] * r * gn[1] / (1.0f + __expf(-o1));
            const float y2 = t[j][2] * r * gn[2] / (1.0f + __expf(-o2)), y3 = t[j][3] * r * gn[3] / (1.0f + __expf(-o3));
            *(unsigned*)(g + e) = pk4_fp8(y0, y1, y2, y3); }
    }
}

__device__ __forceinline__ void gmlp_stats_phase(Frame& F, int M) {
    const int gw = F.vcu * NWAVES + F.wave, NGW = F.G * NWAVES;
    float* ST = (float*)(F.ws + WS_STAT);
    for (int row = gw; row < M; row += NGW) {
        const bf16* vr = (const bf16*)(F.ws + WS_Z + ZVV) + (size_t)row * 4096;
        v4u x[8]; float s = 0.f;
#pragma unroll
        for (int j = 0; j < 8; ++j) { x[j] = *(const v4u*)(vr + 8 * F.lane + 512 * j);
            s += (bf_lo(x[j].x) + bf_hi(x[j].x)) + (bf_lo(x[j].y) + bf_hi(x[j].y)) + (bf_lo(x[j].z) + bf_hi(x[j].z)) + (bf_lo(x[j].w) + bf_hi(x[j].w)); }
        const float mean = wsum(s) * (1.0f / 4096.f); float q = 0.f;
#pragma unroll
        for (int j = 0; j < 8; ++j) { float d;
            d = bf_lo(x[j].x) - mean; q += d * d; d = bf_hi(x[j].x) - mean; q += d * d; d = bf_lo(x[j].y) - mean; q += d * d; d = bf_hi(x[j].y) - mean; q += d * d;
            d = bf_lo(x[j].z) - mean; q += d * d; d = bf_hi(x[j].z) - mean; q += d * d; d = bf_lo(x[j].w) - mean; q += d * d; d = bf_hi(x[j].w) - mean; q += d * d; }
        const float rstd = 1.0f / sqrtf(wsum(q) * (1.0f / 4096.f) + LN_EPS);
        if (F.lane == 0) { ST[(size_t)row * 2] = mean; ST[(size_t)row * 2 + 1] = rstd; }
    }
}
__device__ __forceinline__ void gmlp_spatial_phase(Frame& F, int M) {
    LAS unsigned char* lds = F.lds;
    constexpr int GW_W = 0, GW_V = 128 * MP, GW_O = 2 * 128 * MP;
    const bf16* WS = (const bf16*)(F.ws + WS_WS); const float* ST = (const float*)(F.ws + WS_STAT);
    const bf16* U = (const bf16*)(F.ws + WS_Z + ZU); const bf16* V = (const bf16*)(F.ws + WS_Z + ZVV);
    const float* lng = F.in[I_BLNG]; const float* lnb = F.in[I_BLNB]; const float* bs = F.in[I_BBS];
    const int w = F.wave;
    const int nunits = (M / 128) * B_GROUPS;
    for (int u = F.vcu; u < nunits; u += F.G) {
        int tid_l = F.tid; asm volatile("" : "+v"(tid_l));
        const int tid = tid_l, lane = tid & 63, fr = lane & 15, fq = lane >> 4;
        const int chunk = u >> 3, g = u & 7, row0 = chunk * 128;
        const int et = tid >> 2, ec = tid & 3;
        v4u wreg[4], vreg[4][4]; float mean[4], rstd[4];
#pragma unroll
        for (int i = 0; i < 4; ++i) { const int c = tid + 512 * i, r = c >> 4, cc = c & 15;
            wreg[i] = *(const v4u*)(WS + (size_t)g * 16384 + r * 128 + cc * 8);
            mean[i] = ST[(size_t)(row0 + r) * 2]; rstd[i] = ST[(size_t)(row0 + r) * 2 + 1];
#pragma unroll
            for (int dq = 0; dq < 4; ++dq) vreg[dq][i] = *(const v4u*)(V + (size_t)(row0 + r) * 4096 + g * 512 + dq * 128 + cc * 8); }
        const float bst = bs[g * 128 + et];
#pragma unroll
        for (int i = 0; i < 4; ++i) { const int c = tid + 512 * i, r = c >> 4, cc = c & 15; *(LAS v4u*)(lds + GW_W + r * MP + cc * 16) = wreg[i]; }
#pragma unroll
        for (int dq = 0; dq < 4; ++dq) {
            const int col0 = g * 512 + dq * 128;
#pragma unroll
            for (int i = 0; i < 4; ++i) { const int c = tid + 512 * i, r = c >> 4, cc = c & 15;
                const v4u v = vreg[dq][i]; const float mn = mean[i], rs = rstd[i];
                const f32x4 ga = *(const f32x4*)(lng + col0 + cc * 8), gb = *(const f32x4*)(lng + col0 + cc * 8 + 4), ba = *(const f32x4*)(lnb + col0 + cc * 8), bb = *(const f32x4*)(lnb + col0 + cc * 8 + 4);
                v4u o;
                o.x = cvt_pk_bf16((bf_lo(v.x) - mn) * rs * ga[0] + ba[0], (bf_hi(v.x) - mn) * rs * ga[1] + ba[1]);
                o.y = cvt_pk_bf16((bf_lo(v.y) - mn) * rs * ga[2] + ba[2], (bf_hi(v.y) - mn) * rs * ga[3] + ba[3]);
                o.z = cvt_pk_bf16((bf_lo(v.z) - mn) * rs * gb[0] + bb[0], (bf_hi(v.z) - mn) * rs * gb[1] + bb[1]);
                o.w = cvt_pk_bf16((bf_lo(v.w) - mn) * rs * gb[2] + bb[2], (bf_hi(v.w) - mn) * rs * gb[3] + bb[3]);
                *(LAS v4u*)(lds + GW_V + r * MP + cc * 16) = o; }
            __syncthreads();
            v4u ureg[4];
            { const bf16* up = U + (size_t)(row0 + et) * 4096 + col0 + 32 * ec;
#pragma unroll
              for (int k = 0; k < 4; ++k) ureg[k] = *(const v4u*)(up + 8 * k); }
            bf16x8 wf[4];
#pragma unroll
            for (int ss = 0; ss < 4; ++ss) wf[ss] = *(const LAS bf16x8*)(lds + GW_W + (16 * w + fr) * MP + (32 * ss + 8 * fq) * 2);
#pragma unroll
            for (int db = 0; db < 8; ++db) {
                f32x4 acc = zero4();
#pragma unroll
                for (int ss = 0; ss < 4; ++ss) { LAS unsigned char* p = lds + GW_V + (32 * ss + 8 * fq + (fr >> 2)) * MP + (16 * db + 4 * (fr & 3)) * 2;
                    acc = __builtin_amdgcn_mfma_f32_16x16x32_bf16(cat8(tr_read(p), tr_read(p + 4 * MP)), wf[ss], acc, 0, 0, 0); }
                v2u o; o.x = cvt_pk_bf16(acc[0], acc[1]); o.y = cvt_pk_bf16(acc[2], acc[3]);
                *(LAS v2u*)(lds + GW_O + (16 * w + fr) * MP + (16 * db + 4 * fq) * 2) = o;
            }
            __syncthreads();
            { const LAS unsigned char* op = lds + GW_O + et * MP + 64 * ec;
              unsigned char* hp = F.ws + WS_H + (size_t)(row0 + et) * 4096 + col0 + 32 * ec;
              v4u out[2];
#pragma unroll
              for (int k = 0; k < 4; ++k) { const v4u sv = *(const LAS v4u*)(op + 16 * k); const v4u uv = ureg[k];
                  const unsigned lo = pk4_fp8(bf_lo(uv.x) * (bf_lo(sv.x) + bst), bf_hi(uv.x) * (bf_hi(sv.x) + bst), bf_lo(uv.y) * (bf_lo(sv.y) + bst), bf_hi(uv.y) * (bf_hi(sv.y) + bst));
                  const unsigned hi = pk4_fp8(bf_lo(uv.z) * (bf_lo(sv.z) + bst), bf_hi(uv.z) * (bf_hi(sv.z) + bst), bf_lo(uv.w) * (bf_lo(sv.w) + bst), bf_hi(uv.w) * (bf_hi(sv.w) + bst));
                  out[k >> 1][2 * (k & 1)] = lo; out[k >> 1][2 * (k & 1) + 1] = hi; }
              *(v4u*)hp = out[0]; *(v4u*)(hp + 16) = out[1]; }
        }
        __syncthreads();
    }
}

namespace att {
using bf16 = unsigned short;
constexpr int   D = 128, NW = 8, QBLK = 32, KVBLK = 64;
constexpr float SCALE = 0.088388347648318440f;
constexpr float THR = 8.f;
constexpr int SDEPTH = 1;
constexpr int LDQ = 2048, LDK = 512, LDO = 2048;
constexpr size_t SHM_V = KVBLK * D * 2, SHM_K = KVBLK * D * 2, SHM_ATTN = 2 * SHM_V + 2 * SHM_K + NW * 64 * 4;
using bf16x8 = __attribute__((ext_vector_type(8))) short;
using s16x4  = __attribute__((ext_vector_type(4))) short;
using f32x16 = __attribute__((ext_vector_type(16))) float;
using f32x8  = __attribute__((ext_vector_type(8))) float;
using u32x4  = __attribute__((ext_vector_type(4))) unsigned;
#define KSWZ(row, colB) ((row) * 256 + ((colB) ^ (((row) & 7) << 4)))
#define SBAR() __builtin_amdgcn_sched_barrier(0)
__device__ __forceinline__ int crow(int r, int hi) { return (r & 3) + 8 * (r >> 2) + 4 * hi; }
__device__ __forceinline__ unsigned cvtpk(float lo, float hi) { return ::cvt_pk_bf16(lo, hi); }
template <typename TIn> struct Stage;
template <> struct Stage<bf16>  { using T = bf16x8;
  __device__ static __forceinline__ T ld8(const bf16* p) { return *reinterpret_cast<const bf16x8*>(p); }
  __device__ static __forceinline__ bf16x8 tobf(T x) { return x; } };
__device__ __forceinline__ void partialSM(f32x16& p0, f32x16& p1, float& m_reg, float& mn, float& alpha) {
  constexpr float C = SCALE * 1.4426950408889634f;
  float pmax = p0[0]; for (int r = 1; r < 16; ++r) pmax = fmaxf(pmax, p0[r]); for (int r = 0; r < 16; ++r) pmax = fmaxf(pmax, p1[r]);
  { auto rr = __builtin_amdgcn_permlane32_swap(__float_as_uint(pmax), __float_as_uint(pmax), false, false);
    pmax = fmaxf(__uint_as_float(rr[0]), __uint_as_float(rr[1])); }
  if (__builtin_expect(__all(pmax - m_reg <= THR / SCALE), 1)) { mn = m_reg; alpha = 1.f; }
  else { mn = fmaxf(m_reg, pmax); alpha = __builtin_amdgcn_exp2f((m_reg - mn) * C); m_reg = mn; }
  float mnC = -mn * C;
  for (int r = 0; r < 16; ++r) p0[r] = fmaf(p0[r], C, mnC); for (int r = 0; r < 16; ++r) p1[r] = fmaf(p1[r], C, mnC);
  for (int r = 0; r < 16; ++r) p0[r] = __builtin_amdgcn_exp2f(p0[r]);
}
__device__ __forceinline__ void finishSM(f32x16& p0, f32x16& p1, float alpha, float& l_reg, bf16x8& pa0, bf16x8& pa1, bf16x8& pa2, bf16x8& pa3) {
  for (int r = 0; r < 16; ++r) p1[r] = __builtin_amdgcn_exp2f(p1[r]);
  float ps = 0; for (int r = 0; r < 16; ++r) ps += p0[r]; for (int r = 0; r < 16; ++r) ps += p1[r];
  { auto rr = __builtin_amdgcn_permlane32_swap(__float_as_uint(ps), __float_as_uint(ps), false, false);
    ps = __uint_as_float(rr[0]) + __uint_as_float(rr[1]); }
  l_reg = l_reg * alpha + ps;
#define PK4(P, BASE, OUT) do { unsigned a0 = cvtpk(P[BASE + 0], P[BASE + 1]), a1 = cvtpk(P[BASE + 2], P[BASE + 3]);   \
    unsigned b0 = cvtpk(P[BASE + 4], P[BASE + 5]), b1 = cvtpk(P[BASE + 6], P[BASE + 7]);                              \
    auto r0 = __builtin_amdgcn_permlane32_swap(a0, b0, false, false); auto r1 = __builtin_amdgcn_permlane32_swap(a1, b1, false, false); \
    u32x4 w = {r0[0], r1[0], r0[1], r1[1]}; OUT = *reinterpret_cast<bf16x8*>(&w); } while (0)
  PK4(p0, 0, pa0); PK4(p0, 8, pa1); PK4(p1, 0, pa2); PK4(p1, 8, pa3);
#undef PK4
}
__device__ __forceinline__ void qkt(f32x16& p0, f32x16& p1, const bf16* Ks, const bf16x8* qr, int r32, int hi) {
  p0 = f32x16{}; p1 = f32x16{};
  for (int d0 = 0; d0 < 8; ++d0) { int cb = (d0 * 16 + hi * 8) * 2;
    bf16x8 b0 = *reinterpret_cast<const bf16x8*>((const char*)Ks + KSWZ(r32, cb));
    bf16x8 b1 = *reinterpret_cast<const bf16x8*>((const char*)Ks + KSWZ(32 + r32, cb));
    p0 = __builtin_amdgcn_mfma_f32_32x32x16_bf16(b0, qr[d0], p0, 0, 0, 0);
    p1 = __builtin_amdgcn_mfma_f32_32x32x16_bf16(b1, qr[d0], p1, 0, 0, 0); }
}
__device__ __forceinline__ int v_st(int k, int c) { const int kk = (k & ~0xC) | ((k & 4) << 1) | ((k & 8) >> 1); return ((kk >> 3) * 4 + (c >> 5)) * 512 + ((kk & 7) * 32 + (c & 31)) * 2; }
__device__ __forceinline__ int v_rd_base(int lane) { return ((lane & 3) << 3) | (((lane >> 2) & 3) << 6) | (((lane >> 4) & 1) << 5) | (((lane >> 5) & 1) << 8); }
constexpr int v_rd_off(int d0, int ks, int half) { return d0 * 512 + ks * 4096 + half * 2048; }
template <int OFF> __device__ __forceinline__ s16x4 tr_read(int vb) {
  return __builtin_amdgcn_ds_read_tr16_b64_v4i16((__attribute__((address_space(3))) s16x4*)(unsigned long)(unsigned)(vb + OFF));
}
template <int D0> __device__ __forceinline__ void pv_one(f32x16& od, int vb, bf16x8 pa0, bf16x8 pa1, bf16x8 pa2, bf16x8 pa3) {
  const s16x4 l0 = tr_read<v_rd_off(D0, 0, 0)>(vb), h0 = tr_read<v_rd_off(D0, 0, 1)>(vb), l1 = tr_read<v_rd_off(D0, 1, 0)>(vb), h1 = tr_read<v_rd_off(D0, 1, 1)>(vb);
  const s16x4 l2 = tr_read<v_rd_off(D0, 2, 0)>(vb), h2 = tr_read<v_rd_off(D0, 2, 1)>(vb), l3 = tr_read<v_rd_off(D0, 3, 0)>(vb), h3 = tr_read<v_rd_off(D0, 3, 1)>(vb);
#define PK(L, H) (bf16x8){L[0], L[1], L[2], L[3], H[0], H[1], H[2], H[3]}
  od = __builtin_amdgcn_mfma_f32_32x32x16_bf16(pa0, PK(l0, h0), od, 0, 0, 0);
  od = __builtin_amdgcn_mfma_f32_32x32x16_bf16(pa1, PK(l1, h1), od, 0, 0, 0);
  od = __builtin_amdgcn_mfma_f32_32x32x16_bf16(pa2, PK(l2, h2), od, 0, 0, 0);
  od = __builtin_amdgcn_mfma_f32_32x32x16_bf16(pa3, PK(l3, h3), od, 0, 0, 0);
#undef PK
}
__device__ __forceinline__ void pv_d0(f32x16* o, int vb, bf16x8 pa0, bf16x8 pa1, bf16x8 pa2, bf16x8 pa3) {
  pv_one<0>(o[0], vb, pa0, pa1, pa2, pa3); pv_one<1>(o[1], vb, pa0, pa1, pa2, pa3); pv_one<2>(o[2], vb, pa0, pa1, pa2, pa3); pv_one<3>(o[3], vb, pa0, pa1, pa2, pa3);
}

template <typename TQ>
__device__ __forceinline__ void attn_dense_body(const TQ* __restrict__ Qb, const bf16* __restrict__ Kh, const bf16* __restrict__ Vh,
                                                unsigned char* __restrict__ Ob, int seq, char* lds, int tid_in) {
  using St = Stage<bf16>; using SQ = Stage<TQ>;
  const int tid = tid_in, wid = tid >> 6, lane = tid & 63, r32 = lane & 31, hi = lane >> 5;
  bf16* V_lds = (bf16*)lds; bf16* K_lds = (bf16*)(lds + 2 * SHM_V);
  float* ws = (float*)(lds + 2 * SHM_V + 2 * SHM_K) + wid * 64; float* li_l = ws; float* al_l = ws + 32;
  float m_reg = -1e30f, l_reg = 0; f32x16 o[4] = {}; bf16x8 qr[8];
  const TQ* Qw = Qb + (long)(wid * QBLK + r32) * LDQ + hi * 8;
#pragma unroll
  for (int d0 = 0; d0 < 8; ++d0) qr[d0] = SQ::tobf(SQ::ld8(Qw + d0 * 16));
  const int sr = tid >> 4, sc = (tid & 15) * 8, vst0 = v_st(sr, sc), vst1 = v_st(32 + sr, sc);
  const int vb0 = (int)(uintptr_t)V_lds + v_rd_base(lane);
  struct { typename St::T vs0, vs1, ks0, ks1; } sr_[SDEPTH];
#define SLOAD(i, k0) do { sr_[i].vs0 = St::ld8(&Vh[(long)((k0) + sr) * LDK + sc]); sr_[i].vs1 = St::ld8(&Vh[(long)((k0) + 32 + sr) * LDK + sc]); \
    sr_[i].ks0 = St::ld8(&Kh[(long)((k0) + sr) * LDK + sc]); sr_[i].ks1 = St::ld8(&Kh[(long)((k0) + 32 + sr) * LDK + sc]); } while (0)
#define SWRITE(b, i) do { *(bf16x8*)((char*)V_lds + (b) * SHM_V + vst0) = St::tobf(sr_[i].vs0);          \
    *(bf16x8*)((char*)V_lds + (b) * SHM_V + vst1) = St::tobf(sr_[i].vs1); int kc = sc * 2;               \
    *(bf16x8*)((char*)K_lds + (b) * SHM_K + KSWZ(sr, kc)) = St::tobf(sr_[i].ks0);                       \
    *(bf16x8*)((char*)K_lds + (b) * SHM_K + KSWZ(32 + sr, kc)) = St::tobf(sr_[i].ks1); } while (0)
#define SWAIT() do { if constexpr (SDEPTH == 2) asm volatile("s_waitcnt vmcnt(4)" ::: "memory"); else asm volatile("s_waitcnt vmcnt(0)" ::: "memory"); } while (0)
#define RESC(a) do { if (__any((a) < 1.f)) { if (hi == 0) al_l[r32] = (a); asm volatile("s_waitcnt lgkmcnt(0)" ::: "memory"); \
    for (int d = 0; d < 4; ++d) for (int r = 0; r < 16; ++r) o[d][r] *= al_l[crow(r, hi)]; } } while (0)
  f32x16 pA0, pA1, pB0, pB1; float mnA, mnB, alA, alB; bf16x8 pa0, pa1, pa2, pa3; const int NT = seq / KVBLK;
  constexpr int SE = 0, SO = SDEPTH - 1;
  SLOAD(SE, 0); asm volatile("s_waitcnt vmcnt(0)" ::: "memory"); SWRITE(0, SE); __syncthreads();
  qkt(pA0, pA1, K_lds, qr, r32, hi); partialSM(pA0, pA1, m_reg, mnA, alA);
  SLOAD(SO, KVBLK); if constexpr (SDEPTH == 2) { if (2 < NT) SLOAD(SE, 2 * KVBLK); }
  SWAIT(); SWRITE(1, SO); __syncthreads();
  for (int j = 1; j + 1 < NT; j += 2) {
    SBAR(); qkt(pB0, pB1, (bf16*)((char*)K_lds + SHM_K), qr, r32, hi);
    finishSM(pA0, pA1, alA, l_reg, pa0, pa1, pa2, pa3); SBAR();
    SLOAD(SO, (j + SDEPTH) * KVBLK); SBAR();
    pv_d0(o, vb0, pa0, pa1, pa2, pa3); partialSM(pB0, pB1, m_reg, mnB, alB);
    __syncthreads(); SWAIT(); SWRITE(0, SE);
    RESC(alB); __syncthreads();
    SBAR(); qkt(pA0, pA1, K_lds, qr, r32, hi);
    finishSM(pB0, pB1, alB, l_reg, pa0, pa1, pa2, pa3); SBAR();
    if (SDEPTH == 1 || j + 3 < NT) SLOAD(SE, (j + 1 + SDEPTH) * KVBLK); SBAR();
    pv_d0(o, vb0 + (int)SHM_V, pa0, pa1, pa2, pa3); partialSM(pA0, pA1, m_reg, mnA, alA);
    __syncthreads(); SWAIT(); SWRITE(1, SO);
    RESC(alA); __syncthreads();
  }
  SBAR(); qkt(pB0, pB1, (bf16*)((char*)K_lds + SHM_K), qr, r32, hi);
  finishSM(pA0, pA1, alA, l_reg, pa0, pa1, pa2, pa3); SBAR();
  pv_d0(o, vb0, pa0, pa1, pa2, pa3); partialSM(pB0, pB1, m_reg, mnB, alB);
  __syncthreads(); RESC(alB);
  finishSM(pB0, pB1, alB, l_reg, pa0, pa1, pa2, pa3); SBAR();
  pv_d0(o, vb0 + (int)SHM_V, pa0, pa1, pa2, pa3);
  if (hi == 0) li_l[r32] = l_reg; asm volatile("s_waitcnt lgkmcnt(0)" ::: "memory");
  float rli[16];
#pragma unroll
  for (int r = 0; r < 16; ++r) rli[r] = __builtin_amdgcn_rcpf(li_l[crow(r, hi)]);
  unsigned char* Ow = Ob + (long)(wid * QBLK) * LDO;
#pragma unroll
  for (int r = 0; r < 16; ++r) { int orow = crow(r, hi);
    for (int d0 = 0; d0 < 4; ++d0) Ow[(long)orow * LDO + d0 * 32 + r32] = (unsigned char)(__builtin_amdgcn_cvt_pk_fp8_f32(o[d0][r] * rli[r], 0.f, 0, false) & 0xff); }
#undef SLOAD
#undef SWRITE
#undef SWAIT
#undef RESC
}
}

constexpr size_t WS_ROPE = WS_STAT + 512 * 1024;
__device__ __forceinline__ void rope_table(Frame& F) {
    float* R = (float*)(F.ws + WS_ROPE);
    const int i = F.vcu * NTHR + F.tid;
    if (i < 64 * 32) { const int pos = i >> 5, fi = i & 31; const float fr = powf(10000.0f, -(float)fi / 32.0f); const float ang = (float)pos * fr; R[2 * i] = cosf(ang); R[2 * i + 1] = sinf(ang); }
}
__device__ __forceinline__ v4u normrope_seg(const bf16* src, const float* g, const float* R, bool rope, int rowpos, int colpos, int lane) {
    const v4u x = *(const v4u*)(src + 8 * lane);
    float v[8] = {bf_lo(x.x), bf_hi(x.x), bf_lo(x.y), bf_hi(x.y), bf_lo(x.z), bf_hi(x.z), bf_lo(x.w), bf_hi(x.w)};
    float q = 0.f;
#pragma unroll
    for (int i = 0; i < 8; ++i) q += v[i] * v[i];
    const float rstd = 1.0f / sqrtf(row16_sum(q) * (1.0f / 128.f) + LN_EPS);
    const int d0 = 8 * (lane & 15);
    const f32x4 ga = *(const f32x4*)(g + d0), gb = *(const f32x4*)(g + d0 + 4);
#pragma unroll
    for (int i = 0; i < 4; ++i) { v[i] *= rstd * ga[i]; v[4 + i] *= rstd * gb[i]; }
    if (rope) {
        const int pos = ((lane & 15) >> 3) ? colpos : rowpos; const bool hi = (lane & 7) >= 4; const int f0 = 8 * (lane & 3);
#pragma unroll
        for (int i = 0; i < 8; ++i) { const float p = __shfl_xor(v[i], 4); const float cs = R[(pos * 32 + f0 + i) * 2], sn = R[(pos * 32 + f0 + i) * 2 + 1];
            v[i] = hi ? (p * sn + v[i] * cs) : (v[i] * cs - p * sn); }
    }
    v4u o; o.x = cvt_pk_bf16(v[0], v[1]); o.y = cvt_pk_bf16(v[2], v[3]); o.z = cvt_pk_bf16(v[4], v[5]); o.w = cvt_pk_bf16(v[6], v[7]);
    return o;
}
__device__ __forceinline__ void attn_prep_phase(Frame& F) {
    const int gw = F.vcu * NWAVES + F.wave, NGW = F.G * NWAVES;
    const float* R = (const float*)(F.ws + WS_ROPE);
    const float* qg = F.in[I_CQG]; const float* kg = F.in[I_CKG];
    for (int row = gw; row < T; row += NGW) {
        const bool lat = row < TL; const int b = lat ? (row >> 12) : ((row - TL) >> 8); const int s = lat ? (row & 4095) : 0;
        const int rp = s >> 6, cp = s & 63; const int kvrow = lat ? (b * SKV + s) : (b * SKV + SEQ + ((row - TL) & 255));
        bf16* q = (bf16*)(F.ws + WS_Z + ZAQ) + (size_t)row * 2048;
#pragma unroll
        for (int p = 0; p < 4; ++p) { const v4u o = normrope_seg(q + 512 * p, qg, R, lat, rp, cp, F.lane); *(v4u*)(q + 512 * p + 8 * F.lane) = o; }
        const bf16* k = (const bf16*)(F.ws + WS_Z + ZAK) + (size_t)row * 512; const bf16* v = (const bf16*)(F.ws + WS_Z + ZAV) + (size_t)row * 512;
        const v4u ko = normrope_seg(k, kg, R, lat, rp, cp, F.lane);
        *(v4u*)((bf16*)(F.ws + WS_Z + ZKC) + (size_t)kvrow * 512 + 8 * F.lane) = ko;
        *(v4u*)((bf16*)(F.ws + WS_Z + ZVC) + (size_t)kvrow * 512 + 8 * F.lane) = *(const v4u*)(v + 8 * F.lane);
    }
}
__device__ __forceinline__ void attn_phase(Frame& F, char* lds, bool need_ctx) {
    const bf16* Q = (const bf16*)(F.ws + WS_Z + ZAQ); const bf16* KC = (const bf16*)(F.ws + WS_Z + ZKC); const bf16* VC = (const bf16*)(F.ws + WS_Z + ZVC);
    unsigned char* O = F.ws + WS_H;
    const int nunits = 2048 + (need_ctx ? 128 : 0);
    for (int u = F.vcu; u < nunits; u += F.G) {
        const bf16 *qp, *kp, *vp; unsigned char* op; int seq;
        if (u < 2048) { const int qb = u & 15, h = (u >> 4) & 15, b = u >> 8; const size_t qrow = (size_t)b * SEQ + qb * 256;
            qp = Q + qrow * 2048 + h * 128; kp = KC + (size_t)b * SKV * 512 + (h >> 2) * 128; vp = VC + (size_t)b * SKV * 512 + (h >> 2) * 128; op = O + qrow * 2048 + h * 128; seq = SKV;
        } else { const int uu = u - 2048, h = uu & 15, b = uu >> 4; const size_t qrow = (size_t)TL + b * CL;
            qp = Q + qrow * 2048 + h * 128; kp = KC + ((size_t)b * SKV + SEQ) * 512 + (h >> 2) * 128; vp = VC + ((size_t)b * SKV + SEQ) * 512 + (h >> 2) * 128; op = O + qrow * 2048 + h * 128; seq = CL; }
        int tid_l = threadIdx.x; asm volatile("" : "+v"(tid_l));
        att::attn_dense_body<bf16>(qp, kp, vp, op, seq, lds, tid_l);
        __syncthreads();
    }
}

#ifndef MK_N_LAUNCHES
#define MK_N_LAUNCHES 1
#endif
constexpr int NPH = 2 + 8 * DEPTH;
struct Args { const float* in[28]; float* out; unsigned char* ws; int ph_lo, ph_hi; };

typedef pg8::EpiSeg<0> EpiPlain;
__device__ __forceinline__ EpiPlain epi_plain(bf16* o, int ld) { EpiPlain E; E.base = (unsigned char*)o; E.ld = ld; E.bias = nullptr; E.gates = nullptr; E.oscale = 1.0f / WSCALE; return E; }


__global__ void __launch_bounds__(NTHR, 2) fwd_kernel(Args args) {
    extern __shared__ __attribute__((aligned(16))) unsigned char lds_raw[];
    Frame F;
    F.lds = (LAS unsigned char*)lds_raw;
    F.tid = threadIdx.x; F.lane = F.tid & 63; F.wave = __builtin_amdgcn_readfirstlane(F.tid >> 6);
    F.G = gridDim.x; { const int bx = blockIdx.x; F.vcu = (F.G % 8 == 0) ? (bx % 8) * (F.G / 8) + bx / 8 : bx; }
    typedef const Args __attribute__((address_space(4)))* KArgs;
    KArgs ka = (KArgs)__builtin_amdgcn_kernarg_segment_ptr();
    F.in = ka->in; F.out = ka->out; F.ws = ka->ws;
    volatile LAS unsigned* MISC = (volatile LAS unsigned*)(F.lds + MISC_OFF);
    for (int u = F.tid; u < (LDS_BYTES - MISC_OFF) / 4; u += NTHR) MISC[u] = 0u;
    __syncthreads();
    const int lo = ka->ph_lo, hi = ka->ph_hi;
    unsigned* barw = (unsigned*)(F.ws + WS_CTL) + CW_BAR;
    XcdBarrier bar; bar.bar = barw; bar.x = 0; bar.st = nullptr;
    if (hi - lo > 1) bar = xcd_barrier_post(barw, MISC + 8);
#ifdef ONLY_PHASE
#define IN(k) ((k) == ONLY_PHASE && lo <= (k) && (k) < hi)
#else
#define IN(k) (lo <= (k) && (k) < hi)
#endif
#define SEAM(k) do { if (IN(k) && IN((k) + 1)) xcd_barrier(bar); } while (0)
#define RELANE() do { int t_ = threadIdx.x; asm volatile("" : "+v"(t_)); F.tid = t_; F.lane = t_ & 63; KArgs k_ = ka; asm volatile("" : "+s"(k_)); F.in = k_->in; F.out = k_->out; F.ws = k_->ws; } while (0)
#define WT (F.ws + WS_WT)
#define Hb ((bf16*)(F.ws + WS_H))
#define Yb ((bf16*)(F.ws + WS_Y))
#define Zb ((bf16*)(F.ws + WS_Z))

    if (IN(0)) { RELANE(); p0_prologue(F); rope_table(F); } SEAM(0);
    if (IN(1)) { RELANE(); p0b_modulate(F); } SEAM(1);

#define GEMM_PHASE16(EPI, Aptr, Bptr, M_, N_, K_) do { pg8::Gemm g{(const bf16*)(Aptr), (const bf16*)(Bptr), (M_), (N_), (K_)}; pg8::StaticOrder S; S.init((M_), (N_), F.G, (int)blockIdx.x); \
        pg8::gemm_phase<false>(F.lds, g, S, (EPI)); } while (0)
#define GEMM_PHASE(EPI, Aptr, Bptr, M_, N_, K_) do { pg8::Gemm g{(const bf16*)(Aptr), (const bf16*)(Bptr), (M_), (N_), (K_) / 2}; pg8::StaticOrder S; S.init((M_), (N_), F.G, (int)blockIdx.x); \
        pg8::gemm_phase<true>(F.lds, g, S, (EPI)); } while (0)
#define PEER_PHASES(L, PB, M_) do { \
        if (IN((PB) + 4)) { RELANE(); ln1_phase<L>(F, (M_)); } SEAM((PB) + 4); \
        if (IN((PB) + 5)) { RELANE(); EpiPlain E = epi_plain(Zb, 2048); \
            if ((PQ_FP8_MASK >> (L)) & 1) { GEMM_PHASE(E, Hb, WT + WT_PQ + (size_t)(L) * D * D * 2, (M_), 2048, 2048); } \
            else { E.oscale = 1.0f; GEMM_PHASE16(E, Yb, WT + WT_PQ + (size_t)(L) * D * D * 2, (M_), 2048, 2048); } } SEAM((PB) + 5); \
        if (IN((PB) + 6)) { RELANE(); peer_topk_phase<L>(F, (M_)); } SEAM((PB) + 6); \
        if (IN((PB) + 7)) { RELANE(); peer_u_phase<L>(F, (M_)); if (hi - lo > 1) xcd_barrier(bar); RELANE(); peer_v_phase<L>(F, (M_)); } SEAM((PB) + 7); } while (0)
#define MLSTM_PHASES(L, PB, M_) do { \
        if (IN((PB) + 0)) { RELANE(); pg8::EpiSeg<1> E; E.base = F.ws + WS_Z; E.ld = 0; E.bias = nullptr; E.gates = (float*)(F.ws + WS_GATE); E.oscale = 1.0f / WSCALE; \
            GEMM_PHASE(E, Hb, WT + WT_AIN + (size_t)((L) / 3) * A_INP * D, T, A_INP, 2048); } SEAM((PB) + 0); \
        if (IN((PB) + 1)) { RELANE(); mlstm_scan_phase<L>(F); } SEAM((PB) + 1); \
        if (IN((PB) + 2)) { RELANE(); mlstm_post_phase<L>(F, (M_)); } SEAM((PB) + 2); \
        if (IN((PB) + 3)) { RELANE(); EpiPlain E = epi_plain(Yb, 2048); GEMM_PHASE(E, F.ws + WS_Z + ZG, WT + WT_AOUT + (size_t)((L) / 3) * D * D, (M_), 2048, 2048); } SEAM((PB) + 3); } while (0)

    MLSTM_PHASES(0, 2, T);
    PEER_PHASES(0, 2, T);
    if (IN(10)) { RELANE(); pg8::EpiSeg<2> E; E.base = F.ws + WS_Z; E.ld = 0; E.bias = F.in[I_BBIN]; E.gates = nullptr; E.oscale = 1.0f / WSCALE; GEMM_PHASE(E, Hb, WT + WT_BIN, T, 8192, 2048); } SEAM(10);
    if (IN(11)) { RELANE(); gmlp_stats_phase(F, T); } SEAM(11);
    if (IN(12)) { RELANE(); gmlp_spatial_phase(F, T); } SEAM(12);
    if (IN(13)) { RELANE(); EpiPlain E = epi_plain(Yb, 2048); GEMM_PHASE(E, Hb, WT + WT_BOUT, T, 2048, 4096); } SEAM(13);
    PEER_PHASES(1, 10, T);
    if (IN(18)) { RELANE(); pg8::EpiSeg<3> E; E.base = F.ws + WS_Z; E.ld = 0; E.bias = nullptr; E.gates = nullptr; E.oscale = 1.0f / WSCALE; GEMM_PHASE(E, Hb, WT + WT_CQKV, T, C_QKV, 2048); } SEAM(18);
    if (IN(19)) { RELANE(); attn_prep_phase(F); } SEAM(19);
    if (IN(20)) { RELANE(); attn_phase(F, (char*)lds_raw, true); } SEAM(20);
    if (IN(21)) { RELANE(); EpiPlain E = epi_plain(Yb, 2048); GEMM_PHASE(E, Hb, WT + WT_COUT, T, 2048, 2048); } SEAM(21);
    PEER_PHASES(2, 18, T);
    MLSTM_PHASES(3, 26, TL);
    PEER_PHASES(3, 26, TL);
#undef IN
#undef SEAM
#undef WT
#undef Hb
#undef Yb
#undef Zb
}


extern "C" void kernel_launch(void* const* d_in, const int* in_sizes, int n_in, void* d_out, int out_size, void* d_ws, size_t ws_size, hipStream_t stream) {
    static int grid = 0;
    if (grid == 0) {
        if (n_in != 28 || out_size != TL * D || ws_size < WS_END) { fprintf(stderr, "kernel_launch: unexpected shapes: n_in %d out %d ws %zu (need %zu)\n", n_in, out_size, ws_size, (size_t)WS_END); grid = -1; return; }
        int dev = 0, cus = 0, per_cu = 0;
        if (hipGetDevice(&dev) != hipSuccess || hipDeviceGetAttribute(&cus, hipDeviceAttributeMultiprocessorCount, dev) != hipSuccess) { grid = -1; return; }
        if (hipFuncSetAttribute((const void*)fwd_kernel, hipFuncAttributeMaxDynamicSharedMemorySize, LDS_BYTES) != hipSuccess) { fprintf(stderr, "kernel_launch: hipFuncSetAttribute failed\n"); grid = -1; return; }
        if (hipOccupancyMaxActiveBlocksPerMultiprocessor(&per_cu, (const void*)fwd_kernel, NTHR, LDS_BYTES) != hipSuccess || per_cu < 1) { fprintf(stderr, "kernel_launch: occupancy query says %d\n", per_cu); }
        (void)hipGetLastError();
        grid = cus;
    }
    if (grid < 0) return;
    if (hipMemsetAsync((char*)d_ws + WS_CTL, 0, CTL_ZERO_BYTES, stream) != hipSuccess) return;
    Args a{};
    for (int i = 0; i < 28; ++i) a.in[i] = (const float*)d_in[i];
    a.out = (float*)d_out; a.ws = (unsigned char*)d_ws;
#if MK_N_LAUNCHES == 1
    a.ph_lo = 0; a.ph_hi = NPH;
    hipLaunchKernelGGL(fwd_kernel, dim3(grid), dim3(NTHR), LDS_BYTES, stream, a);
#else
    for (int k = 0; k < NPH; ++k) { a.ph_lo = k; a.ph_hi = k + 1; hipLaunchKernelGGL(fwd_kernel, dim3(grid), dim3(NTHR), LDS_BYTES, stream, a); }
#endif
    const hipError_t le = hipPeekAtLastError();
    if (le != hipSuccess) fprintf(stderr, "kernel_launch: launch failed: %s\n", hipGetErrorName(le));
}
```
